# Optimizing an MI355X kernel written in HIP

```python
import math, functools
import jax, jax.numpy as jnp
from jax import lax
import numpy as np

D_MODEL = 2048
BATCH = 2
SEQ = 4096
DEPTH = 4
DEC_BATCH = 8
DEC_SEQ = 8
PAST_LEN = 16384
PAGE_SIZE = 128

N_HEADS = 8
N_KV_HEADS = 2
HEAD_DIM = 128
D_ATTN = N_HEADS * HEAD_DIM
KV_W = N_KV_HEADS * HEAD_DIM
N_IDX_HEADS = 8
IDX_DIM = 64
IDX_SCALE = (N_IDX_HEADS * IDX_DIM) ** -0.5
TOPK_MAX = 256
Q_BLOCK = 128
SSD_HEADS = 16
SSD_HEAD_DIM = 64
D_SSD = SSD_HEADS * SSD_HEAD_DIM
SSD_GROUPS = 2
SSD_STATE = 128
CONV_W = 4
CONV_DIM = D_SSD + 2 * SSD_GROUPS * SSD_STATE
SSD_CHUNK = 128
DT_MIN = 0.001
DT_MAX = 0.1
POOL_WINDOWS = (2, 4, 8, 16)
POOL_W = D_MODEL // 2
POOL_GW = POOL_W // len(POOL_WINDOWS)
POOL_STATE = max(POOL_WINDOWS) - 1
SGU_W = D_MODEL // 2
SGU_GROUPS = 4
SGU_GW = SGU_W // SGU_GROUPS
SGU_CHUNK = 128
D_FF = 4 * D_MODEL
N_AB = (DEPTH + 1) // 2
N_CD = DEPTH // 2
ALPHA = (2 * DEPTH) ** 0.25
BETA = (8 * DEPTH) ** -0.25
EPS = 1e-5
AB_SIZES = (D_ATTN, KV_W, KV_W, N_IDX_HEADS * IDX_DIM, IDX_DIM, N_IDX_HEADS, D_SSD, CONV_DIM, SSD_HEADS)
D_IN_AB = sum(AB_SIZES)
D_IN_CD = POOL_W + 2 * SGU_W

kernel_name = 'hybrid_dsa_ssd_pool_sgu_decode_step'


def layer_norm(x, g, b):
    xf = x.astype(jnp.float32)
    mu = jnp.mean(xf, -1, keepdims=True)
    var = jnp.mean(jnp.square(xf - mu), -1, keepdims=True)
    return ((xf - mu) * lax.rsqrt(var + EPS) * g + b).astype(x.dtype)


def rms_norm(x, g):
    xf = x.astype(jnp.float32)
    return xf * lax.rsqrt(jnp.mean(jnp.square(xf), -1, keepdims=True) + EPS) * g


def sqrelu_mlp(x, w1, w2):
    return jnp.square(jax.nn.relu(x @ w1)) @ w2


def dsa_attend(q, qi, wi, qpos, k_idx, gather_kv, topk):
    b, T = q.shape[:2]
    L = k_idx.shape[1]
    dots = jnp.einsum('bthd,bsd->bths', qi, k_idx).astype(jnp.float32)
    score = jnp.einsum('bth,bths->bts', wi.astype(jnp.float32), jax.nn.relu(dots)) * IDX_SCALE
    key_pos = jnp.arange(L, dtype=jnp.int32)
    score = jnp.where(key_pos[None, None, :] <= qpos[None, :, None], score, -jnp.inf)
    _, sel = lax.top_k(score, topk)
    valid = sel <= qpos[None, :, None]
    ks, vs = gather_kv(sel)
    qg = q.reshape(b, T, N_KV_HEADS, N_HEADS // N_KV_HEADS, HEAD_DIM)
    logits = jnp.einsum('btgrd,btkgd->btgrk', qg, ks).astype(jnp.float32) * HEAD_DIM ** -0.5
    logits = jnp.where(valid[:, :, None, None, :], logits, -jnp.inf)
    p = jax.nn.softmax(logits, axis=-1).astype(vs.dtype)
    o = jnp.einsum('btgrk,btkgd->btgrd', p, vs)
    return o.reshape(b, T, D_ATTN)


def prompt_attend(q, k, v, qi, ki, wi):
    b, n = q.shape[:2]
    topk = min(TOPK_MAX, n // 4)
    blk = math.gcd(n, Q_BLOCK)
    nb = n // blk
    bidx = jnp.arange(b)[:, None, None]

    def gather(sel):
        return k[bidx, sel], v[bidx, sel]

    def to_blocks(a):
        return a.reshape(b, nb, blk, *a.shape[2:]).swapaxes(0, 1)

    pos = jnp.arange(n, dtype=jnp.int32).reshape(nb, blk)

    def one_block(args):
        qb, qib, wib, pb = args
        return dsa_attend(qb, qib, wib, pb, ki, gather, topk)

    o = lax.map(one_block, (to_blocks(q), to_blocks(qi), to_blocks(wi), pos))
    return o.swapaxes(0, 1).reshape(b, n, D_ATTN)


def sample_attend(cache_k_l, cache_v_l, cache_ki_l, page_table, q, k, v, qi, ki, wi):
    b, n = q.shape[:2]
    past = page_table.shape[1] * PAGE_SIZE
    topk = min(TOPK_MAX, (past + n) // 4)
    ki_past = cache_ki_l[page_table].reshape(b, past, IDX_DIM)
    ki_all = jnp.concatenate([ki_past, ki.astype(ki_past.dtype)], axis=1)
    bidx = jnp.arange(b)[:, None, None]

    def gather(sel):
        in_past = (sel < past)[..., None, None]
        ps = jnp.minimum(sel, past - 1)
        phys = page_table[bidx, ps // PAGE_SIZE]
        off = ps % PAGE_SIZE
        ns = jnp.clip(sel - past, 0, n - 1)
        kk = jnp.where(in_past, cache_k_l[phys, off], k[bidx, ns])
        vv = jnp.where(in_past, cache_v_l[phys, off], v[bidx, ns])
        return kk, vv

    qpos = past + jnp.arange(n, dtype=jnp.int32)
    return dsa_attend(q, qi, wi, qpos, ki_all, gather, topk)


def causal_dwconv(x_ext, w, bias, n):
    out = bias
    for j in range(CONV_W):
        out = out + w[j] * x_ext[:, j:j + n]
    return out


def ssd_scan(x, dt, a, bm, cm, h0):
    b, n = x.shape[:2]
    R = SSD_HEADS // SSD_GROUPS
    q = math.gcd(n, SSD_CHUNK)
    nc = n // q
    f32 = jnp.float32
    xc = x.astype(f32).reshape(b, nc, q, SSD_GROUPS, R, SSD_HEAD_DIM)
    dtc = dt.reshape(b, nc, q, SSD_GROUPS, R)
    bc = bm.astype(f32).reshape(b, nc, q, SSD_GROUPS, SSD_STATE)
    cc = cm.astype(f32).reshape(b, nc, q, SSD_GROUPS, SSD_STATE)
    acum = jnp.cumsum(dtc * a.reshape(SSD_GROUPS, R), axis=2)
    causal = jnp.tril(jnp.ones((q, q), bool))
    seg = acum[:, :, :, None] - acum[:, :, None]
    decay_ts = jnp.exp(jnp.where(causal[:, :, None, None], seg, -jnp.inf))
    cb = jnp.einsum('bctgn,bcsgn->bctsg', cc, bc)
    y_diag = jnp.einsum('bctsgr,bcsgrp->bctgrp', cb[..., None] * decay_ts * dtc[:, :, None], xc)
    decay_end = jnp.exp(acum[:, :, -1:] - acum)
    chunk_states = jnp.einsum('bcsgn,bcsgr,bcsgrp->bcgrpn', bc, decay_end * dtc, xc)
    chunk_decay = jnp.exp(acum[:, :, -1])

    def step(h, inp):
        st, dec = inp
        return h * dec[..., None, None] + st, h

    h_init = h0.astype(f32).reshape(b, SSD_GROUPS, R, SSD_HEAD_DIM, SSD_STATE)
    h_last, h_in = lax.scan(step, h_init, (jnp.moveaxis(chunk_states, 1, 0), jnp.moveaxis(chunk_decay, 1, 0)))
    h_in = jnp.moveaxis(h_in, 0, 1)
    y_off = jnp.einsum('bctgn,bcgrpn->bctgrp', cc, h_in) * jnp.exp(acum)[..., None]
    y = (y_diag + y_off).reshape(b, n, SSD_HEADS, SSD_HEAD_DIM)
    return y, h_last.reshape(b, SSD_HEADS, SSD_HEAD_DIM, SSD_STATE)


def ssd_branch(z, xbc_ext, dt_raw, h0, conv_w, conv_b, dt_bias, a_log, d_skip, ssd_g):
    b, n, _ = z.shape
    xbc = jax.nn.silu(causal_dwconv(xbc_ext, conv_w, conv_b, n))
    xs, bm, cm = jnp.split(xbc, [D_SSD, D_SSD + SSD_GROUPS * SSD_STATE], axis=-1)
    dt = jax.nn.softplus(dt_raw.astype(jnp.float32) + dt_bias.astype(jnp.float32))
    a = -jnp.exp(a_log.astype(jnp.float32))
    xh = xs.reshape(b, n, SSD_HEADS, SSD_HEAD_DIM)
    y, h_last = ssd_scan(xh, dt, a,
                         bm.reshape(b, n, SSD_GROUPS, SSD_STATE),
                         cm.reshape(b, n, SSD_GROUPS, SSD_STATE), h0)
    y = y + d_skip.astype(jnp.float32)[:, None] * xh.astype(jnp.float32)
    y = y.reshape(b, n, D_SSD) * jax.nn.silu(z.astype(jnp.float32))
    y = rms_norm(y, ssd_g).astype(z.dtype)
    return y, h_last.astype(h0.dtype), xbc_ext[:, -(CONV_W - 1):]


def ab_mixer(x, conv_prefix, h0, attend, w_in, conv_w, conv_b, dt_bias, a_log, d_skip, ssd_g, w_out):
    b, n, _ = x.shape
    h = x @ w_in
    q, k, v, qi, ki, wi, z, xbc, dt_raw = jnp.split(h, np.cumsum(AB_SIZES)[:-1].tolist(), axis=-1)
    q = q.reshape(b, n, N_HEADS, HEAD_DIM)
    k = k.reshape(b, n, N_KV_HEADS, HEAD_DIM)
    v = v.reshape(b, n, N_KV_HEADS, HEAD_DIM)
    qi = qi.reshape(b, n, N_IDX_HEADS, IDX_DIM)
    attn = attend(q, k, v, qi, ki, wi)
    xbc_ext = jnp.concatenate([conv_prefix.astype(xbc.dtype), xbc], axis=1)
    y_ssd, h_last, conv_new = ssd_branch(z, xbc_ext, dt_raw, h0, conv_w, conv_b, dt_bias, a_log, d_skip, ssd_g)
    out = jnp.concatenate([attn, y_ssd], axis=-1) @ w_out
    return out, k, v, ki, h_last, conv_new


def pool_mix(p_ext, n, pool_w, pool_scale):
    b, le, _ = p_ext.shape
    pg = p_ext.reshape(b, le, len(POOL_WINDOWS), POOL_GW)
    cs = jnp.cumsum(pg.astype(jnp.float32), axis=1)
    cs = jnp.concatenate([jnp.zeros_like(cs[:, :1]), cs], axis=1)
    end = jnp.arange(le - n + 1, le + 1)
    means = []
    for j, w in enumerate(POOL_WINDOWS):
        start = jnp.maximum(end - w, 0)
        cnt = jnp.minimum(end, w).astype(jnp.float32)
        means.append((cs[:, end, j] - cs[:, start, j]) / cnt[None, :, None])
    mean = jnp.stack(means, axis=2)
    d = (mean - pg[:, le - n:].astype(jnp.float32)).astype(p_ext.dtype)
    out = jnp.einsum('bngc,gcd->bngd', d, pool_w).reshape(b, n, POOL_W)
    return out * pool_scale


def sgu_mix(u, v, w_s, b_s):
    b, n, _ = u.shape
    L = -(-n // SGU_CHUNK) * SGU_CHUNK
    vp = jnp.pad(v, ((0, 0), (0, L - n), (0, 0))).reshape(b, L // SGU_CHUNK, SGU_CHUNK, SGU_GROUPS, SGU_GW)
    wm = w_s * jnp.tril(jnp.ones((SGU_CHUNK, SGU_CHUNK), w_s.dtype))
    s = jnp.einsum('gts,bcsgd->bctgd', wm, vp) + b_s.T[None, None, :, :, None]
    s = s.reshape(b, L, SGU_W)[:, :n]
    return u * s


def cd_mixer(x, pool_prefix, w_in, pool_w, pool_scale, sgu_ln_g, sgu_ln_b, sgu_w, sgu_b, w_out):
    n = x.shape[1]
    h = x @ w_in
    p, uv = h[..., :POOL_W], h[..., POOL_W:]
    p_ext = p if pool_prefix is None else jnp.concatenate([pool_prefix.astype(p.dtype), p], axis=1)
    pooled = pool_mix(p_ext, n, pool_w, pool_scale)
    uv = jax.nn.gelu(uv, approximate=False)
    u, v = uv[..., :SGU_W], uv[..., SGU_W:]
    v = layer_norm(v, sgu_ln_g, sgu_ln_b)
    s = sgu_mix(u, v, sgu_w, sgu_b)
    out = jnp.concatenate([pooled, s], axis=-1) @ w_out
    return out, p_ext[:, -POOL_STATE:], v


def setup_inputs(seed: int = 0) -> dict:
    key = jax.random.key(seed)
    keys = jax.random.split(key, 48)
    counter = [0]

    def nxt():
        k = keys[counter[0]]
        counter[0] += 1
        return k

    def nrm(shape, scale=1.0):
        return scale * jax.random.normal(nxt(), shape, jnp.float32)

    n_pages = PAST_LEN // PAGE_SIZE
    n_used = DEC_BATCH * n_pages
    n_pool = (5 * n_used + 3) // 4
    page_table = jax.random.permutation(nxt(), n_pool)[:n_used].reshape(DEC_BATCH, n_pages).astype(jnp.int32)

    u = jax.random.uniform(nxt(), (N_AB, SSD_HEADS), jnp.float32)
    dt0 = jnp.exp(u * (math.log(DT_MAX) - math.log(DT_MIN)) + math.log(DT_MIN))
    dt_bias = dt0 + jnp.log(-jnp.expm1(-dt0))
    a_log = jnp.log(jax.random.uniform(nxt(), (N_AB, SSD_HEADS), jnp.float32, 1.0, 16.0))

    return {
        'x_prompt': nrm((BATCH, SEQ, D_MODEL)),
        'x_sample': nrm((DEC_BATCH, DEC_SEQ, D_MODEL)),
        'cache_k': nrm((N_AB, n_pool, PAGE_SIZE, N_KV_HEADS, HEAD_DIM)),
        'cache_v': nrm((N_AB, n_pool, PAGE_SIZE, N_KV_HEADS, HEAD_DIM)),
        'cache_idx_k': nrm((N_AB, n_pool, PAGE_SIZE, IDX_DIM)),
        'state_ssm': nrm((N_AB, DEC_BATCH, SSD_HEADS, SSD_HEAD_DIM, SSD_STATE), 0.3),
        'state_conv': nrm((N_AB, DEC_BATCH, CONV_W - 1, CONV_DIM)),
        'state_pool': nrm((N_CD, DEC_BATCH, POOL_STATE, POOL_W)),
        'page_table': page_table,
        'ln1_g': 1.0 + nrm((DEPTH, D_MODEL), 0.02),
        'ln1_b': nrm((DEPTH, D_MODEL), 0.02),
        'ln2_g': 1.0 + nrm((DEPTH, D_MODEL), 0.02),
        'ln2_b': nrm((DEPTH, D_MODEL), 0.02),
        'w_in_ab': nrm((N_AB, D_MODEL, D_IN_AB), D_MODEL ** -0.5),
        'conv_w': nrm((N_AB, CONV_W, CONV_DIM), CONV_W ** -0.5),
        'conv_b': nrm((N_AB, CONV_DIM), 0.02),
        'dt_bias': dt_bias,
        'a_log': a_log,
        'd_skip': 1.0 + nrm((N_AB, SSD_HEADS), 0.1),
        'ssd_norm_g': 1.0 + nrm((N_AB, D_SSD), 0.02),
        'w_out_ab': nrm((N_AB, D_ATTN + D_SSD, D_MODEL), BETA * (D_ATTN + D_SSD) ** -0.5),
        'w_in_cd': nrm((N_CD, D_MODEL, D_IN_CD), D_MODEL ** -0.5),
        'pool_w': nrm((N_CD, len(POOL_WINDOWS), POOL_GW, POOL_GW), POOL_GW ** -0.5),
        'pool_scale': 1.0 + nrm((N_CD, POOL_W), 0.02),
        'sgu_ln_g': 1.0 + nrm((N_CD, SGU_W), 0.02),
        'sgu_ln_b': nrm((N_CD, SGU_W), 0.02),
        'sgu_w': nrm((N_CD, SGU_GROUPS, SGU_CHUNK, SGU_CHUNK), SGU_CHUNK ** -0.5),
        'sgu_b': 1.0 + nrm((N_CD, SGU_GROUPS, SGU_CHUNK), 0.02),
        'w_out_cd': nrm((N_CD, POOL_W + SGU_W, D_MODEL), BETA * (POOL_W + SGU_W) ** -0.5),
        'w_ff1': nrm((DEPTH, D_MODEL, D_FF), D_MODEL ** -0.5),
        'w_ff2': nrm((DEPTH, D_FF, D_MODEL), BETA * D_FF ** -0.5),
    }


def reference(x_prompt, x_sample, cache_k, cache_v, cache_idx_k, state_ssm, state_conv, state_pool, page_table,
              ln1_g, ln1_b, ln2_g, ln2_b, w_in_ab, conv_w, conv_b, dt_bias, a_log, d_skip, ssd_norm_g, w_out_ab,
              w_in_cd, pool_w, pool_scale, sgu_ln_g, sgu_ln_b, sgu_w, sgu_b, w_out_cd, w_ff1, w_ff2):
    yp, ys = x_prompt, x_sample
    kp_l, vp_l, ip_l, hp_l, cp_l, pp_l = [], [], [], [], [], []
    ks_l, vs_l, is_l, hs_l, cs_l, ps_l, gs_l = [], [], [], [], [], [], []
    for i in range(DEPTH):
        j = i // 2
        if i % 2 == 0:
            ab_w = (w_in_ab[j], conv_w[j], conv_b[j], dt_bias[j], a_log[j], d_skip[j], ssd_norm_g[j], w_out_ab[j])
            bp = yp.shape[0]
            conv0 = jnp.zeros((bp, CONV_W - 1, CONV_DIM), yp.dtype)
            h00 = jnp.zeros((bp, SSD_HEADS, SSD_HEAD_DIM, SSD_STATE), state_ssm.dtype)
            mp, kp, vp, ip, hp, cp = ab_mixer(yp, conv0, h00, prompt_attend, *ab_w)
            att_s = functools.partial(sample_attend, cache_k[j], cache_v[j], cache_idx_k[j], page_table)
            ms, ks_, vs_, is_, hs, cs = ab_mixer(ys, state_conv[j], state_ssm[j], att_s, *ab_w)
            kp_l.append(kp); vp_l.append(vp); ip_l.append(ip); hp_l.append(hp); cp_l.append(cp)
            ks_l.append(ks_); vs_l.append(vs_); is_l.append(is_); hs_l.append(hs); cs_l.append(cs)
        else:
            cd_w = (w_in_cd[j], pool_w[j], pool_scale[j], sgu_ln_g[j], sgu_ln_b[j], sgu_w[j], sgu_b[j], w_out_cd[j])
            mp, pp, _ = cd_mixer(yp, None, *cd_w)
            ms, ps, gs = cd_mixer(ys, state_pool[j], *cd_w)
            pp_l.append(pp); ps_l.append(ps); gs_l.append(gs)
        yp = layer_norm(ALPHA * yp + mp, ln1_g[i], ln1_b[i])
        ys = layer_norm(ALPHA * ys + ms, ln1_g[i], ln1_b[i])
        yp = layer_norm(ALPHA * yp + sqrelu_mlp(yp, w_ff1[i], w_ff2[i]), ln2_g[i], ln2_b[i])
        ys = layer_norm(ALPHA * ys + sqrelu_mlp(ys, w_ff1[i], w_ff2[i]), ln2_g[i], ln2_b[i])
    k_prompt = jnp.stack(kp_l)
    v_prompt = jnp.stack(vp_l)
    idx_k_prompt = jnp.stack(ip_l)
    ssm_prompt = jnp.stack(hp_l)
    conv_prompt = jnp.stack(cp_l)
    pool_prompt = jnp.stack(pp_l)
    k_sample = jnp.stack(ks_l)
    v_sample = jnp.stack(vs_l)
    idx_k_sample = jnp.stack(is_l)
    ssm_sample = jnp.stack(hs_l)
    conv_sample = jnp.stack(cs_l)
    pool_sample = jnp.stack(ps_l)
    sgu_v_sample = jnp.stack(gs_l)
    return (yp, ys, k_prompt, v_prompt, idx_k_prompt, ssm_prompt, conv_prompt, pool_prompt,
            k_sample, v_sample, idx_k_sample, ssm_sample, conv_sample, pool_sample, sgu_v_sample)
```

```cpp
#include <hip/hip_runtime.h>
#include <stdint.h>
#include <stdio.h>

typedef unsigned short bf16;
typedef float f32x4 __attribute__((ext_vector_type(4)));
typedef unsigned u32x4 __attribute__((ext_vector_type(4)));
#define DEVI __device__ __forceinline__

constexpr int DM = 2048, SEQ = 4096, NBP = 2, MPR = NBP * SEQ;
constexpr int DB = 8, DS = 8, MSR = DB * DS;
constexpr int MR = MPR + MSR;
constexpr int MP = 8448;
constexpr int PAST = 16384, PAGE = 128, NPAGES = PAST / PAGE, NPOOL = 1280;
constexpr int NKEY_S = PAST + DS;
constexpr int SCS_LD = 16400;
constexpr int HC_AB = 4864, HC_CD = 3072, DFF = 8192;
constexpr int TOPK = 256;
constexpr int C_Q = 0, C_K = 1024, C_V = 1280, C_QI = 1536, C_Z = 2048, C_XBC = 3072, C_KI = 4608, C_WI = 4672, C_DT = 4680;
constexpr float ALPHA = 1.681792830507429f;
constexpr float EPS = 1e-5f;
constexpr float IDX_SCALE = 0.04419417382415922f;
constexpr float ATT_SCALE = 0.08838834764831845f;

constexpr size_t O_YP = 0;
constexpr size_t O_YS = O_YP + (size_t)MPR * DM;
constexpr size_t O_KP = O_YS + (size_t)MSR * DM;
constexpr size_t O_VP = O_KP + (size_t)2 * MPR * 256;
constexpr size_t O_IP = O_VP + (size_t)2 * MPR * 256;
constexpr size_t O_HP = O_IP + (size_t)2 * MPR * 64;
constexpr size_t O_CP = O_HP + (size_t)2 * NBP * 16 * 64 * 128;
constexpr size_t O_PP = O_CP + (size_t)2 * NBP * 3 * 1536;
constexpr size_t O_KS = O_PP + (size_t)2 * NBP * 15 * 1024;
constexpr size_t O_VS = O_KS + (size_t)2 * MSR * 256;
constexpr size_t O_IS = O_VS + (size_t)2 * MSR * 256;
constexpr size_t O_HS = O_IS + (size_t)2 * MSR * 64;
constexpr size_t O_CS = O_HS + (size_t)2 * DB * 16 * 64 * 128;
constexpr size_t O_PS = O_CS + (size_t)2 * DB * 3 * 1536;
constexpr size_t O_GS = O_PS + (size_t)2 * DB * 15 * 1024;
constexpr size_t O_END = O_GS + (size_t)2 * MSR * 1024;
static_assert(O_END == 29571072, "output size");

constexpr size_t al256(size_t x) { return (x + 255) & ~(size_t)255; }
constexpr size_t WS_CTL = 0;
constexpr size_t WS_X = 1u << 20;
constexpr size_t WS_XB = WS_X + al256((size_t)MP * DM * 4);
constexpr size_t WS_H = WS_XB + al256((size_t)MP * DM * 2);
constexpr size_t WS_AO = WS_H + al256((size_t)MP * HC_AB * 4);
constexpr size_t WS_HF = WS_AO + al256((size_t)MP * DM * 2);
constexpr size_t WS_SC = WS_HF + al256((size_t)MP * DFF * 2);
constexpr size_t WS_MASK = WS_SC + al256((size_t)MPR * SEQ * 4);
constexpr size_t WS_XC = WS_MASK + al256((size_t)MPR * 64 * 8);
constexpr size_t WS_DT = WS_XC + al256((size_t)MP * 1536 * 4);
constexpr size_t WS_Y = WS_DT + al256((size_t)MP * 16 * 4);
constexpr size_t WS_SCS = WS_Y + al256((size_t)MP * 1024 * 4);
constexpr size_t WS_SELS = WS_SCS + al256((size_t)MSR * SCS_LD * 4);
constexpr size_t WS_DD = WS_SELS + al256((size_t)MSR * TOPK * 4);
constexpr size_t WS_U = WS_DD + al256((size_t)MP * 1024 * 2);
constexpr size_t WS_VLN = WS_U + al256((size_t)MP * 1024 * 2);
constexpr size_t WS_WINAB = WS_VLN + al256((size_t)MP * 1024 * 2);
constexpr size_t WS_WOUTAB = WS_WINAB + (size_t)2 * HC_AB * DM * 2;
constexpr size_t WS_WINCD = WS_WOUTAB + (size_t)2 * DM * DM * 2;
constexpr size_t WS_WOUTCD = WS_WINCD + (size_t)2 * HC_CD * DM * 2;
constexpr size_t WS_WFF1 = WS_WOUTCD + (size_t)2 * DM * DM * 2;
constexpr size_t WS_WFF2 = WS_WFF1 + (size_t)4 * DFF * DM * 2;
constexpr size_t WS_POOLW = WS_WFF2 + (size_t)4 * DFF * DM * 2;
constexpr size_t WS_SGUW = WS_POOLW + (size_t)2 * 4 * 256 * 256 * 2;
constexpr size_t WS_END = WS_SGUW + (size_t)2 * 4 * 128 * 128 * 2;

struct P {
    const float *x_prompt, *x_sample, *cache_k, *cache_v, *cache_ik, *state_ssm, *state_conv, *state_pool;
    const int* page_table;
    const float *ln1_g, *ln1_b, *ln2_g, *ln2_b, *w_in_ab, *conv_w, *conv_b, *dt_bias, *a_log, *d_skip, *ssd_g, *w_out_ab;
    const float *w_in_cd, *pool_w, *pool_scale, *sgu_ln_g, *sgu_ln_b, *sgu_w, *sgu_b, *w_out_cd, *w_ff1, *w_ff2;
    float* out;
    unsigned char* ws;
    const float *lng, *lnb;
    int j, fin, a2, a3;
};
DEVI float* wsf(const P& p, size_t off) { return (float*)(p.ws + off); }
DEVI bf16* wsb(const P& p, size_t off) { return (bf16*)(p.ws + off); }

DEVI float bf2f(bf16 b) { return __uint_as_float(((unsigned)b) << 16); }
DEVI bf16 f2bf(float f) { unsigned u = __float_as_uint(f); u += 0x7fffu + ((u >> 16) & 1u); return (bf16)(u >> 16); }
DEVI unsigned pk2(float lo, float hi) { return (unsigned)f2bf(lo) | ((unsigned)f2bf(hi) << 16); }
DEVI float wave_sum(float v) {
#pragma unroll
    for (int o = 1; o < 64; o <<= 1) v += __shfl_xor(v, o);
    return v;
}
DEVI float silu_f(float x) { return x / (1.f + __expf(-x)); }
DEVI float softplus_f(float x) { return fmaxf(x, 0.f) + log1pf(__expf(-fabsf(x))); }
DEVI float gelu_f(float x) { return 0.5f * x * (1.f + erff(x * 0.70710678118654752f)); }
DEVI unsigned ord_f(float f) { f = f + 0.0f; unsigned u = __float_as_uint(f); return (u & 0x80000000u) ? ~u : (u | 0x80000000u); }
__host__ __device__ inline int ab_dst_col(int n) {
    if (n < 2048) return n;
    if (n < 2112) return C_KI + (n - 2048);
    if (n < 2120) return C_WI + (n - 2112);
    if (n < 3144) return C_Z + (n - 2120);
    if (n < 4680) return C_XBC + (n - 3144);
    return n;
}

DEVI void transpose_unit(const float* W, int K, int N, bf16* WT, int abmap, int unit, float* t  ) {
    const int nbn = (N + 63) / 64, kb = unit / nbn, nb = unit % nbn, k0 = kb * 64, n0 = nb * 64, tid = threadIdx.x;
#pragma unroll
    for (int i = 0; i < 8; ++i) { const int kk = (tid >> 6) + 8 * i, n = n0 + (tid & 63); t[kk * 65 + (tid & 63)] = (n < N) ? W[(size_t)(k0 + kk) * N + n] : 0.f; }
    __syncthreads();
    { const int n = n0 + (tid >> 3), kq = (tid & 7) * 8;
      if (n < N) { const int row = abmap ? ab_dst_col(n) : n; const float* s = t + kq * 65 + (tid >> 3);
          u32x4 o; o.x = pk2(s[0], s[65]); o.y = pk2(s[2 * 65], s[3 * 65]); o.z = pk2(s[4 * 65], s[5 * 65]); o.w = pk2(s[6 * 65], s[7 * 65]);
          *(u32x4*)(WT + (size_t)row * K + k0 + kq) = o; } }
    __syncthreads();
}
struct TJob { const float* W; bf16* WT; int K, N, abmap, units; };
__global__ __launch_bounds__(512) void k_transpose(TJob j) {
    __shared__ float t[64 * 65];
    for (int u = blockIdx.x; u < j.units; u += gridDim.x) transpose_unit(j.W, j.K, j.N, j.WT, j.abmap, u, t);
}
__global__ __launch_bounds__(512) void k_prologue_misc(P p) {
    const int gt = blockIdx.x * 512 + threadIdx.x, ng = gridDim.x * 512;
    bf16* sw = wsb(p, WS_SGUW);
    for (int i = gt; i < 2 * 4 * 128 * 128; i += ng) { const int s = i & 127, t = (i >> 7) & 127; sw[i] = f2bf(s <= t ? p.sgu_w[i] : 0.f); }
    float* X = wsf(p, WS_X); bf16* XB = wsb(p, WS_XB);
    for (size_t i = gt; i < (size_t)MP * DM / 4; i += ng) {
        const size_t e = i * 4; const int row = (int)(e / DM);
        f32x4 v = (f32x4){0.f, 0.f, 0.f, 0.f};
        if (row < MPR) v = *(const f32x4*)(p.x_prompt + e); else if (row < MR) v = *(const f32x4*)(p.x_sample + (e - (size_t)MPR * DM));
        *(f32x4*)(X + e) = v; uint2 o; o.x = pk2(v.x, v.y); o.y = pk2(v.z, v.w); *(uint2*)(XB + e) = o;
    }
}

enum { EPI_F32 = 0, EPI_RESID = 1, EPI_RELU2 = 2, EPI_POOL = 3 };
struct GE { const bf16* A; const bf16* Bt; float* C; bf16* O; const float* scale; int lda, ldb, K, ldc, ldo, pad; };
template <int EPI> __global__ __launch_bounds__(256) void k_gemm_naive(GE e) {
    const bf16* A = e.A; const bf16* Bt = e.Bt; const int lda = e.lda, ldb = e.ldb, K = e.K;
    __shared__ float As[32][68], Bs[32][68];
    const int tid = threadIdx.x, tx = tid & 15, ty = tid >> 4, m0 = blockIdx.y * 64, n0 = blockIdx.x * 64;
    float acc[4][4] = {};
    const int lr = tid >> 2, lk = (tid & 3) * 8;
    for (int k0 = 0; k0 < K; k0 += 32) {
        const u32x4 av = *(const u32x4*)(A + (size_t)(m0 + lr) * lda + k0 + lk), bv = *(const u32x4*)(Bt + (size_t)(n0 + lr) * ldb + k0 + lk);
        const unsigned aw[4] = {av.x, av.y, av.z, av.w}, bw[4] = {bv.x, bv.y, bv.z, bv.w};
#pragma unroll
        for (int i = 0; i < 4; ++i) { As[lk + 2 * i][lr] = __uint_as_float(aw[i] << 16); As[lk + 2 * i + 1][lr] = __uint_as_float(aw[i] & 0xffff0000u);
                                      Bs[lk + 2 * i][lr] = __uint_as_float(bw[i] << 16); Bs[lk + 2 * i + 1][lr] = __uint_as_float(bw[i] & 0xffff0000u); }
        __syncthreads();
#pragma unroll 8
        for (int kk = 0; kk < 32; ++kk) { const f32x4 a = *(const f32x4*)&As[kk][ty * 4], b = *(const f32x4*)&Bs[kk][tx * 4];
#pragma unroll
            for (int i = 0; i < 4; ++i)
#pragma unroll
                for (int j = 0; j < 4; ++j) acc[i][j] += a[i] * b[j]; }
        __syncthreads();
    }
#pragma unroll
    for (int i = 0; i < 4; ++i)
#pragma unroll
        for (int j = 0; j < 4; ++j) { const int r = m0 + ty * 4 + i, c = n0 + tx * 4 + j; const float v = acc[i][j];
            if (EPI == EPI_F32) e.C[(size_t)r * e.ldc + c] = v;
            if (EPI == EPI_RESID) { float* q = e.C + (size_t)r * e.ldc + c; *q = ALPHA * (*q) + v; }
            if (EPI == EPI_RELU2) { const float w = fmaxf(v, 0.f); e.O[(size_t)r * e.ldo + c] = f2bf(w * w); }
            if (EPI == EPI_POOL) e.O[(size_t)r * e.ldo + c] = f2bf(v * e.scale[c]); }
}

DEVI void ph_ln(const P& p, const float* g, const float* b, int final_out, int vb, int nvb) {
    float* X = wsf(p, WS_X); bf16* XB = wsb(p, WS_XB);
    const int lane = threadIdx.x & 63, wv = threadIdx.x >> 6;
    for (int row = vb * 8 + wv; row < MR; row += nvb * 8) {
        float* xr = X + (size_t)row * DM; f32x4 v[8]; float s = 0.f;
#pragma unroll
        for (int i = 0; i < 8; ++i) { v[i] = *(const f32x4*)(xr + (i * 64 + lane) * 4); s += (v[i].x + v[i].y) + (v[i].z + v[i].w); }
        const float mean = wave_sum(s) * (1.f / DM); float q = 0.f;
#pragma unroll
        for (int i = 0; i < 8; ++i) { v[i] = v[i] - mean; q += (v[i].x * v[i].x + v[i].y * v[i].y) + (v[i].z * v[i].z + v[i].w * v[i].w); }
        const float rstd = 1.f / sqrtf(wave_sum(q) * (1.f / DM) + EPS);
        float* o = final_out ? (row < MPR ? p.out + O_YP + (size_t)row * DM : p.out + O_YS + (size_t)(row - MPR) * DM) : nullptr;
#pragma unroll
        for (int i = 0; i < 8; ++i) { const int c = (i * 64 + lane) * 4; const f32x4 gg = *(const f32x4*)(g + c), bb = *(const f32x4*)(b + c);
            const f32x4 y = v[i] * rstd * gg + bb; *(f32x4*)(xr + c) = y; uint2 w; w.x = pk2(y.x, y.y); w.y = pk2(y.z, y.w); *(uint2*)(XB + (size_t)row * DM + c) = w;
            if (final_out) *(f32x4*)(o + c) = y; }
    }
}
__global__ __launch_bounds__(512) void k_ln(P p) { ph_ln(p, p.lng, p.lnb, p.fin, blockIdx.x, gridDim.x); }

DEVI void ph_ab_copy(const P& p, int j, int vb, int nvb) {
    const float* H = wsf(p, WS_H); const int tid = threadIdx.x;
    for (int row = vb; row < MR; row += nvb) {
        const float* h = H + (size_t)row * HC_AB;
        float *ko, *vo, *io;
        if (row < MPR) { ko = p.out + O_KP + ((size_t)j * MPR + row) * 256; vo = p.out + O_VP + ((size_t)j * MPR + row) * 256; io = p.out + O_IP + ((size_t)j * MPR + row) * 64; }
        else { const int sr = row - MPR; ko = p.out + O_KS + ((size_t)j * MSR + sr) * 256; vo = p.out + O_VS + ((size_t)j * MSR + sr) * 256; io = p.out + O_IS + ((size_t)j * MSR + sr) * 64; }
        if (tid < 256) ko[tid] = h[C_K + tid]; else vo[tid - 256] = h[C_V + tid - 256];
        if (tid < 64) io[tid] = h[C_KI + tid];
        int ci = -1; float* co = nullptr;
        if (row < MPR) { const int b = row / SEQ, t = row % SEQ; if (t >= SEQ - 3) { ci = t - (SEQ - 3); co = p.out + O_CP + (((size_t)j * NBP + b) * 3 + ci) * 1536; } }
        else { const int b = (row - MPR) / DS, t = (row - MPR) % DS; if (t >= DS - 3) { ci = t - (DS - 3); co = p.out + O_CS + (((size_t)j * DB + b) * 3 + ci) * 1536; } }
        if (ci >= 0) for (int c = tid; c < 1536; c += 512) co[c] = h[C_XBC + c];
    }
}
__global__ __launch_bounds__(512) void k_ab_copy(P p) { ph_ab_copy(p, p.j, blockIdx.x, gridDim.x); }

DEVI void ph_conv(const P& p, int j, int vb, int nvb) {
    const float* H = wsf(p, WS_H); float* XC = wsf(p, WS_XC); float* DT = wsf(p, WS_DT);
    const float* cw = p.conv_w + (size_t)j * 4 * 1536; const float* cb = p.conv_b + (size_t)j * 1536;
    for (int row = vb; row < MR; row += nvb) {
        const bool pr = row < MPR; const int b = pr ? row / SEQ : (row - MPR) / DS, t = pr ? row % SEQ : (row - MPR) % DS;
        for (int c = threadIdx.x; c < 1536; c += 512) {
            float acc = cb[c];
#pragma unroll
            for (int jj = 0; jj < 4; ++jj) { const int tt = t - 3 + jj; float xv;
                if (tt >= 0) xv = H[(size_t)(row - t + tt) * HC_AB + C_XBC + c];
                else xv = pr ? 0.f : p.state_conv[(((size_t)j * DB + b) * 3 + (3 + tt)) * 1536 + c];
                acc += cw[jj * 1536 + c] * xv; }
            XC[(size_t)row * 1536 + c] = silu_f(acc);
        }
        if (threadIdx.x < 16) DT[row * 16 + threadIdx.x] = softplus_f(H[(size_t)row * HC_AB + C_DT + threadIdx.x] + p.dt_bias[j * 16 + threadIdx.x]);
    }
}
__global__ __launch_bounds__(512) void k_conv(P p) { ph_conv(p, p.j, blockIdx.x, gridDim.x); }

DEVI void ssd_seq_unit(const P& p, int j, int sq  , int h, int lane) {
    const float* XC = wsf(p, WS_XC); const float* DT = wsf(p, WS_DT); float* Y = wsf(p, WS_Y);
    const bool pr = sq < NBP; const int b = pr ? sq : sq - NBP, n = pr ? SEQ : DS, row0 = pr ? b * SEQ : MPR + b * DS, g = h >> 3;
    const float a = -__expf(p.a_log[j * 16 + h]), Dk = p.d_skip[j * 16 + h];
    float st[128];
    if (pr) {
#pragma unroll
        for (int i = 0; i < 128; ++i) st[i] = 0.f;
    } else { const float* h0 = p.state_ssm + ((((size_t)j * DB + b) * 16 + h) * 64 + lane) * 128;
#pragma unroll
        for (int i = 0; i < 32; ++i) { const f32x4 v = *(const f32x4*)(h0 + 4 * i); st[4 * i] = v.x; st[4 * i + 1] = v.y; st[4 * i + 2] = v.z; st[4 * i + 3] = v.w; } }
    for (int t = 0; t < n; ++t) {
        const int row = row0 + t; const float dt = DT[row * 16 + h], dA = __expf(dt * a), x = XC[(size_t)row * 1536 + h * 64 + lane], cf = dt * x;
        const float* Bp = XC + (size_t)row * 1536 + 1024 + g * 128; const float* Cp = Bp + 256;
        float y = 0.f;
#pragma unroll
        for (int i = 0; i < 32; ++i) { const f32x4 bv = *(const f32x4*)(Bp + 4 * i), cv = *(const f32x4*)(Cp + 4 * i);
            st[4 * i] = st[4 * i] * dA + cf * bv.x; st[4 * i + 1] = st[4 * i + 1] * dA + cf * bv.y; st[4 * i + 2] = st[4 * i + 2] * dA + cf * bv.z; st[4 * i + 3] = st[4 * i + 3] * dA + cf * bv.w;
            y += cv.x * st[4 * i] + cv.y * st[4 * i + 1] + cv.z * st[4 * i + 2] + cv.w * st[4 * i + 3]; }
        Y[(size_t)row * 1024 + h * 64 + lane] = y + Dk * x;
    }
    float* ho = pr ? p.out + O_HP + ((((size_t)j * NBP + b) * 16 + h) * 64 + lane) * 128 : p.out + O_HS + ((((size_t)j * DB + b) * 16 + h) * 64 + lane) * 128;
#pragma unroll
    for (int i = 0; i < 32; ++i) *(f32x4*)(ho + 4 * i) = (f32x4){st[4 * i], st[4 * i + 1], st[4 * i + 2], st[4 * i + 3]};
}
__global__ __launch_bounds__(64) void k_ssd_seq(P p) { ssd_seq_unit(p, p.j, blockIdx.x / 16, blockIdx.x % 16, threadIdx.x); }

DEVI void ph_ssd_gate(const P& p, int j, int vb, int nvb) {
    const float* H = wsf(p, WS_H); const float* Y = wsf(p, WS_Y); bf16* AO = wsb(p, WS_AO); const float* g = p.ssd_g + (size_t)j * 1024;
    const int lane = threadIdx.x & 63, wv = threadIdx.x >> 6;
    for (int row = vb * 8 + wv; row < MR; row += nvb * 8) {
        f32x4 v[4]; float q = 0.f;
#pragma unroll
        for (int i = 0; i < 4; ++i) { const int c = (i * 64 + lane) * 4; const f32x4 y = *(const f32x4*)(Y + (size_t)row * 1024 + c), z = *(const f32x4*)(H + (size_t)row * HC_AB + C_Z + c);
            v[i] = (f32x4){y.x * silu_f(z.x), y.y * silu_f(z.y), y.z * silu_f(z.z), y.w * silu_f(z.w)}; q += (v[i].x * v[i].x + v[i].y * v[i].y) + (v[i].z * v[i].z + v[i].w * v[i].w); }
        const float rs = 1.f / sqrtf(wave_sum(q) * (1.f / 1024.f) + EPS);
#pragma unroll
        for (int i = 0; i < 4; ++i) { const int c = (i * 64 + lane) * 4; const f32x4 gg = *(const f32x4*)(g + c); const f32x4 o = v[i] * rs * gg;
            uint2 w; w.x = pk2(o.x, o.y); w.y = pk2(o.z, o.w); *(uint2*)(AO + (size_t)row * DM + 1024 + c) = w; }
    }
}
__global__ __launch_bounds__(512) void k_ssd_gate(P p) { ph_ssd_gate(p, p.j, blockIdx.x, gridDim.x); }

__global__ __launch_bounds__(256) void k_idx_prompt_naive(P p) {
    __shared__ float sq[512], sw[8];
    const float* H = wsf(p, WS_H); float* SC = wsf(p, WS_SC);
    const int row = blockIdx.x, b = row / SEQ, t = row % SEQ, tid = threadIdx.x;
    sq[tid] = H[(size_t)row * HC_AB + C_QI + tid]; sq[tid + 256] = H[(size_t)row * HC_AB + C_QI + 256 + tid]; if (tid < 8) sw[tid] = H[(size_t)row * HC_AB + C_WI + tid];
    __syncthreads();
    for (int s = tid; s <= t; s += 256) {
        const float* kr = H + (size_t)(b * SEQ + s) * HC_AB + C_KI; float k[64];
#pragma unroll
        for (int i = 0; i < 16; ++i) { const f32x4 v = *(const f32x4*)(kr + 4 * i); k[4 * i] = v.x; k[4 * i + 1] = v.y; k[4 * i + 2] = v.z; k[4 * i + 3] = v.w; }
        float sc = 0.f;
#pragma unroll
        for (int h = 0; h < 8; ++h) { float d = 0.f;
#pragma unroll
            for (int i = 0; i < 64; ++i) d += sq[h * 64 + i] * k[i];
            sc += sw[h] * fmaxf(d, 0.f); }
        SC[(size_t)row * SEQ + s] = sc * IDX_SCALE;
    }
}

DEVI void select_prompt_row(const float* SC, unsigned long long* MASK, int row, int lane) {
    const int t = row % SEQ, nk = t + 1; const float* sc = SC + (size_t)row * SEQ;
    unsigned v[64];
#pragma unroll
    for (int jj = 0; jj < 64; ++jj) { const int key = jj * 64 + lane; v[jj] = key < nk ? ord_f(sc[key]) : 0u; }
    unsigned long long mine = 0ull;
    if (nk <= TOPK) {
#pragma unroll
        for (int jj = 0; jj < 64; ++jj) { const unsigned long long m = __ballot(jj * 64 + lane < nk); if (lane == jj) mine = m; }
    } else {
        unsigned T = 0u;
        for (int bit = 31; bit >= 0; --bit) { const unsigned cand = T | (1u << bit); int cnt = 0;
#pragma unroll
            for (int jj = 0; jj < 64; ++jj) cnt += __popcll(__ballot(v[jj] >= cand));
            if (cnt >= TOPK) T = cand; if (cnt == TOPK) break; }
        int cgt = 0;
#pragma unroll
        for (int jj = 0; jj < 64; ++jj) cgt += __popcll(__ballot(v[jj] > T));
        const int need = TOPK - cgt; int run = 0; const unsigned long long lt = (1ull << lane) - 1ull;
#pragma unroll
        for (int jj = 0; jj < 64; ++jj) { const bool eq = v[jj] == T; const unsigned long long me = __ballot(eq); const int pre = run + __popcll(me & lt);
            const bool sel = (v[jj] > T) || (eq && pre < need); run += __popcll(me); const unsigned long long m = __ballot(sel); if (lane == jj) mine = m; }
    }
    MASK[((size_t)(row >> 5) * 64 + lane) * 32 + (row & 31)] = mine;
}
DEVI void ph_select_prompt(const P& p, int vb, int nvb) {
    const int lane = threadIdx.x & 63, wv = threadIdx.x >> 6;
    for (int row = vb * 8 + wv; row < MPR; row += nvb * 8) select_prompt_row(wsf(p, WS_SC), (unsigned long long*)(p.ws + WS_MASK), row, lane);
}
__global__ __launch_bounds__(512) void k_select_prompt(P p) { ph_select_prompt(p, blockIdx.x, gridDim.x); }

__global__ __launch_bounds__(512) void k_attn_prompt_naive(P p) {
    const float* H = wsf(p, WS_H); const unsigned long long* MASK = (const unsigned long long*)(p.ws + WS_MASK); bf16* AO = wsb(p, WS_AO);
    const int row = blockIdx.x, b = row / SEQ, t = row % SEQ, h = threadIdx.x >> 6, lane = threadIdx.x & 63, g = h >> 2;
    const float q0 = H[(size_t)row * HC_AB + C_Q + h * 128 + lane], q1 = H[(size_t)row * HC_AB + C_Q + h * 128 + 64 + lane];
    float m = -1e30f, l = 0.f, o0 = 0.f, o1 = 0.f;
    for (int jt = 0; jt <= t / 64; ++jt) {
        unsigned long long w = MASK[((size_t)(row >> 5) * 64 + jt) * 32 + (row & 31)];
        while (w) { const int bit = __builtin_ctzll(w); w &= w - 1ull; const int s = jt * 64 + bit;
            const float* kr = H + (size_t)(b * SEQ + s) * HC_AB + C_K + g * 128; const float* vr = H + (size_t)(b * SEQ + s) * HC_AB + C_V + g * 128;
            const float lg = wave_sum(q0 * kr[lane] + q1 * kr[lane + 64]) * ATT_SCALE;
            const float mn = fmaxf(m, lg), al = __expf(m - mn), pe = __expf(lg - mn);
            l = l * al + pe; o0 = o0 * al + pe * vr[lane]; o1 = o1 * al + pe * vr[lane + 64]; m = mn; }
    }
    const float il = 1.f / l;
    AO[(size_t)row * DM + h * 128 + lane] = f2bf(o0 * il); AO[(size_t)row * DM + h * 128 + 64 + lane] = f2bf(o1 * il);
}

DEVI void idx_sample_unit(const P& p, int j, int b, int kb, float* sq  ) {
    const float* H = wsf(p, WS_H); float* SCS = wsf(p, WS_SCS); const int tid = threadIdx.x;
    for (int i = tid; i < 8 * 512; i += 512) sq[i] = H[(size_t)(MPR + b * DS + (i >> 9)) * HC_AB + C_QI + (i & 511)];
    if (tid < 64) sq[4096 + tid] = H[(size_t)(MPR + b * DS + (tid >> 3)) * HC_AB + C_WI + (tid & 7)];
    __syncthreads();
    const int key = kb * 512 + tid;
    if (key < NKEY_S) {
        const float* kr;
        if (key < PAST) { const int pg = p.page_table[b * NPAGES + key / PAGE]; kr = p.cache_ik + (((size_t)j * NPOOL + pg) * PAGE + key % PAGE) * 64; }
        else kr = H + (size_t)(MPR + b * DS + key - PAST) * HC_AB + C_KI;
        float k[64];
#pragma unroll
        for (int i = 0; i < 16; ++i) { const f32x4 v = *(const f32x4*)(kr + 4 * i); k[4 * i] = v.x; k[4 * i + 1] = v.y; k[4 * i + 2] = v.z; k[4 * i + 3] = v.w; }
        for (int qi = 0; qi < 8; ++qi) { if (key > PAST + qi) continue; float sc = 0.f;
#pragma unroll
            for (int h = 0; h < 8; ++h) { float d = 0.f;
#pragma unroll
                for (int i = 0; i < 64; ++i) d += sq[qi * 512 + h * 64 + i] * k[i];
                sc += sq[4096 + qi * 8 + h] * fmaxf(d, 0.f); }
            SCS[(size_t)(b * DS + qi) * SCS_LD + key] = sc * IDX_SCALE; }
    }
    __syncthreads();
}
__global__ __launch_bounds__(512) void k_idx_sample(P p) { __shared__ float sq[8 * 512 + 64]; idx_sample_unit(p, p.j, blockIdx.y, blockIdx.x, sq); }

DEVI void select_sample_unit(const P& p, int q, int* red  ) {
    const float* sc = wsf(p, WS_SCS) + (size_t)q * SCS_LD; int* SELS = (int*)(p.ws + WS_SELS) + q * TOPK;
    const int tid = threadIdx.x, lane = tid & 63, wv = tid >> 6, nk = PAST + (q % DS) + 1;
    unsigned v[33];
#pragma unroll
    for (int jj = 0; jj < 33; ++jj) { const int key = jj * 512 + tid; v[jj] = key < nk ? ord_f(sc[key]) : 0u; }
    unsigned T = 0u; int par = 0;
    for (int bit = 31; bit >= 0; --bit) { const unsigned cand = T | (1u << bit); int cnt = 0;
#pragma unroll
        for (int jj = 0; jj < 33; ++jj) cnt += __popcll(__ballot(v[jj] >= cand));
        if (lane == 0) red[par * 8 + wv] = cnt; __syncthreads();
        int tot = 0;
#pragma unroll
        for (int w = 0; w < 8; ++w) tot += red[par * 8 + w];
        par ^= 1;
        if (tot >= TOPK) T = cand; if (tot == TOPK) break; }
    __syncthreads();
    int* cg = red + 16; int* ce = cg + 33 * 8; int* pg = ce + 33 * 8; int* pe = pg + 33 * 8;
#pragma unroll
    for (int jj = 0; jj < 33; ++jj) { const int a = __popcll(__ballot(v[jj] > T)), e = __popcll(__ballot(v[jj] == T)); if (lane == 0) { cg[jj * 8 + wv] = a; ce[jj * 8 + wv] = e; } }
    __syncthreads();
    if (tid < 33 * 8) { int a = 0, e = 0; for (int i = 0; i < tid; ++i) { a += cg[i]; e += ce[i]; } pg[tid] = a; pe[tid] = e; }
    if (tid == 0) { int a = 0; for (int i = 0; i < 33 * 8; ++i) a += cg[i]; red[0] = a; }
    __syncthreads();
    const int need = TOPK - red[0]; const unsigned long long lt = (1ull << lane) - 1ull;
#pragma unroll
    for (int jj = 0; jj < 33; ++jj) {
        const bool gt = v[jj] > T, eq = v[jj] == T; const unsigned long long me = __ballot(eq), mg = __ballot(gt);
        const int epre = pe[jj * 8 + wv] + __popcll(me & lt), gpre = pg[jj * 8 + wv] + __popcll(mg & lt); const bool sel = gt || (eq && epre < need);
        const int ebc = epre < need ? epre : need;
        if (sel) SELS[gpre + ebc] = jj * 512 + tid;
    }
    __syncthreads();
}
__global__ __launch_bounds__(512) void k_select_sample(P p) { __shared__ int red[16 + 4 * 33 * 8]; select_sample_unit(p, blockIdx.x, red); }

DEVI void attn_sample_unit(const P& p, int j, int q) {
    const float* H = wsf(p, WS_H); const int* SELS = (const int*)(p.ws + WS_SELS) + q * TOPK; bf16* AO = wsb(p, WS_AO);
    const int row = MPR + q, b = q / DS, h = threadIdx.x >> 6, lane = threadIdx.x & 63, g = h >> 2;
    const float q0 = H[(size_t)row * HC_AB + C_Q + h * 128 + lane], q1 = H[(size_t)row * HC_AB + C_Q + h * 128 + 64 + lane];
    float m = -1e30f, l = 0.f, o0 = 0.f, o1 = 0.f;
    for (int i = 0; i < TOPK; ++i) { const int s = SELS[i]; const float *kr, *vr;
        if (s < PAST) { const int pg = p.page_table[b * NPAGES + s / PAGE]; const size_t o = ((((size_t)j * NPOOL + pg) * PAGE + s % PAGE) * 2 + g) * 128; kr = p.cache_k + o; vr = p.cache_v + o; }
        else { const size_t o = (size_t)(MPR + b * DS + s - PAST) * HC_AB + g * 128; kr = H + o + C_K; vr = H + o + C_V; }
        const float lg = wave_sum(q0 * kr[lane] + q1 * kr[lane + 64]) * ATT_SCALE;
        const float mn = fmaxf(m, lg), al = __expf(m - mn), pe = __expf(lg - mn);
        l = l * al + pe; o0 = o0 * al + pe * vr[lane]; o1 = o1 * al + pe * vr[lane + 64]; m = mn; }
    const float il = 1.f / l;
    AO[(size_t)row * DM + h * 128 + lane] = f2bf(o0 * il); AO[(size_t)row * DM + h * 128 + 64 + lane] = f2bf(o1 * il);
}
__global__ __launch_bounds__(512) void k_attn_sample(P p) { attn_sample_unit(p, p.j, blockIdx.x); }

DEVI void ph_cd_prep(const P& p, int j, int vb, int nvb) {
    const float* H = wsf(p, WS_H); bf16* DD = wsb(p, WS_DD); bf16* U = wsb(p, WS_U); bf16* VLN = wsb(p, WS_VLN);
    const float* lg = p.sgu_ln_g + (size_t)j * 1024; const float* lb = p.sgu_ln_b + (size_t)j * 1024;
    const int lane = threadIdx.x & 63, wv = threadIdx.x >> 6;
    for (int row = vb * 8 + wv; row < MR; row += nvb * 8) {
        const bool pr = row < MPR; const int b = pr ? row / SEQ : (row - MPR) / DS, t = pr ? row % SEQ : (row - MPR) % DS;
        const float* h = H + (size_t)row * HC_CD;
#pragma unroll
        for (int i = 0; i < 4; ++i) { const int c = i * 256 + lane * 4, w = 2 << i; const f32x4 cur = *(const f32x4*)(h + c); f32x4 s = cur; int cnt;
            if (pr) { cnt = (t + 1 < w) ? t + 1 : w; for (int u = 1; u < cnt; ++u) s += *(const f32x4*)(H + (size_t)(row - u) * HC_CD + c); }
            else { cnt = w; for (int u = 1; u < w; ++u) { const int e = 15 + t - u;
                    s += (e >= 15) ? *(const f32x4*)(H + (size_t)(MPR + b * DS + e - 15) * HC_CD + c) : *(const f32x4*)(p.state_pool + (((size_t)j * DB + b) * 15 + e) * 1024 + c); } }
            const float ic = 1.f / (float)cnt; const f32x4 d = s * ic - cur; uint2 o; o.x = pk2(d.x, d.y); o.y = pk2(d.z, d.w); *(uint2*)(DD + (size_t)row * 1024 + c) = o;
            if (pr) { if (t >= SEQ - 15) *(f32x4*)(p.out + O_PP + (((size_t)j * NBP + b) * 15 + (t - (SEQ - 15))) * 1024 + c) = cur; }
            else { *(f32x4*)(p.out + O_PS + (((size_t)j * DB + b) * 15 + 7 + t) * 1024 + c) = cur;
                   if (t == 0) for (int e = 0; e < 7; ++e) *(f32x4*)(p.out + O_PS + (((size_t)j * DB + b) * 15 + e) * 1024 + c) = *(const f32x4*)(p.state_pool + (((size_t)j * DB + b) * 15 + 8 + e) * 1024 + c); }
        }
#pragma unroll
        for (int i = 0; i < 4; ++i) { const int c = (i * 64 + lane) * 4; const f32x4 u = *(const f32x4*)(h + 1024 + c); uint2 o; o.x = pk2(gelu_f(u.x), gelu_f(u.y)); o.y = pk2(gelu_f(u.z), gelu_f(u.w)); *(uint2*)(U + (size_t)row * 1024 + c) = o; }
        f32x4 v[4]; float s = 0.f;
#pragma unroll
        for (int i = 0; i < 4; ++i) { const int c = (i * 64 + lane) * 4; const f32x4 x = *(const f32x4*)(h + 2048 + c); v[i] = (f32x4){gelu_f(x.x), gelu_f(x.y), gelu_f(x.z), gelu_f(x.w)}; s += (v[i].x + v[i].y) + (v[i].z + v[i].w); }
        const float mean = wave_sum(s) * (1.f / 1024.f); float q = 0.f;
#pragma unroll
        for (int i = 0; i < 4; ++i) { v[i] = v[i] - mean; q += (v[i].x * v[i].x + v[i].y * v[i].y) + (v[i].z * v[i].z + v[i].w * v[i].w); }
        const float rstd = 1.f / sqrtf(wave_sum(q) * (1.f / 1024.f) + EPS);
#pragma unroll
        for (int i = 0; i < 4; ++i) { const int c = (i * 64 + lane) * 4; const f32x4 y = v[i] * rstd * *(const f32x4*)(lg + c) + *(const f32x4*)(lb + c);
            uint2 o; o.x = pk2(y.x, y.y); o.y = pk2(y.z, y.w); *(uint2*)(VLN + (size_t)row * 1024 + c) = o;
            if (!pr) *(f32x4*)(p.out + O_GS + ((size_t)j * MSR + (row - MPR)) * 1024 + c) = y; }
    }
}
__global__ __launch_bounds__(512) void k_cd_prep(P p) { ph_cd_prep(p, p.j, blockIdx.x, gridDim.x); }

__global__ __launch_bounds__(256) void k_sgu_naive(P p) {
    const int j = p.j;
    const bf16* VLN = wsb(p, WS_VLN); const bf16* U = wsb(p, WS_U); bf16* AO = wsb(p, WS_AO);
    const int row = blockIdx.x; const bool pr = row < MPR; const int t = pr ? row % SEQ : (row - MPR) % DS;
    const int tt = pr ? (t & 127) : t, base = row - tt;
    for (int d = threadIdx.x; d < 1024; d += 256) { const int g = d >> 8; const float* w = p.sgu_w + (((size_t)j * 4 + g) * 128 + tt) * 128;
        float acc = p.sgu_b[((size_t)j * 4 + g) * 128 + tt];
        for (int s = 0; s <= tt; ++s) acc += w[s] * bf2f(VLN[(size_t)(base + s) * 1024 + d]);
        AO[(size_t)row * DM + 1024 + d] = f2bf(bf2f(U[(size_t)row * 1024 + d]) * acc); }
}

template <int EPI> static void gemm_naive(hipStream_t st, const bf16* A, int lda, const bf16* Bt, int ldb, int M, int N, int K, float* C, int ldc, bf16* O, int ldo, const float* scale) {
    GE e{}; e.A = A; e.Bt = Bt; e.C = C; e.O = O; e.scale = scale; e.lda = lda; e.ldb = ldb; e.K = K; e.ldc = ldc; e.ldo = ldo; e.pad = 0;
    k_gemm_naive<EPI><<<dim3(N / 64, M / 64), 256, 0, st>>>(e);
}
static void transpose(hipStream_t st, const float* W, int K, int N, bf16* WT, int abmap) {
    TJob j{}; j.W = W; j.WT = WT; j.K = K; j.N = N; j.abmap = abmap; j.units = (K / 64) * ((N + 63) / 64);
    k_transpose<<<1024, 512, 0, st>>>(j);
}

extern "C" void kernel_launch(void* const* d_in, const int* in_sizes, int n_in, void* d_out, int out_size, void* d_ws, size_t ws_size, hipStream_t stream) {
    if (n_in != 31 || (size_t)out_size != O_END || ws_size < WS_END) { fprintf(stderr, "kernel_launch: unexpected sizes n_in %d out %d ws %zu (need %zu)\n", n_in, out_size, ws_size, (size_t)WS_END); return; }
    P p{};
    p.x_prompt = (const float*)d_in[0]; p.x_sample = (const float*)d_in[1]; p.cache_k = (const float*)d_in[2]; p.cache_v = (const float*)d_in[3]; p.cache_ik = (const float*)d_in[4];
    p.state_ssm = (const float*)d_in[5]; p.state_conv = (const float*)d_in[6]; p.state_pool = (const float*)d_in[7]; p.page_table = (const int*)d_in[8];
    p.ln1_g = (const float*)d_in[9]; p.ln1_b = (const float*)d_in[10]; p.ln2_g = (const float*)d_in[11]; p.ln2_b = (const float*)d_in[12];
    p.w_in_ab = (const float*)d_in[13]; p.conv_w = (const float*)d_in[14]; p.conv_b = (const float*)d_in[15]; p.dt_bias = (const float*)d_in[16]; p.a_log = (const float*)d_in[17];
    p.d_skip = (const float*)d_in[18]; p.ssd_g = (const float*)d_in[19]; p.w_out_ab = (const float*)d_in[20]; p.w_in_cd = (const float*)d_in[21]; p.pool_w = (const float*)d_in[22];
    p.pool_scale = (const float*)d_in[23]; p.sgu_ln_g = (const float*)d_in[24]; p.sgu_ln_b = (const float*)d_in[25]; p.sgu_w = (const float*)d_in[26]; p.sgu_b = (const float*)d_in[27];
    p.w_out_cd = (const float*)d_in[28]; p.w_ff1 = (const float*)d_in[29]; p.w_ff2 = (const float*)d_in[30];
    p.out = (float*)d_out; p.ws = (unsigned char*)d_ws; p.lng = p.ln1_g; p.lnb = p.ln1_b;
    unsigned char* ws = p.ws;
    bf16 *WINAB = (bf16*)(ws + WS_WINAB), *WOUTAB = (bf16*)(ws + WS_WOUTAB), *WINCD = (bf16*)(ws + WS_WINCD), *WOUTCD = (bf16*)(ws + WS_WOUTCD), *WFF1 = (bf16*)(ws + WS_WFF1), *WFF2 = (bf16*)(ws + WS_WFF2), *POOLW = (bf16*)(ws + WS_POOLW);
    bf16 *XB = (bf16*)(ws + WS_XB), *AO = (bf16*)(ws + WS_AO), *HF = (bf16*)(ws + WS_HF), *DD = (bf16*)(ws + WS_DD);
    float *X = (float*)(ws + WS_X), *H = (float*)(ws + WS_H);
    (void)hipMemsetAsync(ws + WS_WINAB, 0, (size_t)2 * HC_AB * DM * 2, stream);
    for (int j = 0; j < 2; ++j) {
        transpose(stream, p.w_in_ab + (size_t)j * DM * 4696, DM, 4696, WINAB + (size_t)j * HC_AB * DM, 1);
        transpose(stream, p.w_out_ab + (size_t)j * DM * DM, DM, DM, WOUTAB + (size_t)j * DM * DM, 0);
        transpose(stream, p.w_in_cd + (size_t)j * DM * HC_CD, DM, HC_CD, WINCD + (size_t)j * HC_CD * DM, 0);
        transpose(stream, p.w_out_cd + (size_t)j * DM * DM, DM, DM, WOUTCD + (size_t)j * DM * DM, 0);
        for (int g = 0; g < 4; ++g) transpose(stream, p.pool_w + ((size_t)j * 4 + g) * 65536, 256, 256, POOLW + ((size_t)j * 4 + g) * 65536, 0);
    }
    for (int i = 0; i < 4; ++i) {
        transpose(stream, p.w_ff1 + (size_t)i * DM * DFF, DM, DFF, WFF1 + (size_t)i * DFF * DM, 0);
        transpose(stream, p.w_ff2 + (size_t)i * DFF * DM, DFF, DM, WFF2 + (size_t)i * DM * DFF, 0);
    }
    k_prologue_misc<<<1024, 512, 0, stream>>>(p);
    for (int i = 0; i < 4; ++i) {
        const int j = i / 2; p.j = j; p.fin = 0;
        if ((i & 1) == 0) {
            gemm_naive<EPI_F32>(stream, XB, DM, WINAB + (size_t)j * HC_AB * DM, DM, MR, HC_AB, DM, H, HC_AB, nullptr, 0, nullptr);
            k_ab_copy<<<1024, 512, 0, stream>>>(p);
            k_conv<<<2048, 512, 0, stream>>>(p);
            k_idx_prompt_naive<<<MPR, 256, 0, stream>>>(p);
            k_idx_sample<<<dim3((NKEY_S + 511) / 512, DB), 512, 0, stream>>>(p);
            k_select_prompt<<<1024, 512, 0, stream>>>(p);
            k_select_sample<<<MSR, 512, 0, stream>>>(p);
            k_attn_prompt_naive<<<MPR, 512, 0, stream>>>(p);
            k_attn_sample<<<MSR, 512, 0, stream>>>(p);
            k_ssd_seq<<<(NBP + DB) * 16, 64, 0, stream>>>(p);
            k_ssd_gate<<<1032, 512, 0, stream>>>(p);
            gemm_naive<EPI_RESID>(stream, AO, DM, WOUTAB + (size_t)j * DM * DM, DM, MR, DM, DM, X, DM, nullptr, 0, nullptr);
        } else {
            gemm_naive<EPI_F32>(stream, XB, DM, WINCD + (size_t)j * HC_CD * DM, DM, MR, HC_CD, DM, H, HC_CD, nullptr, 0, nullptr);
            k_cd_prep<<<1032, 512, 0, stream>>>(p);
            for (int g = 0; g < 4; ++g) gemm_naive<EPI_POOL>(stream, DD + g * 256, 1024, POOLW + ((size_t)j * 4 + g) * 65536, 256, MR, 256, 256, nullptr, 0, AO + g * 256, DM, p.pool_scale + (size_t)j * 1024 + g * 256);
            k_sgu_naive<<<MR, 256, 0, stream>>>(p);
            gemm_naive<EPI_RESID>(stream, AO, DM, WOUTCD + (size_t)j * DM * DM, DM, MR, DM, DM, X, DM, nullptr, 0, nullptr);
        }
        p.lng = p.ln1_g + (size_t)i * DM; p.lnb = p.ln1_b + (size_t)i * DM; p.fin = 0;
        k_ln<<<1032, 512, 0, stream>>>(p);
        gemm_naive<EPI_RELU2>(stream, XB, DM, WFF1 + (size_t)i * DFF * DM, DM, MR, DFF, DM, nullptr, 0, HF, DFF, nullptr);
        gemm_naive<EPI_RESID>(stream, HF, DFF, WFF2 + (size_t)i * DM * DFF, DFF, MR, DM, DFF, X, DM, nullptr, 0, nullptr);
        p.lng = p.ln2_g + (size_t)i * DM; p.lnb = p.ln2_b + (size_t)i * DM; p.fin = (i == 3);
        k_ln<<<1032, 512, 0, stream>>>(p);
    }
}
```

```cpp
#include <hip/hip_runtime.h>
#include <stdint.h>
#include <stdio.h>

typedef unsigned short bf16;
typedef float f32x4 __attribute__((ext_vector_type(4)));
typedef unsigned u32x4 __attribute__((ext_vector_type(4)));
#define DEVI __device__ __forceinline__

constexpr int DM = 2048, SEQ = 4096, NBP = 2, MPR = NBP * SEQ;
constexpr int DB = 8, DS = 8, MSR = DB * DS;
constexpr int MR = MPR + MSR;
constexpr int MP = 8448;
constexpr int PAST = 16384, PAGE = 128, NPAGES = PAST / PAGE, NPOOL = 1280;
constexpr int NKEY_S = PAST + DS;
constexpr int SCS_LD = 16400;
constexpr int HC_AB = 4864, HC_CD = 3072, DFF = 8192;
constexpr int TOPK = 256;
constexpr int C_Q = 0, C_K = 1024, C_V = 1280, C_QI = 1536, C_Z = 2048, C_XBC = 3072, C_KI = 4608, C_WI = 4672, C_DT = 4680;
constexpr float ALPHA = 1.681792830507429f;
constexpr float EPS = 1e-5f;
constexpr float IDX_SCALE = 0.04419417382415922f;
constexpr float ATT_SCALE = 0.08838834764831845f;

constexpr size_t O_YP = 0;
constexpr size_t O_YS = O_YP + (size_t)MPR * DM;
constexpr size_t O_KP = O_YS + (size_t)MSR * DM;
constexpr size_t O_VP = O_KP + (size_t)2 * MPR * 256;
constexpr size_t O_IP = O_VP + (size_t)2 * MPR * 256;
constexpr size_t O_HP = O_IP + (size_t)2 * MPR * 64;
constexpr size_t O_CP = O_HP + (size_t)2 * NBP * 16 * 64 * 128;
constexpr size_t O_PP = O_CP + (size_t)2 * NBP * 3 * 1536;
constexpr size_t O_KS = O_PP + (size_t)2 * NBP * 15 * 1024;
constexpr size_t O_VS = O_KS + (size_t)2 * MSR * 256;
constexpr size_t O_IS = O_VS + (size_t)2 * MSR * 256;
constexpr size_t O_HS = O_IS + (size_t)2 * MSR * 64;
constexpr size_t O_CS = O_HS + (size_t)2 * DB * 16 * 64 * 128;
constexpr size_t O_PS = O_CS + (size_t)2 * DB * 3 * 1536;
constexpr size_t O_GS = O_PS + (size_t)2 * DB * 15 * 1024;
constexpr size_t O_END = O_GS + (size_t)2 * MSR * 1024;
static_assert(O_END == 29571072, "output size");

constexpr size_t al256(size_t x) { return (x + 255) & ~(size_t)255; }
constexpr size_t WS_CTL = 0;
constexpr size_t WS_X = 1u << 20;
constexpr size_t WS_XB = WS_X + al256((size_t)MP * DM * 4);
constexpr size_t WS_H = WS_XB + al256((size_t)MP * DM * 2);
constexpr size_t WS_AO = WS_H + al256((size_t)MP * HC_AB * 4);
constexpr size_t WS_HF = WS_AO + al256((size_t)MP * DM * 2);
constexpr size_t WS_SC = WS_HF + al256((size_t)MP * DFF * 2);
constexpr size_t WS_MASK = WS_SC + al256((size_t)MPR * SEQ * 4);
constexpr size_t WS_XC = WS_MASK + al256((size_t)MPR * 64 * 8);
constexpr size_t WS_DT = WS_XC + al256((size_t)MP * 1536 * 4);
constexpr size_t WS_Y = WS_DT + al256((size_t)MP * 16 * 4);
constexpr size_t WS_SCS = WS_Y + al256((size_t)MP * 1024 * 4);
constexpr size_t WS_SELS = WS_SCS + al256((size_t)MSR * SCS_LD * 4);
constexpr size_t WS_DD = WS_SELS + al256((size_t)MSR * TOPK * 4);
constexpr size_t WS_U = WS_DD + al256((size_t)MP * 1024 * 2);
constexpr size_t WS_VLN = WS_U + al256((size_t)MP * 1024 * 2);
constexpr size_t WS_WINAB = WS_VLN + al256((size_t)MP * 1024 * 2);
constexpr size_t WS_WOUTAB = WS_WINAB + (size_t)2 * HC_AB * DM * 2;
constexpr size_t WS_WINCD = WS_WOUTAB + (size_t)2 * DM * DM * 2;
constexpr size_t WS_WOUTCD = WS_WINCD + (size_t)2 * HC_CD * DM * 2;
constexpr size_t WS_WFF1 = WS_WOUTCD + (size_t)2 * DM * DM * 2;
constexpr size_t WS_WFF2 = WS_WFF1 + (size_t)4 * DFF * DM * 2;
constexpr size_t WS_POOLW = WS_WFF2 + (size_t)4 * DFF * DM * 2;
constexpr size_t WS_SGUW = WS_POOLW + (size_t)2 * 4 * 256 * 256 * 2;
constexpr size_t WS_END = WS_SGUW + (size_t)2 * 4 * 128 * 128 * 2;

struct P {
    const float *x_prompt, *x_sample, *cache_k, *cache_v, *cache_ik, *state_ssm, *state_conv, *state_pool;
    const int* page_table;
    const float *ln1_g, *ln1_b, *ln2_g, *ln2_b, *w_in_ab, *conv_w, *conv_b, *dt_bias, *a_log, *d_skip, *ssd_g, *w_out_ab;
    const float *w_in_cd, *pool_w, *pool_scale, *sgu_ln_g, *sgu_ln_b, *sgu_w, *sgu_b, *w_out_cd, *w_ff1, *w_ff2;
    float* out;
    unsigned char* ws;
    int ph_lo, ph_hi, a2, a3;
};
typedef const __attribute__((address_space(4))) P* CP;
DEVI CP PP() { CP q = (CP)__builtin_amdgcn_kernarg_segment_ptr(); asm volatile("" : "+s"(q)); return q; }
DEVI float* wsf(CP p, size_t off) { return (float*)(p->ws + off); }
DEVI bf16* wsb(CP p, size_t off) { return (bf16*)(p->ws + off); }

DEVI float bf2f(bf16 b) { return __uint_as_float(((unsigned)b) << 16); }
DEVI bf16 f2bf(float f) { unsigned u = __float_as_uint(f); u += 0x7fffu + ((u >> 16) & 1u); return (bf16)(u >> 16); }
DEVI unsigned pk2(float lo, float hi) { return (unsigned)f2bf(lo) | ((unsigned)f2bf(hi) << 16); }
DEVI float wave_sum(float v) {
#pragma unroll
    for (int o = 1; o < 64; o <<= 1) v += __shfl_xor(v, o);
    return v;
}
DEVI int ltid() { int t = threadIdx.x; asm volatile("" : "+v"(t)); return t; }
DEVI int lvb() { int b = blockIdx.x; asm volatile("" : "+s"(b)); return b; }
DEVI float silu_f(float x) { return x / (1.f + __expf(-x)); }
DEVI float softplus_f(float x) { return fmaxf(x, 0.f) + log1pf(__expf(-fabsf(x))); }
DEVI float gelu_f(float x) { return 0.5f * x * (1.f + erff(x * 0.70710678118654752f)); }
DEVI unsigned ord_f(float f) { f = f + 0.0f; unsigned u = __float_as_uint(f); return (u & 0x80000000u) ? ~u : (u | 0x80000000u); }
__host__ __device__ inline int ab_dst_col(int n) {
    if (n < 2048) return n;
    if (n < 2112) return C_KI + (n - 2048);
    if (n < 2120) return C_WI + (n - 2112);
    if (n < 3144) return C_Z + (n - 2120);
    if (n < 4680) return C_XBC + (n - 3144);
    return n;
}

DEVI void transpose_unit(const float* W, int K, int N, bf16* WT, int abmap, int unit, float* t  ) {
    const int TIDX = ltid();
    const int nbn = (N + 63) / 64, kb = unit / nbn, nb = unit % nbn, k0 = kb * 64, n0 = nb * 64, tid = TIDX;
#pragma unroll
    for (int i = 0; i < 8; ++i) { const int kk = (tid >> 6) + 8 * i, n = n0 + (tid & 63); t[kk * 65 + (tid & 63)] = (n < N) ? W[(size_t)(k0 + kk) * N + n] : 0.f; }
    __syncthreads();
    { const int n = n0 + (tid >> 3), kq = (tid & 7) * 8;
      if (n < N) { const int row = abmap ? ab_dst_col(n) : n; const float* s = t + kq * 65 + (tid >> 3);
          u32x4 o; o.x = pk2(s[0], s[65]); o.y = pk2(s[2 * 65], s[3 * 65]); o.z = pk2(s[4 * 65], s[5 * 65]); o.w = pk2(s[6 * 65], s[7 * 65]);
          *(u32x4*)(WT + (size_t)row * K + k0 + kq) = o; } }
    __syncthreads();
}


DEVI void ph_ln(CP p, const float* g, const float* b, int final_out, int vb, int nvb) {
    const int TIDX = ltid();
    float* X = wsf(p, WS_X); bf16* XB = wsb(p, WS_XB);
    const int lane = TIDX & 63, wv = TIDX >> 6;
    for (int row = vb * 8 + wv; row < MR; row += nvb * 8) {
        float* xr = X + (size_t)row * DM; f32x4 v[8]; float s = 0.f;
#pragma unroll
        for (int i = 0; i < 8; ++i) { v[i] = *(const f32x4*)(xr + (i * 64 + lane) * 4); s += (v[i].x + v[i].y) + (v[i].z + v[i].w); }
        const float mean = wave_sum(s) * (1.f / DM); float q = 0.f;
#pragma unroll
        for (int i = 0; i < 8; ++i) { v[i] = v[i] - mean; q += (v[i].x * v[i].x + v[i].y * v[i].y) + (v[i].z * v[i].z + v[i].w * v[i].w); }
        const float rstd = 1.f / sqrtf(wave_sum(q) * (1.f / DM) + EPS);
        float* o = final_out ? (row < MPR ? p->out + O_YP + (size_t)row * DM : p->out + O_YS + (size_t)(row - MPR) * DM) : nullptr;
#pragma unroll
        for (int i = 0; i < 8; ++i) { const int c = (i * 64 + lane) * 4; const f32x4 gg = *(const f32x4*)(g + c), bb = *(const f32x4*)(b + c);
            const f32x4 y = v[i] * rstd * gg + bb; *(f32x4*)(xr + c) = y; uint2 w; w.x = pk2(y.x, y.y); w.y = pk2(y.z, y.w); *(uint2*)(XB + (size_t)row * DM + c) = w;
            if (final_out) *(f32x4*)(o + c) = y; }
    }
}

DEVI void ph_ab_copy(CP p, int j, int vb, int nvb) {
    const int TIDX = ltid();
    const float* H = wsf(p, WS_H); const int tid = TIDX;
    for (int row = vb; row < MR; row += nvb) {
        const float* h = H + (size_t)row * HC_AB;
        float *ko, *vo, *io;
        if (row < MPR) { ko = p->out + O_KP + ((size_t)j * MPR + row) * 256; vo = p->out + O_VP + ((size_t)j * MPR + row) * 256; io = p->out + O_IP + ((size_t)j * MPR + row) * 64; }
        else { const int sr = row - MPR; ko = p->out + O_KS + ((size_t)j * MSR + sr) * 256; vo = p->out + O_VS + ((size_t)j * MSR + sr) * 256; io = p->out + O_IS + ((size_t)j * MSR + sr) * 64; }
        if (tid < 256) ko[tid] = h[C_K + tid]; else vo[tid - 256] = h[C_V + tid - 256];
        if (tid < 64) io[tid] = h[C_KI + tid];
        int ci = -1; float* co = nullptr;
        if (row < MPR) { const int b = row / SEQ, t = row % SEQ; if (t >= SEQ - 3) { ci = t - (SEQ - 3); co = p->out + O_CP + (((size_t)j * NBP + b) * 3 + ci) * 1536; } }
        else { const int b = (row - MPR) / DS, t = (row - MPR) % DS; if (t >= DS - 3) { ci = t - (DS - 3); co = p->out + O_CS + (((size_t)j * DB + b) * 3 + ci) * 1536; } }
        if (ci >= 0) for (int c = tid; c < 1536; c += 512) co[c] = h[C_XBC + c];
    }
}

DEVI void ph_conv(CP p, int j, int vb, int nvb) {
    const int TIDX = ltid();
    const float* H = wsf(p, WS_H); float* XC = wsf(p, WS_XC); float* DT = wsf(p, WS_DT);
    const float* cw = p->conv_w + (size_t)j * 4 * 1536; const float* cb = p->conv_b + (size_t)j * 1536;
    for (int row = vb; row < MR; row += nvb) {
        const bool pr = row < MPR; const int b = pr ? row / SEQ : (row - MPR) / DS, t = pr ? row % SEQ : (row - MPR) % DS;
        for (int c = TIDX; c < 1536; c += 512) {
            float acc = cb[c];
#pragma unroll
            for (int jj = 0; jj < 4; ++jj) { const int tt = t - 3 + jj; float xv;
                if (tt >= 0) xv = H[(size_t)(row - t + tt) * HC_AB + C_XBC + c];
                else xv = pr ? 0.f : p->state_conv[(((size_t)j * DB + b) * 3 + (3 + tt)) * 1536 + c];
                acc += cw[jj * 1536 + c] * xv; }
            XC[(size_t)row * 1536 + c] = silu_f(acc);
        }
        if (TIDX < 16) DT[row * 16 + TIDX] = softplus_f(H[(size_t)row * HC_AB + C_DT + TIDX] + p->dt_bias[j * 16 + TIDX]);
    }
}

DEVI void ssd_seq_unit(CP p, int j, int sq  , int h, int ph, int lane) {
    const float* XC = wsf(p, WS_XC); const float* DT = wsf(p, WS_DT); float* Y = wsf(p, WS_Y);
    const bool pr = sq < NBP; const int b = pr ? sq : sq - NBP, n = pr ? SEQ : DS, row0 = pr ? b * SEQ : MPR + b * DS, g = h >> 3;
    const int pp = ph * 32 + (lane & 31), nh = lane >> 5;
    const float a = -__expf(p->a_log[j * 16 + h]), Dk = p->d_skip[j * 16 + h];
    float st[64];
    if (pr) {
#pragma unroll
        for (int i = 0; i < 64; ++i) st[i] = 0.f;
    } else { const float* h0 = p->state_ssm + ((((size_t)j * DB + b) * 16 + h) * 64 + pp) * 128 + nh * 64;
#pragma unroll
        for (int i = 0; i < 16; ++i) { const f32x4 v = *(const f32x4*)(h0 + 4 * i); st[4 * i] = v.x; st[4 * i + 1] = v.y; st[4 * i + 2] = v.z; st[4 * i + 3] = v.w; } }
    for (int t = 0; t < n; ++t) {
        const int row = row0 + t; const float dt = DT[row * 16 + h], dA = __expf(dt * a), x = XC[(size_t)row * 1536 + h * 64 + pp], cf = dt * x;
        const float* Bp = XC + (size_t)row * 1536 + 1024 + g * 128 + nh * 64; const float* Cp = Bp + 256;
        float y = 0.f;
#pragma unroll
        for (int i = 0; i < 16; ++i) { if ((i & 7) == 0) asm volatile("" ::: "memory");
            const f32x4 bv = *(const f32x4*)(Bp + 4 * i), cv = *(const f32x4*)(Cp + 4 * i);
            st[4 * i] = st[4 * i] * dA + cf * bv.x; st[4 * i + 1] = st[4 * i + 1] * dA + cf * bv.y; st[4 * i + 2] = st[4 * i + 2] * dA + cf * bv.z; st[4 * i + 3] = st[4 * i + 3] * dA + cf * bv.w;
            y += cv.x * st[4 * i] + cv.y * st[4 * i + 1] + cv.z * st[4 * i + 2] + cv.w * st[4 * i + 3]; }
        y += __shfl_xor(y, 32);
        if (nh == 0) Y[(size_t)row * 1024 + h * 64 + pp] = y + Dk * x;
    }
    float* ho = (pr ? p->out + O_HP + ((((size_t)j * NBP + b) * 16 + h) * 64 + pp) * 128 : p->out + O_HS + ((((size_t)j * DB + b) * 16 + h) * 64 + pp) * 128) + nh * 64;
#pragma unroll
    for (int i = 0; i < 16; ++i) *(f32x4*)(ho + 4 * i) = (f32x4){st[4 * i], st[4 * i + 1], st[4 * i + 2], st[4 * i + 3]};
}

DEVI void ph_ssd_gate(CP p, int j, int vb, int nvb) {
    const int TIDX = ltid();
    const float* H = wsf(p, WS_H); const float* Y = wsf(p, WS_Y); bf16* AO = wsb(p, WS_AO); const float* g = p->ssd_g + (size_t)j * 1024;
    const int lane = TIDX & 63, wv = TIDX >> 6;
    for (int row = vb * 8 + wv; row < MR; row += nvb * 8) {
        f32x4 v[4]; float q = 0.f;
#pragma unroll
        for (int i = 0; i < 4; ++i) { const int c = (i * 64 + lane) * 4; const f32x4 y = *(const f32x4*)(Y + (size_t)row * 1024 + c), z = *(const f32x4*)(H + (size_t)row * HC_AB + C_Z + c);
            v[i] = (f32x4){y.x * silu_f(z.x), y.y * silu_f(z.y), y.z * silu_f(z.z), y.w * silu_f(z.w)}; q += (v[i].x * v[i].x + v[i].y * v[i].y) + (v[i].z * v[i].z + v[i].w * v[i].w); }
        const float rs = 1.f / sqrtf(wave_sum(q) * (1.f / 1024.f) + EPS);
#pragma unroll
        for (int i = 0; i < 4; ++i) { const int c = (i * 64 + lane) * 4; const f32x4 gg = *(const f32x4*)(g + c); const f32x4 o = v[i] * rs * gg;
            uint2 w; w.x = pk2(o.x, o.y); w.y = pk2(o.z, o.w); *(uint2*)(AO + (size_t)row * DM + 1024 + c) = w; }
    }
}

DEVI void ph_idx_prompt_naive(CP p, int vb, int nvb, float* sm) {
    const int TIDX = ltid();
    const float* H = wsf(p, WS_H); float* SC = wsf(p, WS_SC);
    const int half = TIDX >> 8, tid = TIDX & 255; float* sq = sm + half * 520; float* sw = sq + 512;
    for (int row0 = vb * 2; row0 < MPR; row0 += nvb * 2) {
        const int row = row0 + half, b = row / SEQ, t = row % SEQ;
        sq[tid] = H[(size_t)row * HC_AB + C_QI + tid]; sq[tid + 256] = H[(size_t)row * HC_AB + C_QI + 256 + tid]; if (tid < 8) sw[tid] = H[(size_t)row * HC_AB + C_WI + tid];
        __syncthreads();
        for (int s = tid; s <= t; s += 256) {
            const float* kr = H + (size_t)(b * SEQ + s) * HC_AB + C_KI; float k[64];
#pragma unroll
            for (int i = 0; i < 16; ++i) { const f32x4 v = *(const f32x4*)(kr + 4 * i); k[4 * i] = v.x; k[4 * i + 1] = v.y; k[4 * i + 2] = v.z; k[4 * i + 3] = v.w; }
            float sc = 0.f;
#pragma unroll 1
            for (int h = 0; h < 8; ++h) { float d = 0.f;
#pragma unroll
                for (int i = 0; i < 64; ++i) d += sq[h * 64 + i] * k[i];
                sc += sw[h] * fmaxf(d, 0.f); }
            SC[(size_t)row * SEQ + s] = sc * IDX_SCALE;
        }
        __syncthreads();
    }
}

DEVI void select_prompt_row(const float* SC, unsigned long long* MASK, int row, int lane) {
    const int t = row % SEQ, nk = t + 1; const float* sc = SC + (size_t)row * SEQ;
    unsigned v[64];
#pragma unroll
    for (int jj = 0; jj < 64; ++jj) { const int key = jj * 64 + lane; v[jj] = key < nk ? ord_f(sc[key]) : 0u; }
    unsigned long long mine = 0ull;
    if (nk <= TOPK) {
#pragma unroll
        for (int jj = 0; jj < 64; ++jj) { const unsigned long long m = __ballot(jj * 64 + lane < nk); if (lane == jj) mine = m; }
    } else {
        unsigned T = 0u;
        for (int bit = 31; bit >= 0; --bit) { const unsigned cand = T | (1u << bit); int cnt = 0;
#pragma unroll
            for (int jj = 0; jj < 64; ++jj) cnt += __popcll(__ballot(v[jj] >= cand));
            if (cnt >= TOPK) T = cand; if (cnt == TOPK) break; }
        int cgt = 0;
#pragma unroll
        for (int jj = 0; jj < 64; ++jj) cgt += __popcll(__ballot(v[jj] > T));
        const int need = TOPK - cgt; int run = 0; const unsigned long long lt = (1ull << lane) - 1ull;
#pragma unroll
        for (int jj = 0; jj < 64; ++jj) { const bool eq = v[jj] == T; const unsigned long long me = __ballot(eq); const int pre = run + __popcll(me & lt);
            const bool sel = (v[jj] > T) || (eq && pre < need); run += __popcll(me); const unsigned long long m = __ballot(sel); if (lane == jj) mine = m; }
    }
    MASK[((size_t)(row >> 5) * 64 + lane) * 32 + (row & 31)] = mine;
}
DEVI void ph_select_prompt(CP p, int vb, int nvb) {
    const int TIDX = ltid();
    const int lane = TIDX & 63, wv = TIDX >> 6;
    for (int row = vb * 8 + wv; row < MPR; row += nvb * 8) select_prompt_row(wsf(p, WS_SC), (unsigned long long*)(p->ws + WS_MASK), row, lane);
}

DEVI void ph_attn_prompt_naive(CP p, int vb, int nvb) {
    const int TIDX = ltid();
    const float* H = wsf(p, WS_H); const unsigned long long* MASK = (const unsigned long long*)(p->ws + WS_MASK); bf16* AO = wsb(p, WS_AO);
    const int h = TIDX >> 6, lane = TIDX & 63, g = h >> 2;
    for (int row = vb; row < MPR; row += nvb) {
        const int b = row / SEQ, t = row % SEQ;
        const float q0 = H[(size_t)row * HC_AB + C_Q + h * 128 + lane], q1 = H[(size_t)row * HC_AB + C_Q + h * 128 + 64 + lane];
        float m = -1e30f, l = 0.f, o0 = 0.f, o1 = 0.f;
        for (int jt = 0; jt <= t / 64; ++jt) {
            unsigned long long w = MASK[((size_t)(row >> 5) * 64 + jt) * 32 + (row & 31)];
            while (w) { const int bit = __builtin_ctzll(w); w &= w - 1ull; const int s = jt * 64 + bit;
                const float* kr = H + (size_t)(b * SEQ + s) * HC_AB + C_K + g * 128; const float* vr = H + (size_t)(b * SEQ + s) * HC_AB + C_V + g * 128;
                const float lg = wave_sum(q0 * kr[lane] + q1 * kr[lane + 64]) * ATT_SCALE;
                const float mn = fmaxf(m, lg), al = __expf(m - mn), pe = __expf(lg - mn);
                l = l * al + pe; o0 = o0 * al + pe * vr[lane]; o1 = o1 * al + pe * vr[lane + 64]; m = mn; }
        }
        const float il = 1.f / l;
        AO[(size_t)row * DM + h * 128 + lane] = f2bf(o0 * il); AO[(size_t)row * DM + h * 128 + 64 + lane] = f2bf(o1 * il);
    }
}

DEVI void idx_sample_unit(CP p, int j, int b, int kb, float* sq  ) {
    const int TIDX = ltid();
    const float* H = wsf(p, WS_H); float* SCS = wsf(p, WS_SCS); const int tid = TIDX;
    for (int i = tid; i < 8 * 512; i += 512) sq[i] = H[(size_t)(MPR + b * DS + (i >> 9)) * HC_AB + C_QI + (i & 511)];
    if (tid < 64) sq[4096 + tid] = H[(size_t)(MPR + b * DS + (tid >> 3)) * HC_AB + C_WI + (tid & 7)];
    __syncthreads();
    const int key = kb * 512 + tid;
    if (key < NKEY_S) {
        const float* kr;
        if (key < PAST) { const int pg = p->page_table[b * NPAGES + key / PAGE]; kr = p->cache_ik + (((size_t)j * NPOOL + pg) * PAGE + key % PAGE) * 64; }
        else kr = H + (size_t)(MPR + b * DS + key - PAST) * HC_AB + C_KI;
        float k[64];
#pragma unroll
        for (int i = 0; i < 16; ++i) { const f32x4 v = *(const f32x4*)(kr + 4 * i); k[4 * i] = v.x; k[4 * i + 1] = v.y; k[4 * i + 2] = v.z; k[4 * i + 3] = v.w; }
#pragma unroll 1
        for (int qi = 0; qi < 8; ++qi) { if (key > PAST + qi) continue; float sc = 0.f;
#pragma unroll 1
            for (int h = 0; h < 8; ++h) { float d = 0.f;
#pragma unroll
                for (int i = 0; i < 64; ++i) d += sq[qi * 512 + h * 64 + i] * k[i];
                sc += sq[4096 + qi * 8 + h] * fmaxf(d, 0.f); }
            SCS[(size_t)(b * DS + qi) * SCS_LD + key] = sc * IDX_SCALE; }
    }
    __syncthreads();
}

DEVI void select_sample_unit(CP p, int q, int* red  ) {
    const int TIDX = ltid();
    const float* sc = wsf(p, WS_SCS) + (size_t)q * SCS_LD; int* SELS = (int*)(p->ws + WS_SELS) + q * TOPK;
    const int tid = TIDX, lane = tid & 63, wv = tid >> 6, nk = PAST + (q % DS) + 1;
    unsigned v[33];
#pragma unroll
    for (int jj = 0; jj < 33; ++jj) { const int key = jj * 512 + tid; v[jj] = key < nk ? ord_f(sc[key]) : 0u; }
    unsigned T = 0u; int par = 0;
    for (int bit = 31; bit >= 0; --bit) { const unsigned cand = T | (1u << bit); int cnt = 0;
#pragma unroll
        for (int jj = 0; jj < 33; ++jj) cnt += __popcll(__ballot(v[jj] >= cand));
        if (lane == 0) red[par * 8 + wv] = cnt; __syncthreads();
        int tot = 0;
#pragma unroll
        for (int w = 0; w < 8; ++w) tot += red[par * 8 + w];
        par ^= 1;
        if (tot >= TOPK) T = cand; if (tot == TOPK) break; }
    __syncthreads();
    int* cg = red + 16; int* ce = cg + 33 * 8; int* pg = ce + 33 * 8; int* pe = pg + 33 * 8;
#pragma unroll
    for (int jj = 0; jj < 33; ++jj) { const int a = __popcll(__ballot(v[jj] > T)), e = __popcll(__ballot(v[jj] == T)); if (lane == 0) { cg[jj * 8 + wv] = a; ce[jj * 8 + wv] = e; } }
    __syncthreads();
    if (tid < 33 * 8) { int a = 0, e = 0; for (int i = 0; i < tid; ++i) { a += cg[i]; e += ce[i]; } pg[tid] = a; pe[tid] = e; }
    if (tid == 0) { int a = 0; for (int i = 0; i < 33 * 8; ++i) a += cg[i]; red[0] = a; }
    __syncthreads();
    const int need = TOPK - red[0]; const unsigned long long lt = (1ull << lane) - 1ull;
#pragma unroll
    for (int jj = 0; jj < 33; ++jj) {
        const bool gt = v[jj] > T, eq = v[jj] == T; const unsigned long long me = __ballot(eq), mg = __ballot(gt);
        const int epre = pe[jj * 8 + wv] + __popcll(me & lt), gpre = pg[jj * 8 + wv] + __popcll(mg & lt); const bool sel = gt || (eq && epre < need);
        const int ebc = epre < need ? epre : need;
        if (sel) SELS[gpre + ebc] = jj * 512 + tid;
    }
    __syncthreads();
}

DEVI void attn_sample_unit(CP p, int j, int q) {
    const int TIDX = ltid();
    const float* H = wsf(p, WS_H); const int* SELS = (const int*)(p->ws + WS_SELS) + q * TOPK; bf16* AO = wsb(p, WS_AO);
    const int row = MPR + q, b = q / DS, h = TIDX >> 6, lane = TIDX & 63, g = h >> 2;
    const float q0 = H[(size_t)row * HC_AB + C_Q + h * 128 + lane], q1 = H[(size_t)row * HC_AB + C_Q + h * 128 + 64 + lane];
    float m = -1e30f, l = 0.f, o0 = 0.f, o1 = 0.f;
    for (int i = 0; i < TOPK; ++i) { const int s = SELS[i]; const float *kr, *vr;
        if (s < PAST) { const int pg = p->page_table[b * NPAGES + s / PAGE]; const size_t o = ((((size_t)j * NPOOL + pg) * PAGE + s % PAGE) * 2 + g) * 128; kr = p->cache_k + o; vr = p->cache_v + o; }
        else { const size_t o = (size_t)(MPR + b * DS + s - PAST) * HC_AB + g * 128; kr = H + o + C_K; vr = H + o + C_V; }
        const float lg = wave_sum(q0 * kr[lane] + q1 * kr[lane + 64]) * ATT_SCALE;
        const float mn = fmaxf(m, lg), al = __expf(m - mn), pe = __expf(lg - mn);
        l = l * al + pe; o0 = o0 * al + pe * vr[lane]; o1 = o1 * al + pe * vr[lane + 64]; m = mn; }
    const float il = 1.f / l;
    AO[(size_t)row * DM + h * 128 + lane] = f2bf(o0 * il); AO[(size_t)row * DM + h * 128 + 64 + lane] = f2bf(o1 * il);
}

DEVI void ph_cd_prep(CP p, int j, int vb, int nvb) {
    const int TIDX = ltid();
    const float* H = wsf(p, WS_H); bf16* DD = wsb(p, WS_DD); bf16* U = wsb(p, WS_U); bf16* VLN = wsb(p, WS_VLN);
    const float* lg = p->sgu_ln_g + (size_t)j * 1024; const float* lb = p->sgu_ln_b + (size_t)j * 1024;
    const int lane = TIDX & 63, wv = TIDX >> 6;
    for (int row = vb * 8 + wv; row < MR; row += nvb * 8) {
        const bool pr = row < MPR; const int b = pr ? row / SEQ : (row - MPR) / DS, t = pr ? row % SEQ : (row - MPR) % DS;
        const float* h = H + (size_t)row * HC_CD;
#pragma unroll 1
        for (int i = 0; i < 4; ++i) { const int c = i * 256 + lane * 4, w = 2 << i; const f32x4 cur = *(const f32x4*)(h + c); f32x4 s = cur; int cnt;
            if (pr) { cnt = (t + 1 < w) ? t + 1 : w; for (int u = 1; u < cnt; ++u) s += *(const f32x4*)(H + (size_t)(row - u) * HC_CD + c); }
            else { cnt = w; for (int u = 1; u < w; ++u) { const int e = 15 + t - u;
                    s += (e >= 15) ? *(const f32x4*)(H + (size_t)(MPR + b * DS + e - 15) * HC_CD + c) : *(const f32x4*)(p->state_pool + (((size_t)j * DB + b) * 15 + e) * 1024 + c); } }
            const float ic = 1.f / (float)cnt; const f32x4 d = s * ic - cur; uint2 o; o.x = pk2(d.x, d.y); o.y = pk2(d.z, d.w); *(uint2*)(DD + (size_t)row * 1024 + c) = o;
            if (pr) { if (t >= SEQ - 15) *(f32x4*)(p->out + O_PP + (((size_t)j * NBP + b) * 15 + (t - (SEQ - 15))) * 1024 + c) = cur; }
            else { *(f32x4*)(p->out + O_PS + (((size_t)j * DB + b) * 15 + 7 + t) * 1024 + c) = cur;
                   if (t == 0) for (int e = 0; e < 7; ++e) *(f32x4*)(p->out + O_PS + (((size_t)j * DB + b) * 15 + e) * 1024 + c) = *(const f32x4*)(p->state_pool + (((size_t)j * DB + b) * 15 + 8 + e) * 1024 + c); }
        }
        asm volatile("" ::: "memory");
#pragma unroll
        for (int i = 0; i < 4; ++i) { const int c = (i * 64 + lane) * 4; const f32x4 u = *(const f32x4*)(h + 1024 + c); uint2 o; o.x = pk2(gelu_f(u.x), gelu_f(u.y)); o.y = pk2(gelu_f(u.z), gelu_f(u.w)); *(uint2*)(U + (size_t)row * 1024 + c) = o; }
        asm volatile("" ::: "memory");
        f32x4 v[4]; float s = 0.f;
#pragma unroll
        for (int i = 0; i < 4; ++i) { const int c = (i * 64 + lane) * 4; const f32x4 x = *(const f32x4*)(h + 2048 + c); v[i] = (f32x4){gelu_f(x.x), gelu_f(x.y), gelu_f(x.z), gelu_f(x.w)}; s += (v[i].x + v[i].y) + (v[i].z + v[i].w); }
        const float mean = wave_sum(s) * (1.f / 1024.f); float q = 0.f;
#pragma unroll
        for (int i = 0; i < 4; ++i) { v[i] = v[i] - mean; q += (v[i].x * v[i].x + v[i].y * v[i].y) + (v[i].z * v[i].z + v[i].w * v[i].w); }
        const float rstd = 1.f / sqrtf(wave_sum(q) * (1.f / 1024.f) + EPS);
#pragma unroll
        for (int i = 0; i < 4; ++i) { const int c = (i * 64 + lane) * 4; const f32x4 y = v[i] * rstd * *(const f32x4*)(lg + c) + *(const f32x4*)(lb + c);
            uint2 o; o.x = pk2(y.x, y.y); o.y = pk2(y.z, y.w); *(uint2*)(VLN + (size_t)row * 1024 + c) = o;
            if (!pr) *(f32x4*)(p->out + O_GS + ((size_t)j * MSR + (row - MPR)) * 1024 + c) = y; }
    }
}

DEVI void ph_sgu_naive(CP p, int j, int vb, int nvb) {
    const int TIDX = ltid();
    const bf16* VLN = wsb(p, WS_VLN); const bf16* U = wsb(p, WS_U); bf16* AO = wsb(p, WS_AO);
    for (int row = vb; row < MR; row += nvb) {
        const bool pr = row < MPR; const int t = pr ? row % SEQ : (row - MPR) % DS;
        const int tt = pr ? (t & 127) : t, base = row - tt;
        for (int d = TIDX; d < 1024; d += 512) { const int g = d >> 8; const float* w = p->sgu_w + (((size_t)j * 4 + g) * 128 + tt) * 128;
            float acc = p->sgu_b[((size_t)j * 4 + g) * 128 + tt];
            for (int s = 0; s <= tt; ++s) acc += w[s] * bf2f(VLN[(size_t)(base + s) * 1024 + d]);
            AO[(size_t)row * DM + 1024 + d] = f2bf(bf2f(U[(size_t)row * 1024 + d]) * acc); }
    }
}

namespace pg8 {
#define PG8_LAS __attribute__((address_space(3)))
typedef unsigned short bf16_t;
typedef short bf16x8 __attribute__((ext_vector_type(8)));
typedef float f32x4 __attribute__((ext_vector_type(4)));
typedef unsigned u32x4 __attribute__((ext_vector_type(4)));
constexpr int BM = 256, BK = 64, HALF = 128, HTB = HALF * BK * 2  , STAGE_BYTES = 8 * HTB, NXCD = 8, WGM = 8;

__host__ __device__ __forceinline__ int lds_byte(int r, int c) { const int st = (r >> 4) * 2 + (c >> 5), rr = r & 15, cc = c & 31, ob = rr * 64 + cc * 2; return st * 1024 + (ob ^ (((ob >> 9) & 1) << 5)); }
__host__ __device__ __forceinline__ void stage_rc(int b, int& R, int& C) { const int st = b / 1024, sb = b % 1024, swz = sb ^ (((sb >> 9) & 1) << 5); R = (st >> 1) * 16 + swz / 64; C = (st & 1) * 32 + (swz % 64) / 2; }
__host__ __device__ __forceinline__ int perm32(int rho) { const int n = rho >> 4, i = rho & 15; return 8 * (i >> 2) + 4 * n + (i & 3); }

struct Unit { int pm, pn; };
struct Gemm { const bf16_t* A; const bf16_t* Bt; int M, N, K, lda, ldb, acol; };

struct StaticOrder {
    int nM, nN, nwg, G, c;
    __host__ __device__ void init(int M, int N, int G_, int c_) { nM = M / BM; nN = N / BM; nwg = nM * nN; G = G_; c = c_; }
    __host__ __device__ bool next(int i, Unit& u) const {
        const long L = (long)i * G + c; if (L >= nwg) return false;
        int wgid = (int)L; { const int q = nwg / NXCD, r = nwg % NXCD, xcd = wgid % NXCD, off = wgid / NXCD; wgid = (xcd < r ? xcd * (q + 1) : r * (q + 1) + (xcd - r) * q) + off; }
        const int nig = WGM * nN, gid = wgid / nig, fm = gid * WGM, gsz = (nM - fm) < WGM ? (nM - fm) : WGM;
        u.pm = fm + ((wgid % nig) % gsz); u.pn = (wgid % nig) / gsz; return true;
    }
    __device__ __forceinline__ void a_ready(const Unit&) const {}
    __device__ __forceinline__ void done(const Unit&) const {}
};

template <class Epi, class Sched, bool ALIGN_EPI = false, bool SP2 = false>
__device__ __forceinline__ void gemm_phase(PG8_LAS unsigned char* lds, const Gemm g, const Sched& S, const Epi& E) {
    int tid_ = threadIdx.x; asm volatile("" : "+v"(tid_)); const int tid = tid_, wid = __builtin_amdgcn_readfirstlane(tid >> 6), lane = tid & 63, wr = wid >> 2, wc = wid & 3, fr = lane & 15, fq = lane >> 4;
    const int K = g.K, nt = K / BK;
    unsigned voffA[2], voffB[2];
#pragma unroll
    for (int i = 0; i < 2; ++i) { int R, C; stage_rc(tid * 16 + i * 8192, R, C); const int Rb = Epi::PERM ? ((R & ~31) + perm32(R & 31)) : R;
        voffA[i] = (unsigned)(R * g.lda + C) * 2u; voffB[i] = (unsigned)(Rb * g.ldb + C) * 2u; }
    const size_t kstep = (size_t)(BK * 2);
    const size_t hstepA = (size_t)HALF * g.lda * 2, hstepB = (size_t)HALF * g.ldb * 2;
    const size_t tstepA = 2 * hstepA, tstepB = 2 * hstepB, acolB = (size_t)g.acol * 2;
    const unsigned ldsw = (unsigned)wid * 1024u;
    const int aoff = lds_byte(wr * 64 + fr, fq * 8), boff = lds_byte(wc * 32 + fr, fq * 8);
#define PG8_SA(b, h) (((b) * 2 + (h)) * HTB)
#define PG8_SB(b, h) ((4 + (b) * 2 + (h)) * HTB)
#define PG8_STAGE(bufoff, gbase, voff) do { _Pragma("unroll") for (int _i = 0; _i < 2; ++_i) \
        __builtin_amdgcn_global_load_lds((const unsigned*)((const char*)(gbase) + (voff)[_i]), (PG8_LAS unsigned*)(lds + (bufoff) + ldsw + _i * 8192), 16, 0, 0); } while (0)
#define PG8_LDA(dst, b, h) do { _Pragma("unroll") for (int m = 0; m < 4; ++m) _Pragma("unroll") for (int k = 0; k < 2; ++k) dst[m][k] = *(const PG8_LAS bf16x8*)(lds + PG8_SA(b, h) + aoff + m * 2048 + k * 1024); } while (0)
#define PG8_LDB(dst, b, h) do { _Pragma("unroll") for (int n = 0; n < 2; ++n) _Pragma("unroll") for (int k = 0; k < 2; ++k) dst[n][k] = *(const PG8_LAS bf16x8*)(lds + PG8_SB(b, h) + boff + n * 2048 + k * 1024); } while (0)
#define PG8_MMA(ai, bj, At, Bt) do { __builtin_amdgcn_s_setprio(1); _Pragma("unroll") for (int m = 0; m < 4; ++m) _Pragma("unroll") for (int n = 0; n < 2; ++n) _Pragma("unroll") for (int k = 0; k < 2; ++k) \
        acc[ai][bj][m][n] = __builtin_amdgcn_mfma_f32_16x16x32_bf16(Bt[n][k], At[m][k], acc[ai][bj][m][n], 0, 0, 0); __builtin_amdgcn_s_setprio(0); } while (0)
#define PG8_WAIT_V(n) asm volatile("s_waitcnt vmcnt(" #n ")" ::: "memory")
#define PG8_WAIT_L(n) asm volatile("s_waitcnt lgkmcnt(" #n ")" ::: "memory")
#define PG8_BAR __builtin_amdgcn_s_barrier()
#define PG8_SCHED __builtin_amdgcn_sched_barrier(0)
    Unit cur, nxt; int ui = 0;
    if (!S.next(0, cur)) return;
    f32x4 acc[2][2][4][2];
#pragma unroll
    for (int a = 0; a < 2; ++a)
#pragma unroll
        for (int b = 0; b < 2; ++b)
#pragma unroll
            for (int m = 0; m < 4; ++m)
#pragma unroll
                for (int n = 0; n < 2; ++n) acc[a][b][m][n] = (f32x4){0.f, 0.f, 0.f, 0.f};
    bf16x8 At[4][2], B0[2][2], B1[2][2];
    const char* cA = (const char*)g.A + (size_t)cur.pm * tstepA + (size_t)cur.pn * acolB; const char* cB = (const char*)g.Bt + (size_t)cur.pn * tstepB;
    S.a_ready(cur);
    if constexpr (SP2) {
        PG8_STAGE(PG8_SB(0, 0), cB, voffB); PG8_STAGE(PG8_SB(0, 1), cB + hstepB, voffB); PG8_STAGE(PG8_SA(0, 0), cA, voffA); PG8_STAGE(PG8_SA(0, 1), cA + hstepA, voffA);
        if (wr == 1) PG8_BAR;
        PG8_WAIT_V(2); PG8_BAR;
        PG8_STAGE(PG8_SB(1, 0), cB + kstep, voffB); PG8_STAGE(PG8_SA(1, 0), cA + kstep, voffA); PG8_STAGE(PG8_SB(1, 1), cB + hstepB + kstep, voffB);
        PG8_WAIT_V(6); PG8_BAR;
    } else {
        PG8_STAGE(PG8_SB(0, 0), cB, voffB); PG8_STAGE(PG8_SA(0, 0), cA, voffA); PG8_STAGE(PG8_SB(0, 1), cB + hstepB, voffB); PG8_STAGE(PG8_SA(0, 1), cA + hstepA, voffA);
        if (wr == 1) PG8_BAR;
        PG8_WAIT_V(4); PG8_BAR;
        PG8_STAGE(PG8_SB(1, 0), cB + kstep, voffB); PG8_STAGE(PG8_SA(1, 0), cA + kstep, voffA); PG8_STAGE(PG8_SB(1, 1), cB + hstepB + kstep, voffB);
        PG8_WAIT_V(6); PG8_BAR;
    }
    for (;;) {
        const bool has_next = S.next(ui + 1, nxt);
        const char* nA = has_next ? (const char*)g.A + (size_t)nxt.pm * tstepA + (size_t)nxt.pn * acolB : cA; const char* nB = has_next ? (const char*)g.Bt + (size_t)nxt.pn * tstepB : cB;
        for (int t = 0; t < nt; t += 2) {
            const bool last = (t == nt - 2);
            const char* a1 = cA + (size_t)(t + 1) * kstep;
            const char* a2 = last ? nA : cA + (size_t)(t + 2) * kstep; const char* b2 = last ? nB : cB + (size_t)(t + 2) * kstep;
            const char* a3 = a2 + kstep; const char* b3 = b2 + kstep;
            if (last && has_next) S.a_ready(nxt);
            if constexpr (SP2) {
            PG8_LDB(B0, 0, 0); PG8_LDB(B1, 0, 1); PG8_SCHED; PG8_LDA(At, 0, 0); PG8_STAGE(PG8_SA(1, 1), a1 + hstepA, voffA);
            PG8_WAIT_V(8); PG8_WAIT_L(0); PG8_BAR; PG8_MMA(0, 0, At, B0); PG8_MMA(0, 1, At, B1); PG8_BAR; PG8_SCHED;
            PG8_LDA(At, 0, 1); PG8_STAGE(PG8_SB(0, 0), b2, voffB); PG8_STAGE(PG8_SB(0, 1), b2 + hstepB, voffB); PG8_STAGE(PG8_SA(0, 0), a2, voffA);
            PG8_WAIT_V(8); PG8_WAIT_L(0); PG8_BAR; PG8_MMA(1, 0, At, B0); PG8_MMA(1, 1, At, B1); PG8_BAR; PG8_SCHED;
            PG8_LDB(B0, 1, 0); PG8_LDB(B1, 1, 1); PG8_SCHED; PG8_LDA(At, 1, 0); PG8_STAGE(PG8_SA(0, 1), a2 + hstepA, voffA);
            PG8_WAIT_V(8); PG8_WAIT_L(0); PG8_BAR; PG8_MMA(0, 0, At, B0); PG8_MMA(0, 1, At, B1); PG8_BAR; PG8_SCHED;
            PG8_LDA(At, 1, 1); PG8_STAGE(PG8_SB(1, 0), b3, voffB); PG8_STAGE(PG8_SB(1, 1), b3 + hstepB, voffB); PG8_STAGE(PG8_SA(1, 0), a3, voffA);
            PG8_WAIT_V(8); PG8_WAIT_L(0); PG8_BAR; PG8_MMA(1, 0, At, B0); PG8_MMA(1, 1, At, B1); PG8_BAR; PG8_SCHED;
            } else {
            PG8_LDB(B0, 0, 0); PG8_SCHED; PG8_LDA(At, 0, 0); PG8_STAGE(PG8_SA(1, 1), a1 + hstepA, voffA);
            PG8_WAIT_L(8); PG8_BAR; PG8_WAIT_L(0); PG8_MMA(0, 0, At, B0); PG8_BAR; PG8_SCHED;
            PG8_LDB(B1, 0, 1); PG8_STAGE(PG8_SB(0, 0), b2, voffB);
            PG8_BAR; PG8_WAIT_L(0); PG8_MMA(0, 1, At, B1); PG8_BAR;
            PG8_LDA(At, 0, 1); PG8_STAGE(PG8_SA(0, 0), a2, voffA);
            PG8_BAR; PG8_WAIT_L(0); PG8_MMA(1, 0, At, B0); PG8_BAR; PG8_SCHED;
            PG8_STAGE(PG8_SB(0, 1), b2 + hstepB, voffB);
            PG8_WAIT_V(6); PG8_BAR; PG8_MMA(1, 1, At, B1); PG8_BAR;
            PG8_LDB(B0, 1, 0); PG8_SCHED; PG8_LDA(At, 1, 0); PG8_STAGE(PG8_SA(0, 1), a2 + hstepA, voffA);
            PG8_WAIT_L(8); PG8_BAR; PG8_WAIT_L(0); PG8_MMA(0, 0, At, B0); PG8_BAR; PG8_SCHED;
            PG8_LDB(B1, 1, 1); PG8_STAGE(PG8_SB(1, 0), b3, voffB);
            PG8_BAR; PG8_WAIT_L(0); PG8_MMA(0, 1, At, B1); PG8_BAR;
            PG8_LDA(At, 1, 1); PG8_STAGE(PG8_SA(1, 0), a3, voffA);
            PG8_BAR; PG8_WAIT_L(0); PG8_MMA(1, 0, At, B0); PG8_BAR; PG8_SCHED;
            PG8_STAGE(PG8_SB(1, 1), b3 + hstepB, voffB);
            PG8_WAIT_V(6); PG8_BAR; PG8_MMA(1, 1, At, B1); PG8_BAR;
            }
        }
        if constexpr (ALIGN_EPI) { if (wr == 0) PG8_BAR; }
        if constexpr (!Epi::AFTER_DRAIN) { E(acc, cur, wr, wc, fr, fq); S.done(cur); }
        if (!has_next) break;
#pragma unroll
        for (int a = 0; a < 2; ++a)
#pragma unroll
            for (int b = 0; b < 2; ++b)
#pragma unroll
                for (int m = 0; m < 4; ++m)
#pragma unroll
                    for (int n = 0; n < 2; ++n) acc[a][b][m][n] = (f32x4){0.f, 0.f, 0.f, 0.f};
        cur = nxt; cA = nA; cB = nB; ++ui;
        if constexpr (ALIGN_EPI) { if (wr == 1) PG8_BAR; }
    }
    PG8_WAIT_V(0);
    if constexpr (!ALIGN_EPI) { if (wr == 0) PG8_BAR; }
    PG8_BAR;
    if constexpr (Epi::AFTER_DRAIN) { E.fused(acc, cur, wr, wc, fr, fq, lds, wid, lane); S.done(cur); }
#undef PG8_SA
#undef PG8_SB
#undef PG8_STAGE
#undef PG8_LDA
#undef PG8_LDB
#undef PG8_MMA
#undef PG8_WAIT_V
#undef PG8_WAIT_L
#undef PG8_BAR
#undef PG8_SCHED
}
}
namespace pg8 {
__device__ __forceinline__ unsigned cvt_pk_bf16(float lo, float hi) { unsigned r; asm volatile("v_cvt_pk_bf16_f32 %0, %1, %2" : "=v"(r) : "v"(lo), "v"(hi)); return r; }
struct EpiF32 {
    static constexpr bool PERM = false, AFTER_DRAIN = false;
    float* C; int ldc;
    __device__ __forceinline__ void operator()(const f32x4 (&acc)[2][2][4][2], const Unit& u, int wr, int wc, int, int) const {
        int ln_ = threadIdx.x & 63; asm volatile("" : "+v"(ln_)); const int fr = ln_ & 15, fq = ln_ >> 4;
        const int row0 = u.pm * BM + wr * 64 + fr, col0 = u.pn * BM + wc * 32 + 4 * fq;
#pragma unroll
        for (int ai = 0; ai < 2; ++ai)
#pragma unroll
            for (int m = 0; m < 4; ++m) { float* rowp = C + (size_t)(row0 + ai * HALF + m * 16) * ldc + col0;
#pragma unroll
                for (int bj = 0; bj < 2; ++bj)
#pragma unroll
                    for (int n = 0; n < 2; ++n) *(f32x4*)(rowp + bj * HALF + n * 16) = acc[ai][bj][m][n]; }
    }
};
struct EpiResid {
    static constexpr bool PERM = false, AFTER_DRAIN = false;
    float* X; int ldc; float alpha;
    __device__ __forceinline__ void operator()(const f32x4 (&acc)[2][2][4][2], const Unit& u, int wr, int wc, int, int) const {
        int ln_ = threadIdx.x & 63; asm volatile("" : "+v"(ln_)); const int fr = ln_ & 15, fq = ln_ >> 4;
        const int row0 = u.pm * BM + wr * 64 + fr, col0 = u.pn * BM + wc * 32 + 4 * fq;
#pragma unroll
        for (int ai = 0; ai < 2; ++ai)
#pragma unroll
            for (int m = 0; m < 4; ++m) { float* rowp = X + (size_t)(row0 + ai * HALF + m * 16) * ldc + col0;
#pragma unroll
                for (int bj = 0; bj < 2; ++bj) { const f32x4 o0 = *(const f32x4*)(rowp + bj * HALF), o1 = *(const f32x4*)(rowp + bj * HALF + 16);
                    *(f32x4*)(rowp + bj * HALF) = o0 * alpha + acc[ai][bj][m][0]; *(f32x4*)(rowp + bj * HALF + 16) = o1 * alpha + acc[ai][bj][m][1];
                    asm volatile("" ::: "memory"); } }
    }
};
template <int ACT  > struct EpiBf16 {
    static constexpr bool PERM = true, AFTER_DRAIN = false;
    bf16_t* O; int ldc; const float* scale;
    __device__ __forceinline__ void operator()(const f32x4 (&acc)[2][2][4][2], const Unit& u, int wr, int wc, int, int) const {
        int ln_ = threadIdx.x & 63; asm volatile("" : "+v"(ln_)); const int fr = ln_ & 15, fq = ln_ >> 4;
        const int row0 = u.pm * BM + wr * 64 + fr, col0 = u.pn * BM + wc * 32 + 8 * fq;
        f32x4 sv[2][2];
#pragma unroll
        for (int bj = 0; bj < 2; ++bj)
#pragma unroll
            for (int n = 0; n < 2; ++n) sv[bj][n] = (ACT == 0) ? *(const f32x4*)(scale + col0 + bj * HALF + 4 * n) : (f32x4){1.f, 1.f, 1.f, 1.f};
#pragma unroll
        for (int ai = 0; ai < 2; ++ai)
#pragma unroll
            for (int m = 0; m < 4; ++m) { bf16_t* rowp = O + (size_t)(row0 + ai * HALF + m * 16) * ldc + col0;
#pragma unroll
                for (int bj = 0; bj < 2; ++bj) { f32x4 v0 = acc[ai][bj][m][0], v1 = acc[ai][bj][m][1];
                    if (ACT == 0) { v0 = v0 * sv[bj][0]; v1 = v1 * sv[bj][1]; }
                    if (ACT == 1) {
#pragma unroll
                        for (int q = 0; q < 4; ++q) { const float a = fmaxf(v0[q], 0.f), b = fmaxf(v1[q], 0.f); v0[q] = a * a; v1[q] = b * b; } }
                    u32x4 w; w.x = cvt_pk_bf16(v0[0], v0[1]); w.y = cvt_pk_bf16(v0[2], v0[3]); w.z = cvt_pk_bf16(v1[0], v1[1]); w.w = cvt_pk_bf16(v1[2], v1[3]);
                    *(u32x4*)(rowp + bj * HALF) = w; } }
    }
};
}
#define LAS __attribute__((address_space(3)))
#define XB_TMO      128
#define XB_XCNT(j)  (256  + 64 * (j))
#define XB_XSUB(j)  (1280 + 64 * (j))
#define XB_XGEN(j)  (2304 + 64 * (j))
#define XB_TOP      3328
#define XB_TOPGEN   3392
#define XCD_BAR_WORDS 3456
#define XB_SPIN_CAP (1u << 18)

__device__ __forceinline__ unsigned xb_ld(unsigned* p)              { return __hip_atomic_load(p, __ATOMIC_RELAXED, __HIP_MEMORY_SCOPE_AGENT); }
__device__ __forceinline__ unsigned xb_add(unsigned* p, unsigned v) { return __hip_atomic_fetch_add(p, v, __ATOMIC_RELAXED, __HIP_MEMORY_SCOPE_AGENT); }
__device__ __forceinline__ unsigned xb_xcc_id() { return (unsigned)__builtin_amdgcn_s_getreg((3 << 11) | 20) & 0xFu; }
#define XB_SPIN(cond, bar) do { unsigned _sp = 0; while (cond) { __builtin_amdgcn_s_sleep(1); \
    if ((++_sp & 255u) == 0u) { if (xb_ld(&(bar)[XB_TMO])) break; if (_sp > XB_SPIN_CAP) { atomicAdd(&(bar)[XB_TMO], 1u); break; } } } } while (0)

struct XcdBarrier {
    unsigned* bar; unsigned x;
    volatile LAS unsigned* st;
};

__device__ __forceinline__ XcdBarrier xcd_barrier_post(unsigned* bar, volatile LAS unsigned* st) {
    XcdBarrier b; b.bar = bar; b.x = xb_xcc_id(); b.st = st;
    if (threadIdx.x == 0) (void)xb_add(&bar[XB_XCNT(b.x)], 1u);
    return b;
}
__device__ __forceinline__ void xcd_barrier_complete(unsigned* bar, unsigned x, unsigned& nloc, unsigned& nx) {
    const unsigned G = gridDim.x * gridDim.y * gridDim.z;
    unsigned sum, cnt, mine, sp = 0u;
    for (;;) {
        sum = 0u; cnt = 0u; mine = 0u;
#pragma unroll
        for (unsigned j = 0; j < 16; ++j) { const unsigned c = xb_ld(&bar[XB_XCNT(j)]); sum += c; cnt += (c > 0u) ? 1u : 0u; mine = (j == x) ? c : mine; }
        if (sum == G) break;
        __builtin_amdgcn_s_sleep(1);
        if ((++sp & 255u) == 0u) { if (xb_ld(&bar[XB_TMO])) break; if (sp > XB_SPIN_CAP) { atomicAdd(&bar[XB_TMO], 1u); break; } }
    }
    nloc = mine > 0u ? mine : 1u; nx = cnt > 0u ? cnt : 1u;
}

__device__ __attribute__((noinline)) void xcd_barrier_impl(unsigned* bar_, unsigned bx_, volatile LAS unsigned* st_) {
    XcdBarrier b; b.bar = bar_; b.x = bx_; b.st = st_;
    asm volatile("s_waitcnt vmcnt(0)" ::: "memory");
    __syncthreads();
    if (threadIdx.x == 0) {
        unsigned* bar = b.bar;
        __builtin_amdgcn_s_waitcnt(0);
        unsigned nloc = b.st[0], nx = b.st[1];
        if (nloc == 0u) { xcd_barrier_complete(bar, b.x, nloc, nx); b.st[0] = nloc; b.st[1] = nx; }
        const unsigned old = xb_add(&bar[XB_XSUB(b.x)], 1u);
        const unsigned gen = old / nloc;
        if (old + 1u == (gen + 1u) * nloc) {
            __builtin_amdgcn_fence(__ATOMIC_RELEASE, "agent");
            asm volatile("s_waitcnt vmcnt(0)" ::: "memory");
            const unsigned og = xb_add(&bar[XB_TOP], 1u);
            const unsigned tg = og / nx;
            if (og + 1u == (tg + 1u) * nx) xb_add(&bar[XB_TOPGEN], 1u);
            else XB_SPIN(xb_ld(&bar[XB_TOPGEN]) == tg, bar);
            __builtin_amdgcn_fence(__ATOMIC_ACQUIRE, "agent");
            xb_add(&bar[XB_XGEN(b.x)], 1u);
            asm volatile("s_waitcnt vmcnt(0)" ::: "memory");
        } else {
            XB_SPIN(xb_ld(&bar[XB_XGEN(b.x)]) == gen, bar);
            __builtin_amdgcn_fence(__ATOMIC_ACQUIRE, "agent");
            asm volatile("s_waitcnt vmcnt(0)" ::: "memory");
        }
    }
    __syncthreads();
}
__device__ __forceinline__ void xcd_barrier(const XcdBarrier& b) { xcd_barrier_impl(b.bar, b.x, b.st); }
constexpr int NWAVES = 8;
constexpr int RING_BYTES = 131072, LDSCTL_OFF = RING_BYTES, MISC_OFF = LDSCTL_OFF + 320, LDS_BYTES = 147456;
constexpr size_t CTL_ZERO_BYTES = 1u << 20;
constexpr int CW_BAR = 4096;
constexpr int PH_PER_LAYER = 12, N_PHASES = 1 + 4 * PH_PER_LAYER;

DEVI void tr_job(const float* W, int K, int N, bf16* WT, int abmap, int vb, int nvb, float* t) {
    const int units = (K / 64) * ((N + 63) / 64);
    for (int u = vb; u < units; u += nvb) transpose_unit(W, K, N, WT, abmap, u, t);
}
DEVI void ph_prologue(CP p, int vb, int nvb, float* t) {
    bf16 *WINAB = wsb(p, WS_WINAB), *WOUTAB = wsb(p, WS_WOUTAB), *WINCD = wsb(p, WS_WINCD), *WOUTCD = wsb(p, WS_WOUTCD), *WFF1 = wsb(p, WS_WFF1), *WFF2 = wsb(p, WS_WFF2), *POOLW = wsb(p, WS_POOLW);
    for (int j = 0; j < 2; ++j) {
        tr_job(p->w_in_ab + (size_t)j * DM * 4696, DM, 4696, WINAB + (size_t)j * HC_AB * DM, 1, vb, nvb, t);
        tr_job(p->w_out_ab + (size_t)j * DM * DM, DM, DM, WOUTAB + (size_t)j * DM * DM, 0, vb, nvb, t);
        tr_job(p->w_in_cd + (size_t)j * DM * HC_CD, DM, HC_CD, WINCD + (size_t)j * HC_CD * DM, 0, vb, nvb, t);
        tr_job(p->w_out_cd + (size_t)j * DM * DM, DM, DM, WOUTCD + (size_t)j * DM * DM, 0, vb, nvb, t);
        tr_job(p->pool_w + (size_t)j * 4 * 65536, 256, 256, POOLW + (size_t)j * 4 * 65536, 0, vb, nvb, t);
        tr_job(p->pool_w + ((size_t)j * 4 + 1) * 65536, 256, 256, POOLW + ((size_t)j * 4 + 1) * 65536, 0, vb, nvb, t);
        tr_job(p->pool_w + ((size_t)j * 4 + 2) * 65536, 256, 256, POOLW + ((size_t)j * 4 + 2) * 65536, 0, vb, nvb, t);
        tr_job(p->pool_w + ((size_t)j * 4 + 3) * 65536, 256, 256, POOLW + ((size_t)j * 4 + 3) * 65536, 0, vb, nvb, t);
    }
    for (int i = 0; i < 4; ++i) {
        tr_job(p->w_ff1 + (size_t)i * DM * DFF, DM, DFF, WFF1 + (size_t)i * DFF * DM, 0, vb, nvb, t);
        tr_job(p->w_ff2 + (size_t)i * DFF * DM, DFF, DM, WFF2 + (size_t)i * DM * DFF, 0, vb, nvb, t);
    }
    const size_t gt = (size_t)vb * 512 + ltid(), ng = (size_t)nvb * 512;
    for (size_t i = gt; i < (size_t)2 * (HC_AB - 4696) * DM / 8; i += ng) { const size_t per = (size_t)(HC_AB - 4696) * DM / 8; const size_t j = i / per, r = i % per;
        *(u32x4*)(WINAB + j * HC_AB * DM + (size_t)4696 * DM + r * 8) = (u32x4){0u, 0u, 0u, 0u}; }
    bf16* sw = wsb(p, WS_SGUW);
    for (size_t i = gt; i < 2 * 4 * 128 * 128; i += ng) { const int s = (int)i & 127, tt = ((int)i >> 7) & 127; sw[i] = f2bf(s <= tt ? p->sgu_w[i] : 0.f); }
    float* X = wsf(p, WS_X); bf16* XB = wsb(p, WS_XB);
    for (size_t i = gt; i < (size_t)MP * DM / 4; i += ng) {
        const size_t e = i * 4; const int row = (int)(e / DM);
        f32x4 v = (f32x4){0.f, 0.f, 0.f, 0.f};
        if (row < MPR) v = *(const f32x4*)(p->x_prompt + e); else if (row < MR) v = *(const f32x4*)(p->x_sample + (e - (size_t)MPR * DM));
        *(f32x4*)(X + e) = v; uint2 o; o.x = pk2(v.x, v.y); o.y = pk2(v.z, v.w); *(uint2*)(XB + e) = o;
    }
}

template <class Epi> DEVI void run_gemm(PG8_LAS unsigned char* lds, const bf16* A, int lda, int acol, const bf16* Bt, int ldb, int M, int N, int K, const Epi& E) {
    asm volatile("" : "+s"(K));
    pg8::Gemm g{A, Bt, M, N, K, lda, ldb, acol}; pg8::StaticOrder S; S.init(M, N, (int)gridDim.x, lvb());
    pg8::gemm_phase<Epi, pg8::StaticOrder, true, true>(lds, g, S, E);
}

#define LAYER_BODY(i) { constexpr int base = 1 + PH_PER_LAYER * (i), j = (i) >> 1; \
        if (((i) & 1) == 0) { \
            if (IN(base + 0)) { CP p = PP(); run_gemm(L, wsb(p, WS_XB), DM, 0, wsb(p, WS_WINAB) + (size_t)j * HC_AB * DM, DM, MP, HC_AB, DM, pg8::EpiF32{wsf(p, WS_H), HC_AB}); } \
            SEAM(base + 0); \
            if (IN(base + 1)) { \
                ph_ab_copy(PP(), j, lvb(), nvb); \
                ph_conv(PP(), j, lvb(), nvb); \
                ph_idx_prompt_naive(PP(), lvb(), nvb, smf); \
                for (int u = lvb(); u < 8 * 33; u += nvb) idx_sample_unit(PP(), j, u / 33, u % 33, smf); \
            } \
            SEAM(base + 1); \
            if (IN(base + 2)) { \
                ph_select_prompt(PP(), lvb(), nvb); \
                for (int u = lvb(); u < MSR; u += nvb) select_sample_unit(PP(), u, smi); \
                { const int t_ = ltid(), u = (t_ >> 6) * nvb + lvb(); if (u < (NBP + DB) * 32) ssd_seq_unit(PP(), j, u / 32, (u >> 1) & 15, u & 1, t_ & 63); } \
            } \
            SEAM(base + 2); \
            if (IN(base + 3)) { \
                ph_attn_prompt_naive(PP(), lvb(), nvb); \
                for (int u = lvb(); u < MSR; u += nvb) attn_sample_unit(PP(), j, u); \
                ph_ssd_gate(PP(), j, lvb(), nvb); \
            } \
            SEAM(base + 3); \
            if (IN(base + 4)) { CP p = PP(); run_gemm(L, wsb(p, WS_AO), DM, 0, wsb(p, WS_WOUTAB) + (size_t)j * DM * DM, DM, MP, DM, DM, pg8::EpiResid{wsf(p, WS_X), DM, ALPHA}); } \
            SEAM(base + 4); \
        } else { \
            if (IN(base + 0)) { CP p = PP(); run_gemm(L, wsb(p, WS_XB), DM, 0, wsb(p, WS_WINCD) + (size_t)j * HC_CD * DM, DM, MP, HC_CD, DM, pg8::EpiF32{wsf(p, WS_H), HC_CD}); } \
            SEAM(base + 0); \
            if (IN(base + 1)) ph_cd_prep(PP(), j, lvb(), nvb); \
            SEAM(base + 1); \
            if (IN(base + 2)) { \
                { CP p = PP(); run_gemm(L, wsb(p, WS_DD), 1024, 256, wsb(p, WS_POOLW) + (size_t)j * 4 * 65536, 256, MP, 1024, 256, pg8::EpiBf16<0>{wsb(p, WS_AO), DM, p->pool_scale + (size_t)j * 1024}); } \
                ph_sgu_naive(PP(), j, lvb(), nvb); \
            } \
            SEAM(base + 2); \
            SEAM(base + 3); \
            if (IN(base + 4)) { CP p = PP(); run_gemm(L, wsb(p, WS_AO), DM, 0, wsb(p, WS_WOUTCD) + (size_t)j * DM * DM, DM, MP, DM, DM, pg8::EpiResid{wsf(p, WS_X), DM, ALPHA}); } \
            SEAM(base + 4); \
        } \
        if (IN(base + 5)) { CP p = PP(); ph_ln(p, p->ln1_g + (size_t)(i) * DM, p->ln1_b + (size_t)(i) * DM, 0, lvb(), nvb); } \
        SEAM(base + 5); \
        if (IN(base + 6)) { CP p = PP(); run_gemm(L, wsb(p, WS_XB), DM, 0, wsb(p, WS_WFF1) + (size_t)(i) * DFF * DM, DM, MP, DFF, DM, pg8::EpiBf16<1>{wsb(p, WS_HF), DFF, nullptr}); } \
        SEAM(base + 6); \
        if (IN(base + 7)) { CP p = PP(); run_gemm(L, wsb(p, WS_HF), DFF, 0, wsb(p, WS_WFF2) + (size_t)(i) * DM * DFF, DFF, MP, DM, DFF, pg8::EpiResid{wsf(p, WS_X), DM, ALPHA}); } \
        SEAM(base + 7); \
        if (IN(base + 8)) { CP p = PP(); ph_ln(p, p->ln2_g + (size_t)(i) * DM, p->ln2_b + (size_t)(i) * DM, (i) == 3, lvb(), nvb); } \
        if ((i) < 3) { SEAM(base + 8); } \
 \
    }
__global__ void __launch_bounds__(NWAVES * 64, 2) mk_fwd(P p_kernarg) {
    extern __shared__ __attribute__((aligned(16))) unsigned char lds[];
    LAS unsigned char* L = (LAS unsigned char*)lds;
    volatile LAS unsigned* MISC = (volatile LAS unsigned*)(L + MISC_OFF);
    const int nvb = gridDim.x;
    for (int u = threadIdx.x; u < (LDS_BYTES - LDSCTL_OFF) / 4; u += NWAVES * 64) ((LAS unsigned*)(L + LDSCTL_OFF))[u] = 0u;
    __syncthreads();
    unsigned* ctl = (unsigned*)(PP()->ws + WS_CTL);
    XcdBarrier bar = xcd_barrier_post(ctl + CW_BAR, MISC + 8);
    float* smf = (float*)lds; int* smi = (int*)lds;
    const int lo = PP()->ph_lo, hi = PP()->ph_hi;
#define IN(k) (lo <= (k) && (k) < hi)
#define SEAM(k) do { if (IN(k) && (k) + 1 < hi) xcd_barrier(bar); } while (0)

    if (IN(0)) ph_prologue(PP(), lvb(), nvb, smf);
    SEAM(0);
    LAYER_BODY(0) LAYER_BODY(1) LAYER_BODY(2) LAYER_BODY(3)
#undef IN
#undef SEAM
}

#ifndef MK_PER_PHASE
#define MK_PER_PHASE 0
#endif
extern "C" void kernel_launch(void* const* d_in, const int* in_sizes, int n_in, void* d_out, int out_size, void* d_ws, size_t ws_size, hipStream_t stream) {
    if (n_in != 31 || (size_t)out_size != O_END || ws_size < WS_END) { fprintf(stderr, "kernel_launch: unexpected sizes n_in %d out %d ws %zu (need %zu)\n", n_in, out_size, ws_size, (size_t)WS_END); return; }
    static int grid = 0;
    if (grid == 0) {
        int dev = 0, cus = 0, per_cu = 0;
        if (hipGetDevice(&dev) != hipSuccess || hipDeviceGetAttribute(&cus, hipDeviceAttributeMultiprocessorCount, dev) != hipSuccess) { grid = -1; return; }
        if (hipFuncSetAttribute((const void*)mk_fwd, hipFuncAttributeMaxDynamicSharedMemorySize, LDS_BYTES) != hipSuccess) { fprintf(stderr, "kernel_launch: hipFuncSetAttribute failed\n"); grid = -1; return; }
        if (hipOccupancyMaxActiveBlocksPerMultiprocessor(&per_cu, (const void*)mk_fwd, NWAVES * 64, LDS_BYTES) != hipSuccess || per_cu < 1) fprintf(stderr, "kernel_launch: occupancy query says %d\n", per_cu);
        (void)hipGetLastError();
        grid = cus;
    }
    if (grid < 0) return;
    (void)hipMemsetAsync((char*)d_ws + WS_CTL, 0, CTL_ZERO_BYTES, stream);
    P p{};
    p.x_prompt = (const float*)d_in[0]; p.x_sample = (const float*)d_in[1]; p.cache_k = (const float*)d_in[2]; p.cache_v = (const float*)d_in[3]; p.cache_ik = (const float*)d_in[4];
    p.state_ssm = (const float*)d_in[5]; p.state_conv = (const float*)d_in[6]; p.state_pool = (const float*)d_in[7]; p.page_table = (const int*)d_in[8];
    p.ln1_g = (const float*)d_in[9]; p.ln1_b = (const float*)d_in[10]; p.ln2_g = (const float*)d_in[11]; p.ln2_b = (const float*)d_in[12];
    p.w_in_ab = (const float*)d_in[13]; p.conv_w = (const float*)d_in[14]; p.conv_b = (const float*)d_in[15]; p.dt_bias = (const float*)d_in[16]; p.a_log = (const float*)d_in[17];
    p.d_skip = (const float*)d_in[18]; p.ssd_g = (const float*)d_in[19]; p.w_out_ab = (const float*)d_in[20]; p.w_in_cd = (const float*)d_in[21]; p.pool_w = (const float*)d_in[22];
    p.pool_scale = (const float*)d_in[23]; p.sgu_ln_g = (const float*)d_in[24]; p.sgu_ln_b = (const float*)d_in[25]; p.sgu_w = (const float*)d_in[26]; p.sgu_b = (const float*)d_in[27];
    p.w_out_cd = (const float*)d_in[28]; p.w_ff1 = (const float*)d_in[29]; p.w_ff2 = (const float*)d_in[30];
    p.out = (float*)d_out; p.ws = (unsigned char*)d_ws;
#if MK_PER_PHASE
    for (int k = 0; k < N_PHASES; ++k) { const int r = (k - 1) % PH_PER_LAYER; if (k > 0 && r > 8) continue; p.ph_lo = k; p.ph_hi = k + 1; hipLaunchKernelGGL(mk_fwd, dim3(grid), dim3(NWAVES * 64), LDS_BYTES, stream, p); }
#else
    p.ph_lo = 0; p.ph_hi = N_PHASES;
    hipLaunchKernelGGL(mk_fwd, dim3(grid), dim3(NWAVES * 64), LDS_BYTES, stream, p);
#endif
}
```

```cpp
#include <hip/hip_runtime.h>
#include <stdint.h>
#include <stdio.h>

typedef unsigned short bf16;
typedef float f32x4 __attribute__((ext_vector_type(4)));
typedef unsigned u32x4 __attribute__((ext_vector_type(4)));
#define DEVI __device__ __forceinline__
typedef short bf16x8 __attribute__((ext_vector_type(8)));
typedef unsigned u32x2 __attribute__((ext_vector_type(2)));
DEVI f32x4 mfma16(bf16x8 bt, bf16x8 a, f32x4 c) { return __builtin_amdgcn_mfma_f32_16x16x32_bf16(bt, a, c, 0, 0, 0); }
typedef float f32x2_t __attribute__((ext_vector_type(2))); typedef __bf16 bf16x2_t __attribute__((ext_vector_type(2)));
DEVI unsigned cvtpk(float lo, float hi) { f32x2_t v = {lo, hi}; bf16x2_t b = __builtin_convertvector(v, bf16x2_t); return __builtin_bit_cast(unsigned, b); }
DEVI float bflo(unsigned w) { return __uint_as_float(w << 16); }
DEVI float bfhi(unsigned w) { return __uint_as_float(w & 0xffff0000u); }

constexpr int DM = 2048, SEQ = 4096, NBP = 2, MPR = NBP * SEQ;
constexpr int DB = 8, DS = 8, MSR = DB * DS;
constexpr int MR = MPR + MSR;
constexpr int MP = 8448;
constexpr int PAST = 16384, PAGE = 128, NPAGES = PAST / PAGE, NPOOL = 1280;
constexpr int NKEY_S = PAST + DS;
constexpr int SCS_LD = 16400;
constexpr int HC_AB = 4864, HC_CD = 3072, DFF = 8192;
constexpr int TOPK = 256;
constexpr int C_Q = 0, C_K = 1024, C_V = 1280, C_QI = 1536, C_Z = 2048, C_XBC = 3072, C_KI = 4608, C_WI = 4672, C_DT = 4680;
constexpr float ALPHA = 1.681792830507429f;
constexpr float EPS = 1e-5f;
constexpr float IDX_SCALE = 0.04419417382415922f;
constexpr float ATT_SCALE = 0.08838834764831845f;

constexpr size_t O_YP = 0;
constexpr size_t O_YS = O_YP + (size_t)MPR * DM;
constexpr size_t O_KP = O_YS + (size_t)MSR * DM;
constexpr size_t O_VP = O_KP + (size_t)2 * MPR * 256;
constexpr size_t O_IP = O_VP + (size_t)2 * MPR * 256;
constexpr size_t O_HP = O_IP + (size_t)2 * MPR * 64;
constexpr size_t O_CP = O_HP + (size_t)2 * NBP * 16 * 64 * 128;
constexpr size_t O_PP = O_CP + (size_t)2 * NBP * 3 * 1536;
constexpr size_t O_KS = O_PP + (size_t)2 * NBP * 15 * 1024;
constexpr size_t O_VS = O_KS + (size_t)2 * MSR * 256;
constexpr size_t O_IS = O_VS + (size_t)2 * MSR * 256;
constexpr size_t O_HS = O_IS + (size_t)2 * MSR * 64;
constexpr size_t O_CS = O_HS + (size_t)2 * DB * 16 * 64 * 128;
constexpr size_t O_PS = O_CS + (size_t)2 * DB * 3 * 1536;
constexpr size_t O_GS = O_PS + (size_t)2 * DB * 15 * 1024;
constexpr size_t O_END = O_GS + (size_t)2 * MSR * 1024;
static_assert(O_END == 29571072, "output size");

constexpr size_t al256(size_t x) { return (x + 255) & ~(size_t)255; }
constexpr size_t WS_CTL = 0;
constexpr size_t WS_X = 1u << 20;
constexpr size_t WS_XB = WS_X + al256((size_t)MP * DM * 4);
constexpr size_t WS_H = WS_XB + al256((size_t)MP * DM * 2);
constexpr size_t WS_AO = WS_H + al256((size_t)MP * HC_AB * 4);
constexpr size_t WS_HF = WS_AO + al256((size_t)MP * DM * 2);
constexpr size_t WS_SC = WS_HF + al256((size_t)MP * DFF * 2);
constexpr size_t WS_MASK = WS_SC + al256((size_t)MPR * SEQ * 4);
constexpr size_t WS_XC = WS_MASK + al256((size_t)MPR * 64 * 8);
constexpr size_t WS_DT = WS_XC + al256((size_t)MP * 1536 * 4);
constexpr size_t WS_Y = WS_DT + al256((size_t)MP * 16 * 4);
constexpr size_t WS_SCS = WS_Y + al256((size_t)MP * 1024 * 4);
constexpr size_t WS_SELS = WS_SCS + al256((size_t)MSR * SCS_LD * 4);
constexpr size_t WS_DD = WS_SELS + al256((size_t)MSR * TOPK * 4);
constexpr size_t WS_U = WS_DD + al256((size_t)MP * 1024 * 2);
constexpr size_t WS_VLN = WS_U + al256((size_t)MP * 1024 * 2);
constexpr size_t WS_WINAB = WS_VLN + al256((size_t)MP * 1024 * 2);
constexpr size_t WS_WOUTAB = WS_WINAB + (size_t)2 * HC_AB * DM * 2;
constexpr size_t WS_WINCD = WS_WOUTAB + (size_t)2 * DM * DM * 2;
constexpr size_t WS_WOUTCD = WS_WINCD + (size_t)2 * HC_CD * DM * 2;
constexpr size_t WS_WFF1 = WS_WOUTCD + (size_t)2 * DM * DM * 2;
constexpr size_t WS_WFF2 = WS_WFF1 + (size_t)4 * DFF * DM * 2;
constexpr size_t WS_POOLW = WS_WFF2 + (size_t)4 * DFF * DM * 2;
constexpr size_t WS_SGUW = WS_POOLW + (size_t)2 * 4 * 256 * 256 * 2;
constexpr size_t WS_XCN = WS_SGUW + (size_t)2 * 4 * 128 * 128 * 2;
constexpr size_t WS_XCT = WS_XCN + al256((size_t)MP * 1536 * 2);
constexpr size_t WS_ACUM = WS_XCT + al256((size_t)64 * 1536 * 128 * 2);
constexpr size_t WS_DTC = WS_ACUM + al256((size_t)64 * 16 * 128 * 4);
constexpr size_t WS_CDEC = WS_DTC + al256((size_t)64 * 16 * 128 * 4);
constexpr size_t WS_ST = WS_CDEC + al256((size_t)64 * 16 * 4);
constexpr size_t WS_HIN = WS_ST + al256((size_t)64 * 16 * 64 * 128 * 4);
constexpr size_t WS_END = WS_HIN + al256((size_t)64 * 16 * 64 * 128 * 2);

struct P {
    const float *x_prompt, *x_sample, *cache_k, *cache_v, *cache_ik, *state_ssm, *state_conv, *state_pool;
    const int* page_table;
    const float *ln1_g, *ln1_b, *ln2_g, *ln2_b, *w_in_ab, *conv_w, *conv_b, *dt_bias, *a_log, *d_skip, *ssd_g, *w_out_ab;
    const float *w_in_cd, *pool_w, *pool_scale, *sgu_ln_g, *sgu_ln_b, *sgu_w, *sgu_b, *w_out_cd, *w_ff1, *w_ff2;
    float* out;
    unsigned char* ws;
    int ph_lo, ph_hi, a2, a3;
};
typedef const __attribute__((address_space(4))) P* CP;
DEVI CP PP() { CP q = (CP)__builtin_amdgcn_kernarg_segment_ptr(); asm volatile("" : "+s"(q)); return q; }
DEVI float* wsf(CP p, size_t off) { return (float*)(p->ws + off); }
DEVI bf16* wsb(CP p, size_t off) { return (bf16*)(p->ws + off); }

DEVI float bf2f(bf16 b) { return __uint_as_float(((unsigned)b) << 16); }
DEVI bf16 f2bf(float f) { unsigned u = __float_as_uint(f); u += 0x7fffu + ((u >> 16) & 1u); return (bf16)(u >> 16); }
DEVI unsigned pk2(float lo, float hi) { return (unsigned)f2bf(lo) | ((unsigned)f2bf(hi) << 16); }
DEVI float wave_sum(float v) {
#pragma unroll
    for (int o = 1; o < 64; o <<= 1) v += __shfl_xor(v, o);
    return v;
}
DEVI int ltid() { int t = threadIdx.x; asm volatile("" : "+v"(t)); return t; }
DEVI int lvb() { int b = blockIdx.x; asm volatile("" : "+s"(b)); return b; }
DEVI float silu_f(float x) { return x / (1.f + __expf(-x)); }
DEVI float softplus_f(float x) { return fmaxf(x, 0.f) + log1pf(__expf(-fabsf(x))); }
DEVI float gelu_f(float x) { return 0.5f * x * (1.f + erff(x * 0.70710678118654752f)); }
DEVI unsigned ord_f(float f) { f = f + 0.0f; unsigned u = __float_as_uint(f); return (u & 0x80000000u) ? ~u : (u | 0x80000000u); }
__host__ __device__ inline int ab_dst_col(int n) {
    if (n < 2048) return n;
    if (n < 2112) return C_KI + (n - 2048);
    if (n < 2120) return C_WI + (n - 2112);
    if (n < 3144) return C_Z + (n - 2120);
    if (n < 4680) return C_XBC + (n - 3144);
    return n;
}

DEVI void transpose_unit(const float* W, int K, int N, bf16* WT, int abmap, int unit, float* t  ) {
    const int TIDX = ltid();
    const int nbn = (N + 63) / 64, kb = unit / nbn, nb = unit % nbn, k0 = kb * 64, n0 = nb * 64, tid = TIDX;
#pragma unroll
    for (int i = 0; i < 8; ++i) { const int kk = (tid >> 6) + 8 * i, n = n0 + (tid & 63); t[kk * 65 + (tid & 63)] = (n < N) ? W[(size_t)(k0 + kk) * N + n] : 0.f; }
    __syncthreads();
    { const int n = n0 + (tid >> 3), kq = (tid & 7) * 8;
      if (n < N) { const int row = abmap ? ab_dst_col(n) : n; const float* s = t + kq * 65 + (tid >> 3);
          u32x4 o; o.x = pk2(s[0], s[65]); o.y = pk2(s[2 * 65], s[3 * 65]); o.z = pk2(s[4 * 65], s[5 * 65]); o.w = pk2(s[6 * 65], s[7 * 65]);
          *(u32x4*)(WT + (size_t)row * K + k0 + kq) = o; } }
    __syncthreads();
}


DEVI void ph_ln(CP p, const float* g, const float* b, int final_out, int vb, int nvb) {
    const int TIDX = ltid();
    float* X = wsf(p, WS_X); bf16* XB = wsb(p, WS_XB);
    const int lane = TIDX & 63, wv = TIDX >> 6;
    for (int row = vb * 8 + wv; row < MR; row += nvb * 8) {
        float* xr = X + (size_t)row * DM; f32x4 v[8]; float s = 0.f;
#pragma unroll
        for (int i = 0; i < 8; ++i) { v[i] = *(const f32x4*)(xr + (i * 64 + lane) * 4); s += (v[i].x + v[i].y) + (v[i].z + v[i].w); }
        const float mean = wave_sum(s) * (1.f / DM); float q = 0.f;
#pragma unroll
        for (int i = 0; i < 8; ++i) { v[i] = v[i] - mean; q += (v[i].x * v[i].x + v[i].y * v[i].y) + (v[i].z * v[i].z + v[i].w * v[i].w); }
        const float rstd = 1.f / sqrtf(wave_sum(q) * (1.f / DM) + EPS);
        float* o = final_out ? (row < MPR ? p->out + O_YP + (size_t)row * DM : p->out + O_YS + (size_t)(row - MPR) * DM) : nullptr;
#pragma unroll
        for (int i = 0; i < 8; ++i) { const int c = (i * 64 + lane) * 4; const f32x4 gg = *(const f32x4*)(g + c), bb = *(const f32x4*)(b + c);
            const f32x4 y = v[i] * rstd * gg + bb; *(f32x4*)(xr + c) = y; uint2 w; w.x = pk2(y.x, y.y); w.y = pk2(y.z, y.w); *(uint2*)(XB + (size_t)row * DM + c) = w;
            if (final_out) *(f32x4*)(o + c) = y; }
    }
}

DEVI void ph_ab_copy(CP p, int j, int vb, int nvb) {
    const int TIDX = ltid();
    const float* H = wsf(p, WS_H); const int tid = TIDX;
    for (int row = vb; row < MR; row += nvb) {
        const float* h = H + (size_t)row * HC_AB;
        float *ko, *vo, *io;
        if (row < MPR) { ko = p->out + O_KP + ((size_t)j * MPR + row) * 256; vo = p->out + O_VP + ((size_t)j * MPR + row) * 256; io = p->out + O_IP + ((size_t)j * MPR + row) * 64; }
        else { const int sr = row - MPR; ko = p->out + O_KS + ((size_t)j * MSR + sr) * 256; vo = p->out + O_VS + ((size_t)j * MSR + sr) * 256; io = p->out + O_IS + ((size_t)j * MSR + sr) * 64; }
        if (tid < 256) ko[tid] = h[C_K + tid]; else vo[tid - 256] = h[C_V + tid - 256];
        if (tid < 64) io[tid] = h[C_KI + tid];
        int ci = -1; float* co = nullptr;
        if (row < MPR) { const int b = row / SEQ, t = row % SEQ; if (t >= SEQ - 3) { ci = t - (SEQ - 3); co = p->out + O_CP + (((size_t)j * NBP + b) * 3 + ci) * 1536; } }
        else { const int b = (row - MPR) / DS, t = (row - MPR) % DS; if (t >= DS - 3) { ci = t - (DS - 3); co = p->out + O_CS + (((size_t)j * DB + b) * 3 + ci) * 1536; } }
        if (ci >= 0) for (int c = tid; c < 1536; c += 512) co[c] = h[C_XBC + c];
    }
}

DEVI void ph_conv(CP p, int j, int vb, int nvb) {
    const int TIDX = ltid();
    const float* H = wsf(p, WS_H); float* XC = wsf(p, WS_XC); float* DT = wsf(p, WS_DT);
    const float* cw = p->conv_w + (size_t)j * 4 * 1536; const float* cb = p->conv_b + (size_t)j * 1536;
#ifdef EXP_OLDY
    for (int row = vb; row < MR; row += nvb) {
#else
    for (int row = MPR + vb; row < MR; row += nvb) {
#endif
        const bool pr = row < MPR; const int b = pr ? row / SEQ : (row - MPR) / DS, t = pr ? row % SEQ : (row - MPR) % DS;
        for (int c = TIDX; c < 1536; c += 512) {
            float acc = cb[c];
#pragma unroll
            for (int jj = 0; jj < 4; ++jj) { const int tt = t - 3 + jj; float xv;
                if (tt >= 0) xv = H[(size_t)(row - t + tt) * HC_AB + C_XBC + c];
                else xv = pr ? 0.f : p->state_conv[(((size_t)j * DB + b) * 3 + (3 + tt)) * 1536 + c];
                acc += cw[jj * 1536 + c] * xv; }
            XC[(size_t)row * 1536 + c] = silu_f(acc);
        }
        if (TIDX < 16) DT[row * 16 + TIDX] = softplus_f(H[(size_t)row * HC_AB + C_DT + TIDX] + p->dt_bias[j * 16 + TIDX]);
    }
}

DEVI void ssd_seq_unit(CP p, int j, int sq  , int h, int ph, int lane) {
    const float* XC = wsf(p, WS_XC); const float* DT = wsf(p, WS_DT); float* Y = wsf(p, WS_Y);
    const bool pr = sq < NBP; const int b = pr ? sq : sq - NBP, n = pr ? SEQ : DS, row0 = pr ? b * SEQ : MPR + b * DS, g = h >> 3;
    const int pp = ph * 32 + (lane & 31), nh = lane >> 5;
    const float a = -__expf(p->a_log[j * 16 + h]), Dk = p->d_skip[j * 16 + h];
    float st[64];
    if (pr) {
#pragma unroll
        for (int i = 0; i < 64; ++i) st[i] = 0.f;
    } else { const float* h0 = p->state_ssm + ((((size_t)j * DB + b) * 16 + h) * 64 + pp) * 128 + nh * 64;
#pragma unroll
        for (int i = 0; i < 16; ++i) { const f32x4 v = *(const f32x4*)(h0 + 4 * i); st[4 * i] = v.x; st[4 * i + 1] = v.y; st[4 * i + 2] = v.z; st[4 * i + 3] = v.w; } }
    for (int t = 0; t < n; ++t) {
        const int row = row0 + t; const float dt = DT[row * 16 + h], dA = __expf(dt * a), x = XC[(size_t)row * 1536 + h * 64 + pp], cf = dt * x;
        const float* Bp = XC + (size_t)row * 1536 + 1024 + g * 128 + nh * 64; const float* Cp = Bp + 256;
        float y = 0.f;
#pragma unroll
        for (int i = 0; i < 16; ++i) { if ((i & 7) == 0) asm volatile("" ::: "memory");
            const f32x4 bv = *(const f32x4*)(Bp + 4 * i), cv = *(const f32x4*)(Cp + 4 * i);
            st[4 * i] = st[4 * i] * dA + cf * bv.x; st[4 * i + 1] = st[4 * i + 1] * dA + cf * bv.y; st[4 * i + 2] = st[4 * i + 2] * dA + cf * bv.z; st[4 * i + 3] = st[4 * i + 3] * dA + cf * bv.w;
            y += cv.x * st[4 * i] + cv.y * st[4 * i + 1] + cv.z * st[4 * i + 2] + cv.w * st[4 * i + 3]; }
        y += __shfl_xor(y, 32);
        if (nh == 0) Y[(size_t)row * 1024 + h * 64 + pp] = y + Dk * x;
    }
#ifdef EXP_OLDY
    if (pr) return;
#endif
    float* ho = (pr ? p->out + O_HP + ((((size_t)j * NBP + b) * 16 + h) * 64 + pp) * 128 : p->out + O_HS + ((((size_t)j * DB + b) * 16 + h) * 64 + pp) * 128) + nh * 64;
#pragma unroll
    for (int i = 0; i < 16; ++i) *(f32x4*)(ho + 4 * i) = (f32x4){st[4 * i], st[4 * i + 1], st[4 * i + 2], st[4 * i + 3]};
}

DEVI void conv_prompt_unit(CP p, int j, int ck, int cb, bf16* T  ) {
    const int tid = ltid(), ch = tid & 63, sg = tid >> 6;
    const float* H = wsf(p, WS_H); bf16* XCN = wsb(p, WS_XCN); bf16* XCT = wsb(p, WS_XCT);
    const int row0 = ck * 128, col = cb * 64 + ch, s0 = sg * 16;
    const float* cw = p->conv_w + (size_t)j * 4 * 1536 + col; const float w0 = cw[0], w1 = cw[1536], w2 = cw[2 * 1536], w3 = cw[3 * 1536], bias = p->conv_b[(size_t)j * 1536 + col];
    const float* hp = H + (size_t)(row0 + s0) * HC_AB + C_XBC + col;
    const bool first = ((ck & 31) == 0) && (sg == 0);
    float x0 = first ? 0.f : hp[-3 * HC_AB], x1 = first ? 0.f : hp[-2 * HC_AB], x2 = first ? 0.f : hp[-HC_AB];
#pragma unroll 4
    for (int i = 0; i < 16; ++i) { const float x3 = hp[(size_t)i * HC_AB]; const bf16 v = f2bf(silu_f(bias + w0 * x0 + w1 * x1 + w2 * x2 + w3 * x3));
        XCN[(size_t)(row0 + s0 + i) * 1536 + col] = v; T[ch * 136 + s0 + i] = v; x0 = x1; x1 = x2; x2 = x3; }
    if (cb == 0) for (int idx = tid; idx < 128 * 16; idx += 512) { const int s = idx >> 4, hh = idx & 15;
        wsf(p, WS_DT)[(row0 + s) * 16 + hh] = softplus_f(H[(size_t)(row0 + s) * HC_AB + C_DT + hh] + p->dt_bias[j * 16 + hh]); }
    __syncthreads();
    { const int chh = tid >> 3, sq = (tid & 7) * 16; const u32x4 a = *(const u32x4*)(T + chh * 136 + sq), b = *(const u32x4*)(T + chh * 136 + sq + 8);
      bf16* dst = XCT + ((size_t)ck * 1536 + cb * 64 + chh) * 128 + sq; *(u32x4*)dst = a; *(u32x4*)(dst + 8) = b; }
    __syncthreads();
}
DEVI void ssd1_unit(CP p, int j, int ck, int h, float* sm  ) {
    const int tid = ltid(), lane = tid & 63, wv = tid >> 6, fr = lane & 15, fq = lane >> 4, g = h >> 3;
    if (wv == 0) {
        const float* DT = wsf(p, WS_DT) + (size_t)ck * 128 * 16 + h; const float a = -__expf(p->a_log[j * 16 + h]);
        float* ACUM = wsf(p, WS_ACUM) + ((size_t)ck * 16 + h) * 128; float* DTC = wsf(p, WS_DTC) + ((size_t)ck * 16 + h) * 128;
        const float d0 = DT[(2 * lane) * 16], d1 = DT[(2 * lane + 1) * 16], v0 = d0 * a, v1 = v0 + d1 * a;
        float run = v1;
#pragma unroll
        for (int o = 1; o < 64; o <<= 1) { const float t = __shfl_up(run, o); if (lane >= o) run += t; }
        const float ex = run - v1, a0 = ex + v0, a1 = ex + v1, last = __shfl(run, 63);
        sm[2 * lane] = a0; sm[2 * lane + 1] = a1; ACUM[2 * lane] = a0; ACUM[2 * lane + 1] = a1; DTC[2 * lane] = d0; DTC[2 * lane + 1] = d1;
        sm[128 + 2 * lane] = d0 * __expf(last - a0); sm[128 + 2 * lane + 1] = d1 * __expf(last - a1);
        if (lane == 0) wsf(p, WS_CDEC)[ck * 16 + h] = __expf(last);
    }
    __syncthreads();
    const bf16* XCT = wsb(p, WS_XCT) + (size_t)ck * 1536 * 128;
    const bf16* Btp = XCT + (size_t)(1024 + g * 128 + wv * 16 + fr) * 128 + fq * 8;
    const bf16* xp = XCT + (size_t)(h * 64 + fr) * 128 + fq * 8;
    f32x4 acc[4];
#pragma unroll
    for (int pt = 0; pt < 4; ++pt) acc[pt] = (f32x4){0.f, 0.f, 0.f, 0.f};
#pragma unroll
    for (int k = 0; k < 4; ++k) {
        const bf16x8 bfrag = *(const bf16x8*)(Btp + k * 32);
        const f32x4 wa = *(const f32x4*)(sm + 128 + k * 32 + fq * 8), wb = *(const f32x4*)(sm + 128 + k * 32 + fq * 8 + 4);
#pragma unroll
        for (int pt = 0; pt < 4; ++pt) { const u32x4 xv = *(const u32x4*)(xp + (size_t)pt * 16 * 128 + k * 32);
            u32x4 sv; sv.x = cvtpk(bflo(xv.x) * wa.x, bfhi(xv.x) * wa.y); sv.y = cvtpk(bflo(xv.y) * wa.z, bfhi(xv.y) * wa.w); sv.z = cvtpk(bflo(xv.z) * wb.x, bfhi(xv.z) * wb.y); sv.w = cvtpk(bflo(xv.w) * wb.z, bfhi(xv.w) * wb.w);
            acc[pt] = mfma16(bfrag, __builtin_bit_cast(bf16x8, sv), acc[pt]); }
    }
    float* ST = wsf(p, WS_ST) + ((size_t)ck * 16 + h) * 8192;
#pragma unroll
    for (int pt = 0; pt < 4; ++pt) *(f32x4*)(ST + (size_t)(pt * 16 + fr) * 128 + wv * 16 + fq * 4) = acc[pt];
    __syncthreads();
}
DEVI void ph_ssd_scan(CP p, int j, int vb, int nvb) {
    const float* ST = wsf(p, WS_ST); const float* CDEC = wsf(p, WS_CDEC); bf16* HIN = wsb(p, WS_HIN);
    const int tid = ltid();
    for (int e4 = vb * 512 + tid; e4 < NBP * 16 * 64 * 128 / 4; e4 += nvb * 512) {
        const int b = e4 / (16 * 64 * 32), r = e4 % (16 * 64 * 32), h = r / (64 * 32);
        f32x4 st = (f32x4){0.f, 0.f, 0.f, 0.f};
#pragma unroll 8
        for (int c = 0; c < 32; ++c) { const int ck = b * 32 + c; const size_t off = (size_t)ck * 16 * 8192 + (size_t)r * 4;
            u32x2 o; o.x = cvtpk(st.x, st.y); o.y = cvtpk(st.z, st.w); *(u32x2*)(HIN + off) = o;
            const f32x4 sv = *(const f32x4*)(ST + off); const float d = CDEC[ck * 16 + h]; st = st * d + sv; }
        *(f32x4*)(p->out + O_HP + ((size_t)j * NBP + b) * 16 * 8192 + (size_t)r * 4) = st;
    }
}
DEVI void ssd3_unit(CP p, int j, int ck, int tt, float* red  , bf16* AO) {
    const int tid = ltid(), lane = tid & 63, wv = tid >> 6, fr = lane & 15, fq = lane >> 4, g = wv >> 2;
    const int t0 = tt * 16; const size_t row = (size_t)ck * 128 + t0 + fr;
    const bf16* XCN = wsb(p, WS_XCN); const bf16* XCT = wsb(p, WS_XCT) + (size_t)ck * 1536 * 128; const float* H = wsf(p, WS_H);
    bf16x8 cf[4];
#pragma unroll
    for (int k = 0; k < 4; ++k) cf[k] = *(const bf16x8*)(XCN + row * 1536 + 1280 + g * 128 + k * 32 + fq * 8);
    f32x4 cbt[8];
#pragma unroll
    for (int jt = 0; jt < 8; ++jt) { cbt[jt] = (f32x4){0.f, 0.f, 0.f, 0.f};
        if (jt <= tt) { const bf16* bp = XCN + ((size_t)ck * 128 + jt * 16 + fr) * 1536 + 1024 + g * 128 + fq * 8;
#pragma unroll
            for (int k = 0; k < 4; ++k) cbt[jt] = mfma16(*(const bf16x8*)(bp + k * 32), cf[k], cbt[jt]); } }
    f32x4 yv[2][4]; float ss = 0.f;
#pragma unroll
    for (int hh = 0; hh < 2; ++hh) {
        const int h = 2 * wv + hh;
        const float* AC = wsf(p, WS_ACUM) + ((size_t)ck * 16 + h) * 128; const float* DC = wsf(p, WS_DTC) + ((size_t)ck * 16 + h) * 128;
        const float at = AC[t0 + fr], Dk = p->d_skip[j * 16 + h];
        f32x4 yd[4];
#pragma unroll
        for (int pt = 0; pt < 4; ++pt) yd[pt] = (f32x4){0.f, 0.f, 0.f, 0.f};
#pragma unroll
        for (int q = 0; q < 4; ++q) if (2 * q <= tt) {
            const int sa = 2 * q * 16 + 4 * fq, sb = sa + 16;
            const f32x4 aa = *(const f32x4*)(AC + sa), da = *(const f32x4*)(DC + sa), ab = *(const f32x4*)(AC + sb), db = *(const f32x4*)(DC + sb);
            float la[4], lb[4];
#pragma unroll
            for (int i = 0; i < 4; ++i) { la[i] = (sa + i <= t0 + fr) ? cbt[2 * q][i] * __expf(fminf(at - aa[i], 0.f)) * da[i] : 0.f;
                                          lb[i] = (2 * q + 1 <= tt && sb + i <= t0 + fr) ? cbt[2 * q + 1][i] * __expf(fminf(at - ab[i], 0.f)) * db[i] : 0.f; }
            u32x4 lw; lw.x = cvtpk(la[0], la[1]); lw.y = cvtpk(la[2], la[3]); lw.z = cvtpk(lb[0], lb[1]); lw.w = cvtpk(lb[2], lb[3]);
            const bf16x8 lf = __builtin_bit_cast(bf16x8, lw);
#pragma unroll
            for (int pt = 0; pt < 4; ++pt) { const bf16* xq = XCT + (size_t)(h * 64 + pt * 16 + fr) * 128;
                const u32x2 xa = *(const u32x2*)(xq + sa), xb = *(const u32x2*)(xq + sb); u32x4 xw; xw.x = xa.x; xw.y = xa.y; xw.z = xb.x; xw.w = xb.y;
                yd[pt] = mfma16(__builtin_bit_cast(bf16x8, xw), lf, yd[pt]); }
        }
        const bf16* hq = wsb(p, WS_HIN) + ((size_t)ck * 16 + h) * 8192 + (size_t)fr * 128 + fq * 8; const float eat = __expf(at);
#pragma unroll
        for (int pt = 0; pt < 4; ++pt) { f32x4 of = (f32x4){0.f, 0.f, 0.f, 0.f};
#pragma unroll
            for (int k = 0; k < 4; ++k) of = mfma16(*(const bf16x8*)(hq + (size_t)pt * 16 * 128 + k * 32), cf[k], of);
            const int c0 = h * 64 + pt * 16 + 4 * fq;
            const u32x2 xw = *(const u32x2*)(XCN + row * 1536 + c0); const f32x4 z = *(const f32x4*)(H + row * HC_AB + C_Z + c0);
            f32x4 y = yd[pt] + of * eat;
            y.x += Dk * bflo(xw.x); y.y += Dk * bfhi(xw.x); y.z += Dk * bflo(xw.y); y.w += Dk * bfhi(xw.y);
            y.x *= silu_f(z.x); y.y *= silu_f(z.y); y.z *= silu_f(z.z); y.w *= silu_f(z.w);
            ss += (y.x * y.x + y.y * y.y) + (y.z * y.z + y.w * y.w); yv[hh][pt] = y; }
    }
    ss += __shfl_xor(ss, 16); ss += __shfl_xor(ss, 32);
    if (fq == 0) red[wv * 16 + fr] = ss;
    __syncthreads();
    float tot = 0.f;
#pragma unroll
    for (int w = 0; w < 8; ++w) tot += red[w * 16 + fr];
    const float rs = 1.f / sqrtf(tot * (1.f / 1024.f) + EPS);
    const float* gg = p->ssd_g + (size_t)j * 1024;
#pragma unroll
    for (int hh = 0; hh < 2; ++hh)
#pragma unroll
        for (int pt = 0; pt < 4; ++pt) { const int c0 = (2 * wv + hh) * 64 + pt * 16 + 4 * fq; const f32x4 gv = *(const f32x4*)(gg + c0); const f32x4 o = yv[hh][pt] * rs * gv;
            u32x2 w; w.x = cvtpk(o.x, o.y); w.y = cvtpk(o.z, o.w); *(u32x2*)(AO + row * DM + 1024 + c0) = w; }
    __syncthreads();
}

DEVI void ph_ssd_gate(CP p, int j, int vb, int nvb) {
    const int TIDX = ltid();
    const float* H = wsf(p, WS_H); const float* Y = wsf(p, WS_Y); bf16* AO = wsb(p, WS_AO); const float* g = p->ssd_g + (size_t)j * 1024;
    const int lane = TIDX & 63, wv = TIDX >> 6;
#ifdef EXP_OLDY
    for (int row = vb * 8 + wv; row < MR; row += nvb * 8) {
#else
    for (int row = MPR + vb * 8 + wv; row < MR; row += nvb * 8) {
#endif
        f32x4 v[4]; float q = 0.f;
#pragma unroll
        for (int i = 0; i < 4; ++i) { const int c = (i * 64 + lane) * 4; const f32x4 y = *(const f32x4*)(Y + (size_t)row * 1024 + c), z = *(const f32x4*)(H + (size_t)row * HC_AB + C_Z + c);
            v[i] = (f32x4){y.x * silu_f(z.x), y.y * silu_f(z.y), y.z * silu_f(z.z), y.w * silu_f(z.w)}; q += (v[i].x * v[i].x + v[i].y * v[i].y) + (v[i].z * v[i].z + v[i].w * v[i].w); }
        const float rs = 1.f / sqrtf(wave_sum(q) * (1.f / 1024.f) + EPS);
#pragma unroll
        for (int i = 0; i < 4; ++i) { const int c = (i * 64 + lane) * 4; const f32x4 gg = *(const f32x4*)(g + c); const f32x4 o = v[i] * rs * gg;
            uint2 w; w.x = pk2(o.x, o.y); w.y = pk2(o.z, o.w); *(uint2*)(AO + (size_t)row * DM + 1024 + c) = w; }
    }
}

DEVI void ph_idx_prompt_naive(CP p, int vb, int nvb, float* sm) {
    const int TIDX = ltid();
    const float* H = wsf(p, WS_H); float* SC = wsf(p, WS_SC);
    const int half = TIDX >> 8, tid = TIDX & 255; float* sq = sm + half * 520; float* sw = sq + 512;
    for (int row0 = vb * 2; row0 < MPR; row0 += nvb * 2) {
        const int row = row0 + half, b = row / SEQ, t = row % SEQ;
        sq[tid] = H[(size_t)row * HC_AB + C_QI + tid]; sq[tid + 256] = H[(size_t)row * HC_AB + C_QI + 256 + tid]; if (tid < 8) sw[tid] = H[(size_t)row * HC_AB + C_WI + tid];
        __syncthreads();
        for (int s = tid; s <= t; s += 256) {
            const float* kr = H + (size_t)(b * SEQ + s) * HC_AB + C_KI; float k[64];
#pragma unroll
            for (int i = 0; i < 16; ++i) { const f32x4 v = *(const f32x4*)(kr + 4 * i); k[4 * i] = v.x; k[4 * i + 1] = v.y; k[4 * i + 2] = v.z; k[4 * i + 3] = v.w; }
            float sc = 0.f;
#pragma unroll 1
            for (int h = 0; h < 8; ++h) { float d = 0.f;
#pragma unroll
                for (int i = 0; i < 64; ++i) d += sq[h * 64 + i] * k[i];
                sc += sw[h] * fmaxf(d, 0.f); }
            SC[(size_t)row * SEQ + s] = sc * IDX_SCALE;
        }
        __syncthreads();
    }
}

DEVI void select_prompt_row(const float* SC, unsigned long long* MASK, int row, int lane) {
    const int t = row % SEQ, nk = t + 1; const float* sc = SC + (size_t)row * SEQ;
    unsigned v[64];
#pragma unroll
    for (int jj = 0; jj < 64; ++jj) { const int key = jj * 64 + lane; v[jj] = key < nk ? ord_f(sc[key]) : 0u; }
    unsigned long long mine = 0ull;
    if (nk <= TOPK) {
#pragma unroll
        for (int jj = 0; jj < 64; ++jj) { const unsigned long long m = __ballot(jj * 64 + lane < nk); if (lane == jj) mine = m; }
    } else {
        unsigned T = 0u;
        for (int bit = 31; bit >= 0; --bit) { const unsigned cand = T | (1u << bit); int cnt = 0;
#pragma unroll
            for (int jj = 0; jj < 64; ++jj) cnt += __popcll(__ballot(v[jj] >= cand));
            if (cnt >= TOPK) T = cand; if (cnt == TOPK) break; }
        int cgt = 0;
#pragma unroll
        for (int jj = 0; jj < 64; ++jj) cgt += __popcll(__ballot(v[jj] > T));
        const int need = TOPK - cgt; int run = 0; const unsigned long long lt = (1ull << lane) - 1ull;
#pragma unroll
        for (int jj = 0; jj < 64; ++jj) { const bool eq = v[jj] == T; const unsigned long long me = __ballot(eq); const int pre = run + __popcll(me & lt);
            const bool sel = (v[jj] > T) || (eq && pre < need); run += __popcll(me); const unsigned long long m = __ballot(sel); if (lane == jj) mine = m; }
    }
    MASK[((size_t)(row >> 5) * 64 + lane) * 32 + (row & 31)] = mine;
}
DEVI void ph_select_prompt(CP p, int vb, int nvb) {
    const int TIDX = ltid();
    const int lane = TIDX & 63, wv = TIDX >> 6;
    for (int row = vb * 8 + wv; row < MPR; row += nvb * 8) select_prompt_row(wsf(p, WS_SC), (unsigned long long*)(p->ws + WS_MASK), row, lane);
}

DEVI void ph_attn_prompt_naive(CP p, int vb, int nvb) {
    const int TIDX = ltid();
    const float* H = wsf(p, WS_H); const unsigned long long* MASK = (const unsigned long long*)(p->ws + WS_MASK); bf16* AO = wsb(p, WS_AO);
    const int h = TIDX >> 6, lane = TIDX & 63, g = h >> 2;
    for (int row = vb; row < MPR; row += nvb) {
        const int b = row / SEQ, t = row % SEQ;
        const float q0 = H[(size_t)row * HC_AB + C_Q + h * 128 + lane], q1 = H[(size_t)row * HC_AB + C_Q + h * 128 + 64 + lane];
        float m = -1e30f, l = 0.f, o0 = 0.f, o1 = 0.f;
        for (int jt = 0; jt <= t / 64; ++jt) {
            unsigned long long w = MASK[((size_t)(row >> 5) * 64 + jt) * 32 + (row & 31)];
            while (w) { const int bit = __builtin_ctzll(w); w &= w - 1ull; const int s = jt * 64 + bit;
                const float* kr = H + (size_t)(b * SEQ + s) * HC_AB + C_K + g * 128; const float* vr = H + (size_t)(b * SEQ + s) * HC_AB + C_V + g * 128;
                const float lg = wave_sum(q0 * kr[lane] + q1 * kr[lane + 64]) * ATT_SCALE;
                const float mn = fmaxf(m, lg), al = __expf(m - mn), pe = __expf(lg - mn);
                l = l * al + pe; o0 = o0 * al + pe * vr[lane]; o1 = o1 * al + pe * vr[lane + 64]; m = mn; }
        }
        const float il = 1.f / l;
        AO[(size_t)row * DM + h * 128 + lane] = f2bf(o0 * il); AO[(size_t)row * DM + h * 128 + 64 + lane] = f2bf(o1 * il);
    }
}

DEVI void idx_sample_unit(CP p, int j, int b, int kb, float* sq  ) {
    const int TIDX = ltid();
    const float* H = wsf(p, WS_H); float* SCS = wsf(p, WS_SCS); const int tid = TIDX;
    for (int i = tid; i < 8 * 512; i += 512) sq[i] = H[(size_t)(MPR + b * DS + (i >> 9)) * HC_AB + C_QI + (i & 511)];
    if (tid < 64) sq[4096 + tid] = H[(size_t)(MPR + b * DS + (tid >> 3)) * HC_AB + C_WI + (tid & 7)];
    __syncthreads();
    const int key = kb * 512 + tid;
    if (key < NKEY_S) {
        const float* kr;
        if (key < PAST) { const int pg = p->page_table[b * NPAGES + key / PAGE]; kr = p->cache_ik + (((size_t)j * NPOOL + pg) * PAGE + key % PAGE) * 64; }
        else kr = H + (size_t)(MPR + b * DS + key - PAST) * HC_AB + C_KI;
        float k[64];
#pragma unroll
        for (int i = 0; i < 16; ++i) { const f32x4 v = *(const f32x4*)(kr + 4 * i); k[4 * i] = v.x; k[4 * i + 1] = v.y; k[4 * i + 2] = v.z; k[4 * i + 3] = v.w; }
#pragma unroll 1
        for (int qi = 0; qi < 8; ++qi) { if (key > PAST + qi) continue; float sc = 0.f;
#pragma unroll 1
            for (int h = 0; h < 8; ++h) { float d = 0.f;
#pragma unroll
                for (int i = 0; i < 64; ++i) d += sq[qi * 512 + h * 64 + i] * k[i];
                sc += sq[4096 + qi * 8 + h] * fmaxf(d, 0.f); }
            SCS[(size_t)(b * DS + qi) * SCS_LD + key] = sc * IDX_SCALE; }
    }
    __syncthreads();
}

DEVI void select_sample_unit(CP p, int q, int* red  ) {
    const int TIDX = ltid();
    const float* sc = wsf(p, WS_SCS) + (size_t)q * SCS_LD; int* SELS = (int*)(p->ws + WS_SELS) + q * TOPK;
    const int tid = TIDX, lane = tid & 63, wv = tid >> 6, nk = PAST + (q % DS) + 1;
    unsigned v[33];
#pragma unroll
    for (int jj = 0; jj < 33; ++jj) { const int key = jj * 512 + tid; v[jj] = key < nk ? ord_f(sc[key]) : 0u; }
    unsigned T = 0u; int par = 0;
    for (int bit = 31; bit >= 0; --bit) { const unsigned cand = T | (1u << bit); int cnt = 0;
#pragma unroll
        for (int jj = 0; jj < 33; ++jj) cnt += __popcll(__ballot(v[jj] >= cand));
        if (lane == 0) red[par * 8 + wv] = cnt; __syncthreads();
        int tot = 0;
#pragma unroll
        for (int w = 0; w < 8; ++w) tot += red[par * 8 + w];
        par ^= 1;
        if (tot >= TOPK) T = cand; if (tot == TOPK) break; }
    __syncthreads();
    int* cg = red + 16; int* ce = cg + 33 * 8; int* pg = ce + 33 * 8; int* pe = pg + 33 * 8;
#pragma unroll
    for (int jj = 0; jj < 33; ++jj) { const int a = __popcll(__ballot(v[jj] > T)), e = __popcll(__ballot(v[jj] == T)); if (lane == 0) { cg[jj * 8 + wv] = a; ce[jj * 8 + wv] = e; } }
    __syncthreads();
    if (tid < 33 * 8) { int a = 0, e = 0; for (int i = 0; i < tid; ++i) { a += cg[i]; e += ce[i]; } pg[tid] = a; pe[tid] = e; }
    if (tid == 0) { int a = 0; for (int i = 0; i < 33 * 8; ++i) a += cg[i]; red[0] = a; }
    __syncthreads();
    const int need = TOPK - red[0]; const unsigned long long lt = (1ull << lane) - 1ull;
#pragma unroll
    for (int jj = 0; jj < 33; ++jj) {
        const bool gt = v[jj] > T, eq = v[jj] == T; const unsigned long long me = __ballot(eq), mg = __ballot(gt);
        const int epre = pe[jj * 8 + wv] + __popcll(me & lt), gpre = pg[jj * 8 + wv] + __popcll(mg & lt); const bool sel = gt || (eq && epre < need);
        const int ebc = epre < need ? epre : need;
        if (sel) SELS[gpre + ebc] = jj * 512 + tid;
    }
    __syncthreads();
}

DEVI void attn_sample_unit(CP p, int j, int q) {
    const int TIDX = ltid();
    const float* H = wsf(p, WS_H); const int* SELS = (const int*)(p->ws + WS_SELS) + q * TOPK; bf16* AO = wsb(p, WS_AO);
    const int row = MPR + q, b = q / DS, h = TIDX >> 6, lane = TIDX & 63, g = h >> 2;
    const float q0 = H[(size_t)row * HC_AB + C_Q + h * 128 + lane], q1 = H[(size_t)row * HC_AB + C_Q + h * 128 + 64 + lane];
    float m = -1e30f, l = 0.f, o0 = 0.f, o1 = 0.f;
    for (int i = 0; i < TOPK; ++i) { const int s = SELS[i]; const float *kr, *vr;
        if (s < PAST) { const int pg = p->page_table[b * NPAGES + s / PAGE]; const size_t o = ((((size_t)j * NPOOL + pg) * PAGE + s % PAGE) * 2 + g) * 128; kr = p->cache_k + o; vr = p->cache_v + o; }
        else { const size_t o = (size_t)(MPR + b * DS + s - PAST) * HC_AB + g * 128; kr = H + o + C_K; vr = H + o + C_V; }
        const float lg = wave_sum(q0 * kr[lane] + q1 * kr[lane + 64]) * ATT_SCALE;
        const float mn = fmaxf(m, lg), al = __expf(m - mn), pe = __expf(lg - mn);
        l = l * al + pe; o0 = o0 * al + pe * vr[lane]; o1 = o1 * al + pe * vr[lane + 64]; m = mn; }
    const float il = 1.f / l;
    AO[(size_t)row * DM + h * 128 + lane] = f2bf(o0 * il); AO[(size_t)row * DM + h * 128 + 64 + lane] = f2bf(o1 * il);
}

DEVI void ph_cd_prep(CP p, int j, int vb, int nvb) {
    const int TIDX = ltid();
    const float* H = wsf(p, WS_H); bf16* DD = wsb(p, WS_DD); bf16* U = wsb(p, WS_U); bf16* VLN = wsb(p, WS_VLN);
    const float* lg = p->sgu_ln_g + (size_t)j * 1024; const float* lb = p->sgu_ln_b + (size_t)j * 1024;
    const int lane = TIDX & 63, wv = TIDX >> 6;
    for (int row = vb * 8 + wv; row < MR; row += nvb * 8) {
        const bool pr = row < MPR; const int b = pr ? row / SEQ : (row - MPR) / DS, t = pr ? row % SEQ : (row - MPR) % DS;
        const float* h = H + (size_t)row * HC_CD;
#pragma unroll 1
        for (int i = 0; i < 4; ++i) { const int c = i * 256 + lane * 4, w = 2 << i; const f32x4 cur = *(const f32x4*)(h + c); f32x4 s = cur; int cnt;
            if (pr) { cnt = (t + 1 < w) ? t + 1 : w; for (int u = 1; u < cnt; ++u) s += *(const f32x4*)(H + (size_t)(row - u) * HC_CD + c); }
            else { cnt = w; for (int u = 1; u < w; ++u) { const int e = 15 + t - u;
                    s += (e >= 15) ? *(const f32x4*)(H + (size_t)(MPR + b * DS + e - 15) * HC_CD + c) : *(const f32x4*)(p->state_pool + (((size_t)j * DB + b) * 15 + e) * 1024 + c); } }
            const float ic = 1.f / (float)cnt; const f32x4 d = s * ic - cur; uint2 o; o.x = pk2(d.x, d.y); o.y = pk2(d.z, d.w); *(uint2*)(DD + (size_t)row * 1024 + c) = o;
            if (pr) { if (t >= SEQ - 15) *(f32x4*)(p->out + O_PP + (((size_t)j * NBP + b) * 15 + (t - (SEQ - 15))) * 1024 + c) = cur; }
            else { *(f32x4*)(p->out + O_PS + (((size_t)j * DB + b) * 15 + 7 + t) * 1024 + c) = cur;
                   if (t == 0) for (int e = 0; e < 7; ++e) *(f32x4*)(p->out + O_PS + (((size_t)j * DB + b) * 15 + e) * 1024 + c) = *(const f32x4*)(p->state_pool + (((size_t)j * DB + b) * 15 + 8 + e) * 1024 + c); }
        }
        asm volatile("" ::: "memory");
#pragma unroll
        for (int i = 0; i < 4; ++i) { const int c = (i * 64 + lane) * 4; const f32x4 u = *(const f32x4*)(h + 1024 + c); uint2 o; o.x = pk2(gelu_f(u.x), gelu_f(u.y)); o.y = pk2(gelu_f(u.z), gelu_f(u.w)); *(uint2*)(U + (size_t)row * 1024 + c) = o; }
        asm volatile("" ::: "memory");
        f32x4 v[4]; float s = 0.f;
#pragma unroll
        for (int i = 0; i < 4; ++i) { const int c = (i * 64 + lane) * 4; const f32x4 x = *(const f32x4*)(h + 2048 + c); v[i] = (f32x4){gelu_f(x.x), gelu_f(x.y), gelu_f(x.z), gelu_f(x.w)}; s += (v[i].x + v[i].y) + (v[i].z + v[i].w); }
        const float mean = wave_sum(s) * (1.f / 1024.f); float q = 0.f;
#pragma unroll
        for (int i = 0; i < 4; ++i) { v[i] = v[i] - mean; q += (v[i].x * v[i].x + v[i].y * v[i].y) + (v[i].z * v[i].z + v[i].w * v[i].w); }
        const float rstd = 1.f / sqrtf(wave_sum(q) * (1.f / 1024.f) + EPS);
#pragma unroll
        for (int i = 0; i < 4; ++i) { const int c = (i * 64 + lane) * 4; const f32x4 y = v[i] * rstd * *(const f32x4*)(lg + c) + *(const f32x4*)(lb + c);
            uint2 o; o.x = pk2(y.x, y.y); o.y = pk2(y.z, y.w); *(uint2*)(VLN + (size_t)row * 1024 + c) = o;
            if (!pr) *(f32x4*)(p->out + O_GS + ((size_t)j * MSR + (row - MPR)) * 1024 + c) = y; }
    }
}

DEVI void ph_sgu_naive(CP p, int j, int vb, int nvb) {
    const int TIDX = ltid();
    const bf16* VLN = wsb(p, WS_VLN); const bf16* U = wsb(p, WS_U); bf16* AO = wsb(p, WS_AO);
    for (int row = vb; row < MR; row += nvb) {
        const bool pr = row < MPR; const int t = pr ? row % SEQ : (row - MPR) % DS;
        const int tt = pr ? (t & 127) : t, base = row - tt;
        for (int d = TIDX; d < 1024; d += 512) { const int g = d >> 8; const float* w = p->sgu_w + (((size_t)j * 4 + g) * 128 + tt) * 128;
            float acc = p->sgu_b[((size_t)j * 4 + g) * 128 + tt];
            for (int s = 0; s <= tt; ++s) acc += w[s] * bf2f(VLN[(size_t)(base + s) * 1024 + d]);
            AO[(size_t)row * DM + 1024 + d] = f2bf(bf2f(U[(size_t)row * 1024 + d]) * acc); }
    }
}


DEVI void diag_cmp(CP p, int k, const bf16* a, int lda, const bf16* b, int ldb, int rows, int cols, int vb, int nvb) {
    unsigned* ctl = (unsigned*)(p->ws + WS_CTL); const int tid = ltid(); float mx = 0.f; unsigned bad = 0;
    for (int r = vb; r < rows; r += nvb) for (int c = tid; c < cols; c += 512) { const float x = bf2f(a[(size_t)r * lda + c]), y = bf2f(b[(size_t)r * ldb + c]); const float d = fabsf(x - y);
        if (!(d == d) || d > 1e30f) bad++; else mx = fmaxf(mx, d); }
    atomicMax(ctl + 64 + 2 * k, __float_as_uint(mx)); if (bad) atomicAdd(ctl + 65 + 2 * k, bad);
}
DEVI void diag_cmp_f32(CP p, int k, const float* a, int lda, const bf16* b, int ldb, int rows, int cols, int vb, int nvb) {
    unsigned* ctl = (unsigned*)(p->ws + WS_CTL); const int tid = ltid(); float mx = 0.f; unsigned bad = 0;
    for (int r = vb; r < rows; r += nvb) for (int c = tid; c < cols; c += 512) { const float x = a[(size_t)r * lda + c], y = bf2f(b[(size_t)r * ldb + c]); const float d = fabsf(x - y);
        if (!(d == d) || d > 1e30f) bad++; else mx = fmaxf(mx, d); }
    atomicMax(ctl + 64 + 2 * k, __float_as_uint(mx)); if (bad) atomicAdd(ctl + 65 + 2 * k, bad);
}
DEVI void diag_fin_f32(CP p, int k, const float* a, size_t n, int vb, int nvb) {
    unsigned* ctl = (unsigned*)(p->ws + WS_CTL); unsigned bad = 0;
    for (size_t i = (size_t)vb * 512 + ltid(); i < n; i += (size_t)nvb * 512) { const float x = a[i]; if (!(x == x) || fabsf(x) > 1e30f) bad++; }
    if (bad) atomicAdd(ctl + 65 + 2 * k, bad);
}
DEVI void diag_fin_bf16(CP p, int k, const bf16* a, size_t n, int vb, int nvb) {
    unsigned* ctl = (unsigned*)(p->ws + WS_CTL); unsigned bad = 0;
    for (size_t i = (size_t)vb * 512 + ltid(); i < n; i += (size_t)nvb * 512) { const float x = bf2f(a[i]); if (!(x == x) || fabsf(x) > 1e30f) bad++; }
    if (bad) atomicAdd(ctl + 65 + 2 * k, bad);
}
DEVI void diag_report(CP p, int nchecks) {
    unsigned* ctl = (unsigned*)(p->ws + WS_CTL);
    if (blockIdx.x == 0 && threadIdx.x == 0) { const unsigned fl = __hip_atomic_load(ctl + 96, __ATOMIC_RELAXED, __HIP_MEMORY_SCOPE_AGENT); if (fl) { p->out[O_KP] = (float)fl * 1e12f; return; } }
    if (blockIdx.x == 0 && threadIdx.x == 0) for (int k = 0; k < nchecks; ++k) { const float mx = __uint_as_float(__hip_atomic_load(ctl + 64 + 2 * k, __ATOMIC_RELAXED, __HIP_MEMORY_SCOPE_AGENT)); const unsigned bad = __hip_atomic_load(ctl + 65 + 2 * k, __ATOMIC_RELAXED, __HIP_MEMORY_SCOPE_AGENT);
        if (bad) { p->out[O_KP] = (70.f + k) * 1e19f; break; } if (mx > 0.06f) { p->out[O_KP] = mx * 1e8f; break; } }
}
namespace pg8 {
#define PG8_LAS __attribute__((address_space(3)))
typedef unsigned short bf16_t;
typedef short bf16x8 __attribute__((ext_vector_type(8)));
typedef float f32x4 __attribute__((ext_vector_type(4)));
typedef unsigned u32x4 __attribute__((ext_vector_type(4)));
constexpr int BM = 256, BK = 64, HALF = 128, HTB = HALF * BK * 2  , STAGE_BYTES = 8 * HTB, NXCD = 8, WGM = 8;

__host__ __device__ __forceinline__ int lds_byte(int r, int c) { const int st = (r >> 4) * 2 + (c >> 5), rr = r & 15, cc = c & 31, ob = rr * 64 + cc * 2; return st * 1024 + (ob ^ (((ob >> 9) & 1) << 5)); }
__host__ __device__ __forceinline__ void stage_rc(int b, int& R, int& C) { const int st = b / 1024, sb = b % 1024, swz = sb ^ (((sb >> 9) & 1) << 5); R = (st >> 1) * 16 + swz / 64; C = (st & 1) * 32 + (swz % 64) / 2; }
__host__ __device__ __forceinline__ int perm32(int rho) { const int n = rho >> 4, i = rho & 15; return 8 * (i >> 2) + 4 * n + (i & 3); }

struct Unit { int pm, pn; };
struct Gemm { const bf16_t* A; const bf16_t* Bt; int M, N, K, lda, ldb, acol; };

struct StaticOrder {
    int nM, nN, nwg, G, c;
    __host__ __device__ void init(int M, int N, int G_, int c_) { nM = M / BM; nN = N / BM; nwg = nM * nN; G = G_; c = c_; }
    __host__ __device__ bool next(int i, Unit& u) const {
        const long L = (long)i * G + c; if (L >= nwg) return false;
        int wgid = (int)L; { const int q = nwg / NXCD, r = nwg % NXCD, xcd = wgid % NXCD, off = wgid / NXCD; wgid = (xcd < r ? xcd * (q + 1) : r * (q + 1) + (xcd - r) * q) + off; }
        const int nig = WGM * nN, gid = wgid / nig, fm = gid * WGM, gsz = (nM - fm) < WGM ? (nM - fm) : WGM;
        u.pm = fm + ((wgid % nig) % gsz); u.pn = (wgid % nig) / gsz; return true;
    }
    __device__ __forceinline__ void a_ready(const Unit&) const {}
    __device__ __forceinline__ void done(const Unit&) const {}
};

template <class Epi, class Sched, bool ALIGN_EPI = false, bool SP2 = false>
__device__ __forceinline__ void gemm_phase(PG8_LAS unsigned char* lds, const Gemm g, const Sched& S, const Epi& E) {
    int tid_ = threadIdx.x; asm volatile("" : "+v"(tid_)); const int tid = tid_, wid = __builtin_amdgcn_readfirstlane(tid >> 6), lane = tid & 63, wr = wid >> 2, wc = wid & 3, fr = lane & 15, fq = lane >> 4;
    const int K = g.K, nt = K / BK;
    unsigned voffA[2], voffB[2];
#pragma unroll
    for (int i = 0; i < 2; ++i) { int R, C; stage_rc(tid * 16 + i * 8192, R, C); const int Rb = Epi::PERM ? ((R & ~31) + perm32(R & 31)) : R;
        voffA[i] = (unsigned)(R * g.lda + C) * 2u; voffB[i] = (unsigned)(Rb * g.ldb + C) * 2u; }
    const size_t kstep = (size_t)(BK * 2);
    const size_t hstepA = (size_t)HALF * g.lda * 2, hstepB = (size_t)HALF * g.ldb * 2;
    const size_t tstepA = 2 * hstepA, tstepB = 2 * hstepB, acolB = (size_t)g.acol * 2;
    const unsigned ldsw = (unsigned)wid * 1024u;
    const int aoff = lds_byte(wr * 64 + fr, fq * 8), boff = lds_byte(wc * 32 + fr, fq * 8);
#define PG8_SA(b, h) (((b) * 2 + (h)) * HTB)
#define PG8_SB(b, h) ((4 + (b) * 2 + (h)) * HTB)
#define PG8_STAGE(bufoff, gbase, voff) do { _Pragma("unroll") for (int _i = 0; _i < 2; ++_i) \
        __builtin_amdgcn_global_load_lds((const unsigned*)((const char*)(gbase) + (voff)[_i]), (PG8_LAS unsigned*)(lds + (bufoff) + ldsw + _i * 8192), 16, 0, 0); } while (0)
#define PG8_LDA(dst, b, h) do { _Pragma("unroll") for (int m = 0; m < 4; ++m) _Pragma("unroll") for (int k = 0; k < 2; ++k) dst[m][k] = *(const PG8_LAS bf16x8*)(lds + PG8_SA(b, h) + aoff + m * 2048 + k * 1024); } while (0)
#define PG8_LDB(dst, b, h) do { _Pragma("unroll") for (int n = 0; n < 2; ++n) _Pragma("unroll") for (int k = 0; k < 2; ++k) dst[n][k] = *(const PG8_LAS bf16x8*)(lds + PG8_SB(b, h) + boff + n * 2048 + k * 1024); } while (0)
#define PG8_MMA(ai, bj, At, Bt) do { __builtin_amdgcn_s_setprio(1); _Pragma("unroll") for (int m = 0; m < 4; ++m) _Pragma("unroll") for (int n = 0; n < 2; ++n) _Pragma("unroll") for (int k = 0; k < 2; ++k) \
        acc[ai][bj][m][n] = __builtin_amdgcn_mfma_f32_16x16x32_bf16(Bt[n][k], At[m][k], acc[ai][bj][m][n], 0, 0, 0); __builtin_amdgcn_s_setprio(0); } while (0)
#define PG8_WAIT_V(n) asm volatile("s_waitcnt vmcnt(" #n ")" ::: "memory")
#define PG8_WAIT_L(n) asm volatile("s_waitcnt lgkmcnt(" #n ")" ::: "memory")
#define PG8_BAR __builtin_amdgcn_s_barrier()
#define PG8_SCHED __builtin_amdgcn_sched_barrier(0)
    Unit cur, nxt; int ui = 0;
    if (!S.next(0, cur)) return;
    f32x4 acc[2][2][4][2];
#pragma unroll
    for (int a = 0; a < 2; ++a)
#pragma unroll
        for (int b = 0; b < 2; ++b)
#pragma unroll
            for (int m = 0; m < 4; ++m)
#pragma unroll
                for (int n = 0; n < 2; ++n) acc[a][b][m][n] = (f32x4){0.f, 0.f, 0.f, 0.f};
    bf16x8 At[4][2], B0[2][2], B1[2][2];
    const char* cA = (const char*)g.A + (size_t)cur.pm * tstepA + (size_t)cur.pn * acolB; const char* cB = (const char*)g.Bt + (size_t)cur.pn * tstepB;
    S.a_ready(cur);
    if constexpr (SP2) {
        PG8_STAGE(PG8_SB(0, 0), cB, voffB); PG8_STAGE(PG8_SB(0, 1), cB + hstepB, voffB); PG8_STAGE(PG8_SA(0, 0), cA, voffA); PG8_STAGE(PG8_SA(0, 1), cA + hstepA, voffA);
        if (wr == 1) PG8_BAR;
        PG8_WAIT_V(2); PG8_BAR;
        PG8_STAGE(PG8_SB(1, 0), cB + kstep, voffB); PG8_STAGE(PG8_SA(1, 0), cA + kstep, voffA); PG8_STAGE(PG8_SB(1, 1), cB + hstepB + kstep, voffB);
        PG8_WAIT_V(6); PG8_BAR;
    } else {
        PG8_STAGE(PG8_SB(0, 0), cB, voffB); PG8_STAGE(PG8_SA(0, 0), cA, voffA); PG8_STAGE(PG8_SB(0, 1), cB + hstepB, voffB); PG8_STAGE(PG8_SA(0, 1), cA + hstepA, voffA);
        if (wr == 1) PG8_BAR;
        PG8_WAIT_V(4); PG8_BAR;
        PG8_STAGE(PG8_SB(1, 0), cB + kstep, voffB); PG8_STAGE(PG8_SA(1, 0), cA + kstep, voffA); PG8_STAGE(PG8_SB(1, 1), cB + hstepB + kstep, voffB);
        PG8_WAIT_V(6); PG8_BAR;
    }
    for (;;) {
        const bool has_next = S.next(ui + 1, nxt);
        const char* nA = has_next ? (const char*)g.A + (size_t)nxt.pm * tstepA + (size_t)nxt.pn * acolB : cA; const char* nB = has_next ? (const char*)g.Bt + (size_t)nxt.pn * tstepB : cB;
        for (int t = 0; t < nt; t += 2) {
            const bool last = (t == nt - 2);
            const char* a1 = cA + (size_t)(t + 1) * kstep;
            const char* a2 = last ? nA : cA + (size_t)(t + 2) * kstep; const char* b2 = last ? nB : cB + (size_t)(t + 2) * kstep;
            const char* a3 = a2 + kstep; const char* b3 = b2 + kstep;
            if (last && has_next) S.a_ready(nxt);
            if constexpr (SP2) {
            PG8_LDB(B0, 0, 0); PG8_LDB(B1, 0, 1); PG8_SCHED; PG8_LDA(At, 0, 0); PG8_STAGE(PG8_SA(1, 1), a1 + hstepA, voffA);
            PG8_WAIT_V(8); PG8_WAIT_L(0); PG8_BAR; PG8_MMA(0, 0, At, B0); PG8_MMA(0, 1, At, B1); PG8_BAR; PG8_SCHED;
            PG8_LDA(At, 0, 1); PG8_STAGE(PG8_SB(0, 0), b2, voffB); PG8_STAGE(PG8_SB(0, 1), b2 + hstepB, voffB); PG8_STAGE(PG8_SA(0, 0), a2, voffA);
            PG8_WAIT_V(8); PG8_WAIT_L(0); PG8_BAR; PG8_MMA(1, 0, At, B0); PG8_MMA(1, 1, At, B1); PG8_BAR; PG8_SCHED;
            PG8_LDB(B0, 1, 0); PG8_LDB(B1, 1, 1); PG8_SCHED; PG8_LDA(At, 1, 0); PG8_STAGE(PG8_SA(0, 1), a2 + hstepA, voffA);
            PG8_WAIT_V(8); PG8_WAIT_L(0); PG8_BAR; PG8_MMA(0, 0, At, B0); PG8_MMA(0, 1, At, B1); PG8_BAR; PG8_SCHED;
            PG8_LDA(At, 1, 1); PG8_STAGE(PG8_SB(1, 0), b3, voffB); PG8_STAGE(PG8_SB(1, 1), b3 + hstepB, voffB); PG8_STAGE(PG8_SA(1, 0), a3, voffA);
            PG8_WAIT_V(8); PG8_WAIT_L(0); PG8_BAR; PG8_MMA(1, 0, At, B0); PG8_MMA(1, 1, At, B1); PG8_BAR; PG8_SCHED;
            } else {
            PG8_LDB(B0, 0, 0); PG8_SCHED; PG8_LDA(At, 0, 0); PG8_STAGE(PG8_SA(1, 1), a1 + hstepA, voffA);
            PG8_WAIT_L(8); PG8_BAR; PG8_WAIT_L(0); PG8_MMA(0, 0, At, B0); PG8_BAR; PG8_SCHED;
            PG8_LDB(B1, 0, 1); PG8_STAGE(PG8_SB(0, 0), b2, voffB);
            PG8_BAR; PG8_WAIT_L(0); PG8_MMA(0, 1, At, B1); PG8_BAR;
            PG8_LDA(At, 0, 1); PG8_STAGE(PG8_SA(0, 0), a2, voffA);
            PG8_BAR; PG8_WAIT_L(0); PG8_MMA(1, 0, At, B0); PG8_BAR; PG8_SCHED;
            PG8_STAGE(PG8_SB(0, 1), b2 + hstepB, voffB);
            PG8_WAIT_V(6); PG8_BAR; PG8_MMA(1, 1, At, B1); PG8_BAR;
            PG8_LDB(B0, 1, 0); PG8_SCHED; PG8_LDA(At, 1, 0); PG8_STAGE(PG8_SA(0, 1), a2 + hstepA, voffA);
            PG8_WAIT_L(8); PG8_BAR; PG8_WAIT_L(0); PG8_MMA(0, 0, At, B0); PG8_BAR; PG8_SCHED;
            PG8_LDB(B1, 1, 1); PG8_STAGE(PG8_SB(1, 0), b3, voffB);
            PG8_BAR; PG8_WAIT_L(0); PG8_MMA(0, 1, At, B1); PG8_BAR;
            PG8_LDA(At, 1, 1); PG8_STAGE(PG8_SA(1, 0), a3, voffA);
            PG8_BAR; PG8_WAIT_L(0); PG8_MMA(1, 0, At, B0); PG8_BAR; PG8_SCHED;
            PG8_STAGE(PG8_SB(1, 1), b3 + hstepB, voffB);
            PG8_WAIT_V(6); PG8_BAR; PG8_MMA(1, 1, At, B1); PG8_BAR;
            }
        }
        if constexpr (ALIGN_EPI) { if (wr == 0) PG8_BAR; }
        if constexpr (!Epi::AFTER_DRAIN) { E(acc, cur, wr, wc, fr, fq); S.done(cur); }
        if (!has_next) break;
#pragma unroll
        for (int a = 0; a < 2; ++a)
#pragma unroll
            for (int b = 0; b < 2; ++b)
#pragma unroll
                for (int m = 0; m < 4; ++m)
#pragma unroll
                    for (int n = 0; n < 2; ++n) acc[a][b][m][n] = (f32x4){0.f, 0.f, 0.f, 0.f};
        cur = nxt; cA = nA; cB = nB; ++ui;
        if constexpr (ALIGN_EPI) { if (wr == 1) PG8_BAR; }
    }
    PG8_WAIT_V(0);
    if constexpr (!ALIGN_EPI) { if (wr == 0) PG8_BAR; }
    PG8_BAR;
    if constexpr (Epi::AFTER_DRAIN) { E.fused(acc, cur, wr, wc, fr, fq, lds, wid, lane); S.done(cur); }
#undef PG8_SA
#undef PG8_SB
#undef PG8_STAGE
#undef PG8_LDA
#undef PG8_LDB
#undef PG8_MMA
#undef PG8_WAIT_V
#undef PG8_WAIT_L
#undef PG8_BAR
#undef PG8_SCHED
}
}
namespace pg8 {
__device__ __forceinline__ unsigned cvt_pk_bf16(float lo, float hi) { unsigned r; asm volatile("v_cvt_pk_bf16_f32 %0, %1, %2" : "=v"(r) : "v"(lo), "v"(hi)); return r; }
struct EpiF32 {
    static constexpr bool PERM = false, AFTER_DRAIN = false;
    float* C; int ldc;
    __device__ __forceinline__ void operator()(const f32x4 (&acc)[2][2][4][2], const Unit& u, int wr, int wc, int, int) const {
        int ln_ = threadIdx.x & 63; asm volatile("" : "+v"(ln_)); const int fr = ln_ & 15, fq = ln_ >> 4;
        const int row0 = u.pm * BM + wr * 64 + fr, col0 = u.pn * BM + wc * 32 + 4 * fq;
#pragma unroll
        for (int ai = 0; ai < 2; ++ai)
#pragma unroll
            for (int m = 0; m < 4; ++m) { float* rowp = C + (size_t)(row0 + ai * HALF + m * 16) * ldc + col0;
#pragma unroll
                for (int bj = 0; bj < 2; ++bj)
#pragma unroll
                    for (int n = 0; n < 2; ++n) *(f32x4*)(rowp + bj * HALF + n * 16) = acc[ai][bj][m][n]; }
    }
};
struct EpiResid {
    static constexpr bool PERM = false, AFTER_DRAIN = false;
    float* X; int ldc; float alpha;
    __device__ __forceinline__ void operator()(const f32x4 (&acc)[2][2][4][2], const Unit& u, int wr, int wc, int, int) const {
        int ln_ = threadIdx.x & 63; asm volatile("" : "+v"(ln_)); const int fr = ln_ & 15, fq = ln_ >> 4;
        const int row0 = u.pm * BM + wr * 64 + fr, col0 = u.pn * BM + wc * 32 + 4 * fq;
#pragma unroll
        for (int ai = 0; ai < 2; ++ai)
#pragma unroll
            for (int m = 0; m < 4; ++m) { float* rowp = X + (size_t)(row0 + ai * HALF + m * 16) * ldc + col0;
#pragma unroll
                for (int bj = 0; bj < 2; ++bj) { const f32x4 o0 = *(const f32x4*)(rowp + bj * HALF), o1 = *(const f32x4*)(rowp + bj * HALF + 16);
                    *(f32x4*)(rowp + bj * HALF) = o0 * alpha + acc[ai][bj][m][0]; *(f32x4*)(rowp + bj * HALF + 16) = o1 * alpha + acc[ai][bj][m][1];
                    asm volatile("" ::: "memory"); } }
    }
};
template <int ACT  > struct EpiBf16 {
    static constexpr bool PERM = true, AFTER_DRAIN = false;
    bf16_t* O; int ldc; const float* scale;
    __device__ __forceinline__ void operator()(const f32x4 (&acc)[2][2][4][2], const Unit& u, int wr, int wc, int, int) const {
        int ln_ = threadIdx.x & 63; asm volatile("" : "+v"(ln_)); const int fr = ln_ & 15, fq = ln_ >> 4;
        const int row0 = u.pm * BM + wr * 64 + fr, col0 = u.pn * BM + wc * 32 + 8 * fq;
        f32x4 sv[2][2];
#pragma unroll
        for (int bj = 0; bj < 2; ++bj)
#pragma unroll
            for (int n = 0; n < 2; ++n) sv[bj][n] = (ACT == 0) ? *(const f32x4*)(scale + col0 + bj * HALF + 4 * n) : (f32x4){1.f, 1.f, 1.f, 1.f};
#pragma unroll
        for (int ai = 0; ai < 2; ++ai)
#pragma unroll
            for (int m = 0; m < 4; ++m) { bf16_t* rowp = O + (size_t)(row0 + ai * HALF + m * 16) * ldc + col0;
#pragma unroll
                for (int bj = 0; bj < 2; ++bj) { f32x4 v0 = acc[ai][bj][m][0], v1 = acc[ai][bj][m][1];
                    if (ACT == 0) { v0 = v0 * sv[bj][0]; v1 = v1 * sv[bj][1]; }
                    if (ACT == 1) {
#pragma unroll
                        for (int q = 0; q < 4; ++q) { const float a = fmaxf(v0[q], 0.f), b = fmaxf(v1[q], 0.f); v0[q] = a * a; v1[q] = b * b; } }
                    u32x4 w; w.x = cvt_pk_bf16(v0[0], v0[1]); w.y = cvt_pk_bf16(v0[2], v0[3]); w.z = cvt_pk_bf16(v1[0], v1[1]); w.w = cvt_pk_bf16(v1[2], v1[3]);
                    *(u32x4*)(rowp + bj * HALF) = w; } }
    }
};
}
#define LAS __attribute__((address_space(3)))
#define XB_TMO      128
#define XB_XCNT(j)  (256  + 64 * (j))
#define XB_XSUB(j)  (1280 + 64 * (j))
#define XB_XGEN(j)  (2304 + 64 * (j))
#define XB_TOP      3328
#define XB_TOPGEN   3392
#define XCD_BAR_WORDS 3456
#define XB_SPIN_CAP (1u << 18)

__device__ __forceinline__ unsigned xb_ld(unsigned* p)              { return __hip_atomic_load(p, __ATOMIC_RELAXED, __HIP_MEMORY_SCOPE_AGENT); }
__device__ __forceinline__ unsigned xb_add(unsigned* p, unsigned v) { return __hip_atomic_fetch_add(p, v, __ATOMIC_RELAXED, __HIP_MEMORY_SCOPE_AGENT); }
__device__ __forceinline__ unsigned xb_xcc_id() { return (unsigned)__builtin_amdgcn_s_getreg((3 << 11) | 20) & 0xFu; }
#define XB_SPIN(cond, bar) do { unsigned _sp = 0; while (cond) { __builtin_amdgcn_s_sleep(1); \
    if ((++_sp & 255u) == 0u) { if (xb_ld(&(bar)[XB_TMO])) break; if (_sp > XB_SPIN_CAP) { atomicAdd(&(bar)[XB_TMO], 1u); break; } } } } while (0)

struct XcdBarrier {
    unsigned* bar; unsigned x;
    volatile LAS unsigned* st;
};

__device__ __forceinline__ XcdBarrier xcd_barrier_post(unsigned* bar, volatile LAS unsigned* st) {
    XcdBarrier b; b.bar = bar; b.x = xb_xcc_id(); b.st = st;
    if (threadIdx.x == 0) (void)xb_add(&bar[XB_XCNT(b.x)], 1u);
    return b;
}
__device__ __forceinline__ void xcd_barrier_complete(unsigned* bar, unsigned x, unsigned& nloc, unsigned& nx) {
    const unsigned G = gridDim.x * gridDim.y * gridDim.z;
    unsigned sum, cnt, mine, sp = 0u;
    for (;;) {
        sum = 0u; cnt = 0u; mine = 0u;
#pragma unroll
        for (unsigned j = 0; j < 16; ++j) { const unsigned c = xb_ld(&bar[XB_XCNT(j)]); sum += c; cnt += (c > 0u) ? 1u : 0u; mine = (j == x) ? c : mine; }
        if (sum == G) break;
        __builtin_amdgcn_s_sleep(1);
        if ((++sp & 255u) == 0u) { if (xb_ld(&bar[XB_TMO])) break; if (sp > XB_SPIN_CAP) { atomicAdd(&bar[XB_TMO], 1u); break; } }
    }
    nloc = mine > 0u ? mine : 1u; nx = cnt > 0u ? cnt : 1u;
}

__device__ __attribute__((noinline)) void xcd_barrier_impl(unsigned* bar_, unsigned bx_, volatile LAS unsigned* st_) {
    XcdBarrier b; b.bar = bar_; b.x = bx_; b.st = st_;
    asm volatile("s_waitcnt vmcnt(0)" ::: "memory");
    __syncthreads();
    if (threadIdx.x == 0) {
        unsigned* bar = b.bar;
        __builtin_amdgcn_s_waitcnt(0);
        unsigned nloc = b.st[0], nx = b.st[1];
        if (nloc == 0u) { xcd_barrier_complete(bar, b.x, nloc, nx); b.st[0] = nloc; b.st[1] = nx; }
        const unsigned old = xb_add(&bar[XB_XSUB(b.x)], 1u);
        const unsigned gen = old / nloc;
        if (old + 1u == (gen + 1u) * nloc) {
            __builtin_amdgcn_fence(__ATOMIC_RELEASE, "agent");
            asm volatile("s_waitcnt vmcnt(0)" ::: "memory");
            const unsigned og = xb_add(&bar[XB_TOP], 1u);
            const unsigned tg = og / nx;
            if (og + 1u == (tg + 1u) * nx) xb_add(&bar[XB_TOPGEN], 1u);
            else XB_SPIN(xb_ld(&bar[XB_TOPGEN]) == tg, bar);
            __builtin_amdgcn_fence(__ATOMIC_ACQUIRE, "agent");
            xb_add(&bar[XB_XGEN(b.x)], 1u);
            asm volatile("s_waitcnt vmcnt(0)" ::: "memory");
        } else {
            XB_SPIN(xb_ld(&bar[XB_XGEN(b.x)]) == gen, bar);
            __builtin_amdgcn_fence(__ATOMIC_ACQUIRE, "agent");
            asm volatile("s_waitcnt vmcnt(0)" ::: "memory");
        }
    }
    __syncthreads();
}
__device__ __forceinline__ void xcd_barrier(const XcdBarrier& b) { xcd_barrier_impl(b.bar, b.x, b.st); }
constexpr int NWAVES = 8;
constexpr int RING_BYTES = 131072, LDSCTL_OFF = RING_BYTES, MISC_OFF = LDSCTL_OFF + 320, LDS_BYTES = 147456;
constexpr size_t CTL_ZERO_BYTES = 1u << 20;
constexpr int CW_BAR = 4096;
constexpr int PH_PER_LAYER = 12, N_PHASES = 1 + 4 * PH_PER_LAYER;

DEVI void tr_job(const float* W, int K, int N, bf16* WT, int abmap, int vb, int nvb, float* t) {
    const int units = (K / 64) * ((N + 63) / 64);
    for (int u = vb; u < units; u += nvb) transpose_unit(W, K, N, WT, abmap, u, t);
}
DEVI void ph_prologue(CP p, int vb, int nvb, float* t) {
    bf16 *WINAB = wsb(p, WS_WINAB), *WOUTAB = wsb(p, WS_WOUTAB), *WINCD = wsb(p, WS_WINCD), *WOUTCD = wsb(p, WS_WOUTCD), *WFF1 = wsb(p, WS_WFF1), *WFF2 = wsb(p, WS_WFF2), *POOLW = wsb(p, WS_POOLW);
    for (int j = 0; j < 2; ++j) {
        tr_job(p->w_in_ab + (size_t)j * DM * 4696, DM, 4696, WINAB + (size_t)j * HC_AB * DM, 1, vb, nvb, t);
        tr_job(p->w_out_ab + (size_t)j * DM * DM, DM, DM, WOUTAB + (size_t)j * DM * DM, 0, vb, nvb, t);
        tr_job(p->w_in_cd + (size_t)j * DM * HC_CD, DM, HC_CD, WINCD + (size_t)j * HC_CD * DM, 0, vb, nvb, t);
        tr_job(p->w_out_cd + (size_t)j * DM * DM, DM, DM, WOUTCD + (size_t)j * DM * DM, 0, vb, nvb, t);
        tr_job(p->pool_w + (size_t)j * 4 * 65536, 256, 256, POOLW + (size_t)j * 4 * 65536, 0, vb, nvb, t);
        tr_job(p->pool_w + ((size_t)j * 4 + 1) * 65536, 256, 256, POOLW + ((size_t)j * 4 + 1) * 65536, 0, vb, nvb, t);
        tr_job(p->pool_w + ((size_t)j * 4 + 2) * 65536, 256, 256, POOLW + ((size_t)j * 4 + 2) * 65536, 0, vb, nvb, t);
        tr_job(p->pool_w + ((size_t)j * 4 + 3) * 65536, 256, 256, POOLW + ((size_t)j * 4 + 3) * 65536, 0, vb, nvb, t);
    }
    for (int i = 0; i < 4; ++i) {
        tr_job(p->w_ff1 + (size_t)i * DM * DFF, DM, DFF, WFF1 + (size_t)i * DFF * DM, 0, vb, nvb, t);
        tr_job(p->w_ff2 + (size_t)i * DFF * DM, DFF, DM, WFF2 + (size_t)i * DM * DFF, 0, vb, nvb, t);
    }
    const size_t gt = (size_t)vb * 512 + ltid(), ng = (size_t)nvb * 512;
    for (size_t i = gt; i < (size_t)2 * (HC_AB - 4696) * DM / 8; i += ng) { const size_t per = (size_t)(HC_AB - 4696) * DM / 8; const size_t j = i / per, r = i % per;
        *(u32x4*)(WINAB + j * HC_AB * DM + (size_t)4696 * DM + r * 8) = (u32x4){0u, 0u, 0u, 0u}; }
    bf16* sw = wsb(p, WS_SGUW);
    for (size_t i = gt; i < 2 * 4 * 128 * 128; i += ng) { const int s = (int)i & 127, tt = ((int)i >> 7) & 127; sw[i] = f2bf(s <= tt ? p->sgu_w[i] : 0.f); }
    float* X = wsf(p, WS_X); bf16* XB = wsb(p, WS_XB);
    for (size_t i = gt; i < (size_t)MP * DM / 4; i += ng) {
        const size_t e = i * 4; const int row = (int)(e / DM);
        f32x4 v = (f32x4){0.f, 0.f, 0.f, 0.f};
        if (row < MPR) v = *(const f32x4*)(p->x_prompt + e); else if (row < MR) v = *(const f32x4*)(p->x_sample + (e - (size_t)MPR * DM));
        *(f32x4*)(X + e) = v; uint2 o; o.x = pk2(v.x, v.y); o.y = pk2(v.z, v.w); *(uint2*)(XB + e) = o;
    }
}

template <class Epi> DEVI void run_gemm(PG8_LAS unsigned char* lds, const bf16* A, int lda, int acol, const bf16* Bt, int ldb, int M, int N, int K, const Epi& E) {
    asm volatile("" : "+s"(K));
    pg8::Gemm g{A, Bt, M, N, K, lda, ldb, acol}; pg8::StaticOrder S; S.init(M, N, (int)gridDim.x, lvb());
    pg8::gemm_phase<Epi, pg8::StaticOrder, true, true>(lds, g, S, E);
}

#define IN(k) (lo <= (k) && (k) < hi)
#define SEAM(k) do { if (IN(k) && (k) + 1 < hi) xcd_barrier(bar); } while (0)
template <int I> DEVI void layer_phases(LAS unsigned char* L, unsigned char* lds, const XcdBarrier& bar, int lo, int hi, int nvb) {
    constexpr int base = 1 + PH_PER_LAYER * I, j = I >> 1;
    float* smf = (float*)lds; int* smi = (int*)lds;
    if constexpr ((I & 1) == 0) {
        if (IN(base + 0)) { CP p = PP(); run_gemm(L, wsb(p, WS_XB), DM, 0, wsb(p, WS_WINAB) + (size_t)j * HC_AB * DM, DM, MP, HC_AB, DM, pg8::EpiF32{wsf(p, WS_H), HC_AB}); }
        SEAM(base + 0);
        if (IN(base + 1)) {
            ph_ab_copy(PP(), j, lvb(), nvb);
            for (int u = lvb(); u < 64 * 24; u += nvb) conv_prompt_unit(PP(), j, u / 24, u % 24, (bf16*)lds);
            ph_conv(PP(), j, lvb(), nvb);
            ph_idx_prompt_naive(PP(), lvb(), nvb, smf);
            for (int u = lvb(); u < 8 * 33; u += nvb) idx_sample_unit(PP(), j, u / 33, u % 33, smf);
        }
        SEAM(base + 1);
        if (IN(base + 2)) {
            ph_select_prompt(PP(), lvb(), nvb);
            for (int u = lvb(); u < MSR; u += nvb) select_sample_unit(PP(), u, smi);
            for (int u = lvb(); u < 64 * 16; u += nvb) ssd1_unit(PP(), j, u >> 4, u & 15, smf);
#ifdef EXP_OLDY
            { const int t_ = ltid(), u = (t_ >> 6) * nvb + lvb(); if (u < (NBP + DB) * 32) ssd_seq_unit(PP(), j, u / 32, (u >> 1) & 15, u & 1, t_ & 63); }
#else
            { const int t_ = ltid(), u = (t_ >> 6) * nvb + lvb(); if (u < DB * 32) ssd_seq_unit(PP(), j, NBP + u / 32, (u >> 1) & 15, u & 1, t_ & 63); }
#endif
        }
        SEAM(base + 2);
        if (IN(base + 3)) {
            ph_ssd_scan(PP(), j, lvb(), nvb);
            for (int u = lvb(); u < MSR; u += nvb) attn_sample_unit(PP(), j, u);
            ph_ssd_gate(PP(), j, lvb(), nvb);
        }
        SEAM(base + 3);
        if (IN(base + 4)) {
            ph_attn_prompt_naive(PP(), lvb(), nvb);
#ifdef EXP_OLDY
            for (int u = lvb(); u < 64 * 8; u += nvb) ssd3_unit(PP(), j, u >> 3, u & 7, smf, wsb(PP(), WS_HF));
#else
            for (int u = lvb(); u < 64 * 8; u += nvb) ssd3_unit(PP(), j, u >> 3, u & 7, smf, wsb(PP(), WS_AO));
#endif
        }
        SEAM(base + 4);
#ifdef EXP_OLDY
        if (IN(base + 5) && I == 0) { CP p = PP(); const int vb_ = lvb();
            diag_cmp_f32(p, 0, wsf(p, WS_XC), 1536, wsb(p, WS_XCN), 1536, MPR, 1536, vb_, nvb);
            diag_fin_f32(p, 1, wsf(p, WS_ACUM), (size_t)64 * 16 * 128, vb_, nvb);
            diag_fin_f32(p, 2, wsf(p, WS_DTC), (size_t)64 * 16 * 128, vb_, nvb);
            diag_fin_bf16(p, 3, wsb(p, WS_HIN), (size_t)64 * 16 * 8192, vb_, nvb);
            diag_fin_bf16(p, 4, wsb(p, WS_XCT), (size_t)64 * 1536 * 128, vb_, nvb);
            diag_cmp(p, 5, wsb(p, WS_AO) + 1024, DM, wsb(p, WS_HF) + 1024, DM, MPR, 1024, vb_, nvb); }
#endif
        if (IN(base + 5)) { CP p = PP(); run_gemm(L, wsb(p, WS_AO), DM, 0, wsb(p, WS_WOUTAB) + (size_t)j * DM * DM, DM, MP, DM, DM, pg8::EpiResid{wsf(p, WS_X), DM, ALPHA}); }
        SEAM(base + 5);
    } else {
        if (IN(base + 0)) { CP p = PP(); run_gemm(L, wsb(p, WS_XB), DM, 0, wsb(p, WS_WINCD) + (size_t)j * HC_CD * DM, DM, MP, HC_CD, DM, pg8::EpiF32{wsf(p, WS_H), HC_CD}); }
        SEAM(base + 0);
        if (IN(base + 1)) ph_cd_prep(PP(), j, lvb(), nvb);
        SEAM(base + 1);
        if (IN(base + 2)) {
            { CP p = PP(); run_gemm(L, wsb(p, WS_DD), 1024, 256, wsb(p, WS_POOLW) + (size_t)j * 4 * 65536, 256, MP, 1024, 256, pg8::EpiBf16<0>{wsb(p, WS_AO), DM, p->pool_scale + (size_t)j * 1024}); }
            ph_sgu_naive(PP(), j, lvb(), nvb);
        }
        if (IN(base + 2) && base + 5 < hi) xcd_barrier(bar);
        if (IN(base + 5)) { CP p = PP(); run_gemm(L, wsb(p, WS_AO), DM, 0, wsb(p, WS_WOUTCD) + (size_t)j * DM * DM, DM, MP, DM, DM, pg8::EpiResid{wsf(p, WS_X), DM, ALPHA}); }
        SEAM(base + 5);
    }
#ifdef EXP_OLDY
    if (IN(base + 6) && I == 0) diag_report(PP(), 6);
#endif
    if (IN(base + 6)) { CP p = PP(); ph_ln(p, p->ln1_g + (size_t)I * DM, p->ln1_b + (size_t)I * DM, 0, lvb(), nvb); }
    SEAM(base + 6);
    if (IN(base + 7)) { CP p = PP(); run_gemm(L, wsb(p, WS_XB), DM, 0, wsb(p, WS_WFF1) + (size_t)I * DFF * DM, DM, MP, DFF, DM, pg8::EpiBf16<1>{wsb(p, WS_HF), DFF, nullptr}); }
    SEAM(base + 7);
    if (IN(base + 8)) { CP p = PP(); run_gemm(L, wsb(p, WS_HF), DFF, 0, wsb(p, WS_WFF2) + (size_t)I * DM * DFF, DFF, MP, DM, DFF, pg8::EpiResid{wsf(p, WS_X), DM, ALPHA}); }
    SEAM(base + 8);
    if (IN(base + 9)) { CP p = PP(); ph_ln(p, p->ln2_g + (size_t)I * DM, p->ln2_b + (size_t)I * DM, I == 3, lvb(), nvb); }
    if (I < 3) { if (IN(base + 9) && base + PH_PER_LAYER < hi) xcd_barrier(bar); }
}

__global__ void __launch_bounds__(NWAVES * 64, 2) mk_fwd(P p_kernarg) {
    extern __shared__ __attribute__((aligned(16))) unsigned char lds[];
    LAS unsigned char* L = (LAS unsigned char*)lds;
    volatile LAS unsigned* MISC = (volatile LAS unsigned*)(L + MISC_OFF);
    const int nvb = gridDim.x;
    for (int u = threadIdx.x; u < (LDS_BYTES - LDSCTL_OFF) / 4; u += NWAVES * 64) ((LAS unsigned*)(L + LDSCTL_OFF))[u] = 0u;
    __syncthreads();
    unsigned* ctl = (unsigned*)(PP()->ws + WS_CTL);
    XcdBarrier bar = xcd_barrier_post(ctl + CW_BAR, MISC + 8);
    const int lo = PP()->ph_lo, hi = PP()->ph_hi;
    if (IN(0)) ph_prologue(PP(), lvb(), nvb, (float*)lds);
    SEAM(0);
    layer_phases<0>(L, lds, bar, lo, hi, nvb);
    layer_phases<1>(L, lds, bar, lo, hi, nvb);
    layer_phases<2>(L, lds, bar, lo, hi, nvb);
    layer_phases<3>(L, lds, bar, lo, hi, nvb);
}
#undef IN
#undef SEAM

#ifndef MK_PER_PHASE
#define MK_PER_PHASE 0
#endif
extern "C" void kernel_launch(void* const* d_in, const int* in_sizes, int n_in, void* d_out, int out_size, void* d_ws, size_t ws_size, hipStream_t stream) {
    if (n_in != 31 || (size_t)out_size != O_END || ws_size < WS_END) { fprintf(stderr, "kernel_launch: unexpected sizes n_in %d out %d ws %zu (need %zu)\n", n_in, out_size, ws_size, (size_t)WS_END); return; }
    static int grid = 0;
    if (grid == 0) {
        int dev = 0, cus = 0, per_cu = 0;
        if (hipGetDevice(&dev) != hipSuccess || hipDeviceGetAttribute(&cus, hipDeviceAttributeMultiprocessorCount, dev) != hipSuccess) { grid = -1; return; }
        if (hipFuncSetAttribute((const void*)mk_fwd, hipFuncAttributeMaxDynamicSharedMemorySize, LDS_BYTES) != hipSuccess) { fprintf(stderr, "kernel_launch: hipFuncSetAttribute failed\n"); grid = -1; return; }
        if (hipOccupancyMaxActiveBlocksPerMultiprocessor(&per_cu, (const void*)mk_fwd, NWAVES * 64, LDS_BYTES) != hipSuccess || per_cu < 1) fprintf(stderr, "kernel_launch: occupancy query says %d\n", per_cu);
        (void)hipGetLastError();
        grid = cus;
    }
    if (grid < 0) return;
    (void)hipMemsetAsync((char*)d_ws + WS_CTL, 0, CTL_ZERO_BYTES, stream);
    P p{};
    p.x_prompt = (const float*)d_in[0]; p.x_sample = (const float*)d_in[1]; p.cache_k = (const float*)d_in[2]; p.cache_v = (const float*)d_in[3]; p.cache_ik = (const float*)d_in[4];
    p.state_ssm = (const float*)d_in[5]; p.state_conv = (const float*)d_in[6]; p.state_pool = (const float*)d_in[7]; p.page_table = (const int*)d_in[8];
    p.ln1_g = (const float*)d_in[9]; p.ln1_b = (const float*)d_in[10]; p.ln2_g = (const float*)d_in[11]; p.ln2_b = (const float*)d_in[12];
    p.w_in_ab = (const float*)d_in[13]; p.conv_w = (const float*)d_in[14]; p.conv_b = (const float*)d_in[15]; p.dt_bias = (const float*)d_in[16]; p.a_log = (const float*)d_in[17];
    p.d_skip = (const float*)d_in[18]; p.ssd_g = (const float*)d_in[19]; p.w_out_ab = (const float*)d_in[20]; p.w_in_cd = (const float*)d_in[21]; p.pool_w = (const float*)d_in[22];
    p.pool_scale = (const float*)d_in[23]; p.sgu_ln_g = (const float*)d_in[24]; p.sgu_ln_b = (const float*)d_in[25]; p.sgu_w = (const float*)d_in[26]; p.sgu_b = (const float*)d_in[27];
    p.w_out_cd = (const float*)d_in[28]; p.w_ff1 = (const float*)d_in[29]; p.w_ff2 = (const float*)d_in[30];
    p.out = (float*)d_out; p.ws = (unsigned char*)d_ws;
#if MK_PER_PHASE
    for (int k = 0; k < N_PHASES; ++k) { const int r = (k - 1) % PH_PER_LAYER; if (k > 0 && (r > 9 || (((k - 1) / PH_PER_LAYER) & 1) && (r == 3 || r == 4))) continue; p.ph_lo = k; p.ph_hi = k + 1; hipLaunchKernelGGL(mk_fwd, dim3(grid), dim3(NWAVES * 64), LDS_BYTES, stream, p); }
#else
    p.ph_lo = 0; p.ph_hi = N_PHASES;
    hipLaunchKernelGGL(mk_fwd, dim3(grid), dim3(NWAVES * 64), LDS_BYTES, stream, p);
#endif
}
```

```cpp
#include <hip/hip_runtime.h>
#include <stdint.h>
#include <stdio.h>

typedef unsigned short bf16;
typedef float f32x4 __attribute__((ext_vector_type(4)));
typedef unsigned u32x4 __attribute__((ext_vector_type(4)));
#define DEVI __device__ __forceinline__
typedef short bf16x8 __attribute__((ext_vector_type(8)));
typedef unsigned u32x2 __attribute__((ext_vector_type(2)));
DEVI f32x4 mfma16(bf16x8 bt, bf16x8 a, f32x4 c) { return __builtin_amdgcn_mfma_f32_16x16x32_bf16(bt, a, c, 0, 0, 0); }
typedef float f32x2_t __attribute__((ext_vector_type(2))); typedef __bf16 bf16x2_t __attribute__((ext_vector_type(2)));
DEVI unsigned cvtpk(float lo, float hi) { f32x2_t v = {lo, hi}; bf16x2_t b = __builtin_convertvector(v, bf16x2_t); return __builtin_bit_cast(unsigned, b); }
DEVI float bflo(unsigned w) { return __uint_as_float(w << 16); }
DEVI float bfhi(unsigned w) { return __uint_as_float(w & 0xffff0000u); }

constexpr int DM = 2048, SEQ = 4096, NBP = 2, MPR = NBP * SEQ;
constexpr int DB = 8, DS = 8, MSR = DB * DS;
constexpr int MR = MPR + MSR;
constexpr int MP = 8448;
constexpr int PAST = 16384, PAGE = 128, NPAGES = PAST / PAGE, NPOOL = 1280;
constexpr int NKEY_S = PAST + DS;
constexpr int SCS_LD = 16400;
constexpr int HC_AB = 4864, HC_CD = 3072, DFF = 8192;
constexpr int TOPK = 256;
constexpr int C_Q = 0, C_K = 1024, C_V = 1280, C_QI = 1536, C_Z = 2048, C_XBC = 3072, C_KI = 4608, C_WI = 4672, C_DT = 4680;
constexpr float ALPHA = 1.681792830507429f;
constexpr float EPS = 1e-5f;
constexpr float IDX_SCALE = 0.04419417382415922f;
constexpr float ATT_SCALE = 0.08838834764831845f;

constexpr size_t O_YP = 0;
constexpr size_t O_YS = O_YP + (size_t)MPR * DM;
constexpr size_t O_KP = O_YS + (size_t)MSR * DM;
constexpr size_t O_VP = O_KP + (size_t)2 * MPR * 256;
constexpr size_t O_IP = O_VP + (size_t)2 * MPR * 256;
constexpr size_t O_HP = O_IP + (size_t)2 * MPR * 64;
constexpr size_t O_CP = O_HP + (size_t)2 * NBP * 16 * 64 * 128;
constexpr size_t O_PP = O_CP + (size_t)2 * NBP * 3 * 1536;
constexpr size_t O_KS = O_PP + (size_t)2 * NBP * 15 * 1024;
constexpr size_t O_VS = O_KS + (size_t)2 * MSR * 256;
constexpr size_t O_IS = O_VS + (size_t)2 * MSR * 256;
constexpr size_t O_HS = O_IS + (size_t)2 * MSR * 64;
constexpr size_t O_CS = O_HS + (size_t)2 * DB * 16 * 64 * 128;
constexpr size_t O_PS = O_CS + (size_t)2 * DB * 3 * 1536;
constexpr size_t O_GS = O_PS + (size_t)2 * DB * 15 * 1024;
constexpr size_t O_END = O_GS + (size_t)2 * MSR * 1024;
static_assert(O_END == 29571072, "output size");

constexpr size_t al256(size_t x) { return (x + 255) & ~(size_t)255; }
constexpr size_t WS_CTL = 0;
constexpr size_t WS_X = 1u << 20;
constexpr size_t WS_XB = WS_X + al256((size_t)MP * DM * 4);
constexpr size_t WS_H = WS_XB + al256((size_t)MP * DM * 2);
constexpr size_t WS_AO = WS_H + al256((size_t)MP * HC_AB * 4);
constexpr size_t WS_HF = WS_AO + al256((size_t)MP * DM * 2);
constexpr size_t WS_SC = WS_HF + al256((size_t)MP * DFF * 2);
constexpr size_t WS_MASK = WS_SC + al256((size_t)MPR * SEQ * 4);
constexpr size_t WS_XC = WS_MASK + al256((size_t)MPR * 64 * 8);
constexpr size_t WS_DT = WS_XC + al256((size_t)MP * 1536 * 4);
constexpr size_t WS_Y = WS_DT + al256((size_t)MP * 16 * 4);
constexpr size_t WS_SCS = WS_Y + al256((size_t)MP * 1024 * 4);
constexpr size_t WS_SELS = WS_SCS + al256((size_t)MSR * SCS_LD * 4);
constexpr size_t WS_DD = WS_SELS + al256((size_t)MSR * TOPK * 4);
constexpr size_t WS_U = WS_DD + al256((size_t)MP * 1024 * 2);
constexpr size_t WS_VLN = WS_U + al256((size_t)MP * 1024 * 2);
constexpr size_t WS_WINAB = WS_VLN + al256((size_t)MP * 1024 * 2);
constexpr size_t WS_WOUTAB = WS_WINAB + (size_t)2 * HC_AB * DM * 2;
constexpr size_t WS_WINCD = WS_WOUTAB + (size_t)2 * DM * DM * 2;
constexpr size_t WS_WOUTCD = WS_WINCD + (size_t)2 * HC_CD * DM * 2;
constexpr size_t WS_WFF1 = WS_WOUTCD + (size_t)2 * DM * DM * 2;
constexpr size_t WS_WFF2 = WS_WFF1 + (size_t)4 * DFF * DM * 2;
constexpr size_t WS_POOLW = WS_WFF2 + (size_t)4 * DFF * DM * 2;
constexpr size_t WS_SGUW = WS_POOLW + (size_t)2 * 4 * 256 * 256 * 2;
constexpr size_t WS_XCN = WS_SGUW + (size_t)2 * 4 * 128 * 128 * 2;
constexpr size_t WS_XCT = WS_XCN + al256((size_t)MP * 1536 * 2);
constexpr size_t WS_ACUM = WS_XCT + al256((size_t)64 * 1536 * 128 * 2);
constexpr size_t WS_DTC = WS_ACUM + al256((size_t)64 * 16 * 128 * 4);
constexpr size_t WS_CDEC = WS_DTC + al256((size_t)64 * 16 * 128 * 4);
constexpr size_t WS_ST = WS_CDEC + al256((size_t)64 * 16 * 4);
constexpr size_t WS_HIN = WS_ST + al256((size_t)64 * 16 * 64 * 128 * 4);
constexpr size_t WS_QB = WS_HIN + al256((size_t)64 * 16 * 64 * 128 * 2);
constexpr size_t WS_KB = WS_QB + al256((size_t)MPR * 1024 * 2);
constexpr size_t WS_VB = WS_KB + al256((size_t)MPR * 256 * 2);
constexpr size_t WS_END = WS_VB + al256((size_t)MPR * 256 * 2);

struct P {
    const float *x_prompt, *x_sample, *cache_k, *cache_v, *cache_ik, *state_ssm, *state_conv, *state_pool;
    const int* page_table;
    const float *ln1_g, *ln1_b, *ln2_g, *ln2_b, *w_in_ab, *conv_w, *conv_b, *dt_bias, *a_log, *d_skip, *ssd_g, *w_out_ab;
    const float *w_in_cd, *pool_w, *pool_scale, *sgu_ln_g, *sgu_ln_b, *sgu_w, *sgu_b, *w_out_cd, *w_ff1, *w_ff2;
    float* out;
    unsigned char* ws;
    int ph_lo, ph_hi, a2, a3;
};
typedef const __attribute__((address_space(4))) P* CP;
DEVI CP PP() { CP q = (CP)__builtin_amdgcn_kernarg_segment_ptr(); asm volatile("" : "+s"(q)); return q; }
DEVI float* wsf(CP p, size_t off) { return (float*)(p->ws + off); }
DEVI bf16* wsb(CP p, size_t off) { return (bf16*)(p->ws + off); }

DEVI float bf2f(bf16 b) { return __uint_as_float(((unsigned)b) << 16); }
DEVI bf16 f2bf(float f) { unsigned u = __float_as_uint(f); u += 0x7fffu + ((u >> 16) & 1u); return (bf16)(u >> 16); }
DEVI unsigned pk2(float lo, float hi) { return (unsigned)f2bf(lo) | ((unsigned)f2bf(hi) << 16); }
DEVI float wave_sum(float v) {
#pragma unroll
    for (int o = 1; o < 64; o <<= 1) v += __shfl_xor(v, o);
    return v;
}
DEVI int ltid() { int t = threadIdx.x; asm volatile("" : "+v"(t)); return t; }
DEVI int lvb() { int b = blockIdx.x; asm volatile("" : "+s"(b)); return b; }
DEVI float silu_f(float x) { return x / (1.f + __expf(-x)); }
DEVI float softplus_f(float x) { return fmaxf(x, 0.f) + log1pf(__expf(-fabsf(x))); }
DEVI float gelu_f(float x) { return 0.5f * x * (1.f + erff(x * 0.70710678118654752f)); }
DEVI unsigned ord_f(float f) { f = f + 0.0f; unsigned u = __float_as_uint(f); return (u & 0x80000000u) ? ~u : (u | 0x80000000u); }
__host__ __device__ inline int ab_dst_col(int n) {
    if (n < 2048) return n;
    if (n < 2112) return C_KI + (n - 2048);
    if (n < 2120) return C_WI + (n - 2112);
    if (n < 3144) return C_Z + (n - 2120);
    if (n < 4680) return C_XBC + (n - 3144);
    return n;
}

DEVI void transpose_unit(const float* W, int K, int N, bf16* WT, int abmap, int unit, float* t  ) {
    const int TIDX = ltid();
    const int nbn = (N + 63) / 64, kb = unit / nbn, nb = unit % nbn, k0 = kb * 64, n0 = nb * 64, tid = TIDX;
#pragma unroll
    for (int i = 0; i < 8; ++i) { const int kk = (tid >> 6) + 8 * i, n = n0 + (tid & 63); t[kk * 65 + (tid & 63)] = (n < N) ? W[(size_t)(k0 + kk) * N + n] : 0.f; }
    __syncthreads();
    { const int n = n0 + (tid >> 3), kq = (tid & 7) * 8;
      if (n < N) { const int row = abmap ? ab_dst_col(n) : n; const float* s = t + kq * 65 + (tid >> 3);
          u32x4 o; o.x = pk2(s[0], s[65]); o.y = pk2(s[2 * 65], s[3 * 65]); o.z = pk2(s[4 * 65], s[5 * 65]); o.w = pk2(s[6 * 65], s[7 * 65]);
          *(u32x4*)(WT + (size_t)row * K + k0 + kq) = o; } }
    __syncthreads();
}


DEVI void ph_ln(CP p, const float* g, const float* b, int final_out, int vb, int nvb) {
    const int TIDX = ltid();
    float* X = wsf(p, WS_X); bf16* XB = wsb(p, WS_XB);
    const int lane = TIDX & 63, wv = TIDX >> 6;
    for (int row = vb * 8 + wv; row < MR; row += nvb * 8) {
        float* xr = X + (size_t)row * DM; f32x4 v[8]; float s = 0.f;
#pragma unroll
        for (int i = 0; i < 8; ++i) { v[i] = *(const f32x4*)(xr + (i * 64 + lane) * 4); s += (v[i].x + v[i].y) + (v[i].z + v[i].w); }
        const float mean = wave_sum(s) * (1.f / DM); float q = 0.f;
#pragma unroll
        for (int i = 0; i < 8; ++i) { v[i] = v[i] - mean; q += (v[i].x * v[i].x + v[i].y * v[i].y) + (v[i].z * v[i].z + v[i].w * v[i].w); }
        const float rstd = 1.f / sqrtf(wave_sum(q) * (1.f / DM) + EPS);
        float* o = final_out ? (row < MPR ? p->out + O_YP + (size_t)row * DM : p->out + O_YS + (size_t)(row - MPR) * DM) : nullptr;
#pragma unroll
        for (int i = 0; i < 8; ++i) { const int c = (i * 64 + lane) * 4; const f32x4 gg = *(const f32x4*)(g + c), bb = *(const f32x4*)(b + c);
            const f32x4 y = v[i] * rstd * gg + bb; *(f32x4*)(xr + c) = y; uint2 w; w.x = pk2(y.x, y.y); w.y = pk2(y.z, y.w); *(uint2*)(XB + (size_t)row * DM + c) = w;
            if (final_out) *(f32x4*)(o + c) = y; }
    }
}

DEVI void ph_ab_copy(CP p, int j, int vb, int nvb) {
    const int TIDX = ltid();
    const float* H = wsf(p, WS_H); const int tid = TIDX;
    for (int row = vb; row < MR; row += nvb) {
        const float* h = H + (size_t)row * HC_AB;
        float *ko, *vo, *io;
        if (row < MPR) { ko = p->out + O_KP + ((size_t)j * MPR + row) * 256; vo = p->out + O_VP + ((size_t)j * MPR + row) * 256; io = p->out + O_IP + ((size_t)j * MPR + row) * 64; }
        else { const int sr = row - MPR; ko = p->out + O_KS + ((size_t)j * MSR + sr) * 256; vo = p->out + O_VS + ((size_t)j * MSR + sr) * 256; io = p->out + O_IS + ((size_t)j * MSR + sr) * 64; }
        if (tid < 256) ko[tid] = h[C_K + tid]; else vo[tid - 256] = h[C_V + tid - 256];
        if (row < MPR) { const float qs = ATT_SCALE * 1.4426950408889634f;
            *(unsigned*)(wsb(p, WS_QB) + (size_t)row * 1024 + 2 * tid) = cvtpk(h[C_Q + 2 * tid] * qs, h[C_Q + 2 * tid + 1] * qs);
            if (tid < 128) *(unsigned*)(wsb(p, WS_KB) + (size_t)row * 256 + 2 * tid) = cvtpk(h[C_K + 2 * tid], h[C_K + 2 * tid + 1]);
            else if (tid < 256) *(unsigned*)(wsb(p, WS_VB) + (size_t)row * 256 + 2 * (tid - 128)) = cvtpk(h[C_V + 2 * (tid - 128)], h[C_V + 2 * (tid - 128) + 1]); }
        if (tid < 64) io[tid] = h[C_KI + tid];
        int ci = -1; float* co = nullptr;
        if (row < MPR) { const int b = row / SEQ, t = row % SEQ; if (t >= SEQ - 3) { ci = t - (SEQ - 3); co = p->out + O_CP + (((size_t)j * NBP + b) * 3 + ci) * 1536; } }
        else { const int b = (row - MPR) / DS, t = (row - MPR) % DS; if (t >= DS - 3) { ci = t - (DS - 3); co = p->out + O_CS + (((size_t)j * DB + b) * 3 + ci) * 1536; } }
        if (ci >= 0) for (int c = tid; c < 1536; c += 512) co[c] = h[C_XBC + c];
    }
}

DEVI void ph_conv(CP p, int j, int vb, int nvb) {
    const int TIDX = ltid();
    const float* H = wsf(p, WS_H); float* XC = wsf(p, WS_XC); float* DT = wsf(p, WS_DT);
    const float* cw = p->conv_w + (size_t)j * 4 * 1536; const float* cb = p->conv_b + (size_t)j * 1536;
#ifdef EXP_OLDY
    for (int row = vb; row < MR; row += nvb) {
#else
    for (int row = MPR + vb; row < MR; row += nvb) {
#endif
        const bool pr = row < MPR; const int b = pr ? row / SEQ : (row - MPR) / DS, t = pr ? row % SEQ : (row - MPR) % DS;
        for (int c = TIDX; c < 1536; c += 512) {
            float acc = cb[c];
#pragma unroll
            for (int jj = 0; jj < 4; ++jj) { const int tt = t - 3 + jj; float xv;
                if (tt >= 0) xv = H[(size_t)(row - t + tt) * HC_AB + C_XBC + c];
                else xv = pr ? 0.f : p->state_conv[(((size_t)j * DB + b) * 3 + (3 + tt)) * 1536 + c];
                acc += cw[jj * 1536 + c] * xv; }
            XC[(size_t)row * 1536 + c] = silu_f(acc);
        }
        if (TIDX < 16) DT[row * 16 + TIDX] = softplus_f(H[(size_t)row * HC_AB + C_DT + TIDX] + p->dt_bias[j * 16 + TIDX]);
    }
}

DEVI void ssd_seq_unit(CP p, int j, int sq  , int h, int ph, int lane) {
    const float* XC = wsf(p, WS_XC); const float* DT = wsf(p, WS_DT); float* Y = wsf(p, WS_Y);
    const bool pr = sq < NBP; const int b = pr ? sq : sq - NBP, n = pr ? SEQ : DS, row0 = pr ? b * SEQ : MPR + b * DS, g = h >> 3;
    const int pp = ph * 32 + (lane & 31), nh = lane >> 5;
    const float a = -__expf(p->a_log[j * 16 + h]), Dk = p->d_skip[j * 16 + h];
    float st[64];
    if (pr) {
#pragma unroll
        for (int i = 0; i < 64; ++i) st[i] = 0.f;
    } else { const float* h0 = p->state_ssm + ((((size_t)j * DB + b) * 16 + h) * 64 + pp) * 128 + nh * 64;
#pragma unroll
        for (int i = 0; i < 16; ++i) { const f32x4 v = *(const f32x4*)(h0 + 4 * i); st[4 * i] = v.x; st[4 * i + 1] = v.y; st[4 * i + 2] = v.z; st[4 * i + 3] = v.w; } }
    for (int t = 0; t < n; ++t) {
        const int row = row0 + t; const float dt = DT[row * 16 + h], dA = __expf(dt * a), x = XC[(size_t)row * 1536 + h * 64 + pp], cf = dt * x;
        const float* Bp = XC + (size_t)row * 1536 + 1024 + g * 128 + nh * 64; const float* Cp = Bp + 256;
        float y = 0.f;
#pragma unroll
        for (int i = 0; i < 16; ++i) { if ((i & 7) == 0) asm volatile("" ::: "memory");
            const f32x4 bv = *(const f32x4*)(Bp + 4 * i), cv = *(const f32x4*)(Cp + 4 * i);
            st[4 * i] = st[4 * i] * dA + cf * bv.x; st[4 * i + 1] = st[4 * i + 1] * dA + cf * bv.y; st[4 * i + 2] = st[4 * i + 2] * dA + cf * bv.z; st[4 * i + 3] = st[4 * i + 3] * dA + cf * bv.w;
            y += cv.x * st[4 * i] + cv.y * st[4 * i + 1] + cv.z * st[4 * i + 2] + cv.w * st[4 * i + 3]; }
        y += __shfl_xor(y, 32);
        if (nh == 0) Y[(size_t)row * 1024 + h * 64 + pp] = y + Dk * x;
    }
#ifdef EXP_OLDY
    if (pr) return;
#endif
    float* ho = (pr ? p->out + O_HP + ((((size_t)j * NBP + b) * 16 + h) * 64 + pp) * 128 : p->out + O_HS + ((((size_t)j * DB + b) * 16 + h) * 64 + pp) * 128) + nh * 64;
#pragma unroll
    for (int i = 0; i < 16; ++i) *(f32x4*)(ho + 4 * i) = (f32x4){st[4 * i], st[4 * i + 1], st[4 * i + 2], st[4 * i + 3]};
}

DEVI void conv_prompt_unit(CP p, int j, int ck, int cb, bf16* T  ) {
    const int tid = ltid(), ch = tid & 63, sg = tid >> 6;
    const float* H = wsf(p, WS_H); bf16* XCN = wsb(p, WS_XCN); bf16* XCT = wsb(p, WS_XCT);
    const int row0 = ck * 128, col = cb * 64 + ch, s0 = sg * 16;
    const float* cw = p->conv_w + (size_t)j * 4 * 1536 + col; const float w0 = cw[0], w1 = cw[1536], w2 = cw[2 * 1536], w3 = cw[3 * 1536], bias = p->conv_b[(size_t)j * 1536 + col];
    const float* hp = H + (size_t)(row0 + s0) * HC_AB + C_XBC + col;
    const bool first = ((ck & 31) == 0) && (sg == 0);
    float x0 = first ? 0.f : hp[-3 * HC_AB], x1 = first ? 0.f : hp[-2 * HC_AB], x2 = first ? 0.f : hp[-HC_AB];
#pragma unroll 4
    for (int i = 0; i < 16; ++i) { const float x3 = hp[(size_t)i * HC_AB]; const bf16 v = f2bf(silu_f(bias + w0 * x0 + w1 * x1 + w2 * x2 + w3 * x3));
        XCN[(size_t)(row0 + s0 + i) * 1536 + col] = v; T[ch * 136 + s0 + i] = v; x0 = x1; x1 = x2; x2 = x3; }
    if (cb == 0) for (int idx = tid; idx < 128 * 16; idx += 512) { const int s = idx >> 4, hh = idx & 15;
        wsf(p, WS_DT)[(row0 + s) * 16 + hh] = softplus_f(H[(size_t)(row0 + s) * HC_AB + C_DT + hh] + p->dt_bias[j * 16 + hh]); }
    __syncthreads();
    { const int chh = tid >> 3, sq = (tid & 7) * 16; const u32x4 a = *(const u32x4*)(T + chh * 136 + sq), b = *(const u32x4*)(T + chh * 136 + sq + 8);
      bf16* dst = XCT + ((size_t)ck * 1536 + cb * 64 + chh) * 128 + sq; *(u32x4*)dst = a; *(u32x4*)(dst + 8) = b; }
    __syncthreads();
}
DEVI void ssd1_unit(CP p, int j, int ck, int h, float* sm  ) {
    const int tid = ltid(), lane = tid & 63, wv = tid >> 6, fr = lane & 15, fq = lane >> 4, g = h >> 3;
    if (wv == 0) {
        const float* DT = wsf(p, WS_DT) + (size_t)ck * 128 * 16 + h; const float a = -__expf(p->a_log[j * 16 + h]);
        float* ACUM = wsf(p, WS_ACUM) + ((size_t)ck * 16 + h) * 128; float* DTC = wsf(p, WS_DTC) + ((size_t)ck * 16 + h) * 128;
        const float d0 = DT[(2 * lane) * 16], d1 = DT[(2 * lane + 1) * 16], v0 = d0 * a, v1 = v0 + d1 * a;
        float run = v1;
#pragma unroll
        for (int o = 1; o < 64; o <<= 1) { const float t = __shfl_up(run, o); if (lane >= o) run += t; }
        const float ex = run - v1, a0 = ex + v0, a1 = ex + v1, last = __shfl(run, 63);
        sm[2 * lane] = a0; sm[2 * lane + 1] = a1; ACUM[2 * lane] = a0; ACUM[2 * lane + 1] = a1; DTC[2 * lane] = d0; DTC[2 * lane + 1] = d1;
        sm[128 + 2 * lane] = d0 * __expf(last - a0); sm[128 + 2 * lane + 1] = d1 * __expf(last - a1);
        if (lane == 0) wsf(p, WS_CDEC)[ck * 16 + h] = __expf(last);
    }
    __syncthreads();
    const bf16* XCT = wsb(p, WS_XCT) + (size_t)ck * 1536 * 128;
    const bf16* Btp = XCT + (size_t)(1024 + g * 128 + wv * 16 + fr) * 128 + fq * 8;
    const bf16* xp = XCT + (size_t)(h * 64 + fr) * 128 + fq * 8;
    f32x4 acc[4];
#pragma unroll
    for (int pt = 0; pt < 4; ++pt) acc[pt] = (f32x4){0.f, 0.f, 0.f, 0.f};
#pragma unroll
    for (int k = 0; k < 4; ++k) {
        const bf16x8 bfrag = *(const bf16x8*)(Btp + k * 32);
        const f32x4 wa = *(const f32x4*)(sm + 128 + k * 32 + fq * 8), wb = *(const f32x4*)(sm + 128 + k * 32 + fq * 8 + 4);
#pragma unroll
        for (int pt = 0; pt < 4; ++pt) { const u32x4 xv = *(const u32x4*)(xp + (size_t)pt * 16 * 128 + k * 32);
            u32x4 sv; sv.x = cvtpk(bflo(xv.x) * wa.x, bfhi(xv.x) * wa.y); sv.y = cvtpk(bflo(xv.y) * wa.z, bfhi(xv.y) * wa.w); sv.z = cvtpk(bflo(xv.z) * wb.x, bfhi(xv.z) * wb.y); sv.w = cvtpk(bflo(xv.w) * wb.z, bfhi(xv.w) * wb.w);
            acc[pt] = mfma16(bfrag, __builtin_bit_cast(bf16x8, sv), acc[pt]); }
    }
    float* ST = wsf(p, WS_ST) + ((size_t)ck * 16 + h) * 8192;
#pragma unroll
    for (int pt = 0; pt < 4; ++pt) *(f32x4*)(ST + (size_t)(pt * 16 + fr) * 128 + wv * 16 + fq * 4) = acc[pt];
    __syncthreads();
}
DEVI void ph_ssd_scan(CP p, int j, int vb, int nvb) {
    const float* ST = wsf(p, WS_ST); const float* CDEC = wsf(p, WS_CDEC); bf16* HIN = wsb(p, WS_HIN);
    const int tid = ltid();
    for (int e4 = vb * 512 + tid; e4 < NBP * 16 * 64 * 128 / 4; e4 += nvb * 512) {
        const int b = e4 / (16 * 64 * 32), r = e4 % (16 * 64 * 32), h = r / (64 * 32);
        f32x4 st = (f32x4){0.f, 0.f, 0.f, 0.f};
#pragma unroll 8
        for (int c = 0; c < 32; ++c) { const int ck = b * 32 + c; const size_t off = (size_t)ck * 16 * 8192 + (size_t)r * 4;
            u32x2 o; o.x = cvtpk(st.x, st.y); o.y = cvtpk(st.z, st.w); *(u32x2*)(HIN + off) = o;
            const f32x4 sv = *(const f32x4*)(ST + off); const float d = CDEC[ck * 16 + h]; st = st * d + sv; }
        *(f32x4*)(p->out + O_HP + ((size_t)j * NBP + b) * 16 * 8192 + (size_t)r * 4) = st;
    }
}
DEVI void ssd3_unit(CP p, int j, int ck, int tt, float* red  , bf16* AO) {
    const int tid = ltid(), lane = tid & 63, wv = tid >> 6, fr = lane & 15, fq = lane >> 4, g = wv >> 2;
    const int t0 = tt * 16; const size_t row = (size_t)ck * 128 + t0 + fr;
    const bf16* XCN = wsb(p, WS_XCN); const bf16* XCT = wsb(p, WS_XCT) + (size_t)ck * 1536 * 128; const float* H = wsf(p, WS_H);
    bf16x8 cf[4];
#pragma unroll
    for (int k = 0; k < 4; ++k) cf[k] = *(const bf16x8*)(XCN + row * 1536 + 1280 + g * 128 + k * 32 + fq * 8);
    f32x4 cbt[8];
#pragma unroll
    for (int jt = 0; jt < 8; ++jt) { cbt[jt] = (f32x4){0.f, 0.f, 0.f, 0.f};
        if (jt <= tt) { const bf16* bp = XCN + ((size_t)ck * 128 + jt * 16 + fr) * 1536 + 1024 + g * 128 + fq * 8;
#pragma unroll
            for (int k = 0; k < 4; ++k) cbt[jt] = mfma16(*(const bf16x8*)(bp + k * 32), cf[k], cbt[jt]); } }
    f32x4 yv[2][4]; float ss = 0.f;
#pragma unroll
    for (int hh = 0; hh < 2; ++hh) {
        const int h = 2 * wv + hh;
        const float* AC = wsf(p, WS_ACUM) + ((size_t)ck * 16 + h) * 128; const float* DC = wsf(p, WS_DTC) + ((size_t)ck * 16 + h) * 128;
        const float at = AC[t0 + fr], Dk = p->d_skip[j * 16 + h];
        f32x4 yd[4];
#pragma unroll
        for (int pt = 0; pt < 4; ++pt) yd[pt] = (f32x4){0.f, 0.f, 0.f, 0.f};
#pragma unroll
        for (int q = 0; q < 4; ++q) if (2 * q <= tt) {
            const int sa = 2 * q * 16 + 4 * fq, sb = sa + 16;
            const f32x4 aa = *(const f32x4*)(AC + sa), da = *(const f32x4*)(DC + sa), ab = *(const f32x4*)(AC + sb), db = *(const f32x4*)(DC + sb);
            float la[4], lb[4];
#pragma unroll
            for (int i = 0; i < 4; ++i) { la[i] = (sa + i <= t0 + fr) ? cbt[2 * q][i] * __expf(fminf(at - aa[i], 0.f)) * da[i] : 0.f;
                                          lb[i] = (2 * q + 1 <= tt && sb + i <= t0 + fr) ? cbt[2 * q + 1][i] * __expf(fminf(at - ab[i], 0.f)) * db[i] : 0.f; }
            u32x4 lw; lw.x = cvtpk(la[0], la[1]); lw.y = cvtpk(la[2], la[3]); lw.z = cvtpk(lb[0], lb[1]); lw.w = cvtpk(lb[2], lb[3]);
            const bf16x8 lf = __builtin_bit_cast(bf16x8, lw);
#pragma unroll
            for (int pt = 0; pt < 4; ++pt) { const bf16* xq = XCT + (size_t)(h * 64 + pt * 16 + fr) * 128;
                const u32x2 xa = *(const u32x2*)(xq + sa), xb = *(const u32x2*)(xq + sb); u32x4 xw; xw.x = xa.x; xw.y = xa.y; xw.z = xb.x; xw.w = xb.y;
                yd[pt] = mfma16(__builtin_bit_cast(bf16x8, xw), lf, yd[pt]); }
        }
        const bf16* hq = wsb(p, WS_HIN) + ((size_t)ck * 16 + h) * 8192 + (size_t)fr * 128 + fq * 8; const float eat = __expf(at);
#pragma unroll
        for (int pt = 0; pt < 4; ++pt) { f32x4 of = (f32x4){0.f, 0.f, 0.f, 0.f};
#pragma unroll
            for (int k = 0; k < 4; ++k) of = mfma16(*(const bf16x8*)(hq + (size_t)pt * 16 * 128 + k * 32), cf[k], of);
            const int c0 = h * 64 + pt * 16 + 4 * fq;
            const u32x2 xw = *(const u32x2*)(XCN + row * 1536 + c0); const f32x4 z = *(const f32x4*)(H + row * HC_AB + C_Z + c0);
            f32x4 y = yd[pt] + of * eat;
            y.x += Dk * bflo(xw.x); y.y += Dk * bfhi(xw.x); y.z += Dk * bflo(xw.y); y.w += Dk * bfhi(xw.y);
            y.x *= silu_f(z.x); y.y *= silu_f(z.y); y.z *= silu_f(z.z); y.w *= silu_f(z.w);
            ss += (y.x * y.x + y.y * y.y) + (y.z * y.z + y.w * y.w); yv[hh][pt] = y; }
    }
    ss += __shfl_xor(ss, 16); ss += __shfl_xor(ss, 32);
    if (fq == 0) red[wv * 16 + fr] = ss;
    __syncthreads();
    float tot = 0.f;
#pragma unroll
    for (int w = 0; w < 8; ++w) tot += red[w * 16 + fr];
    const float rs = 1.f / sqrtf(tot * (1.f / 1024.f) + EPS);
    const float* gg = p->ssd_g + (size_t)j * 1024;
#pragma unroll
    for (int hh = 0; hh < 2; ++hh)
#pragma unroll
        for (int pt = 0; pt < 4; ++pt) { const int c0 = (2 * wv + hh) * 64 + pt * 16 + 4 * fq; const f32x4 gv = *(const f32x4*)(gg + c0); const f32x4 o = yv[hh][pt] * rs * gv;
            u32x2 w; w.x = cvtpk(o.x, o.y); w.y = cvtpk(o.z, o.w); *(u32x2*)(AO + row * DM + 1024 + c0) = w; }
    __syncthreads();
}

DEVI void ph_ssd_gate(CP p, int j, int vb, int nvb) {
    const int TIDX = ltid();
    const float* H = wsf(p, WS_H); const float* Y = wsf(p, WS_Y); bf16* AO = wsb(p, WS_AO); const float* g = p->ssd_g + (size_t)j * 1024;
    const int lane = TIDX & 63, wv = TIDX >> 6;
#ifdef EXP_OLDY
    for (int row = vb * 8 + wv; row < MR; row += nvb * 8) {
#else
    for (int row = MPR + vb * 8 + wv; row < MR; row += nvb * 8) {
#endif
        f32x4 v[4]; float q = 0.f;
#pragma unroll
        for (int i = 0; i < 4; ++i) { const int c = (i * 64 + lane) * 4; const f32x4 y = *(const f32x4*)(Y + (size_t)row * 1024 + c), z = *(const f32x4*)(H + (size_t)row * HC_AB + C_Z + c);
            v[i] = (f32x4){y.x * silu_f(z.x), y.y * silu_f(z.y), y.z * silu_f(z.z), y.w * silu_f(z.w)}; q += (v[i].x * v[i].x + v[i].y * v[i].y) + (v[i].z * v[i].z + v[i].w * v[i].w); }
        const float rs = 1.f / sqrtf(wave_sum(q) * (1.f / 1024.f) + EPS);
#pragma unroll
        for (int i = 0; i < 4; ++i) { const int c = (i * 64 + lane) * 4; const f32x4 gg = *(const f32x4*)(g + c); const f32x4 o = v[i] * rs * gg;
            uint2 w; w.x = pk2(o.x, o.y); w.y = pk2(o.z, o.w); *(uint2*)(AO + (size_t)row * DM + 1024 + c) = w; }
    }
}

DEVI void ph_idx_prompt_naive(CP p, int vb, int nvb, float* sm) {
    const int TIDX = ltid();
    const float* H = wsf(p, WS_H); float* SC = wsf(p, WS_SC);
    const int half = TIDX >> 8, tid = TIDX & 255; float* sq = sm + half * 520; float* sw = sq + 512;
    for (int row0 = vb * 2; row0 < MPR; row0 += nvb * 2) {
        const int row = row0 + half, b = row / SEQ, t = row % SEQ;
        sq[tid] = H[(size_t)row * HC_AB + C_QI + tid]; sq[tid + 256] = H[(size_t)row * HC_AB + C_QI + 256 + tid]; if (tid < 8) sw[tid] = H[(size_t)row * HC_AB + C_WI + tid];
        __syncthreads();
        for (int s = tid; s <= t; s += 256) {
            const float* kr = H + (size_t)(b * SEQ + s) * HC_AB + C_KI; float k[64];
#pragma unroll
            for (int i = 0; i < 16; ++i) { const f32x4 v = *(const f32x4*)(kr + 4 * i); k[4 * i] = v.x; k[4 * i + 1] = v.y; k[4 * i + 2] = v.z; k[4 * i + 3] = v.w; }
            float sc = 0.f;
#pragma unroll 1
            for (int h = 0; h < 8; ++h) { float d = 0.f;
#pragma unroll
                for (int i = 0; i < 64; ++i) d += sq[h * 64 + i] * k[i];
                sc += sw[h] * fmaxf(d, 0.f); }
            SC[(size_t)row * SEQ + s] = sc * IDX_SCALE;
        }
        __syncthreads();
    }
}

DEVI void select_prompt_row(const float* SC, unsigned long long* MASK, int row, int lane) {
    const int t = row % SEQ, nk = t + 1; const float* sc = SC + (size_t)row * SEQ;
    unsigned v[64];
#pragma unroll
    for (int jj = 0; jj < 64; ++jj) { const int key = jj * 64 + lane; v[jj] = key < nk ? ord_f(sc[key]) : 0u; }
    unsigned long long mine = 0ull;
    if (nk <= TOPK) {
#pragma unroll
        for (int jj = 0; jj < 64; ++jj) { const unsigned long long m = __ballot(jj * 64 + lane < nk); if (lane == jj) mine = m; }
    } else {
        unsigned T = 0u;
        for (int bit = 31; bit >= 0; --bit) { const unsigned cand = T | (1u << bit); int cnt = 0;
#pragma unroll
            for (int jj = 0; jj < 64; ++jj) cnt += __popcll(__ballot(v[jj] >= cand));
            if (cnt >= TOPK) T = cand; if (cnt == TOPK) break; }
        int cgt = 0;
#pragma unroll
        for (int jj = 0; jj < 64; ++jj) cgt += __popcll(__ballot(v[jj] > T));
        const int need = TOPK - cgt; int run = 0; const unsigned long long lt = (1ull << lane) - 1ull;
#pragma unroll
        for (int jj = 0; jj < 64; ++jj) { const bool eq = v[jj] == T; const unsigned long long me = __ballot(eq); const int pre = run + __popcll(me & lt);
            const bool sel = (v[jj] > T) || (eq && pre < need); run += __popcll(me); const unsigned long long m = __ballot(sel); if (lane == jj) mine = m; }
    }
    MASK[((size_t)(row >> 5) * 64 + lane) * 32 + (row & 31)] = mine;
}
DEVI void ph_select_prompt(CP p, int vb, int nvb) {
    const int TIDX = ltid();
    const int lane = TIDX & 63, wv = TIDX >> 6;
    for (int row = vb * 8 + wv; row < MPR; row += nvb * 8) select_prompt_row(wsf(p, WS_SC), (unsigned long long*)(p->ws + WS_MASK), row, lane);
}

DEVI void ph_attn_prompt_naive(CP p, int vb, int nvb) {
    const int TIDX = ltid();
    const float* H = wsf(p, WS_H); const unsigned long long* MASK = (const unsigned long long*)(p->ws + WS_MASK); bf16* AO = wsb(p, WS_AO);
    const int h = TIDX >> 6, lane = TIDX & 63, g = h >> 2;
    for (int row = vb; row < MPR; row += nvb) {
        const int b = row / SEQ, t = row % SEQ;
        const float q0 = H[(size_t)row * HC_AB + C_Q + h * 128 + lane], q1 = H[(size_t)row * HC_AB + C_Q + h * 128 + 64 + lane];
        float m = -1e30f, l = 0.f, o0 = 0.f, o1 = 0.f;
        for (int jt = 0; jt <= t / 64; ++jt) {
            unsigned long long w = MASK[((size_t)(row >> 5) * 64 + jt) * 32 + (row & 31)];
            while (w) { const int bit = __builtin_ctzll(w); w &= w - 1ull; const int s = jt * 64 + bit;
                const float* kr = H + (size_t)(b * SEQ + s) * HC_AB + C_K + g * 128; const float* vr = H + (size_t)(b * SEQ + s) * HC_AB + C_V + g * 128;
                const float lg = wave_sum(q0 * kr[lane] + q1 * kr[lane + 64]) * ATT_SCALE;
                const float mn = fmaxf(m, lg), al = __expf(m - mn), pe = __expf(lg - mn);
                l = l * al + pe; o0 = o0 * al + pe * vr[lane]; o1 = o1 * al + pe * vr[lane + 64]; m = mn; }
        }
        const float il = 1.f / l;
        AO[(size_t)row * DM + h * 128 + lane] = f2bf(o0 * il); AO[(size_t)row * DM + h * 128 + 64 + lane] = f2bf(o1 * il);
    }
}

constexpr int ATT_KS = 136, ATT_VS = 72, ATT_BUF = 64 * ATT_KS * 2 + 128 * ATT_VS * 2;
DEVI void attn_unit(CP p, int b, int h, int qb, unsigned char* lds, bf16* AO) {
    const int tid = ltid(), lane = tid & 63, wv = tid >> 6, fr = lane & 15, fq = lane >> 4, g = h >> 2;
    const bf16* QB = wsb(p, WS_QB); const bf16* KB = wsb(p, WS_KB) + (size_t)b * SEQ * 256 + g * 128; const bf16* VB = wsb(p, WS_VB) + (size_t)b * SEQ * 256 + g * 128;
    const unsigned long long* MASK = (const unsigned long long*)(p->ws + WS_MASK);
    const int pos0 = qb * 256 + wv * 32;
    const size_t row0 = (size_t)b * SEQ + pos0;
    bf16x8 qf[2][4];
#pragma unroll
    for (int mt = 0; mt < 2; ++mt)
#pragma unroll
        for (int k = 0; k < 4; ++k) qf[mt][k] = *(const bf16x8*)(QB + (row0 + mt * 16 + fr) * 1024 + h * 128 + k * 32 + fq * 8);
    const unsigned long long* mkp = MASK + (row0 >> 5) * 64 * 32 + fr;
    f32x4 o[2][8];
#pragma unroll
    for (int mt = 0; mt < 2; ++mt)
#pragma unroll
        for (int dt = 0; dt < 8; ++dt) o[mt][dt] = (f32x4){0.f, 0.f, 0.f, 0.f};
    float mrow[2] = {-1e30f, -1e30f}, lrow[2] = {0.f, 0.f};
    const int NT = 4 * (qb + 1);
    const int skey = tid >> 3, spart = tid & 7;
    const bf16* kg = KB + (size_t)skey * 256 + spart * 16; const bf16* vg = VB + (size_t)skey * 256 + spart * 16;
    u32x4 sk0, sk1, sv0, sv1; unsigned long long mw[2];
    sk0 = *(const u32x4*)(kg); sk1 = *(const u32x4*)(kg + 8); sv0 = *(const u32x4*)(vg); sv1 = *(const u32x4*)(vg + 8);
    mw[0] = mkp[0]; mw[1] = mkp[16];
    for (int jt = 0; jt < NT; ++jt) {
        unsigned char* buf = lds + (jt & 1) * ATT_BUF; bf16* Ks = (bf16*)buf; bf16* Vt = (bf16*)(buf + 64 * ATT_KS * 2);
        *(u32x4*)(Ks + skey * ATT_KS + spart * 16) = sk0; *(u32x4*)(Ks + skey * ATT_KS + spart * 16 + 8) = sk1;
        { const unsigned w[8] = {sv0.x, sv0.y, sv0.z, sv0.w, sv1.x, sv1.y, sv1.z, sv1.w};
#pragma unroll
          for (int i = 0; i < 8; ++i) { Vt[(spart * 16 + 2 * i) * ATT_VS + skey] = (bf16)(w[i] & 0xffffu); Vt[(spart * 16 + 2 * i + 1) * ATT_VS + skey] = (bf16)(w[i] >> 16); } }
        const unsigned long long m0 = mw[0], m1 = mw[1];
        __syncthreads();
        if (jt + 1 < NT) { const size_t go = (size_t)(jt + 1) * 64 * 256; sk0 = *(const u32x4*)(kg + go); sk1 = *(const u32x4*)(kg + go + 8); sv0 = *(const u32x4*)(vg + go); sv1 = *(const u32x4*)(vg + go + 8);
            mw[0] = mkp[(jt + 1) * 32]; mw[1] = mkp[(jt + 1) * 32 + 16]; }
        if (jt * 64 > pos0 + 31) continue;
        f32x4 sc[2][4];
#pragma unroll
        for (int mt = 0; mt < 2; ++mt)
#pragma unroll
            for (int kt = 0; kt < 4; ++kt) sc[mt][kt] = (f32x4){0.f, 0.f, 0.f, 0.f};
#pragma unroll
        for (int kt = 0; kt < 4; ++kt)
#pragma unroll
            for (int k = 0; k < 4; ++k) { const bf16x8 kf = *(const bf16x8*)(Ks + (kt * 16 + fr) * ATT_KS + k * 32 + fq * 8);
                sc[0][kt] = mfma16(kf, qf[0][k], sc[0][kt]); sc[1][kt] = mfma16(kf, qf[1][k], sc[1][kt]); }
        bf16x8 pf[2][2];
#pragma unroll
        for (int mt = 0; mt < 2; ++mt) {
            const unsigned long long mk = (mt ? m1 : m0) >> (4 * fq);
            float mx = -1e30f;
#pragma unroll
            for (int kt = 0; kt < 4; ++kt)
#pragma unroll
                for (int i = 0; i < 4; ++i) { const bool on = (mk >> (16 * kt + i)) & 1ull; sc[mt][kt][i] = on ? sc[mt][kt][i] : -1e30f; mx = fmaxf(mx, sc[mt][kt][i]); }
            mx = fmaxf(mx, __shfl_xor(mx, 16)); mx = fmaxf(mx, __shfl_xor(mx, 32));
            const float mn = fmaxf(mrow[mt], mx), al = __builtin_amdgcn_exp2f(mrow[mt] - mn); mrow[mt] = mn;
            float ps = 0.f;
#pragma unroll
            for (int kt = 0; kt < 4; ++kt)
#pragma unroll
                for (int i = 0; i < 4; ++i) { const float e = (sc[mt][kt][i] > -1e29f) ? __builtin_amdgcn_exp2f(sc[mt][kt][i] - mn) : 0.f; sc[mt][kt][i] = e; ps += e; }
            lrow[mt] = lrow[mt] * al + ps;
            if (!__all(al == 1.f)) {
#pragma unroll
                for (int dt = 0; dt < 8; ++dt) o[mt][dt] = o[mt][dt] * al; }
#pragma unroll
            for (int ks = 0; ks < 2; ++ks) { u32x4 w; w.x = cvtpk(sc[mt][2 * ks][0], sc[mt][2 * ks][1]); w.y = cvtpk(sc[mt][2 * ks][2], sc[mt][2 * ks][3]);
                w.z = cvtpk(sc[mt][2 * ks + 1][0], sc[mt][2 * ks + 1][1]); w.w = cvtpk(sc[mt][2 * ks + 1][2], sc[mt][2 * ks + 1][3]); pf[mt][ks] = __builtin_bit_cast(bf16x8, w); }
        }
#pragma unroll
        for (int dt = 0; dt < 8; ++dt)
#pragma unroll
            for (int ks = 0; ks < 2; ++ks) { const bf16* vp = Vt + (dt * 16 + fr) * ATT_VS + ks * 32 + 4 * fq;
                const u32x2 va = *(const u32x2*)vp, vb2 = *(const u32x2*)(vp + 16); u32x4 w; w.x = va.x; w.y = va.y; w.z = vb2.x; w.w = vb2.y; const bf16x8 vf = __builtin_bit_cast(bf16x8, w);
                o[0][dt] = mfma16(vf, pf[0][ks], o[0][dt]); o[1][dt] = mfma16(vf, pf[1][ks], o[1][dt]); }
    }
#pragma unroll
    for (int mt = 0; mt < 2; ++mt) { float l = lrow[mt]; l += __shfl_xor(l, 16); l += __shfl_xor(l, 32); const float il = 1.f / l;
        bf16* orow = AO + (row0 + mt * 16 + fr) * DM + h * 128 + 4 * fq;
#pragma unroll
        for (int dt = 0; dt < 8; ++dt) { const f32x4 v = o[mt][dt] * il; u32x2 w; w.x = cvtpk(v.x, v.y); w.y = cvtpk(v.z, v.w); *(u32x2*)(orow + dt * 16) = w; } }
    __syncthreads();
}

DEVI void idx_sample_unit(CP p, int j, int b, int kb, float* sq  ) {
    const int TIDX = ltid();
    const float* H = wsf(p, WS_H); float* SCS = wsf(p, WS_SCS); const int tid = TIDX;
    for (int i = tid; i < 8 * 512; i += 512) sq[i] = H[(size_t)(MPR + b * DS + (i >> 9)) * HC_AB + C_QI + (i & 511)];
    if (tid < 64) sq[4096 + tid] = H[(size_t)(MPR + b * DS + (tid >> 3)) * HC_AB + C_WI + (tid & 7)];
    __syncthreads();
    const int key = kb * 512 + tid;
    if (key < NKEY_S) {
        const float* kr;
        if (key < PAST) { const int pg = p->page_table[b * NPAGES + key / PAGE]; kr = p->cache_ik + (((size_t)j * NPOOL + pg) * PAGE + key % PAGE) * 64; }
        else kr = H + (size_t)(MPR + b * DS + key - PAST) * HC_AB + C_KI;
        float k[64];
#pragma unroll
        for (int i = 0; i < 16; ++i) { const f32x4 v = *(const f32x4*)(kr + 4 * i); k[4 * i] = v.x; k[4 * i + 1] = v.y; k[4 * i + 2] = v.z; k[4 * i + 3] = v.w; }
#pragma unroll 1
        for (int qi = 0; qi < 8; ++qi) { if (key > PAST + qi) continue; float sc = 0.f;
#pragma unroll 1
            for (int h = 0; h < 8; ++h) { float d = 0.f;
#pragma unroll
                for (int i = 0; i < 64; ++i) d += sq[qi * 512 + h * 64 + i] * k[i];
                sc += sq[4096 + qi * 8 + h] * fmaxf(d, 0.f); }
            SCS[(size_t)(b * DS + qi) * SCS_LD + key] = sc * IDX_SCALE; }
    }
    __syncthreads();
}

DEVI void select_sample_unit(CP p, int q, int* red  ) {
    const int TIDX = ltid();
    const float* sc = wsf(p, WS_SCS) + (size_t)q * SCS_LD; int* SELS = (int*)(p->ws + WS_SELS) + q * TOPK;
    const int tid = TIDX, lane = tid & 63, wv = tid >> 6, nk = PAST + (q % DS) + 1;
    unsigned v[33];
#pragma unroll
    for (int jj = 0; jj < 33; ++jj) { const int key = jj * 512 + tid; v[jj] = key < nk ? ord_f(sc[key]) : 0u; }
    unsigned T = 0u; int par = 0;
    for (int bit = 31; bit >= 0; --bit) { const unsigned cand = T | (1u << bit); int cnt = 0;
#pragma unroll
        for (int jj = 0; jj < 33; ++jj) cnt += __popcll(__ballot(v[jj] >= cand));
        if (lane == 0) red[par * 8 + wv] = cnt; __syncthreads();
        int tot = 0;
#pragma unroll
        for (int w = 0; w < 8; ++w) tot += red[par * 8 + w];
        par ^= 1;
        if (tot >= TOPK) T = cand; if (tot == TOPK) break; }
    __syncthreads();
    int* cg = red + 16; int* ce = cg + 33 * 8; int* pg = ce + 33 * 8; int* pe = pg + 33 * 8;
#pragma unroll
    for (int jj = 0; jj < 33; ++jj) { const int a = __popcll(__ballot(v[jj] > T)), e = __popcll(__ballot(v[jj] == T)); if (lane == 0) { cg[jj * 8 + wv] = a; ce[jj * 8 + wv] = e; } }
    __syncthreads();
    if (tid < 33 * 8) { int a = 0, e = 0; for (int i = 0; i < tid; ++i) { a += cg[i]; e += ce[i]; } pg[tid] = a; pe[tid] = e; }
    if (tid == 0) { int a = 0; for (int i = 0; i < 33 * 8; ++i) a += cg[i]; red[0] = a; }
    __syncthreads();
    const int need = TOPK - red[0]; const unsigned long long lt = (1ull << lane) - 1ull;
#pragma unroll
    for (int jj = 0; jj < 33; ++jj) {
        const bool gt = v[jj] > T, eq = v[jj] == T; const unsigned long long me = __ballot(eq), mg = __ballot(gt);
        const int epre = pe[jj * 8 + wv] + __popcll(me & lt), gpre = pg[jj * 8 + wv] + __popcll(mg & lt); const bool sel = gt || (eq && epre < need);
        const int ebc = epre < need ? epre : need;
        if (sel) SELS[gpre + ebc] = jj * 512 + tid;
    }
    __syncthreads();
}

DEVI void attn_sample_unit(CP p, int j, int q) {
    const int TIDX = ltid();
    const float* H = wsf(p, WS_H); const int* SELS = (const int*)(p->ws + WS_SELS) + q * TOPK; bf16* AO = wsb(p, WS_AO);
    const int row = MPR + q, b = q / DS, h = TIDX >> 6, lane = TIDX & 63, g = h >> 2;
    const float q0 = H[(size_t)row * HC_AB + C_Q + h * 128 + lane], q1 = H[(size_t)row * HC_AB + C_Q + h * 128 + 64 + lane];
    float m = -1e30f, l = 0.f, o0 = 0.f, o1 = 0.f;
    for (int i = 0; i < TOPK; ++i) { const int s = SELS[i]; const float *kr, *vr;
        if (s < PAST) { const int pg = p->page_table[b * NPAGES + s / PAGE]; const size_t o = ((((size_t)j * NPOOL + pg) * PAGE + s % PAGE) * 2 + g) * 128; kr = p->cache_k + o; vr = p->cache_v + o; }
        else { const size_t o = (size_t)(MPR + b * DS + s - PAST) * HC_AB + g * 128; kr = H + o + C_K; vr = H + o + C_V; }
        const float lg = wave_sum(q0 * kr[lane] + q1 * kr[lane + 64]) * ATT_SCALE;
        const float mn = fmaxf(m, lg), al = __expf(m - mn), pe = __expf(lg - mn);
        l = l * al + pe; o0 = o0 * al + pe * vr[lane]; o1 = o1 * al + pe * vr[lane + 64]; m = mn; }
    const float il = 1.f / l;
    AO[(size_t)row * DM + h * 128 + lane] = f2bf(o0 * il); AO[(size_t)row * DM + h * 128 + 64 + lane] = f2bf(o1 * il);
}

DEVI void ph_cd_prep(CP p, int j, int vb, int nvb) {
    const int TIDX = ltid();
    const float* H = wsf(p, WS_H); bf16* DD = wsb(p, WS_DD); bf16* U = wsb(p, WS_U); bf16* VLN = wsb(p, WS_VLN);
    const float* lg = p->sgu_ln_g + (size_t)j * 1024; const float* lb = p->sgu_ln_b + (size_t)j * 1024;
    const int lane = TIDX & 63, wv = TIDX >> 6;
    for (int row = vb * 8 + wv; row < MR; row += nvb * 8) {
        const bool pr = row < MPR; const int b = pr ? row / SEQ : (row - MPR) / DS, t = pr ? row % SEQ : (row - MPR) % DS;
        const float* h = H + (size_t)row * HC_CD;
#pragma unroll 1
        for (int i = 0; i < 4; ++i) { const int c = i * 256 + lane * 4, w = 2 << i; const f32x4 cur = *(const f32x4*)(h + c); f32x4 s = cur; int cnt;
            if (pr) { cnt = (t + 1 < w) ? t + 1 : w; for (int u = 1; u < cnt; ++u) s += *(const f32x4*)(H + (size_t)(row - u) * HC_CD + c); }
            else { cnt = w; for (int u = 1; u < w; ++u) { const int e = 15 + t - u;
                    s += (e >= 15) ? *(const f32x4*)(H + (size_t)(MPR + b * DS + e - 15) * HC_CD + c) : *(const f32x4*)(p->state_pool + (((size_t)j * DB + b) * 15 + e) * 1024 + c); } }
            const float ic = 1.f / (float)cnt; const f32x4 d = s * ic - cur; uint2 o; o.x = pk2(d.x, d.y); o.y = pk2(d.z, d.w); *(uint2*)(DD + (size_t)row * 1024 + c) = o;
            if (pr) { if (t >= SEQ - 15) *(f32x4*)(p->out + O_PP + (((size_t)j * NBP + b) * 15 + (t - (SEQ - 15))) * 1024 + c) = cur; }
            else { *(f32x4*)(p->out + O_PS + (((size_t)j * DB + b) * 15 + 7 + t) * 1024 + c) = cur;
                   if (t == 0) for (int e = 0; e < 7; ++e) *(f32x4*)(p->out + O_PS + (((size_t)j * DB + b) * 15 + e) * 1024 + c) = *(const f32x4*)(p->state_pool + (((size_t)j * DB + b) * 15 + 8 + e) * 1024 + c); }
        }
        asm volatile("" ::: "memory");
#pragma unroll
        for (int i = 0; i < 4; ++i) { const int c = (i * 64 + lane) * 4; const f32x4 u = *(const f32x4*)(h + 1024 + c); uint2 o; o.x = pk2(gelu_f(u.x), gelu_f(u.y)); o.y = pk2(gelu_f(u.z), gelu_f(u.w)); *(uint2*)(U + (size_t)row * 1024 + c) = o; }
        asm volatile("" ::: "memory");
        f32x4 v[4]; float s = 0.f;
#pragma unroll
        for (int i = 0; i < 4; ++i) { const int c = (i * 64 + lane) * 4; const f32x4 x = *(const f32x4*)(h + 2048 + c); v[i] = (f32x4){gelu_f(x.x), gelu_f(x.y), gelu_f(x.z), gelu_f(x.w)}; s += (v[i].x + v[i].y) + (v[i].z + v[i].w); }
        const float mean = wave_sum(s) * (1.f / 1024.f); float q = 0.f;
#pragma unroll
        for (int i = 0; i < 4; ++i) { v[i] = v[i] - mean; q += (v[i].x * v[i].x + v[i].y * v[i].y) + (v[i].z * v[i].z + v[i].w * v[i].w); }
        const float rstd = 1.f / sqrtf(wave_sum(q) * (1.f / 1024.f) + EPS);
#pragma unroll
        for (int i = 0; i < 4; ++i) { const int c = (i * 64 + lane) * 4; const f32x4 y = v[i] * rstd * *(const f32x4*)(lg + c) + *(const f32x4*)(lb + c);
            uint2 o; o.x = pk2(y.x, y.y); o.y = pk2(y.z, y.w); *(uint2*)(VLN + (size_t)row * 1024 + c) = o;
            if (!pr) *(f32x4*)(p->out + O_GS + ((size_t)j * MSR + (row - MPR)) * 1024 + c) = y; }
    }
}

DEVI void ph_sgu_naive(CP p, int j, int vb, int nvb) {
    const int TIDX = ltid();
    const bf16* VLN = wsb(p, WS_VLN); const bf16* U = wsb(p, WS_U); bf16* AO = wsb(p, WS_AO);
    for (int row = vb; row < MR; row += nvb) {
        const bool pr = row < MPR; const int t = pr ? row % SEQ : (row - MPR) % DS;
        const int tt = pr ? (t & 127) : t, base = row - tt;
        for (int d = TIDX; d < 1024; d += 512) { const int g = d >> 8; const float* w = p->sgu_w + (((size_t)j * 4 + g) * 128 + tt) * 128;
            float acc = p->sgu_b[((size_t)j * 4 + g) * 128 + tt];
            for (int s = 0; s <= tt; ++s) acc += w[s] * bf2f(VLN[(size_t)(base + s) * 1024 + d]);
            AO[(size_t)row * DM + 1024 + d] = f2bf(bf2f(U[(size_t)row * 1024 + d]) * acc); }
    }
}


DEVI void diag_cmp(CP p, int k, const bf16* a, int lda, const bf16* b, int ldb, int rows, int cols, int vb, int nvb) {
    unsigned* ctl = (unsigned*)(p->ws + WS_CTL); const int tid = ltid(); float mx = 0.f; unsigned bad = 0;
    for (int r = vb; r < rows; r += nvb) for (int c = tid; c < cols; c += 512) { const float x = bf2f(a[(size_t)r * lda + c]), y = bf2f(b[(size_t)r * ldb + c]); const float d = fabsf(x - y);
        if (!(d == d) || d > 1e30f) bad++; else mx = fmaxf(mx, d); }
    atomicMax(ctl + 64 + 2 * k, __float_as_uint(mx)); if (bad) atomicAdd(ctl + 65 + 2 * k, bad);
}
DEVI void diag_cmp_f32(CP p, int k, const float* a, int lda, const bf16* b, int ldb, int rows, int cols, int vb, int nvb) {
    unsigned* ctl = (unsigned*)(p->ws + WS_CTL); const int tid = ltid(); float mx = 0.f; unsigned bad = 0;
    for (int r = vb; r < rows; r += nvb) for (int c = tid; c < cols; c += 512) { const float x = a[(size_t)r * lda + c], y = bf2f(b[(size_t)r * ldb + c]); const float d = fabsf(x - y);
        if (!(d == d) || d > 1e30f) bad++; else mx = fmaxf(mx, d); }
    atomicMax(ctl + 64 + 2 * k, __float_as_uint(mx)); if (bad) atomicAdd(ctl + 65 + 2 * k, bad);
}
DEVI void diag_fin_f32(CP p, int k, const float* a, size_t n, int vb, int nvb) {
    unsigned* ctl = (unsigned*)(p->ws + WS_CTL); unsigned bad = 0;
    for (size_t i = (size_t)vb * 512 + ltid(); i < n; i += (size_t)nvb * 512) { const float x = a[i]; if (!(x == x) || fabsf(x) > 1e30f) bad++; }
    if (bad) atomicAdd(ctl + 65 + 2 * k, bad);
}
DEVI void diag_fin_bf16(CP p, int k, const bf16* a, size_t n, int vb, int nvb) {
    unsigned* ctl = (unsigned*)(p->ws + WS_CTL); unsigned bad = 0;
    for (size_t i = (size_t)vb * 512 + ltid(); i < n; i += (size_t)nvb * 512) { const float x = bf2f(a[i]); if (!(x == x) || fabsf(x) > 1e30f) bad++; }
    if (bad) atomicAdd(ctl + 65 + 2 * k, bad);
}
DEVI void diag_report(CP p, int nchecks) {
    unsigned* ctl = (unsigned*)(p->ws + WS_CTL);
    if (blockIdx.x == 0 && threadIdx.x == 0) { const unsigned fl = __hip_atomic_load(ctl + 96, __ATOMIC_RELAXED, __HIP_MEMORY_SCOPE_AGENT); if (fl) { p->out[O_KP] = (float)fl * 1e12f; return; } }
    if (blockIdx.x == 0 && threadIdx.x == 0) for (int k = 0; k < nchecks; ++k) { const float mx = __uint_as_float(__hip_atomic_load(ctl + 64 + 2 * k, __ATOMIC_RELAXED, __HIP_MEMORY_SCOPE_AGENT)); const unsigned bad = __hip_atomic_load(ctl + 65 + 2 * k, __ATOMIC_RELAXED, __HIP_MEMORY_SCOPE_AGENT);
        if (bad) { p->out[O_KP] = (70.f + k) * 1e19f; break; } if (mx > 0.06f) { p->out[O_KP] = mx * 1e8f; break; } }
}
namespace pg8 {
#define PG8_LAS __attribute__((address_space(3)))
typedef unsigned short bf16_t;
typedef short bf16x8 __attribute__((ext_vector_type(8)));
typedef float f32x4 __attribute__((ext_vector_type(4)));
typedef unsigned u32x4 __attribute__((ext_vector_type(4)));
constexpr int BM = 256, BK = 64, HALF = 128, HTB = HALF * BK * 2  , STAGE_BYTES = 8 * HTB, NXCD = 8, WGM = 8;

__host__ __device__ __forceinline__ int lds_byte(int r, int c) { const int st = (r >> 4) * 2 + (c >> 5), rr = r & 15, cc = c & 31, ob = rr * 64 + cc * 2; return st * 1024 + (ob ^ (((ob >> 9) & 1) << 5)); }
__host__ __device__ __forceinline__ void stage_rc(int b, int& R, int& C) { const int st = b / 1024, sb = b % 1024, swz = sb ^ (((sb >> 9) & 1) << 5); R = (st >> 1) * 16 + swz / 64; C = (st & 1) * 32 + (swz % 64) / 2; }
__host__ __device__ __forceinline__ int perm32(int rho) { const int n = rho >> 4, i = rho & 15; return 8 * (i >> 2) + 4 * n + (i & 3); }

struct Unit { int pm, pn; };
struct Gemm { const bf16_t* A; const bf16_t* Bt; int M, N, K, lda, ldb, acol; };

struct StaticOrder {
    int nM, nN, nwg, G, c;
    __host__ __device__ void init(int M, int N, int G_, int c_) { nM = M / BM; nN = N / BM; nwg = nM * nN; G = G_; c = c_; }
    __host__ __device__ bool next(int i, Unit& u) const {
        const long L = (long)i * G + c; if (L >= nwg) return false;
        int wgid = (int)L; { const int q = nwg / NXCD, r = nwg % NXCD, xcd = wgid % NXCD, off = wgid / NXCD; wgid = (xcd < r ? xcd * (q + 1) : r * (q + 1) + (xcd - r) * q) + off; }
        const int nig = WGM * nN, gid = wgid / nig, fm = gid * WGM, gsz = (nM - fm) < WGM ? (nM - fm) : WGM;
        u.pm = fm + ((wgid % nig) % gsz); u.pn = (wgid % nig) / gsz; return true;
    }
    __device__ __forceinline__ void a_ready(const Unit&) const {}
    __device__ __forceinline__ void done(const Unit&) const {}
};

template <class Epi, class Sched, bool ALIGN_EPI = false, bool SP2 = false>
__device__ __forceinline__ void gemm_phase(PG8_LAS unsigned char* lds, const Gemm g, const Sched& S, const Epi& E) {
    int tid_ = threadIdx.x; asm volatile("" : "+v"(tid_)); const int tid = tid_, wid = __builtin_amdgcn_readfirstlane(tid >> 6), lane = tid & 63, wr = wid >> 2, wc = wid & 3, fr = lane & 15, fq = lane >> 4;
    const int K = g.K, nt = K / BK;
    unsigned voffA[2], voffB[2];
#pragma unroll
    for (int i = 0; i < 2; ++i) { int R, C; stage_rc(tid * 16 + i * 8192, R, C); const int Rb = Epi::PERM ? ((R & ~31) + perm32(R & 31)) : R;
        voffA[i] = (unsigned)(R * g.lda + C) * 2u; voffB[i] = (unsigned)(Rb * g.ldb + C) * 2u; }
    const size_t kstep = (size_t)(BK * 2);
    const size_t hstepA = (size_t)HALF * g.lda * 2, hstepB = (size_t)HALF * g.ldb * 2;
    const size_t tstepA = 2 * hstepA, tstepB = 2 * hstepB, acolB = (size_t)g.acol * 2;
    const unsigned ldsw = (unsigned)wid * 1024u;
    const int aoff = lds_byte(wr * 64 + fr, fq * 8), boff = lds_byte(wc * 32 + fr, fq * 8);
#define PG8_SA(b, h) (((b) * 2 + (h)) * HTB)
#define PG8_SB(b, h) ((4 + (b) * 2 + (h)) * HTB)
#define PG8_STAGE(bufoff, gbase, voff) do { _Pragma("unroll") for (int _i = 0; _i < 2; ++_i) \
        __builtin_amdgcn_global_load_lds((const unsigned*)((const char*)(gbase) + (voff)[_i]), (PG8_LAS unsigned*)(lds + (bufoff) + ldsw + _i * 8192), 16, 0, 0); } while (0)
#define PG8_LDA(dst, b, h) do { _Pragma("unroll") for (int m = 0; m < 4; ++m) _Pragma("unroll") for (int k = 0; k < 2; ++k) dst[m][k] = *(const PG8_LAS bf16x8*)(lds + PG8_SA(b, h) + aoff + m * 2048 + k * 1024); } while (0)
#define PG8_LDB(dst, b, h) do { _Pragma("unroll") for (int n = 0; n < 2; ++n) _Pragma("unroll") for (int k = 0; k < 2; ++k) dst[n][k] = *(const PG8_LAS bf16x8*)(lds + PG8_SB(b, h) + boff + n * 2048 + k * 1024); } while (0)
#define PG8_MMA(ai, bj, At, Bt) do { __builtin_amdgcn_s_setprio(1); _Pragma("unroll") for (int m = 0; m < 4; ++m) _Pragma("unroll") for (int n = 0; n < 2; ++n) _Pragma("unroll") for (int k = 0; k < 2; ++k) \
        acc[ai][bj][m][n] = __builtin_amdgcn_mfma_f32_16x16x32_bf16(Bt[n][k], At[m][k], acc[ai][bj][m][n], 0, 0, 0); __builtin_amdgcn_s_setprio(0); } while (0)
#define PG8_WAIT_V(n) asm volatile("s_waitcnt vmcnt(" #n ")" ::: "memory")
#define PG8_WAIT_L(n) asm volatile("s_waitcnt lgkmcnt(" #n ")" ::: "memory")
#define PG8_BAR __builtin_amdgcn_s_barrier()
#define PG8_SCHED __builtin_amdgcn_sched_barrier(0)
    Unit cur, nxt; int ui = 0;
    if (!S.next(0, cur)) return;
    f32x4 acc[2][2][4][2];
#pragma unroll
    for (int a = 0; a < 2; ++a)
#pragma unroll
        for (int b = 0; b < 2; ++b)
#pragma unroll
            for (int m = 0; m < 4; ++m)
#pragma unroll
                for (int n = 0; n < 2; ++n) acc[a][b][m][n] = (f32x4){0.f, 0.f, 0.f, 0.f};
    bf16x8 At[4][2], B0[2][2], B1[2][2];
    const char* cA = (const char*)g.A + (size_t)cur.pm * tstepA + (size_t)cur.pn * acolB; const char* cB = (const char*)g.Bt + (size_t)cur.pn * tstepB;
    S.a_ready(cur);
    if constexpr (SP2) {
        PG8_STAGE(PG8_SB(0, 0), cB, voffB); PG8_STAGE(PG8_SB(0, 1), cB + hstepB, voffB); PG8_STAGE(PG8_SA(0, 0), cA, voffA); PG8_STAGE(PG8_SA(0, 1), cA + hstepA, voffA);
        if (wr == 1) PG8_BAR;
        PG8_WAIT_V(2); PG8_BAR;
        PG8_STAGE(PG8_SB(1, 0), cB + kstep, voffB); PG8_STAGE(PG8_SA(1, 0), cA + kstep, voffA); PG8_STAGE(PG8_SB(1, 1), cB + hstepB + kstep, voffB);
        PG8_WAIT_V(6); PG8_BAR;
    } else {
        PG8_STAGE(PG8_SB(0, 0), cB, voffB); PG8_STAGE(PG8_SA(0, 0), cA, voffA); PG8_STAGE(PG8_SB(0, 1), cB + hstepB, voffB); PG8_STAGE(PG8_SA(0, 1), cA + hstepA, voffA);
        if (wr == 1) PG8_BAR;
        PG8_WAIT_V(4); PG8_BAR;
        PG8_STAGE(PG8_SB(1, 0), cB + kstep, voffB); PG8_STAGE(PG8_SA(1, 0), cA + kstep, voffA); PG8_STAGE(PG8_SB(1, 1), cB + hstepB + kstep, voffB);
        PG8_WAIT_V(6); PG8_BAR;
    }
    for (;;) {
        const bool has_next = S.next(ui + 1, nxt);
        const char* nA = has_next ? (const char*)g.A + (size_t)nxt.pm * tstepA + (size_t)nxt.pn * acolB : cA; const char* nB = has_next ? (const char*)g.Bt + (size_t)nxt.pn * tstepB : cB;
        for (int t = 0; t < nt; t += 2) {
            const bool last = (t == nt - 2);
            const char* a1 = cA + (size_t)(t + 1) * kstep;
            const char* a2 = last ? nA : cA + (size_t)(t + 2) * kstep; const char* b2 = last ? nB : cB + (size_t)(t + 2) * kstep;
            const char* a3 = a2 + kstep; const char* b3 = b2 + kstep;
            if (last && has_next) S.a_ready(nxt);
            if constexpr (SP2) {
            PG8_LDB(B0, 0, 0); PG8_LDB(B1, 0, 1); PG8_SCHED; PG8_LDA(At, 0, 0); PG8_STAGE(PG8_SA(1, 1), a1 + hstepA, voffA);
            PG8_WAIT_V(8); PG8_WAIT_L(0); PG8_BAR; PG8_MMA(0, 0, At, B0); PG8_MMA(0, 1, At, B1); PG8_BAR; PG8_SCHED;
            PG8_LDA(At, 0, 1); PG8_STAGE(PG8_SB(0, 0), b2, voffB); PG8_STAGE(PG8_SB(0, 1), b2 + hstepB, voffB); PG8_STAGE(PG8_SA(0, 0), a2, voffA);
            PG8_WAIT_V(8); PG8_WAIT_L(0); PG8_BAR; PG8_MMA(1, 0, At, B0); PG8_MMA(1, 1, At, B1); PG8_BAR; PG8_SCHED;
            PG8_LDB(B0, 1, 0); PG8_LDB(B1, 1, 1); PG8_SCHED; PG8_LDA(At, 1, 0); PG8_STAGE(PG8_SA(0, 1), a2 + hstepA, voffA);
            PG8_WAIT_V(8); PG8_WAIT_L(0); PG8_BAR; PG8_MMA(0, 0, At, B0); PG8_MMA(0, 1, At, B1); PG8_BAR; PG8_SCHED;
            PG8_LDA(At, 1, 1); PG8_STAGE(PG8_SB(1, 0), b3, voffB); PG8_STAGE(PG8_SB(1, 1), b3 + hstepB, voffB); PG8_STAGE(PG8_SA(1, 0), a3, voffA);
            PG8_WAIT_V(8); PG8_WAIT_L(0); PG8_BAR; PG8_MMA(1, 0, At, B0); PG8_MMA(1, 1, At, B1); PG8_BAR; PG8_SCHED;
            } else {
            PG8_LDB(B0, 0, 0); PG8_SCHED; PG8_LDA(At, 0, 0); PG8_STAGE(PG8_SA(1, 1), a1 + hstepA, voffA);
            PG8_WAIT_L(8); PG8_BAR; PG8_WAIT_L(0); PG8_MMA(0, 0, At, B0); PG8_BAR; PG8_SCHED;
            PG8_LDB(B1, 0, 1); PG8_STAGE(PG8_SB(0, 0), b2, voffB);
            PG8_BAR; PG8_WAIT_L(0); PG8_MMA(0, 1, At, B1); PG8_BAR;
            PG8_LDA(At, 0, 1); PG8_STAGE(PG8_SA(0, 0), a2, voffA);
            PG8_BAR; PG8_WAIT_L(0); PG8_MMA(1, 0, At, B0); PG8_BAR; PG8_SCHED;
            PG8_STAGE(PG8_SB(0, 1), b2 + hstepB, voffB);
            PG8_WAIT_V(6); PG8_BAR; PG8_MMA(1, 1, At, B1); PG8_BAR;
            PG8_LDB(B0, 1, 0); PG8_SCHED; PG8_LDA(At, 1, 0); PG8_STAGE(PG8_SA(0, 1), a2 + hstepA, voffA);
            PG8_WAIT_L(8); PG8_BAR; PG8_WAIT_L(0); PG8_MMA(0, 0, At, B0); PG8_BAR; PG8_SCHED;
            PG8_LDB(B1, 1, 1); PG8_STAGE(PG8_SB(1, 0), b3, voffB);
            PG8_BAR; PG8_WAIT_L(0); PG8_MMA(0, 1, At, B1); PG8_BAR;
            PG8_LDA(At, 1, 1); PG8_STAGE(PG8_SA(1, 0), a3, voffA);
            PG8_BAR; PG8_WAIT_L(0); PG8_MMA(1, 0, At, B0); PG8_BAR; PG8_SCHED;
            PG8_STAGE(PG8_SB(1, 1), b3 + hstepB, voffB);
            PG8_WAIT_V(6); PG8_BAR; PG8_MMA(1, 1, At, B1); PG8_BAR;
            }
        }
        if constexpr (ALIGN_EPI) { if (wr == 0) PG8_BAR; }
        if constexpr (!Epi::AFTER_DRAIN) { E(acc, cur, wr, wc, fr, fq); S.done(cur); }
        if (!has_next) break;
#pragma unroll
        for (int a = 0; a < 2; ++a)
#pragma unroll
            for (int b = 0; b < 2; ++b)
#pragma unroll
                for (int m = 0; m < 4; ++m)
#pragma unroll
                    for (int n = 0; n < 2; ++n) acc[a][b][m][n] = (f32x4){0.f, 0.f, 0.f, 0.f};
        cur = nxt; cA = nA; cB = nB; ++ui;
        if constexpr (ALIGN_EPI) { if (wr == 1) PG8_BAR; }
    }
    PG8_WAIT_V(0);
    if constexpr (!ALIGN_EPI) { if (wr == 0) PG8_BAR; }
    PG8_BAR;
    if constexpr (Epi::AFTER_DRAIN) { E.fused(acc, cur, wr, wc, fr, fq, lds, wid, lane); S.done(cur); }
#undef PG8_SA
#undef PG8_SB
#undef PG8_STAGE
#undef PG8_LDA
#undef PG8_LDB
#undef PG8_MMA
#undef PG8_WAIT_V
#undef PG8_WAIT_L
#undef PG8_BAR
#undef PG8_SCHED
}
}
namespace pg8 {
__device__ __forceinline__ unsigned cvt_pk_bf16(float lo, float hi) { unsigned r; asm volatile("v_cvt_pk_bf16_f32 %0, %1, %2" : "=v"(r) : "v"(lo), "v"(hi)); return r; }
struct EpiF32 {
    static constexpr bool PERM = false, AFTER_DRAIN = false;
    float* C; int ldc;
    __device__ __forceinline__ void operator()(const f32x4 (&acc)[2][2][4][2], const Unit& u, int wr, int wc, int, int) const {
        int ln_ = threadIdx.x & 63; asm volatile("" : "+v"(ln_)); const int fr = ln_ & 15, fq = ln_ >> 4;
        const int row0 = u.pm * BM + wr * 64 + fr, col0 = u.pn * BM + wc * 32 + 4 * fq;
#pragma unroll
        for (int ai = 0; ai < 2; ++ai)
#pragma unroll
            for (int m = 0; m < 4; ++m) { float* rowp = C + (size_t)(row0 + ai * HALF + m * 16) * ldc + col0;
#pragma unroll
                for (int bj = 0; bj < 2; ++bj)
#pragma unroll
                    for (int n = 0; n < 2; ++n) *(f32x4*)(rowp + bj * HALF + n * 16) = acc[ai][bj][m][n]; }
    }
};
struct EpiResid {
    static constexpr bool PERM = false, AFTER_DRAIN = false;
    float* X; int ldc; float alpha;
    __device__ __forceinline__ void operator()(const f32x4 (&acc)[2][2][4][2], const Unit& u, int wr, int wc, int, int) const {
        int ln_ = threadIdx.x & 63; asm volatile("" : "+v"(ln_)); const int fr = ln_ & 15, fq = ln_ >> 4;
        const int row0 = u.pm * BM + wr * 64 + fr, col0 = u.pn * BM + wc * 32 + 4 * fq;
#pragma unroll
        for (int ai = 0; ai < 2; ++ai)
#pragma unroll
            for (int m = 0; m < 4; ++m) { float* rowp = X + (size_t)(row0 + ai * HALF + m * 16) * ldc + col0;
#pragma unroll
                for (int bj = 0; bj < 2; ++bj) { const f32x4 o0 = *(const f32x4*)(rowp + bj * HALF), o1 = *(const f32x4*)(rowp + bj * HALF + 16);
                    *(f32x4*)(rowp + bj * HALF) = o0 * alpha + acc[ai][bj][m][0]; *(f32x4*)(rowp + bj * HALF + 16) = o1 * alpha + acc[ai][bj][m][1];
                    asm volatile("" ::: "memory"); } }
    }
};
template <int ACT  > struct EpiBf16 {
    static constexpr bool PERM = true, AFTER_DRAIN = false;
    bf16_t* O; int ldc; const float* scale;
    __device__ __forceinline__ void operator()(const f32x4 (&acc)[2][2][4][2], const Unit& u, int wr, int wc, int, int) const {
        int ln_ = threadIdx.x & 63; asm volatile("" : "+v"(ln_)); const int fr = ln_ & 15, fq = ln_ >> 4;
        const int row0 = u.pm * BM + wr * 64 + fr, col0 = u.pn * BM + wc * 32 + 8 * fq;
        f32x4 sv[2][2];
#pragma unroll
        for (int bj = 0; bj < 2; ++bj)
#pragma unroll
            for (int n = 0; n < 2; ++n) sv[bj][n] = (ACT == 0) ? *(const f32x4*)(scale + col0 + bj * HALF + 4 * n) : (f32x4){1.f, 1.f, 1.f, 1.f};
#pragma unroll
        for (int ai = 0; ai < 2; ++ai)
#pragma unroll
            for (int m = 0; m < 4; ++m) { bf16_t* rowp = O + (size_t)(row0 + ai * HALF + m * 16) * ldc + col0;
#pragma unroll
                for (int bj = 0; bj < 2; ++bj) { f32x4 v0 = acc[ai][bj][m][0], v1 = acc[ai][bj][m][1];
                    if (ACT == 0) { v0 = v0 * sv[bj][0]; v1 = v1 * sv[bj][1]; }
                    if (ACT == 1) {
#pragma unroll
                        for (int q = 0; q < 4; ++q) { const float a = fmaxf(v0[q], 0.f), b = fmaxf(v1[q], 0.f); v0[q] = a * a; v1[q] = b * b; } }
                    u32x4 w; w.x = cvt_pk_bf16(v0[0], v0[1]); w.y = cvt_pk_bf16(v0[2], v0[3]); w.z = cvt_pk_bf16(v1[0], v1[1]); w.w = cvt_pk_bf16(v1[2], v1[3]);
                    *(u32x4*)(rowp + bj * HALF) = w; } }
    }
};
}
#define LAS __attribute__((address_space(3)))
#define XB_TMO      128
#define XB_XCNT(j)  (256  + 64 * (j))
#define XB_XSUB(j)  (1280 + 64 * (j))
#define XB_XGEN(j)  (2304 + 64 * (j))
#define XB_TOP      3328
#define XB_TOPGEN   3392
#define XCD_BAR_WORDS 3456
#define XB_SPIN_CAP (1u << 18)

__device__ __forceinline__ unsigned xb_ld(unsigned* p)              { return __hip_atomic_load(p, __ATOMIC_RELAXED, __HIP_MEMORY_SCOPE_AGENT); }
__device__ __forceinline__ unsigned xb_add(unsigned* p, unsigned v) { return __hip_atomic_fetch_add(p, v, __ATOMIC_RELAXED, __HIP_MEMORY_SCOPE_AGENT); }
__device__ __forceinline__ unsigned xb_xcc_id() { return (unsigned)__builtin_amdgcn_s_getreg((3 << 11) | 20) & 0xFu; }
#define XB_SPIN(cond, bar) do { unsigned _sp = 0; while (cond) { __builtin_amdgcn_s_sleep(1); \
    if ((++_sp & 255u) == 0u) { if (xb_ld(&(bar)[XB_TMO])) break; if (_sp > XB_SPIN_CAP) { atomicAdd(&(bar)[XB_TMO], 1u); break; } } } } while (0)

struct XcdBarrier {
    unsigned* bar; unsigned x;
    volatile LAS unsigned* st;
};

__device__ __forceinline__ XcdBarrier xcd_barrier_post(unsigned* bar, volatile LAS unsigned* st) {
    XcdBarrier b; b.bar = bar; b.x = xb_xcc_id(); b.st = st;
    if (threadIdx.x == 0) (void)xb_add(&bar[XB_XCNT(b.x)], 1u);
    return b;
}
__device__ __forceinline__ void xcd_barrier_complete(unsigned* bar, unsigned x, unsigned& nloc, unsigned& nx) {
    const unsigned G = gridDim.x * gridDim.y * gridDim.z;
    unsigned sum, cnt, mine, sp = 0u;
    for (;;) {
        sum = 0u; cnt = 0u; mine = 0u;
#pragma unroll
        for (unsigned j = 0; j < 16; ++j) { const unsigned c = xb_ld(&bar[XB_XCNT(j)]); sum += c; cnt += (c > 0u) ? 1u : 0u; mine = (j == x) ? c : mine; }
        if (sum == G) break;
        __builtin_amdgcn_s_sleep(1);
        if ((++sp & 255u) == 0u) { if (xb_ld(&bar[XB_TMO])) break; if (sp > XB_SPIN_CAP) { atomicAdd(&bar[XB_TMO], 1u); break; } }
    }
    nloc = mine > 0u ? mine : 1u; nx = cnt > 0u ? cnt : 1u;
}

__device__ __attribute__((noinline)) void xcd_barrier_impl(unsigned* bar_, unsigned bx_, volatile LAS unsigned* st_) {
    XcdBarrier b; b.bar = bar_; b.x = bx_; b.st = st_;
    asm volatile("s_waitcnt vmcnt(0)" ::: "memory");
    __syncthreads();
    if (threadIdx.x == 0) {
        unsigned* bar = b.bar;
        __builtin_amdgcn_s_waitcnt(0);
        unsigned nloc = b.st[0], nx = b.st[1];
        if (nloc == 0u) { xcd_barrier_complete(bar, b.x, nloc, nx); b.st[0] = nloc; b.st[1] = nx; }
        const unsigned old = xb_add(&bar[XB_XSUB(b.x)], 1u);
        const unsigned gen = old / nloc;
        if (old + 1u == (gen + 1u) * nloc) {
            __builtin_amdgcn_fence(__ATOMIC_RELEASE, "agent");
            asm volatile("s_waitcnt vmcnt(0)" ::: "memory");
            const unsigned og = xb_add(&bar[XB_TOP], 1u);
            const unsigned tg = og / nx;
            if (og + 1u == (tg + 1u) * nx) xb_add(&bar[XB_TOPGEN], 1u);
            else XB_SPIN(xb_ld(&bar[XB_TOPGEN]) == tg, bar);
            __builtin_amdgcn_fence(__ATOMIC_ACQUIRE, "agent");
            xb_add(&bar[XB_XGEN(b.x)], 1u);
            asm volatile("s_waitcnt vmcnt(0)" ::: "memory");
        } else {
            XB_SPIN(xb_ld(&bar[XB_XGEN(b.x)]) == gen, bar);
            __builtin_amdgcn_fence(__ATOMIC_ACQUIRE, "agent");
            asm volatile("s_waitcnt vmcnt(0)" ::: "memory");
        }
    }
    __syncthreads();
}
__device__ __forceinline__ void xcd_barrier(const XcdBarrier& b) { xcd_barrier_impl(b.bar, b.x, b.st); }
constexpr int NWAVES = 8;
constexpr int RING_BYTES = 131072, LDSCTL_OFF = RING_BYTES, MISC_OFF = LDSCTL_OFF + 320, LDS_BYTES = 147456;
constexpr size_t CTL_ZERO_BYTES = 1u << 20;
constexpr int CW_BAR = 4096;
constexpr int PH_PER_LAYER = 12, N_PHASES = 1 + 4 * PH_PER_LAYER;

DEVI void tr_job(const float* W, int K, int N, bf16* WT, int abmap, int vb, int nvb, float* t) {
    const int units = (K / 64) * ((N + 63) / 64);
    for (int u = vb; u < units; u += nvb) transpose_unit(W, K, N, WT, abmap, u, t);
}
DEVI void ph_prologue(CP p, int vb, int nvb, float* t) {
    bf16 *WINAB = wsb(p, WS_WINAB), *WOUTAB = wsb(p, WS_WOUTAB), *WINCD = wsb(p, WS_WINCD), *WOUTCD = wsb(p, WS_WOUTCD), *WFF1 = wsb(p, WS_WFF1), *WFF2 = wsb(p, WS_WFF2), *POOLW = wsb(p, WS_POOLW);
    for (int j = 0; j < 2; ++j) {
        tr_job(p->w_in_ab + (size_t)j * DM * 4696, DM, 4696, WINAB + (size_t)j * HC_AB * DM, 1, vb, nvb, t);
        tr_job(p->w_out_ab + (size_t)j * DM * DM, DM, DM, WOUTAB + (size_t)j * DM * DM, 0, vb, nvb, t);
        tr_job(p->w_in_cd + (size_t)j * DM * HC_CD, DM, HC_CD, WINCD + (size_t)j * HC_CD * DM, 0, vb, nvb, t);
        tr_job(p->w_out_cd + (size_t)j * DM * DM, DM, DM, WOUTCD + (size_t)j * DM * DM, 0, vb, nvb, t);
        tr_job(p->pool_w + (size_t)j * 4 * 65536, 256, 256, POOLW + (size_t)j * 4 * 65536, 0, vb, nvb, t);
        tr_job(p->pool_w + ((size_t)j * 4 + 1) * 65536, 256, 256, POOLW + ((size_t)j * 4 + 1) * 65536, 0, vb, nvb, t);
        tr_job(p->pool_w + ((size_t)j * 4 + 2) * 65536, 256, 256, POOLW + ((size_t)j * 4 + 2) * 65536, 0, vb, nvb, t);
        tr_job(p->pool_w + ((size_t)j * 4 + 3) * 65536, 256, 256, POOLW + ((size_t)j * 4 + 3) * 65536, 0, vb, nvb, t);
    }
    for (int i = 0; i < 4; ++i) {
        tr_job(p->w_ff1 + (size_t)i * DM * DFF, DM, DFF, WFF1 + (size_t)i * DFF * DM, 0, vb, nvb, t);
        tr_job(p->w_ff2 + (size_t)i * DFF * DM, DFF, DM, WFF2 + (size_t)i * DM * DFF, 0, vb, nvb, t);
    }
    const size_t gt = (size_t)vb * 512 + ltid(), ng = (size_t)nvb * 512;
    for (size_t i = gt; i < (size_t)2 * (HC_AB - 4696) * DM / 8; i += ng) { const size_t per = (size_t)(HC_AB - 4696) * DM / 8; const size_t j = i / per, r = i % per;
        *(u32x4*)(WINAB + j * HC_AB * DM + (size_t)4696 * DM + r * 8) = (u32x4){0u, 0u, 0u, 0u}; }
    bf16* sw = wsb(p, WS_SGUW);
    for (size_t i = gt; i < 2 * 4 * 128 * 128; i += ng) { const int s = (int)i & 127, tt = ((int)i >> 7) & 127; sw[i] = f2bf(s <= tt ? p->sgu_w[i] : 0.f); }
    float* X = wsf(p, WS_X); bf16* XB = wsb(p, WS_XB);
    for (size_t i = gt; i < (size_t)MP * DM / 4; i += ng) {
        const size_t e = i * 4; const int row = (int)(e / DM);
        f32x4 v = (f32x4){0.f, 0.f, 0.f, 0.f};
        if (row < MPR) v = *(const f32x4*)(p->x_prompt + e); else if (row < MR) v = *(const f32x4*)(p->x_sample + (e - (size_t)MPR * DM));
        *(f32x4*)(X + e) = v; uint2 o; o.x = pk2(v.x, v.y); o.y = pk2(v.z, v.w); *(uint2*)(XB + e) = o;
    }
}

template <class Epi> DEVI void run_gemm(PG8_LAS unsigned char* lds, const bf16* A, int lda, int acol, const bf16* Bt, int ldb, int M, int N, int K, const Epi& E) {
    asm volatile("" : "+s"(K));
    pg8::Gemm g{A, Bt, M, N, K, lda, ldb, acol}; pg8::StaticOrder S; S.init(M, N, (int)gridDim.x, lvb());
    pg8::gemm_phase<Epi, pg8::StaticOrder, true, true>(lds, g, S, E);
}

#define IN(k) (lo <= (k) && (k) < hi)
#define SEAM(k) do { if (IN(k) && (k) + 1 < hi) xcd_barrier(bar); } while (0)
template <int I> DEVI void layer_phases(LAS unsigned char* L, unsigned char* lds, const XcdBarrier& bar, int lo, int hi, int nvb) {
    constexpr int base = 1 + PH_PER_LAYER * I, j = I >> 1;
    float* smf = (float*)lds; int* smi = (int*)lds;
    if constexpr ((I & 1) == 0) {
        if (IN(base + 0)) { CP p = PP(); run_gemm(L, wsb(p, WS_XB), DM, 0, wsb(p, WS_WINAB) + (size_t)j * HC_AB * DM, DM, MP, HC_AB, DM, pg8::EpiF32{wsf(p, WS_H), HC_AB}); }
        SEAM(base + 0);
        if (IN(base + 1)) {
            ph_ab_copy(PP(), j, lvb(), nvb);
            for (int u = lvb(); u < 64 * 24; u += nvb) conv_prompt_unit(PP(), j, u / 24, u % 24, (bf16*)lds);
            ph_conv(PP(), j, lvb(), nvb);
            ph_idx_prompt_naive(PP(), lvb(), nvb, smf);
            for (int u = lvb(); u < 8 * 33; u += nvb) idx_sample_unit(PP(), j, u / 33, u % 33, smf);
        }
        SEAM(base + 1);
        if (IN(base + 2)) {
            ph_select_prompt(PP(), lvb(), nvb);
            for (int u = lvb(); u < MSR; u += nvb) select_sample_unit(PP(), u, smi);
            for (int u = lvb(); u < 64 * 16; u += nvb) ssd1_unit(PP(), j, u >> 4, u & 15, smf);
#ifdef EXP_OLDY
            { const int t_ = ltid(), u = (t_ >> 6) * nvb + lvb(); if (u < (NBP + DB) * 32) ssd_seq_unit(PP(), j, u / 32, (u >> 1) & 15, u & 1, t_ & 63); }
#else
            { const int t_ = ltid(), u = (t_ >> 6) * nvb + lvb(); if (u < DB * 32) ssd_seq_unit(PP(), j, NBP + u / 32, (u >> 1) & 15, u & 1, t_ & 63); }
#endif
        }
        SEAM(base + 2);
        if (IN(base + 3)) {
            ph_ssd_scan(PP(), j, lvb(), nvb);
            for (int u = lvb(); u < MSR; u += nvb) attn_sample_unit(PP(), j, u);
            ph_ssd_gate(PP(), j, lvb(), nvb);
        }
        SEAM(base + 3);
        if (IN(base + 4)) {
#ifdef EXP_ATT
            ph_attn_prompt_naive(PP(), lvb(), nvb);
            for (int u = lvb(); u < 256; u += nvb) attn_unit(PP(), (u >> 3) & 1, u & 7, u >> 4, lds, wsb(PP(), WS_HF));
#else
            for (int u = lvb(); u < 256; u += nvb) attn_unit(PP(), (u >> 3) & 1, u & 7, u >> 4, lds, wsb(PP(), WS_AO));
#endif
#ifdef EXP_OLDY
            for (int u = lvb(); u < 64 * 8; u += nvb) ssd3_unit(PP(), j, u >> 3, u & 7, smf, wsb(PP(), WS_HF));
#else
            if (nvb == 256) {
                const int vb_ = lvb(), qb_ = vb_ >> 4, n_ = (0x0001112222333444ull >> (4 * qb_)) & 15, off_ = (qb_ < 3 ? 4 * qb_ : qb_ < 6 ? 12 + 3 * (qb_ - 3) : qb_ < 10 ? 21 + 2 * (qb_ - 6) : qb_ < 13 ? 29 + (qb_ - 10) : 32);
                for (int i = 0; i < n_; ++i) { const int u = off_ * 16 + (vb_ & 15) * n_ + i; ssd3_unit(PP(), j, u >> 3, u & 7, smf, wsb(PP(), WS_AO)); }
            } else for (int u = lvb(); u < 64 * 8; u += nvb) ssd3_unit(PP(), j, u >> 3, u & 7, smf, wsb(PP(), WS_AO));
#endif
        }
        SEAM(base + 4);
#ifdef EXP_ATT
        if (IN(base + 5) && I == 0) { CP p = PP(); diag_cmp(p, 0, wsb(p, WS_AO), DM, wsb(p, WS_HF), DM, MPR, 1024, lvb(), nvb); }
#endif
#ifdef EXP_OLDY
        if (IN(base + 5) && I == 0) { CP p = PP(); const int vb_ = lvb();
            diag_cmp_f32(p, 0, wsf(p, WS_XC), 1536, wsb(p, WS_XCN), 1536, MPR, 1536, vb_, nvb);
            diag_fin_f32(p, 1, wsf(p, WS_ACUM), (size_t)64 * 16 * 128, vb_, nvb);
            diag_fin_f32(p, 2, wsf(p, WS_DTC), (size_t)64 * 16 * 128, vb_, nvb);
            diag_fin_bf16(p, 3, wsb(p, WS_HIN), (size_t)64 * 16 * 8192, vb_, nvb);
            diag_fin_bf16(p, 4, wsb(p, WS_XCT), (size_t)64 * 1536 * 128, vb_, nvb);
            diag_cmp(p, 5, wsb(p, WS_AO) + 1024, DM, wsb(p, WS_HF) + 1024, DM, MPR, 1024, vb_, nvb); }
#endif
        if (IN(base + 5)) { CP p = PP(); run_gemm(L, wsb(p, WS_AO), DM, 0, wsb(p, WS_WOUTAB) + (size_t)j * DM * DM, DM, MP, DM, DM, pg8::EpiResid{wsf(p, WS_X), DM, ALPHA}); }
        SEAM(base + 5);
    } else {
        if (IN(base + 0)) { CP p = PP(); run_gemm(L, wsb(p, WS_XB), DM, 0, wsb(p, WS_WINCD) + (size_t)j * HC_CD * DM, DM, MP, HC_CD, DM, pg8::EpiF32{wsf(p, WS_H), HC_CD}); }
        SEAM(base + 0);
        if (IN(base + 1)) ph_cd_prep(PP(), j, lvb(), nvb);
        SEAM(base + 1);
        if (IN(base + 2)) {
            { CP p = PP(); run_gemm(L, wsb(p, WS_DD), 1024, 256, wsb(p, WS_POOLW) + (size_t)j * 4 * 65536, 256, MP, 1024, 256, pg8::EpiBf16<0>{wsb(p, WS_AO), DM, p->pool_scale + (size_t)j * 1024}); }
            ph_sgu_naive(PP(), j, lvb(), nvb);
        }
        if (IN(base + 2) && base + 5 < hi) xcd_barrier(bar);
        if (IN(base + 5)) { CP p = PP(); run_gemm(L, wsb(p, WS_AO), DM, 0, wsb(p, WS_WOUTCD) + (size_t)j * DM * DM, DM, MP, DM, DM, pg8::EpiResid{wsf(p, WS_X), DM, ALPHA}); }
        SEAM(base + 5);
    }
#ifdef EXP_OLDY
    if (IN(base + 6) && I == 0) diag_report(PP(), 6);
#endif
#ifdef EXP_ATT
    if (IN(base + 6) && I == 0) diag_report(PP(), 1);
#endif
    if (IN(base + 6)) { CP p = PP(); ph_ln(p, p->ln1_g + (size_t)I * DM, p->ln1_b + (size_t)I * DM, 0, lvb(), nvb); }
    SEAM(base + 6);
    if (IN(base + 7)) { CP p = PP(); run_gemm(L, wsb(p, WS_XB), DM, 0, wsb(p, WS_WFF1) + (size_t)I * DFF * DM, DM, MP, DFF, DM, pg8::EpiBf16<1>{wsb(p, WS_HF), DFF, nullptr}); }
    SEAM(base + 7);
    if (IN(base + 8)) { CP p = PP(); run_gemm(L, wsb(p, WS_HF), DFF, 0, wsb(p, WS_WFF2) + (size_t)I * DM * DFF, DFF, MP, DM, DFF, pg8::EpiResid{wsf(p, WS_X), DM, ALPHA}); }
    SEAM(base + 8);
    if (IN(base + 9)) { CP p = PP(); ph_ln(p, p->ln2_g + (size_t)I * DM, p->ln2_b + (size_t)I * DM, I == 3, lvb(), nvb); }
    if (I < 3) { if (IN(base + 9) && base + PH_PER_LAYER < hi) xcd_barrier(bar); }
}

__global__ void __launch_bounds__(NWAVES * 64, 2) mk_fwd(P p_kernarg) {
    extern __shared__ __attribute__((aligned(16))) unsigned char lds[];
    LAS unsigned char* L = (LAS unsigned char*)lds;
    volatile LAS unsigned* MISC = (volatile LAS unsigned*)(L + MISC_OFF);
    const int nvb = gridDim.x;
    for (int u = threadIdx.x; u < (LDS_BYTES - LDSCTL_OFF) / 4; u += NWAVES * 64) ((LAS unsigned*)(L + LDSCTL_OFF))[u] = 0u;
    __syncthreads();
    unsigned* ctl = (unsigned*)(PP()->ws + WS_CTL);
    XcdBarrier bar = xcd_barrier_post(ctl + CW_BAR, MISC + 8);
    const int lo = PP()->ph_lo, hi = PP()->ph_hi;
    if (IN(0)) ph_prologue(PP(), lvb(), nvb, (float*)lds);
    SEAM(0);
    layer_phases<0>(L, lds, bar, lo, hi, nvb);
    layer_phases<1>(L, lds, bar, lo, hi, nvb);
    layer_phases<2>(L, lds, bar, lo, hi, nvb);
    layer_phases<3>(L, lds, bar, lo, hi, nvb);
}
#undef IN
#undef SEAM

#ifndef MK_PER_PHASE
#define MK_PER_PHASE 0
#endif
extern "C" void kernel_launch(void* const* d_in, const int* in_sizes, int n_in, void* d_out, int out_size, void* d_ws, size_t ws_size, hipStream_t stream) {
    if (n_in != 31 || (size_t)out_size != O_END || ws_size < WS_END) { fprintf(stderr, "kernel_launch: unexpected sizes n_in %d out %d ws %zu (need %zu)\n", n_in, out_size, ws_size, (size_t)WS_END); return; }
    static int grid = 0;
    if (grid == 0) {
        int dev = 0, cus = 0, per_cu = 0;
        if (hipGetDevice(&dev) != hipSuccess || hipDeviceGetAttribute(&cus, hipDeviceAttributeMultiprocessorCount, dev) != hipSuccess) { grid = -1; return; }
        if (hipFuncSetAttribute((const void*)mk_fwd, hipFuncAttributeMaxDynamicSharedMemorySize, LDS_BYTES) != hipSuccess) { fprintf(stderr, "kernel_launch: hipFuncSetAttribute failed\n"); grid = -1; return; }
        if (hipOccupancyMaxActiveBlocksPerMultiprocessor(&per_cu, (const void*)mk_fwd, NWAVES * 64, LDS_BYTES) != hipSuccess || per_cu < 1) fprintf(stderr, "kernel_launch: occupancy query says %d\n", per_cu);
        (void)hipGetLastError();
        grid = cus;
    }
    if (grid < 0) return;
    (void)hipMemsetAsync((char*)d_ws + WS_CTL, 0, CTL_ZERO_BYTES, stream);
    P p{};
    p.x_prompt = (const float*)d_in[0]; p.x_sample = (const float*)d_in[1]; p.cache_k = (const float*)d_in[2]; p.cache_v = (const float*)d_in[3]; p.cache_ik = (const float*)d_in[4];
    p.state_ssm = (const float*)d_in[5]; p.state_conv = (const float*)d_in[6]; p.state_pool = (const float*)d_in[7]; p.page_table = (const int*)d_in[8];
    p.ln1_g = (const float*)d_in[9]; p.ln1_b = (const float*)d_in[10]; p.ln2_g = (const float*)d_in[11]; p.ln2_b = (const float*)d_in[12];
    p.w_in_ab = (const float*)d_in[13]; p.conv_w = (const float*)d_in[14]; p.conv_b = (const float*)d_in[15]; p.dt_bias = (const float*)d_in[16]; p.a_log = (const float*)d_in[17];
    p.d_skip = (const float*)d_in[18]; p.ssd_g = (const float*)d_in[19]; p.w_out_ab = (const float*)d_in[20]; p.w_in_cd = (const float*)d_in[21]; p.pool_w = (const float*)d_in[22];
    p.pool_scale = (const float*)d_in[23]; p.sgu_ln_g = (const float*)d_in[24]; p.sgu_ln_b = (const float*)d_in[25]; p.sgu_w = (const float*)d_in[26]; p.sgu_b = (const float*)d_in[27];
    p.w_out_cd = (const float*)d_in[28]; p.w_ff1 = (const float*)d_in[29]; p.w_ff2 = (const float*)d_in[30];
    p.out = (float*)d_out; p.ws = (unsigned char*)d_ws;
#if MK_PER_PHASE
    for (int k = 0; k < N_PHASES; ++k) { const int r = (k - 1) % PH_PER_LAYER; if (k > 0 && (r > 9 || (((k - 1) / PH_PER_LAYER) & 1) && (r == 3 || r == 4))) continue; p.ph_lo = k; p.ph_hi = k + 1; hipLaunchKernelGGL(mk_fwd, dim3(grid), dim3(NWAVES * 64), LDS_BYTES, stream, p); }
#else
    p.ph_lo = 0; p.ph_hi = N_PHASES;
    hipLaunchKernelGGL(mk_fwd, dim3(grid), dim3(NWAVES * 64), LDS_BYTES, stream, p);
#endif
}
```

```cpp
#include <hip/hip_runtime.h>
#include <stdint.h>
#include <stdio.h>

typedef unsigned short bf16;
typedef float f32x4 __attribute__((ext_vector_type(4)));
typedef unsigned u32x4 __attribute__((ext_vector_type(4)));
#define DEVI __device__ __forceinline__
typedef short bf16x8 __attribute__((ext_vector_type(8)));
typedef unsigned u32x2 __attribute__((ext_vector_type(2)));
DEVI f32x4 mfma16(bf16x8 bt, bf16x8 a, f32x4 c) { return __builtin_amdgcn_mfma_f32_16x16x32_bf16(bt, a, c, 0, 0, 0); }
typedef float f32x2_t __attribute__((ext_vector_type(2))); typedef __bf16 bf16x2_t __attribute__((ext_vector_type(2)));
DEVI unsigned cvtpk(float lo, float hi) { f32x2_t v = {lo, hi}; bf16x2_t b = __builtin_convertvector(v, bf16x2_t); return __builtin_bit_cast(unsigned, b); }
DEVI float bflo(unsigned w) { return __uint_as_float(w << 16); }
DEVI float bfhi(unsigned w) { return __uint_as_float(w & 0xffff0000u); }

constexpr int DM = 2048, SEQ = 4096, NBP = 2, MPR = NBP * SEQ;
constexpr int DB = 8, DS = 8, MSR = DB * DS;
constexpr int MR = MPR + MSR;
constexpr int MP = 8448;
constexpr int PAST = 16384, PAGE = 128, NPAGES = PAST / PAGE, NPOOL = 1280;
constexpr int NKEY_S = PAST + DS;
constexpr int SCS_LD = 16400;
constexpr int HC_AB = 4864, HC_CD = 3072, DFF = 8192;
constexpr int TOPK = 256;
constexpr int C_Q = 0, C_K = 1024, C_V = 1280, C_QI = 1536, C_Z = 2048, C_XBC = 3072, C_KI = 4608, C_WI = 4672, C_DT = 4680;
constexpr float ALPHA = 1.681792830507429f;
constexpr float EPS = 1e-5f;
constexpr float IDX_SCALE = 0.04419417382415922f;
constexpr float ATT_SCALE = 0.08838834764831845f;

constexpr size_t O_YP = 0;
constexpr size_t O_YS = O_YP + (size_t)MPR * DM;
constexpr size_t O_KP = O_YS + (size_t)MSR * DM;
constexpr size_t O_VP = O_KP + (size_t)2 * MPR * 256;
constexpr size_t O_IP = O_VP + (size_t)2 * MPR * 256;
constexpr size_t O_HP = O_IP + (size_t)2 * MPR * 64;
constexpr size_t O_CP = O_HP + (size_t)2 * NBP * 16 * 64 * 128;
constexpr size_t O_PP = O_CP + (size_t)2 * NBP * 3 * 1536;
constexpr size_t O_KS = O_PP + (size_t)2 * NBP * 15 * 1024;
constexpr size_t O_VS = O_KS + (size_t)2 * MSR * 256;
constexpr size_t O_IS = O_VS + (size_t)2 * MSR * 256;
constexpr size_t O_HS = O_IS + (size_t)2 * MSR * 64;
constexpr size_t O_CS = O_HS + (size_t)2 * DB * 16 * 64 * 128;
constexpr size_t O_PS = O_CS + (size_t)2 * DB * 3 * 1536;
constexpr size_t O_GS = O_PS + (size_t)2 * DB * 15 * 1024;
constexpr size_t O_END = O_GS + (size_t)2 * MSR * 1024;
static_assert(O_END == 29571072, "output size");

constexpr size_t al256(size_t x) { return (x + 255) & ~(size_t)255; }
constexpr size_t WS_CTL = 0;
constexpr size_t WS_X = 1u << 20;
constexpr size_t WS_XB = WS_X + al256((size_t)MP * DM * 4);
constexpr size_t WS_H = WS_XB + al256((size_t)MP * DM * 2);
constexpr size_t WS_AO = WS_H + al256((size_t)MP * HC_AB * 4);
constexpr size_t WS_HF = WS_AO + al256((size_t)MP * DM * 2);
constexpr size_t WS_SC = WS_HF + al256((size_t)MP * DFF * 2);
constexpr size_t WS_MASK = WS_SC + al256((size_t)MPR * SEQ * 4);
constexpr size_t WS_XC = WS_MASK + al256((size_t)MPR * 64 * 8);
constexpr size_t WS_DT = WS_XC + al256((size_t)MP * 1536 * 4);
constexpr size_t WS_Y = WS_DT + al256((size_t)MP * 16 * 4);
constexpr size_t WS_SCS = WS_Y + al256((size_t)MP * 1024 * 4);
constexpr size_t WS_SELS = WS_SCS + al256((size_t)MSR * SCS_LD * 4);
constexpr size_t WS_DD = WS_SELS + al256((size_t)MSR * TOPK * 4);
constexpr size_t WS_U = WS_DD + al256((size_t)MP * 1024 * 2);
constexpr size_t WS_VLN = WS_U + al256((size_t)MP * 1024 * 2);
constexpr size_t WS_WINAB = WS_VLN + al256((size_t)MP * 1024 * 2);
constexpr size_t WS_WOUTAB = WS_WINAB + (size_t)2 * HC_AB * DM * 2;
constexpr size_t WS_WINCD = WS_WOUTAB + (size_t)2 * DM * DM * 2;
constexpr size_t WS_WOUTCD = WS_WINCD + (size_t)2 * HC_CD * DM * 2;
constexpr size_t WS_WFF1 = WS_WOUTCD + (size_t)2 * DM * DM * 2;
constexpr size_t WS_WFF2 = WS_WFF1 + (size_t)4 * DFF * DM * 2;
constexpr size_t WS_POOLW = WS_WFF2 + (size_t)4 * DFF * DM * 2;
constexpr size_t WS_SGUW = WS_POOLW + (size_t)2 * 4 * 256 * 256 * 2;
constexpr size_t WS_XCN = WS_SGUW + (size_t)2 * 4 * 128 * 128 * 2;
constexpr size_t WS_XCT = WS_XCN + al256((size_t)MP * 1536 * 2);
constexpr size_t WS_ACUM = WS_XCT + al256((size_t)64 * 1536 * 128 * 2);
constexpr size_t WS_DTC = WS_ACUM + al256((size_t)64 * 16 * 128 * 4);
constexpr size_t WS_CDEC = WS_DTC + al256((size_t)64 * 16 * 128 * 4);
constexpr size_t WS_ST = WS_CDEC + al256((size_t)64 * 16 * 4);
constexpr size_t WS_HIN = WS_ST + al256((size_t)64 * 16 * 64 * 128 * 4);
constexpr size_t WS_QB = WS_HIN + al256((size_t)64 * 16 * 64 * 128 * 2);
constexpr size_t WS_KB = WS_QB + al256((size_t)MPR * 1024 * 2);
constexpr size_t WS_VB = WS_KB + al256((size_t)MPR * 256 * 2);
constexpr size_t WS_QIB = WS_VB + al256((size_t)MPR * 256 * 2);
constexpr size_t WS_KIB = WS_QIB + al256((size_t)MPR * 512 * 2);
constexpr size_t WS_END = WS_KIB + al256((size_t)MPR * 64 * 2);

struct P {
    const float *x_prompt, *x_sample, *cache_k, *cache_v, *cache_ik, *state_ssm, *state_conv, *state_pool;
    const int* page_table;
    const float *ln1_g, *ln1_b, *ln2_g, *ln2_b, *w_in_ab, *conv_w, *conv_b, *dt_bias, *a_log, *d_skip, *ssd_g, *w_out_ab;
    const float *w_in_cd, *pool_w, *pool_scale, *sgu_ln_g, *sgu_ln_b, *sgu_w, *sgu_b, *w_out_cd, *w_ff1, *w_ff2;
    float* out;
    unsigned char* ws;
    int ph_lo, ph_hi, a2, a3;
};
typedef const __attribute__((address_space(4))) P* CP;
DEVI CP PP() { CP q = (CP)__builtin_amdgcn_kernarg_segment_ptr(); asm volatile("" : "+s"(q)); return q; }
DEVI float* wsf(CP p, size_t off) { return (float*)(p->ws + off); }
DEVI bf16* wsb(CP p, size_t off) { return (bf16*)(p->ws + off); }

DEVI float bf2f(bf16 b) { return __uint_as_float(((unsigned)b) << 16); }
DEVI bf16 f2bf(float f) { unsigned u = __float_as_uint(f); u += 0x7fffu + ((u >> 16) & 1u); return (bf16)(u >> 16); }
DEVI unsigned pk2(float lo, float hi) { return (unsigned)f2bf(lo) | ((unsigned)f2bf(hi) << 16); }
DEVI float wave_sum(float v) {
#pragma unroll
    for (int o = 1; o < 64; o <<= 1) v += __shfl_xor(v, o);
    return v;
}
DEVI int ltid() { int t = threadIdx.x; asm volatile("" : "+v"(t)); return t; }
DEVI int lvb() { int b = blockIdx.x; asm volatile("" : "+s"(b)); return b; }
DEVI float silu_f(float x) { return x / (1.f + __expf(-x)); }
DEVI float softplus_f(float x) { return fmaxf(x, 0.f) + log1pf(__expf(-fabsf(x))); }
DEVI float gelu_f(float x) { return 0.5f * x * (1.f + erff(x * 0.70710678118654752f)); }
DEVI unsigned ord_f(float f) { f = f + 0.0f; unsigned u = __float_as_uint(f); return (u & 0x80000000u) ? ~u : (u | 0x80000000u); }
__host__ __device__ inline int ab_dst_col(int n) {
    if (n < 2048) return n;
    if (n < 2112) return C_KI + (n - 2048);
    if (n < 2120) return C_WI + (n - 2112);
    if (n < 3144) return C_Z + (n - 2120);
    if (n < 4680) return C_XBC + (n - 3144);
    return n;
}

DEVI void transpose_unit(const float* W, int K, int N, bf16* WT, int abmap, int unit, float* t  ) {
    const int TIDX = ltid();
    const int nbn = (N + 63) / 64, kb = unit / nbn, nb = unit % nbn, k0 = kb * 64, n0 = nb * 64, tid = TIDX;
#pragma unroll
    for (int i = 0; i < 8; ++i) { const int kk = (tid >> 6) + 8 * i, n = n0 + (tid & 63); t[kk * 65 + (tid & 63)] = (n < N) ? W[(size_t)(k0 + kk) * N + n] : 0.f; }
    __syncthreads();
    { const int n = n0 + (tid >> 3), kq = (tid & 7) * 8;
      if (n < N) { const int row = abmap ? ab_dst_col(n) : n; const float* s = t + kq * 65 + (tid >> 3);
          u32x4 o; o.x = pk2(s[0], s[65]); o.y = pk2(s[2 * 65], s[3 * 65]); o.z = pk2(s[4 * 65], s[5 * 65]); o.w = pk2(s[6 * 65], s[7 * 65]);
          *(u32x4*)(WT + (size_t)row * K + k0 + kq) = o; } }
    __syncthreads();
}


DEVI void ph_ln(CP p, const float* g, const float* b, int final_out, int vb, int nvb) {
    const int TIDX = ltid();
    float* X = wsf(p, WS_X); bf16* XB = wsb(p, WS_XB);
    const int lane = TIDX & 63, wv = TIDX >> 6;
    for (int row = vb * 8 + wv; row < MR; row += nvb * 8) {
        float* xr = X + (size_t)row * DM; f32x4 v[8]; float s = 0.f;
#pragma unroll
        for (int i = 0; i < 8; ++i) { v[i] = *(const f32x4*)(xr + (i * 64 + lane) * 4); s += (v[i].x + v[i].y) + (v[i].z + v[i].w); }
        const float mean = wave_sum(s) * (1.f / DM); float q = 0.f;
#pragma unroll
        for (int i = 0; i < 8; ++i) { v[i] = v[i] - mean; q += (v[i].x * v[i].x + v[i].y * v[i].y) + (v[i].z * v[i].z + v[i].w * v[i].w); }
        const float rstd = 1.f / sqrtf(wave_sum(q) * (1.f / DM) + EPS);
        float* o = final_out ? (row < MPR ? p->out + O_YP + (size_t)row * DM : p->out + O_YS + (size_t)(row - MPR) * DM) : nullptr;
#pragma unroll
        for (int i = 0; i < 8; ++i) { const int c = (i * 64 + lane) * 4; const f32x4 gg = *(const f32x4*)(g + c), bb = *(const f32x4*)(b + c);
            const f32x4 y = v[i] * rstd * gg + bb; *(f32x4*)(xr + c) = y; uint2 w; w.x = pk2(y.x, y.y); w.y = pk2(y.z, y.w); *(uint2*)(XB + (size_t)row * DM + c) = w;
            if (final_out) *(f32x4*)(o + c) = y; }
    }
}

DEVI void ph_ab_copy(CP p, int j, int vb, int nvb) {
    const int TIDX = ltid();
    const float* H = wsf(p, WS_H); const int tid = TIDX;
    for (int row = vb; row < MR; row += nvb) {
        const float* h = H + (size_t)row * HC_AB;
        float *ko, *vo, *io;
        if (row < MPR) { ko = p->out + O_KP + ((size_t)j * MPR + row) * 256; vo = p->out + O_VP + ((size_t)j * MPR + row) * 256; io = p->out + O_IP + ((size_t)j * MPR + row) * 64; }
        else { const int sr = row - MPR; ko = p->out + O_KS + ((size_t)j * MSR + sr) * 256; vo = p->out + O_VS + ((size_t)j * MSR + sr) * 256; io = p->out + O_IS + ((size_t)j * MSR + sr) * 64; }
        if (tid < 256) ko[tid] = h[C_K + tid]; else vo[tid - 256] = h[C_V + tid - 256];
        if (row < MPR) { const float qs = ATT_SCALE * 1.4426950408889634f;
            *(unsigned*)(wsb(p, WS_QB) + (size_t)row * 1024 + 2 * tid) = cvtpk(h[C_Q + 2 * tid] * qs, h[C_Q + 2 * tid + 1] * qs);
            if (tid < 128) *(unsigned*)(wsb(p, WS_KB) + (size_t)row * 256 + 2 * tid) = cvtpk(h[C_K + 2 * tid], h[C_K + 2 * tid + 1]);
            else if (tid < 256) *(unsigned*)(wsb(p, WS_VB) + (size_t)row * 256 + 2 * (tid - 128)) = cvtpk(h[C_V + 2 * (tid - 128)], h[C_V + 2 * (tid - 128) + 1]);
            else if (tid < 512) *(unsigned*)(wsb(p, WS_QIB) + (size_t)row * 512 + 2 * (tid - 256)) = cvtpk(h[C_QI + 2 * (tid - 256)], h[C_QI + 2 * (tid - 256) + 1]);
            if (tid < 32) *(unsigned*)(wsb(p, WS_KIB) + (size_t)row * 64 + 2 * tid) = cvtpk(h[C_KI + 2 * tid], h[C_KI + 2 * tid + 1]); }
        if (tid < 64) io[tid] = h[C_KI + tid];
        int ci = -1; float* co = nullptr;
        if (row < MPR) { const int b = row / SEQ, t = row % SEQ; if (t >= SEQ - 3) { ci = t - (SEQ - 3); co = p->out + O_CP + (((size_t)j * NBP + b) * 3 + ci) * 1536; } }
        else { const int b = (row - MPR) / DS, t = (row - MPR) % DS; if (t >= DS - 3) { ci = t - (DS - 3); co = p->out + O_CS + (((size_t)j * DB + b) * 3 + ci) * 1536; } }
        if (ci >= 0) for (int c = tid; c < 1536; c += 512) co[c] = h[C_XBC + c];
    }
}

DEVI void ph_conv(CP p, int j, int vb, int nvb) {
    const int TIDX = ltid();
    const float* H = wsf(p, WS_H); float* XC = wsf(p, WS_XC); float* DT = wsf(p, WS_DT);
    const float* cw = p->conv_w + (size_t)j * 4 * 1536; const float* cb = p->conv_b + (size_t)j * 1536;
#ifdef EXP_OLDY
    for (int row = vb; row < MR; row += nvb) {
#else
    for (int row = MPR + vb; row < MR; row += nvb) {
#endif
        const bool pr = row < MPR; const int b = pr ? row / SEQ : (row - MPR) / DS, t = pr ? row % SEQ : (row - MPR) % DS;
        for (int c = TIDX; c < 1536; c += 512) {
            float acc = cb[c];
#pragma unroll
            for (int jj = 0; jj < 4; ++jj) { const int tt = t - 3 + jj; float xv;
                if (tt >= 0) xv = H[(size_t)(row - t + tt) * HC_AB + C_XBC + c];
                else xv = pr ? 0.f : p->state_conv[(((size_t)j * DB + b) * 3 + (3 + tt)) * 1536 + c];
                acc += cw[jj * 1536 + c] * xv; }
            XC[(size_t)row * 1536 + c] = silu_f(acc);
        }
        if (TIDX < 16) DT[row * 16 + TIDX] = softplus_f(H[(size_t)row * HC_AB + C_DT + TIDX] + p->dt_bias[j * 16 + TIDX]);
    }
}

DEVI void ssd_seq_unit(CP p, int j, int sq  , int h, int ph, int lane) {
    const float* XC = wsf(p, WS_XC); const float* DT = wsf(p, WS_DT); float* Y = wsf(p, WS_Y);
    const bool pr = sq < NBP; const int b = pr ? sq : sq - NBP, n = pr ? SEQ : DS, row0 = pr ? b * SEQ : MPR + b * DS, g = h >> 3;
    const int pp = ph * 32 + (lane & 31), nh = lane >> 5;
    const float a = -__expf(p->a_log[j * 16 + h]), Dk = p->d_skip[j * 16 + h];
    float st[64];
    if (pr) {
#pragma unroll
        for (int i = 0; i < 64; ++i) st[i] = 0.f;
    } else { const float* h0 = p->state_ssm + ((((size_t)j * DB + b) * 16 + h) * 64 + pp) * 128 + nh * 64;
#pragma unroll
        for (int i = 0; i < 16; ++i) { const f32x4 v = *(const f32x4*)(h0 + 4 * i); st[4 * i] = v.x; st[4 * i + 1] = v.y; st[4 * i + 2] = v.z; st[4 * i + 3] = v.w; } }
    for (int t = 0; t < n; ++t) {
        const int row = row0 + t; const float dt = DT[row * 16 + h], dA = __expf(dt * a), x = XC[(size_t)row * 1536 + h * 64 + pp], cf = dt * x;
        const float* Bp = XC + (size_t)row * 1536 + 1024 + g * 128 + nh * 64; const float* Cp = Bp + 256;
        float y = 0.f;
#pragma unroll
        for (int i = 0; i < 16; ++i) { if ((i & 7) == 0) asm volatile("" ::: "memory");
            const f32x4 bv = *(const f32x4*)(Bp + 4 * i), cv = *(const f32x4*)(Cp + 4 * i);
            st[4 * i] = st[4 * i] * dA + cf * bv.x; st[4 * i + 1] = st[4 * i + 1] * dA + cf * bv.y; st[4 * i + 2] = st[4 * i + 2] * dA + cf * bv.z; st[4 * i + 3] = st[4 * i + 3] * dA + cf * bv.w;
            y += cv.x * st[4 * i] + cv.y * st[4 * i + 1] + cv.z * st[4 * i + 2] + cv.w * st[4 * i + 3]; }
        y += __shfl_xor(y, 32);
        if (nh == 0) Y[(size_t)row * 1024 + h * 64 + pp] = y + Dk * x;
    }
#ifdef EXP_OLDY
    if (pr) return;
#endif
    float* ho = (pr ? p->out + O_HP + ((((size_t)j * NBP + b) * 16 + h) * 64 + pp) * 128 : p->out + O_HS + ((((size_t)j * DB + b) * 16 + h) * 64 + pp) * 128) + nh * 64;
#pragma unroll
    for (int i = 0; i < 16; ++i) *(f32x4*)(ho + 4 * i) = (f32x4){st[4 * i], st[4 * i + 1], st[4 * i + 2], st[4 * i + 3]};
}

DEVI void conv_prompt_unit(CP p, int j, int ck, int cb, bf16* T  ) {
    const int tid = ltid(), ch = tid & 63, sg = tid >> 6;
    const float* H = wsf(p, WS_H); bf16* XCN = wsb(p, WS_XCN); bf16* XCT = wsb(p, WS_XCT);
    const int row0 = ck * 128, col = cb * 64 + ch, s0 = sg * 16;
    const float* cw = p->conv_w + (size_t)j * 4 * 1536 + col; const float w0 = cw[0], w1 = cw[1536], w2 = cw[2 * 1536], w3 = cw[3 * 1536], bias = p->conv_b[(size_t)j * 1536 + col];
    const float* hp = H + (size_t)(row0 + s0) * HC_AB + C_XBC + col;
    const bool first = ((ck & 31) == 0) && (sg == 0);
    float x0 = first ? 0.f : hp[-3 * HC_AB], x1 = first ? 0.f : hp[-2 * HC_AB], x2 = first ? 0.f : hp[-HC_AB];
#pragma unroll 4
    for (int i = 0; i < 16; ++i) { const float x3 = hp[(size_t)i * HC_AB]; const bf16 v = f2bf(silu_f(bias + w0 * x0 + w1 * x1 + w2 * x2 + w3 * x3));
        XCN[(size_t)(row0 + s0 + i) * 1536 + col] = v; T[ch * 136 + s0 + i] = v; x0 = x1; x1 = x2; x2 = x3; }
    if (cb == 0) for (int idx = tid; idx < 128 * 16; idx += 512) { const int s = idx >> 4, hh = idx & 15;
        wsf(p, WS_DT)[(row0 + s) * 16 + hh] = softplus_f(H[(size_t)(row0 + s) * HC_AB + C_DT + hh] + p->dt_bias[j * 16 + hh]); }
    __syncthreads();
    { const int chh = tid >> 3, sq = (tid & 7) * 16; const u32x4 a = *(const u32x4*)(T + chh * 136 + sq), b = *(const u32x4*)(T + chh * 136 + sq + 8);
      bf16* dst = XCT + ((size_t)ck * 1536 + cb * 64 + chh) * 128 + sq; *(u32x4*)dst = a; *(u32x4*)(dst + 8) = b; }
    __syncthreads();
}
DEVI void ssd1_unit(CP p, int j, int ck, int h, float* sm  ) {
    const int tid = ltid(), lane = tid & 63, wv = tid >> 6, fr = lane & 15, fq = lane >> 4, g = h >> 3;
    if (wv == 0) {
        const float* DT = wsf(p, WS_DT) + (size_t)ck * 128 * 16 + h; const float a = -__expf(p->a_log[j * 16 + h]);
        float* ACUM = wsf(p, WS_ACUM) + ((size_t)ck * 16 + h) * 128; float* DTC = wsf(p, WS_DTC) + ((size_t)ck * 16 + h) * 128;
        const float d0 = DT[(2 * lane) * 16], d1 = DT[(2 * lane + 1) * 16], v0 = d0 * a, v1 = v0 + d1 * a;
        float run = v1;
#pragma unroll
        for (int o = 1; o < 64; o <<= 1) { const float t = __shfl_up(run, o); if (lane >= o) run += t; }
        const float ex = run - v1, a0 = ex + v0, a1 = ex + v1, last = __shfl(run, 63);
        sm[2 * lane] = a0; sm[2 * lane + 1] = a1; ACUM[2 * lane] = a0; ACUM[2 * lane + 1] = a1; DTC[2 * lane] = d0; DTC[2 * lane + 1] = d1;
        sm[128 + 2 * lane] = d0 * __expf(last - a0); sm[128 + 2 * lane + 1] = d1 * __expf(last - a1);
        if (lane == 0) wsf(p, WS_CDEC)[ck * 16 + h] = __expf(last);
    }
    __syncthreads();
    const bf16* XCT = wsb(p, WS_XCT) + (size_t)ck * 1536 * 128;
    const bf16* Btp = XCT + (size_t)(1024 + g * 128 + wv * 16 + fr) * 128 + fq * 8;
    const bf16* xp = XCT + (size_t)(h * 64 + fr) * 128 + fq * 8;
    f32x4 acc[4];
#pragma unroll
    for (int pt = 0; pt < 4; ++pt) acc[pt] = (f32x4){0.f, 0.f, 0.f, 0.f};
#pragma unroll
    for (int k = 0; k < 4; ++k) {
        const bf16x8 bfrag = *(const bf16x8*)(Btp + k * 32);
        const f32x4 wa = *(const f32x4*)(sm + 128 + k * 32 + fq * 8), wb = *(const f32x4*)(sm + 128 + k * 32 + fq * 8 + 4);
#pragma unroll
        for (int pt = 0; pt < 4; ++pt) { const u32x4 xv = *(const u32x4*)(xp + (size_t)pt * 16 * 128 + k * 32);
            u32x4 sv; sv.x = cvtpk(bflo(xv.x) * wa.x, bfhi(xv.x) * wa.y); sv.y = cvtpk(bflo(xv.y) * wa.z, bfhi(xv.y) * wa.w); sv.z = cvtpk(bflo(xv.z) * wb.x, bfhi(xv.z) * wb.y); sv.w = cvtpk(bflo(xv.w) * wb.z, bfhi(xv.w) * wb.w);
            acc[pt] = mfma16(bfrag, __builtin_bit_cast(bf16x8, sv), acc[pt]); }
    }
    float* ST = wsf(p, WS_ST) + ((size_t)ck * 16 + h) * 8192;
#pragma unroll
    for (int pt = 0; pt < 4; ++pt) *(f32x4*)(ST + (size_t)(pt * 16 + fr) * 128 + wv * 16 + fq * 4) = acc[pt];
    __syncthreads();
}
DEVI void ph_ssd_scan(CP p, int j, int vb, int nvb) {
    const float* ST = wsf(p, WS_ST); const float* CDEC = wsf(p, WS_CDEC); bf16* HIN = wsb(p, WS_HIN);
    const int tid = ltid();
    for (int e4 = vb * 512 + tid; e4 < NBP * 16 * 64 * 128 / 4; e4 += nvb * 512) {
        const int b = e4 / (16 * 64 * 32), r = e4 % (16 * 64 * 32), h = r / (64 * 32);
        f32x4 st = (f32x4){0.f, 0.f, 0.f, 0.f};
#pragma unroll 8
        for (int c = 0; c < 32; ++c) { const int ck = b * 32 + c; const size_t off = (size_t)ck * 16 * 8192 + (size_t)r * 4;
            u32x2 o; o.x = cvtpk(st.x, st.y); o.y = cvtpk(st.z, st.w); *(u32x2*)(HIN + off) = o;
            const f32x4 sv = *(const f32x4*)(ST + off); const float d = CDEC[ck * 16 + h]; st = st * d + sv; }
        *(f32x4*)(p->out + O_HP + ((size_t)j * NBP + b) * 16 * 8192 + (size_t)r * 4) = st;
    }
}
DEVI void ssd3_unit(CP p, int j, int ck, int tt, float* red  , bf16* AO) {
    const int tid = ltid(), lane = tid & 63, wv = tid >> 6, fr = lane & 15, fq = lane >> 4, g = wv >> 2;
    const int t0 = tt * 16; const size_t row = (size_t)ck * 128 + t0 + fr;
    const bf16* XCN = wsb(p, WS_XCN); const bf16* XCT = wsb(p, WS_XCT) + (size_t)ck * 1536 * 128; const float* H = wsf(p, WS_H);
    bf16x8 cf[4];
#pragma unroll
    for (int k = 0; k < 4; ++k) cf[k] = *(const bf16x8*)(XCN + row * 1536 + 1280 + g * 128 + k * 32 + fq * 8);
    f32x4 cbt[8];
#pragma unroll
    for (int jt = 0; jt < 8; ++jt) { cbt[jt] = (f32x4){0.f, 0.f, 0.f, 0.f};
        if (jt <= tt) { const bf16* bp = XCN + ((size_t)ck * 128 + jt * 16 + fr) * 1536 + 1024 + g * 128 + fq * 8;
#pragma unroll
            for (int k = 0; k < 4; ++k) cbt[jt] = mfma16(*(const bf16x8*)(bp + k * 32), cf[k], cbt[jt]); } }
    f32x4 yv[2][4]; float ss = 0.f;
#pragma unroll
    for (int hh = 0; hh < 2; ++hh) {
        const int h = 2 * wv + hh;
        const float* AC = wsf(p, WS_ACUM) + ((size_t)ck * 16 + h) * 128; const float* DC = wsf(p, WS_DTC) + ((size_t)ck * 16 + h) * 128;
        const float at = AC[t0 + fr], Dk = p->d_skip[j * 16 + h];
        f32x4 yd[4];
#pragma unroll
        for (int pt = 0; pt < 4; ++pt) yd[pt] = (f32x4){0.f, 0.f, 0.f, 0.f};
#pragma unroll
        for (int q = 0; q < 4; ++q) if (2 * q <= tt) {
            const int sa = 2 * q * 16 + 4 * fq, sb = sa + 16;
            const f32x4 aa = *(const f32x4*)(AC + sa), da = *(const f32x4*)(DC + sa), ab = *(const f32x4*)(AC + sb), db = *(const f32x4*)(DC + sb);
            float la[4], lb[4];
#pragma unroll
            for (int i = 0; i < 4; ++i) { la[i] = (sa + i <= t0 + fr) ? cbt[2 * q][i] * __expf(fminf(at - aa[i], 0.f)) * da[i] : 0.f;
                                          lb[i] = (2 * q + 1 <= tt && sb + i <= t0 + fr) ? cbt[2 * q + 1][i] * __expf(fminf(at - ab[i], 0.f)) * db[i] : 0.f; }
            u32x4 lw; lw.x = cvtpk(la[0], la[1]); lw.y = cvtpk(la[2], la[3]); lw.z = cvtpk(lb[0], lb[1]); lw.w = cvtpk(lb[2], lb[3]);
            const bf16x8 lf = __builtin_bit_cast(bf16x8, lw);
#pragma unroll
            for (int pt = 0; pt < 4; ++pt) { const bf16* xq = XCT + (size_t)(h * 64 + pt * 16 + fr) * 128;
                const u32x2 xa = *(const u32x2*)(xq + sa), xb = *(const u32x2*)(xq + sb); u32x4 xw; xw.x = xa.x; xw.y = xa.y; xw.z = xb.x; xw.w = xb.y;
                yd[pt] = mfma16(__builtin_bit_cast(bf16x8, xw), lf, yd[pt]); }
        }
        const bf16* hq = wsb(p, WS_HIN) + ((size_t)ck * 16 + h) * 8192 + (size_t)fr * 128 + fq * 8; const float eat = __expf(at);
#pragma unroll
        for (int pt = 0; pt < 4; ++pt) { f32x4 of = (f32x4){0.f, 0.f, 0.f, 0.f};
#pragma unroll
            for (int k = 0; k < 4; ++k) of = mfma16(*(const bf16x8*)(hq + (size_t)pt * 16 * 128 + k * 32), cf[k], of);
            const int c0 = h * 64 + pt * 16 + 4 * fq;
            const u32x2 xw = *(const u32x2*)(XCN + row * 1536 + c0); const f32x4 z = *(const f32x4*)(H + row * HC_AB + C_Z + c0);
            f32x4 y = yd[pt] + of * eat;
            y.x += Dk * bflo(xw.x); y.y += Dk * bfhi(xw.x); y.z += Dk * bflo(xw.y); y.w += Dk * bfhi(xw.y);
            y.x *= silu_f(z.x); y.y *= silu_f(z.y); y.z *= silu_f(z.z); y.w *= silu_f(z.w);
            ss += (y.x * y.x + y.y * y.y) + (y.z * y.z + y.w * y.w); yv[hh][pt] = y; }
    }
    ss += __shfl_xor(ss, 16); ss += __shfl_xor(ss, 32);
    if (fq == 0) red[wv * 16 + fr] = ss;
    __syncthreads();
    float tot = 0.f;
#pragma unroll
    for (int w = 0; w < 8; ++w) tot += red[w * 16 + fr];
    const float rs = 1.f / sqrtf(tot * (1.f / 1024.f) + EPS);
    const float* gg = p->ssd_g + (size_t)j * 1024;
#pragma unroll
    for (int hh = 0; hh < 2; ++hh)
#pragma unroll
        for (int pt = 0; pt < 4; ++pt) { const int c0 = (2 * wv + hh) * 64 + pt * 16 + 4 * fq; const f32x4 gv = *(const f32x4*)(gg + c0); const f32x4 o = yv[hh][pt] * rs * gv;
            u32x2 w; w.x = cvtpk(o.x, o.y); w.y = cvtpk(o.z, o.w); *(u32x2*)(AO + row * DM + 1024 + c0) = w; }
    __syncthreads();
}

DEVI void ph_ssd_gate(CP p, int j, int vb, int nvb) {
    const int TIDX = ltid();
    const float* H = wsf(p, WS_H); const float* Y = wsf(p, WS_Y); bf16* AO = wsb(p, WS_AO); const float* g = p->ssd_g + (size_t)j * 1024;
    const int lane = TIDX & 63, wv = TIDX >> 6;
#ifdef EXP_OLDY
    for (int row = vb * 8 + wv; row < MR; row += nvb * 8) {
#else
    for (int row = MPR + vb * 8 + wv; row < MR; row += nvb * 8) {
#endif
        f32x4 v[4]; float q = 0.f;
#pragma unroll
        for (int i = 0; i < 4; ++i) { const int c = (i * 64 + lane) * 4; const f32x4 y = *(const f32x4*)(Y + (size_t)row * 1024 + c), z = *(const f32x4*)(H + (size_t)row * HC_AB + C_Z + c);
            v[i] = (f32x4){y.x * silu_f(z.x), y.y * silu_f(z.y), y.z * silu_f(z.z), y.w * silu_f(z.w)}; q += (v[i].x * v[i].x + v[i].y * v[i].y) + (v[i].z * v[i].z + v[i].w * v[i].w); }
        const float rs = 1.f / sqrtf(wave_sum(q) * (1.f / 1024.f) + EPS);
#pragma unroll
        for (int i = 0; i < 4; ++i) { const int c = (i * 64 + lane) * 4; const f32x4 gg = *(const f32x4*)(g + c); const f32x4 o = v[i] * rs * gg;
            uint2 w; w.x = pk2(o.x, o.y); w.y = pk2(o.z, o.w); *(uint2*)(AO + (size_t)row * DM + 1024 + c) = w; }
    }
}

DEVI void ph_idx_prompt_naive(CP p, int vb, int nvb, float* sm) {
    const int TIDX = ltid();
    const float* H = wsf(p, WS_H); float* SC = wsf(p, WS_SC);
    const int half = TIDX >> 8, tid = TIDX & 255; float* sq = sm + half * 520; float* sw = sq + 512;
    for (int row0 = vb * 2; row0 < MPR; row0 += nvb * 2) {
        const int row = row0 + half, b = row / SEQ, t = row % SEQ;
        sq[tid] = H[(size_t)row * HC_AB + C_QI + tid]; sq[tid + 256] = H[(size_t)row * HC_AB + C_QI + 256 + tid]; if (tid < 8) sw[tid] = H[(size_t)row * HC_AB + C_WI + tid];
        __syncthreads();
        for (int s = tid; s <= t; s += 256) {
            const float* kr = H + (size_t)(b * SEQ + s) * HC_AB + C_KI; float k[64];
#pragma unroll
            for (int i = 0; i < 16; ++i) { const f32x4 v = *(const f32x4*)(kr + 4 * i); k[4 * i] = v.x; k[4 * i + 1] = v.y; k[4 * i + 2] = v.z; k[4 * i + 3] = v.w; }
            float sc = 0.f;
#pragma unroll 1
            for (int h = 0; h < 8; ++h) { float d = 0.f;
#pragma unroll
                for (int i = 0; i < 64; ++i) d += sq[h * 64 + i] * k[i];
                sc += sw[h] * fmaxf(d, 0.f); }
            SC[(size_t)row * SEQ + s] = sc * IDX_SCALE;
        }
        __syncthreads();
    }
}

DEVI void idx_wave_unit(CP p, int b, int qt, int kc, int lane) {
    const int fr = lane & 15, fq = lane >> 4; const size_t row = (size_t)b * SEQ + qt * 16 + fr;
    const bf16* QIB = wsb(p, WS_QIB) + row * 512 + fq * 8; const float* H = wsf(p, WS_H); float* SC = wsf(p, WS_SC) + row * SEQ + 4 * fq;
    bf16x8 qf[8][2]; float wi[8];
#pragma unroll
    for (int h = 0; h < 8; ++h) { qf[h][0] = *(const bf16x8*)(QIB + h * 64); qf[h][1] = *(const bf16x8*)(QIB + h * 64 + 32); wi[h] = H[row * HC_AB + C_WI + h] * IDX_SCALE; }
    const int kt0 = kc * 64, kt1 = (qt < kt0 + 63) ? qt : kt0 + 63;
    const bf16* kp = wsb(p, WS_KIB) + ((size_t)b * SEQ + fr) * 64 + fq * 8;
    bf16x8 k0 = *(const bf16x8*)(kp + (size_t)kt0 * 16 * 64), k1 = *(const bf16x8*)(kp + (size_t)kt0 * 16 * 64 + 32);
    for (int kt = kt0; kt <= kt1; ++kt) {
        const bf16x8 c0 = k0, c1 = k1;
        if (kt < kt1) { k0 = *(const bf16x8*)(kp + (size_t)(kt + 1) * 16 * 64); k1 = *(const bf16x8*)(kp + (size_t)(kt + 1) * 16 * 64 + 32); }
        f32x4 d[8];
#pragma unroll
        for (int h = 0; h < 8; ++h) { d[h] = mfma16(c0, qf[h][0], (f32x4){0.f, 0.f, 0.f, 0.f}); d[h] = mfma16(c1, qf[h][1], d[h]); }
        f32x4 sc = (f32x4){0.f, 0.f, 0.f, 0.f};
#pragma unroll
        for (int h = 0; h < 8; ++h) { sc.x += wi[h] * fmaxf(d[h].x, 0.f); sc.y += wi[h] * fmaxf(d[h].y, 0.f); sc.z += wi[h] * fmaxf(d[h].z, 0.f); sc.w += wi[h] * fmaxf(d[h].w, 0.f); }
        *(f32x4*)(SC + kt * 16) = sc;
    }
}
DEVI void ph_idx_prompt(CP p, int vb, int nvb) {
    const int tid = ltid(), lane = tid & 63, wv = tid >> 6;
    for (int gw = wv * nvb + vb; gw < 2 * 640; gw += 8 * nvb) { const int b = gw / 640, u = gw % 640; int kc, qt;
        if (u < 256) { kc = 0; qt = u; } else if (u < 448) { kc = 1; qt = 64 + (u - 256); } else if (u < 576) { kc = 2; qt = 128 + (u - 448); } else { kc = 3; qt = 192 + (u - 576); }
        idx_wave_unit(p, b, qt, kc, lane); }
}

DEVI void select_prompt_row(const float* SC, unsigned long long* MASK, int row, int lane) {
    const int t = row % SEQ, nk = t + 1; const float* sc = SC + (size_t)row * SEQ;
    unsigned v[64];
#pragma unroll
    for (int jj = 0; jj < 64; ++jj) { const int key = jj * 64 + lane; v[jj] = key < nk ? ord_f(sc[key]) : 0u; }
    unsigned long long mine = 0ull;
    if (nk <= TOPK) {
#pragma unroll
        for (int jj = 0; jj < 64; ++jj) { const unsigned long long m = __ballot(jj * 64 + lane < nk); if (lane == jj) mine = m; }
    } else {
        unsigned T = 0u;
        for (int bit = 31; bit >= 0; --bit) { const unsigned cand = T | (1u << bit); int cnt = 0;
#pragma unroll
            for (int jj = 0; jj < 64; ++jj) cnt += __popcll(__ballot(v[jj] >= cand));
            if (cnt >= TOPK) T = cand; if (cnt == TOPK) break; }
        int cgt = 0;
#pragma unroll
        for (int jj = 0; jj < 64; ++jj) cgt += __popcll(__ballot(v[jj] > T));
        const int need = TOPK - cgt; int run = 0; const unsigned long long lt = (1ull << lane) - 1ull;
#pragma unroll
        for (int jj = 0; jj < 64; ++jj) { const bool eq = v[jj] == T; const unsigned long long me = __ballot(eq); const int pre = run + __popcll(me & lt);
            const bool sel = (v[jj] > T) || (eq && pre < need); run += __popcll(me); const unsigned long long m = __ballot(sel); if (lane == jj) mine = m; }
    }
    MASK[((size_t)(row >> 5) * 64 + lane) * 32 + (row & 31)] = mine;
}
DEVI void ph_select_prompt(CP p, int vb, int nvb) {
    const int TIDX = ltid();
    const int lane = TIDX & 63, wv = TIDX >> 6;
    for (int row = vb * 8 + wv; row < MPR; row += nvb * 8) select_prompt_row(wsf(p, WS_SC), (unsigned long long*)(p->ws + WS_MASK), row, lane);
}

DEVI void ph_attn_prompt_naive(CP p, int vb, int nvb) {
    const int TIDX = ltid();
    const float* H = wsf(p, WS_H); const unsigned long long* MASK = (const unsigned long long*)(p->ws + WS_MASK); bf16* AO = wsb(p, WS_AO);
    const int h = TIDX >> 6, lane = TIDX & 63, g = h >> 2;
    for (int row = vb; row < MPR; row += nvb) {
        const int b = row / SEQ, t = row % SEQ;
        const float q0 = H[(size_t)row * HC_AB + C_Q + h * 128 + lane], q1 = H[(size_t)row * HC_AB + C_Q + h * 128 + 64 + lane];
        float m = -1e30f, l = 0.f, o0 = 0.f, o1 = 0.f;
        for (int jt = 0; jt <= t / 64; ++jt) {
            unsigned long long w = MASK[((size_t)(row >> 5) * 64 + jt) * 32 + (row & 31)];
            while (w) { const int bit = __builtin_ctzll(w); w &= w - 1ull; const int s = jt * 64 + bit;
                const float* kr = H + (size_t)(b * SEQ + s) * HC_AB + C_K + g * 128; const float* vr = H + (size_t)(b * SEQ + s) * HC_AB + C_V + g * 128;
                const float lg = wave_sum(q0 * kr[lane] + q1 * kr[lane + 64]) * ATT_SCALE;
                const float mn = fmaxf(m, lg), al = __expf(m - mn), pe = __expf(lg - mn);
                l = l * al + pe; o0 = o0 * al + pe * vr[lane]; o1 = o1 * al + pe * vr[lane + 64]; m = mn; }
        }
        const float il = 1.f / l;
        AO[(size_t)row * DM + h * 128 + lane] = f2bf(o0 * il); AO[(size_t)row * DM + h * 128 + 64 + lane] = f2bf(o1 * il);
    }
}

constexpr int ATT_KS = 136, ATT_VS = 72, ATT_BUF = 64 * ATT_KS * 2 + 128 * ATT_VS * 2;
DEVI void attn_unit(CP p, int b, int h, int qb, unsigned char* lds, bf16* AO) {
    const int tid = ltid(), lane = tid & 63, wv = tid >> 6, fr = lane & 15, fq = lane >> 4, g = h >> 2;
    const bf16* QB = wsb(p, WS_QB); const bf16* KB = wsb(p, WS_KB) + (size_t)b * SEQ * 256 + g * 128; const bf16* VB = wsb(p, WS_VB) + (size_t)b * SEQ * 256 + g * 128;
    const unsigned long long* MASK = (const unsigned long long*)(p->ws + WS_MASK);
    const int pos0 = qb * 256 + wv * 32;
    const size_t row0 = (size_t)b * SEQ + pos0;
    bf16x8 qf[2][4];
#pragma unroll
    for (int mt = 0; mt < 2; ++mt)
#pragma unroll
        for (int k = 0; k < 4; ++k) qf[mt][k] = *(const bf16x8*)(QB + (row0 + mt * 16 + fr) * 1024 + h * 128 + k * 32 + fq * 8);
    const unsigned long long* mkp = MASK + (row0 >> 5) * 64 * 32 + fr;
    f32x4 o[2][8];
#pragma unroll
    for (int mt = 0; mt < 2; ++mt)
#pragma unroll
        for (int dt = 0; dt < 8; ++dt) o[mt][dt] = (f32x4){0.f, 0.f, 0.f, 0.f};
    float mrow[2] = {-1e30f, -1e30f}, lrow[2] = {0.f, 0.f};
    const int NT = 4 * (qb + 1);
    const int skey = tid >> 3, spart = tid & 7;
    const bf16* kg = KB + (size_t)skey * 256 + spart * 16; const bf16* vg = VB + (size_t)skey * 256 + spart * 16;
    u32x4 sk0, sk1, sv0, sv1; unsigned long long mw[2];
    sk0 = *(const u32x4*)(kg); sk1 = *(const u32x4*)(kg + 8); sv0 = *(const u32x4*)(vg); sv1 = *(const u32x4*)(vg + 8);
    mw[0] = mkp[0]; mw[1] = mkp[16];
    for (int jt = 0; jt < NT; ++jt) {
        unsigned char* buf = lds + (jt & 1) * ATT_BUF; bf16* Ks = (bf16*)buf; bf16* Vt = (bf16*)(buf + 64 * ATT_KS * 2);
        *(u32x4*)(Ks + skey * ATT_KS + spart * 16) = sk0; *(u32x4*)(Ks + skey * ATT_KS + spart * 16 + 8) = sk1;
        { const unsigned w[8] = {sv0.x, sv0.y, sv0.z, sv0.w, sv1.x, sv1.y, sv1.z, sv1.w};
#pragma unroll
          for (int i = 0; i < 8; ++i) { Vt[(spart * 16 + 2 * i) * ATT_VS + skey] = (bf16)(w[i] & 0xffffu); Vt[(spart * 16 + 2 * i + 1) * ATT_VS + skey] = (bf16)(w[i] >> 16); } }
        const unsigned long long m0 = mw[0], m1 = mw[1];
        __syncthreads();
        if (jt + 1 < NT) { const size_t go = (size_t)(jt + 1) * 64 * 256; sk0 = *(const u32x4*)(kg + go); sk1 = *(const u32x4*)(kg + go + 8); sv0 = *(const u32x4*)(vg + go); sv1 = *(const u32x4*)(vg + go + 8);
            mw[0] = mkp[(jt + 1) * 32]; mw[1] = mkp[(jt + 1) * 32 + 16]; }
        if (jt * 64 > pos0 + 31) continue;
        f32x4 sc[2][4];
#pragma unroll
        for (int mt = 0; mt < 2; ++mt)
#pragma unroll
            for (int kt = 0; kt < 4; ++kt) sc[mt][kt] = (f32x4){0.f, 0.f, 0.f, 0.f};
#pragma unroll
        for (int kt = 0; kt < 4; ++kt)
#pragma unroll
            for (int k = 0; k < 4; ++k) { const bf16x8 kf = *(const bf16x8*)(Ks + (kt * 16 + fr) * ATT_KS + k * 32 + fq * 8);
                sc[0][kt] = mfma16(kf, qf[0][k], sc[0][kt]); sc[1][kt] = mfma16(kf, qf[1][k], sc[1][kt]); }
        bf16x8 pf[2][2];
#pragma unroll
        for (int mt = 0; mt < 2; ++mt) {
            const unsigned long long mk = (mt ? m1 : m0) >> (4 * fq);
            float mx = -1e30f;
#pragma unroll
            for (int kt = 0; kt < 4; ++kt)
#pragma unroll
                for (int i = 0; i < 4; ++i) { const bool on = (mk >> (16 * kt + i)) & 1ull; sc[mt][kt][i] = on ? sc[mt][kt][i] : -1e30f; mx = fmaxf(mx, sc[mt][kt][i]); }
            mx = fmaxf(mx, __shfl_xor(mx, 16)); mx = fmaxf(mx, __shfl_xor(mx, 32));
            const float mn = fmaxf(mrow[mt], mx), al = __builtin_amdgcn_exp2f(mrow[mt] - mn); mrow[mt] = mn;
            float ps = 0.f;
#pragma unroll
            for (int kt = 0; kt < 4; ++kt)
#pragma unroll
                for (int i = 0; i < 4; ++i) { const float e = (sc[mt][kt][i] > -1e29f) ? __builtin_amdgcn_exp2f(sc[mt][kt][i] - mn) : 0.f; sc[mt][kt][i] = e; ps += e; }
            lrow[mt] = lrow[mt] * al + ps;
            if (!__all(al == 1.f)) {
#pragma unroll
                for (int dt = 0; dt < 8; ++dt) o[mt][dt] = o[mt][dt] * al; }
#pragma unroll
            for (int ks = 0; ks < 2; ++ks) { u32x4 w; w.x = cvtpk(sc[mt][2 * ks][0], sc[mt][2 * ks][1]); w.y = cvtpk(sc[mt][2 * ks][2], sc[mt][2 * ks][3]);
                w.z = cvtpk(sc[mt][2 * ks + 1][0], sc[mt][2 * ks + 1][1]); w.w = cvtpk(sc[mt][2 * ks + 1][2], sc[mt][2 * ks + 1][3]); pf[mt][ks] = __builtin_bit_cast(bf16x8, w); }
        }
#pragma unroll
        for (int dt = 0; dt < 8; ++dt)
#pragma unroll
            for (int ks = 0; ks < 2; ++ks) { const bf16* vp = Vt + (dt * 16 + fr) * ATT_VS + ks * 32 + 4 * fq;
                const u32x2 va = *(const u32x2*)vp, vb2 = *(const u32x2*)(vp + 16); u32x4 w; w.x = va.x; w.y = va.y; w.z = vb2.x; w.w = vb2.y; const bf16x8 vf = __builtin_bit_cast(bf16x8, w);
                o[0][dt] = mfma16(vf, pf[0][ks], o[0][dt]); o[1][dt] = mfma16(vf, pf[1][ks], o[1][dt]); }
    }
#pragma unroll
    for (int mt = 0; mt < 2; ++mt) { float l = lrow[mt]; l += __shfl_xor(l, 16); l += __shfl_xor(l, 32); const float il = 1.f / l;
        bf16* orow = AO + (row0 + mt * 16 + fr) * DM + h * 128 + 4 * fq;
#pragma unroll
        for (int dt = 0; dt < 8; ++dt) { const f32x4 v = o[mt][dt] * il; u32x2 w; w.x = cvtpk(v.x, v.y); w.y = cvtpk(v.z, v.w); *(u32x2*)(orow + dt * 16) = w; } }
    __syncthreads();
}

DEVI void idx_sample_unit(CP p, int j, int b, int kb, float* sq  ) {
    const int TIDX = ltid();
    const float* H = wsf(p, WS_H); float* SCS = wsf(p, WS_SCS); const int tid = TIDX;
    for (int i = tid; i < 8 * 512; i += 512) sq[i] = H[(size_t)(MPR + b * DS + (i >> 9)) * HC_AB + C_QI + (i & 511)];
    if (tid < 64) sq[4096 + tid] = H[(size_t)(MPR + b * DS + (tid >> 3)) * HC_AB + C_WI + (tid & 7)];
    __syncthreads();
    const int key = kb * 512 + tid;
    if (key < NKEY_S) {
        const float* kr;
        if (key < PAST) { const int pg = p->page_table[b * NPAGES + key / PAGE]; kr = p->cache_ik + (((size_t)j * NPOOL + pg) * PAGE + key % PAGE) * 64; }
        else kr = H + (size_t)(MPR + b * DS + key - PAST) * HC_AB + C_KI;
        float k[64];
#pragma unroll
        for (int i = 0; i < 16; ++i) { const f32x4 v = *(const f32x4*)(kr + 4 * i); k[4 * i] = v.x; k[4 * i + 1] = v.y; k[4 * i + 2] = v.z; k[4 * i + 3] = v.w; }
#pragma unroll 1
        for (int qi = 0; qi < 8; ++qi) { if (key > PAST + qi) continue; float sc = 0.f;
#pragma unroll 1
            for (int h = 0; h < 8; ++h) { float d = 0.f;
#pragma unroll
                for (int i = 0; i < 64; ++i) d += sq[qi * 512 + h * 64 + i] * k[i];
                sc += sq[4096 + qi * 8 + h] * fmaxf(d, 0.f); }
            SCS[(size_t)(b * DS + qi) * SCS_LD + key] = sc * IDX_SCALE; }
    }
    __syncthreads();
}

DEVI void select_sample_unit(CP p, int q, int* red  ) {
    const int TIDX = ltid();
    const float* sc = wsf(p, WS_SCS) + (size_t)q * SCS_LD; int* SELS = (int*)(p->ws + WS_SELS) + q * TOPK;
    const int tid = TIDX, lane = tid & 63, wv = tid >> 6, nk = PAST + (q % DS) + 1;
    unsigned v[33];
#pragma unroll
    for (int jj = 0; jj < 33; ++jj) { const int key = jj * 512 + tid; v[jj] = key < nk ? ord_f(sc[key]) : 0u; }
    unsigned T = 0u; int par = 0;
    for (int bit = 31; bit >= 0; --bit) { const unsigned cand = T | (1u << bit); int cnt = 0;
#pragma unroll
        for (int jj = 0; jj < 33; ++jj) cnt += __popcll(__ballot(v[jj] >= cand));
        if (lane == 0) red[par * 8 + wv] = cnt; __syncthreads();
        int tot = 0;
#pragma unroll
        for (int w = 0; w < 8; ++w) tot += red[par * 8 + w];
        par ^= 1;
        if (tot >= TOPK) T = cand; if (tot == TOPK) break; }
    __syncthreads();
    int* cg = red + 16; int* ce = cg + 33 * 8; int* pg = ce + 33 * 8; int* pe = pg + 33 * 8;
#pragma unroll
    for (int jj = 0; jj < 33; ++jj) { const int a = __popcll(__ballot(v[jj] > T)), e = __popcll(__ballot(v[jj] == T)); if (lane == 0) { cg[jj * 8 + wv] = a; ce[jj * 8 + wv] = e; } }
    __syncthreads();
    if (tid < 33 * 8) { int a = 0, e = 0; for (int i = 0; i < tid; ++i) { a += cg[i]; e += ce[i]; } pg[tid] = a; pe[tid] = e; }
    if (tid == 0) { int a = 0; for (int i = 0; i < 33 * 8; ++i) a += cg[i]; red[0] = a; }
    __syncthreads();
    const int need = TOPK - red[0]; const unsigned long long lt = (1ull << lane) - 1ull;
#pragma unroll
    for (int jj = 0; jj < 33; ++jj) {
        const bool gt = v[jj] > T, eq = v[jj] == T; const unsigned long long me = __ballot(eq), mg = __ballot(gt);
        const int epre = pe[jj * 8 + wv] + __popcll(me & lt), gpre = pg[jj * 8 + wv] + __popcll(mg & lt); const bool sel = gt || (eq && epre < need);
        const int ebc = epre < need ? epre : need;
        if (sel) SELS[gpre + ebc] = jj * 512 + tid;
    }
    __syncthreads();
}

DEVI void attn_sample_unit(CP p, int j, int q, unsigned char* lds) {
    const int tid = ltid(), lane = tid & 63, h = tid >> 6, g = h >> 2, b = q / DS, row = MPR + q;
    const float* H = wsf(p, WS_H); bf16* AO = wsb(p, WS_AO);
    long long* koff = (long long*)lds; float* lg = (float*)(lds + 256 * 8) + h * 256;
    if (tid < TOPK) { const int s = ((const int*)(p->ws + WS_SELS))[q * TOPK + tid];
        if (s < PAST) { const int pg = p->page_table[b * NPAGES + s / PAGE]; koff[tid] = (long long)((((size_t)j * NPOOL + pg) * PAGE + s % PAGE) * 256); }
        else koff[tid] = -(1ll + (long long)((size_t)(MPR + b * DS + s - PAST) * HC_AB + C_K)); }
    const float qs = ATT_SCALE * 1.4426950408889634f;
    const float q0 = H[(size_t)row * HC_AB + C_Q + h * 128 + lane] * qs, q1 = H[(size_t)row * HC_AB + C_Q + h * 128 + 64 + lane] * qs;
    __syncthreads();
    float mx = -1e30f;
    for (int i0 = 0; i0 < TOPK; i0 += 8) { float a0[8], a1[8];
#pragma unroll
        for (int i = 0; i < 8; ++i) { const long long o = koff[i0 + i]; const float* kr = (o >= 0) ? p->cache_k + o + g * 128 : H + (-(o + 1)) + g * 128; a0[i] = kr[lane]; a1[i] = kr[lane + 64]; }
#pragma unroll
        for (int i = 0; i < 8; ++i) { const float v = wave_sum(q0 * a0[i] + q1 * a1[i]); mx = fmaxf(mx, v); if (lane == 0) lg[i0 + i] = v; } }
    asm volatile("s_waitcnt lgkmcnt(0)" ::: "memory");
    float l = 0.f, o0 = 0.f, o1 = 0.f;
    for (int i0 = 0; i0 < TOPK; i0 += 8) { float a0[8], a1[8];
#pragma unroll
        for (int i = 0; i < 8; ++i) { const long long o = koff[i0 + i]; const float* vr = (o >= 0) ? p->cache_v + o + g * 128 : H + (-(o + 1)) + (C_V - C_K) + g * 128; a0[i] = vr[lane]; a1[i] = vr[lane + 64]; }
#pragma unroll
        for (int i = 0; i < 8; ++i) { const float pe = __builtin_amdgcn_exp2f(lg[i0 + i] - mx); l += pe; o0 += pe * a0[i]; o1 += pe * a1[i]; } }
    const float il = 1.f / l;
    AO[(size_t)row * DM + h * 128 + lane] = f2bf(o0 * il); AO[(size_t)row * DM + h * 128 + 64 + lane] = f2bf(o1 * il);
    __syncthreads();
}

DEVI void ph_cd_prep(CP p, int j, int vb, int nvb) {
    const int TIDX = ltid();
    const float* H = wsf(p, WS_H); bf16* DD = wsb(p, WS_DD); bf16* U = wsb(p, WS_U); bf16* VLN = wsb(p, WS_VLN);
    const float* lg = p->sgu_ln_g + (size_t)j * 1024; const float* lb = p->sgu_ln_b + (size_t)j * 1024;
    const int lane = TIDX & 63, wv = TIDX >> 6;
    for (int row = vb * 8 + wv; row < MR; row += nvb * 8) {
        const bool pr = row < MPR; const int b = pr ? row / SEQ : (row - MPR) / DS, t = pr ? row % SEQ : (row - MPR) % DS;
        const float* h = H + (size_t)row * HC_CD;
#pragma unroll 1
        for (int i = 0; i < 4; ++i) { const int c = i * 256 + lane * 4, w = 2 << i; const f32x4 cur = *(const f32x4*)(h + c); f32x4 s = cur; int cnt;
            if (pr) { cnt = (t + 1 < w) ? t + 1 : w; for (int u = 1; u < cnt; ++u) s += *(const f32x4*)(H + (size_t)(row - u) * HC_CD + c); }
            else { cnt = w; for (int u = 1; u < w; ++u) { const int e = 15 + t - u;
                    s += (e >= 15) ? *(const f32x4*)(H + (size_t)(MPR + b * DS + e - 15) * HC_CD + c) : *(const f32x4*)(p->state_pool + (((size_t)j * DB + b) * 15 + e) * 1024 + c); } }
            const float ic = 1.f / (float)cnt; const f32x4 d = s * ic - cur; uint2 o; o.x = pk2(d.x, d.y); o.y = pk2(d.z, d.w); *(uint2*)(DD + (size_t)row * 1024 + c) = o;
            if (pr) { if (t >= SEQ - 15) *(f32x4*)(p->out + O_PP + (((size_t)j * NBP + b) * 15 + (t - (SEQ - 15))) * 1024 + c) = cur; }
            else { *(f32x4*)(p->out + O_PS + (((size_t)j * DB + b) * 15 + 7 + t) * 1024 + c) = cur;
                   if (t == 0) for (int e = 0; e < 7; ++e) *(f32x4*)(p->out + O_PS + (((size_t)j * DB + b) * 15 + e) * 1024 + c) = *(const f32x4*)(p->state_pool + (((size_t)j * DB + b) * 15 + 8 + e) * 1024 + c); }
        }
        asm volatile("" ::: "memory");
#pragma unroll
        for (int i = 0; i < 4; ++i) { const int c = (i * 64 + lane) * 4; const f32x4 u = *(const f32x4*)(h + 1024 + c); uint2 o; o.x = pk2(gelu_f(u.x), gelu_f(u.y)); o.y = pk2(gelu_f(u.z), gelu_f(u.w)); *(uint2*)(U + (size_t)row * 1024 + c) = o; }
        asm volatile("" ::: "memory");
        f32x4 v[4]; float s = 0.f;
#pragma unroll
        for (int i = 0; i < 4; ++i) { const int c = (i * 64 + lane) * 4; const f32x4 x = *(const f32x4*)(h + 2048 + c); v[i] = (f32x4){gelu_f(x.x), gelu_f(x.y), gelu_f(x.z), gelu_f(x.w)}; s += (v[i].x + v[i].y) + (v[i].z + v[i].w); }
        const float mean = wave_sum(s) * (1.f / 1024.f); float q = 0.f;
#pragma unroll
        for (int i = 0; i < 4; ++i) { v[i] = v[i] - mean; q += (v[i].x * v[i].x + v[i].y * v[i].y) + (v[i].z * v[i].z + v[i].w * v[i].w); }
        const float rstd = 1.f / sqrtf(wave_sum(q) * (1.f / 1024.f) + EPS);
#pragma unroll
        for (int i = 0; i < 4; ++i) { const int c = (i * 64 + lane) * 4; const f32x4 y = v[i] * rstd * *(const f32x4*)(lg + c) + *(const f32x4*)(lb + c);
            uint2 o; o.x = pk2(y.x, y.y); o.y = pk2(y.z, y.w); *(uint2*)(VLN + (size_t)row * 1024 + c) = o;
            if (!pr) *(f32x4*)(p->out + O_GS + ((size_t)j * MSR + (row - MPR)) * 1024 + c) = y; }
    }
}

DEVI void sgu_unit(CP p, int j, int ck, int g, int ds, bf16* Vt  ) {
    const int tid = ltid(), lane = tid & 63, wv = tid >> 6, fr = lane & 15, fq = lane >> 4;
    const bf16* VLN = wsb(p, WS_VLN); const bf16* U = wsb(p, WS_U); bf16* AO = wsb(p, WS_AO);
    const size_t row0 = (size_t)ck * 128; const int c0 = g * 256 + ds * 64;
    { const int sp = tid >> 2, part = tid & 3; const bf16* src = VLN + (row0 + sp) * 1024 + c0 + part * 16; const u32x4 a = *(const u32x4*)src, bq = *(const u32x4*)(src + 8);
      const unsigned w[8] = {a.x, a.y, a.z, a.w, bq.x, bq.y, bq.z, bq.w};
#pragma unroll
      for (int i = 0; i < 8; ++i) { Vt[(part * 16 + 2 * i) * 136 + sp] = (bf16)(w[i] & 0xffffu); Vt[(part * 16 + 2 * i + 1) * 136 + sp] = (bf16)(w[i] >> 16); } }
    __syncthreads();
    const bf16* W = wsb(p, WS_SGUW) + (((size_t)j * 4 + g) * 128 + wv * 16 + fr) * 128 + fq * 8;
    f32x4 acc[4];
#pragma unroll
    for (int nt = 0; nt < 4; ++nt) acc[nt] = (f32x4){0.f, 0.f, 0.f, 0.f};
    const int nk = (wv >> 1) + 1;
#pragma unroll
    for (int k = 0; k < 4; ++k) if (k < nk) { const bf16x8 wf = *(const bf16x8*)(W + k * 32);
#pragma unroll
        for (int nt = 0; nt < 4; ++nt) acc[nt] = mfma16(*(const bf16x8*)(Vt + (nt * 16 + fr) * 136 + k * 32 + fq * 8), wf, acc[nt]); }
    const float bs = p->sgu_b[((size_t)j * 4 + g) * 128 + wv * 16 + fr]; const size_t row = row0 + wv * 16 + fr;
#pragma unroll
    for (int nt = 0; nt < 4; ++nt) { const int c = c0 + nt * 16 + 4 * fq; const u32x2 uw = *(const u32x2*)(U + row * 1024 + c);
        const float o0 = bflo(uw.x) * (acc[nt].x + bs), o1 = bfhi(uw.x) * (acc[nt].y + bs), o2 = bflo(uw.y) * (acc[nt].z + bs), o3 = bfhi(uw.y) * (acc[nt].w + bs);
        u32x2 w; w.x = cvtpk(o0, o1); w.y = cvtpk(o2, o3); *(u32x2*)(AO + row * DM + 1024 + c) = w; }
    __syncthreads();
}
DEVI void ph_sgu_naive(CP p, int j, int vb, int nvb) {
    const int TIDX = ltid();
    const bf16* VLN = wsb(p, WS_VLN); const bf16* U = wsb(p, WS_U); bf16* AO = wsb(p, WS_AO);
    for (int row = MPR + vb; row < MR; row += nvb) {
        const bool pr = row < MPR; const int t = pr ? row % SEQ : (row - MPR) % DS;
        const int tt = pr ? (t & 127) : t, base = row - tt;
        for (int d = TIDX; d < 1024; d += 512) { const int g = d >> 8; const float* w = p->sgu_w + (((size_t)j * 4 + g) * 128 + tt) * 128;
            float acc = p->sgu_b[((size_t)j * 4 + g) * 128 + tt];
            for (int s = 0; s <= tt; ++s) acc += w[s] * bf2f(VLN[(size_t)(base + s) * 1024 + d]);
            AO[(size_t)row * DM + 1024 + d] = f2bf(bf2f(U[(size_t)row * 1024 + d]) * acc); }
    }
}


DEVI void diag_cmp(CP p, int k, const bf16* a, int lda, const bf16* b, int ldb, int rows, int cols, int vb, int nvb) {
    unsigned* ctl = (unsigned*)(p->ws + WS_CTL); const int tid = ltid(); float mx = 0.f; unsigned bad = 0;
    for (int r = vb; r < rows; r += nvb) for (int c = tid; c < cols; c += 512) { const float x = bf2f(a[(size_t)r * lda + c]), y = bf2f(b[(size_t)r * ldb + c]); const float d = fabsf(x - y);
        if (!(d == d) || d > 1e30f) bad++; else mx = fmaxf(mx, d); }
    atomicMax(ctl + 64 + 2 * k, __float_as_uint(mx)); if (bad) atomicAdd(ctl + 65 + 2 * k, bad);
}
DEVI void diag_cmp_f32(CP p, int k, const float* a, int lda, const bf16* b, int ldb, int rows, int cols, int vb, int nvb) {
    unsigned* ctl = (unsigned*)(p->ws + WS_CTL); const int tid = ltid(); float mx = 0.f; unsigned bad = 0;
    for (int r = vb; r < rows; r += nvb) for (int c = tid; c < cols; c += 512) { const float x = a[(size_t)r * lda + c], y = bf2f(b[(size_t)r * ldb + c]); const float d = fabsf(x - y);
        if (!(d == d) || d > 1e30f) bad++; else mx = fmaxf(mx, d); }
    atomicMax(ctl + 64 + 2 * k, __float_as_uint(mx)); if (bad) atomicAdd(ctl + 65 + 2 * k, bad);
}
DEVI void diag_fin_f32(CP p, int k, const float* a, size_t n, int vb, int nvb) {
    unsigned* ctl = (unsigned*)(p->ws + WS_CTL); unsigned bad = 0;
    for (size_t i = (size_t)vb * 512 + ltid(); i < n; i += (size_t)nvb * 512) { const float x = a[i]; if (!(x == x) || fabsf(x) > 1e30f) bad++; }
    if (bad) atomicAdd(ctl + 65 + 2 * k, bad);
}
DEVI void diag_fin_bf16(CP p, int k, const bf16* a, size_t n, int vb, int nvb) {
    unsigned* ctl = (unsigned*)(p->ws + WS_CTL); unsigned bad = 0;
    for (size_t i = (size_t)vb * 512 + ltid(); i < n; i += (size_t)nvb * 512) { const float x = bf2f(a[i]); if (!(x == x) || fabsf(x) > 1e30f) bad++; }
    if (bad) atomicAdd(ctl + 65 + 2 * k, bad);
}
DEVI void diag_report(CP p, int nchecks) {
    unsigned* ctl = (unsigned*)(p->ws + WS_CTL);
    if (blockIdx.x == 0 && threadIdx.x == 0) { const unsigned fl = __hip_atomic_load(ctl + 96, __ATOMIC_RELAXED, __HIP_MEMORY_SCOPE_AGENT); if (fl) { p->out[O_KP] = (float)fl * 1e12f; return; } }
    if (blockIdx.x == 0 && threadIdx.x == 0) for (int k = 0; k < nchecks; ++k) { const float mx = __uint_as_float(__hip_atomic_load(ctl + 64 + 2 * k, __ATOMIC_RELAXED, __HIP_MEMORY_SCOPE_AGENT)); const unsigned bad = __hip_atomic_load(ctl + 65 + 2 * k, __ATOMIC_RELAXED, __HIP_MEMORY_SCOPE_AGENT);
        if (bad) { p->out[O_KP] = (70.f + k) * 1e19f; break; } if (mx > 0.06f) { p->out[O_KP] = mx * 1e8f; break; } }
}
namespace pg8 {
#define PG8_LAS __attribute__((address_space(3)))
typedef unsigned short bf16_t;
typedef short bf16x8 __attribute__((ext_vector_type(8)));
typedef float f32x4 __attribute__((ext_vector_type(4)));
typedef unsigned u32x4 __attribute__((ext_vector_type(4)));
constexpr int BM = 256, BK = 64, HALF = 128, HTB = HALF * BK * 2  , STAGE_BYTES = 8 * HTB, NXCD = 8, WGM = 8;

__host__ __device__ __forceinline__ int lds_byte(int r, int c) { const int st = (r >> 4) * 2 + (c >> 5), rr = r & 15, cc = c & 31, ob = rr * 64 + cc * 2; return st * 1024 + (ob ^ (((ob >> 9) & 1) << 5)); }
__host__ __device__ __forceinline__ void stage_rc(int b, int& R, int& C) { const int st = b / 1024, sb = b % 1024, swz = sb ^ (((sb >> 9) & 1) << 5); R = (st >> 1) * 16 + swz / 64; C = (st & 1) * 32 + (swz % 64) / 2; }
__host__ __device__ __forceinline__ int perm32(int rho) { const int n = rho >> 4, i = rho & 15; return 8 * (i >> 2) + 4 * n + (i & 3); }

struct Unit { int pm, pn; };
struct Gemm { const bf16_t* A; const bf16_t* Bt; int M, N, K, lda, ldb, acol; };

struct StaticOrder {
    int nM, nN, nwg, G, c;
    __host__ __device__ void init(int M, int N, int G_, int c_) { nM = M / BM; nN = N / BM; nwg = nM * nN; G = G_; c = c_; }
    __host__ __device__ bool next(int i, Unit& u) const {
        const long L = (long)i * G + c; if (L >= nwg) return false;
        int wgid = (int)L; { const int q = nwg / NXCD, r = nwg % NXCD, xcd = wgid % NXCD, off = wgid / NXCD; wgid = (xcd < r ? xcd * (q + 1) : r * (q + 1) + (xcd - r) * q) + off; }
        const int nig = WGM * nN, gid = wgid / nig, fm = gid * WGM, gsz = (nM - fm) < WGM ? (nM - fm) : WGM;
        u.pm = fm + ((wgid % nig) % gsz); u.pn = (wgid % nig) / gsz; return true;
    }
    __device__ __forceinline__ void a_ready(const Unit&) const {}
    __device__ __forceinline__ void done(const Unit&) const {}
};

template <class Epi, class Sched, bool ALIGN_EPI = false, bool SP2 = false>
__device__ __forceinline__ void gemm_phase(PG8_LAS unsigned char* lds, const Gemm g, const Sched& S, const Epi& E) {
    int tid_ = threadIdx.x; asm volatile("" : "+v"(tid_)); const int tid = tid_, wid = __builtin_amdgcn_readfirstlane(tid >> 6), lane = tid & 63, wr = wid >> 2, wc = wid & 3, fr = lane & 15, fq = lane >> 4;
    const int K = g.K, nt = K / BK;
    unsigned voffA[2], voffB[2];
#pragma unroll
    for (int i = 0; i < 2; ++i) { int R, C; stage_rc(tid * 16 + i * 8192, R, C); const int Rb = Epi::PERM ? ((R & ~31) + perm32(R & 31)) : R;
        voffA[i] = (unsigned)(R * g.lda + C) * 2u; voffB[i] = (unsigned)(Rb * g.ldb + C) * 2u; }
    const size_t kstep = (size_t)(BK * 2);
    const size_t hstepA = (size_t)HALF * g.lda * 2, hstepB = (size_t)HALF * g.ldb * 2;
    const size_t tstepA = 2 * hstepA, tstepB = 2 * hstepB, acolB = (size_t)g.acol * 2;
    const unsigned ldsw = (unsigned)wid * 1024u;
    const int aoff = lds_byte(wr * 64 + fr, fq * 8), boff = lds_byte(wc * 32 + fr, fq * 8);
#define PG8_SA(b, h) (((b) * 2 + (h)) * HTB)
#define PG8_SB(b, h) ((4 + (b) * 2 + (h)) * HTB)
#define PG8_STAGE(bufoff, gbase, voff) do { _Pragma("unroll") for (int _i = 0; _i < 2; ++_i) \
        __builtin_amdgcn_global_load_lds((const unsigned*)((const char*)(gbase) + (voff)[_i]), (PG8_LAS unsigned*)(lds + (bufoff) + ldsw + _i * 8192), 16, 0, 0); } while (0)
#define PG8_LDA(dst, b, h) do { _Pragma("unroll") for (int m = 0; m < 4; ++m) _Pragma("unroll") for (int k = 0; k < 2; ++k) dst[m][k] = *(const PG8_LAS bf16x8*)(lds + PG8_SA(b, h) + aoff + m * 2048 + k * 1024); } while (0)
#define PG8_LDB(dst, b, h) do { _Pragma("unroll") for (int n = 0; n < 2; ++n) _Pragma("unroll") for (int k = 0; k < 2; ++k) dst[n][k] = *(const PG8_LAS bf16x8*)(lds + PG8_SB(b, h) + boff + n * 2048 + k * 1024); } while (0)
#define PG8_MMA(ai, bj, At, Bt) do { __builtin_amdgcn_s_setprio(1); _Pragma("unroll") for (int m = 0; m < 4; ++m) _Pragma("unroll") for (int n = 0; n < 2; ++n) _Pragma("unroll") for (int k = 0; k < 2; ++k) \
        acc[ai][bj][m][n] = __builtin_amdgcn_mfma_f32_16x16x32_bf16(Bt[n][k], At[m][k], acc[ai][bj][m][n], 0, 0, 0); __builtin_amdgcn_s_setprio(0); } while (0)
#define PG8_WAIT_V(n) asm volatile("s_waitcnt vmcnt(" #n ")" ::: "memory")
#define PG8_WAIT_L(n) asm volatile("s_waitcnt lgkmcnt(" #n ")" ::: "memory")
#define PG8_BAR __builtin_amdgcn_s_barrier()
#define PG8_SCHED __builtin_amdgcn_sched_barrier(0)
    Unit cur, nxt; int ui = 0;
    if (!S.next(0, cur)) return;
    f32x4 acc[2][2][4][2];
#pragma unroll
    for (int a = 0; a < 2; ++a)
#pragma unroll
        for (int b = 0; b < 2; ++b)
#pragma unroll
            for (int m = 0; m < 4; ++m)
#pragma unroll
                for (int n = 0; n < 2; ++n) acc[a][b][m][n] = (f32x4){0.f, 0.f, 0.f, 0.f};
    bf16x8 At[4][2], B0[2][2], B1[2][2];
    const char* cA = (const char*)g.A + (size_t)cur.pm * tstepA + (size_t)cur.pn * acolB; const char* cB = (const char*)g.Bt + (size_t)cur.pn * tstepB;
    S.a_ready(cur);
    if constexpr (SP2) {
        PG8_STAGE(PG8_SB(0, 0), cB, voffB); PG8_STAGE(PG8_SB(0, 1), cB + hstepB, voffB); PG8_STAGE(PG8_SA(0, 0), cA, voffA); PG8_STAGE(PG8_SA(0, 1), cA + hstepA, voffA);
        if (wr == 1) PG8_BAR;
        PG8_WAIT_V(2); PG8_BAR;
        PG8_STAGE(PG8_SB(1, 0), cB + kstep, voffB); PG8_STAGE(PG8_SA(1, 0), cA + kstep, voffA); PG8_STAGE(PG8_SB(1, 1), cB + hstepB + kstep, voffB);
        PG8_WAIT_V(6); PG8_BAR;
    } else {
        PG8_STAGE(PG8_SB(0, 0), cB, voffB); PG8_STAGE(PG8_SA(0, 0), cA, voffA); PG8_STAGE(PG8_SB(0, 1), cB + hstepB, voffB); PG8_STAGE(PG8_SA(0, 1), cA + hstepA, voffA);
        if (wr == 1) PG8_BAR;
        PG8_WAIT_V(4); PG8_BAR;
        PG8_STAGE(PG8_SB(1, 0), cB + kstep, voffB); PG8_STAGE(PG8_SA(1, 0), cA + kstep, voffA); PG8_STAGE(PG8_SB(1, 1), cB + hstepB + kstep, voffB);
        PG8_WAIT_V(6); PG8_BAR;
    }
    for (;;) {
        const bool has_next = S.next(ui + 1, nxt);
        const char* nA = has_next ? (const char*)g.A + (size_t)nxt.pm * tstepA + (size_t)nxt.pn * acolB : cA; const char* nB = has_next ? (const char*)g.Bt + (size_t)nxt.pn * tstepB : cB;
        for (int t = 0; t < nt; t += 2) {
            const bool last = (t == nt - 2);
            const char* a1 = cA + (size_t)(t + 1) * kstep;
            const char* a2 = last ? nA : cA + (size_t)(t + 2) * kstep; const char* b2 = last ? nB : cB + (size_t)(t + 2) * kstep;
            const char* a3 = a2 + kstep; const char* b3 = b2 + kstep;
            if (last && has_next) S.a_ready(nxt);
            if constexpr (SP2) {
            PG8_LDB(B0, 0, 0); PG8_LDB(B1, 0, 1); PG8_SCHED; PG8_LDA(At, 0, 0); PG8_STAGE(PG8_SA(1, 1), a1 + hstepA, voffA);
            PG8_WAIT_V(8); PG8_WAIT_L(0); PG8_BAR; PG8_MMA(0, 0, At, B0); PG8_MMA(0, 1, At, B1); PG8_BAR; PG8_SCHED;
            PG8_LDA(At, 0, 1); PG8_STAGE(PG8_SB(0, 0), b2, voffB); PG8_STAGE(PG8_SB(0, 1), b2 + hstepB, voffB); PG8_STAGE(PG8_SA(0, 0), a2, voffA);
            PG8_WAIT_V(8); PG8_WAIT_L(0); PG8_BAR; PG8_MMA(1, 0, At, B0); PG8_MMA(1, 1, At, B1); PG8_BAR; PG8_SCHED;
            PG8_LDB(B0, 1, 0); PG8_LDB(B1, 1, 1); PG8_SCHED; PG8_LDA(At, 1, 0); PG8_STAGE(PG8_SA(0, 1), a2 + hstepA, voffA);
            PG8_WAIT_V(8); PG8_WAIT_L(0); PG8_BAR; PG8_MMA(0, 0, At, B0); PG8_MMA(0, 1, At, B1); PG8_BAR; PG8_SCHED;
            PG8_LDA(At, 1, 1); PG8_STAGE(PG8_SB(1, 0), b3, voffB); PG8_STAGE(PG8_SB(1, 1), b3 + hstepB, voffB); PG8_STAGE(PG8_SA(1, 0), a3, voffA);
            PG8_WAIT_V(8); PG8_WAIT_L(0); PG8_BAR; PG8_MMA(1, 0, At, B0); PG8_MMA(1, 1, At, B1); PG8_BAR; PG8_SCHED;
            } else {
            PG8_LDB(B0, 0, 0); PG8_SCHED; PG8_LDA(At, 0, 0); PG8_STAGE(PG8_SA(1, 1), a1 + hstepA, voffA);
            PG8_WAIT_L(8); PG8_BAR; PG8_WAIT_L(0); PG8_MMA(0, 0, At, B0); PG8_BAR; PG8_SCHED;
            PG8_LDB(B1, 0, 1); PG8_STAGE(PG8_SB(0, 0), b2, voffB);
            PG8_BAR; PG8_WAIT_L(0); PG8_MMA(0, 1, At, B1); PG8_BAR;
            PG8_LDA(At, 0, 1); PG8_STAGE(PG8_SA(0, 0), a2, voffA);
            PG8_BAR; PG8_WAIT_L(0); PG8_MMA(1, 0, At, B0); PG8_BAR; PG8_SCHED;
            PG8_STAGE(PG8_SB(0, 1), b2 + hstepB, voffB);
            PG8_WAIT_V(6); PG8_BAR; PG8_MMA(1, 1, At, B1); PG8_BAR;
            PG8_LDB(B0, 1, 0); PG8_SCHED; PG8_LDA(At, 1, 0); PG8_STAGE(PG8_SA(0, 1), a2 + hstepA, voffA);
            PG8_WAIT_L(8); PG8_BAR; PG8_WAIT_L(0); PG8_MMA(0, 0, At, B0); PG8_BAR; PG8_SCHED;
            PG8_LDB(B1, 1, 1); PG8_STAGE(PG8_SB(1, 0), b3, voffB);
            PG8_BAR; PG8_WAIT_L(0); PG8_MMA(0, 1, At, B1); PG8_BAR;
            PG8_LDA(At, 1, 1); PG8_STAGE(PG8_SA(1, 0), a3, voffA);
            PG8_BAR; PG8_WAIT_L(0); PG8_MMA(1, 0, At, B0); PG8_BAR; PG8_SCHED;
            PG8_STAGE(PG8_SB(1, 1), b3 + hstepB, voffB);
            PG8_WAIT_V(6); PG8_BAR; PG8_MMA(1, 1, At, B1); PG8_BAR;
            }
        }
        if constexpr (ALIGN_EPI) { if (wr == 0) PG8_BAR; }
        if constexpr (!Epi::AFTER_DRAIN) { E(acc, cur, wr, wc, fr, fq); S.done(cur); }
        if (!has_next) break;
#pragma unroll
        for (int a = 0; a < 2; ++a)
#pragma unroll
            for (int b = 0; b < 2; ++b)
#pragma unroll
                for (int m = 0; m < 4; ++m)
#pragma unroll
                    for (int n = 0; n < 2; ++n) acc[a][b][m][n] = (f32x4){0.f, 0.f, 0.f, 0.f};
        cur = nxt; cA = nA; cB = nB; ++ui;
        if constexpr (ALIGN_EPI) { if (wr == 1) PG8_BAR; }
    }
    PG8_WAIT_V(0);
    if constexpr (!ALIGN_EPI) { if (wr == 0) PG8_BAR; }
    PG8_BAR;
    if constexpr (Epi::AFTER_DRAIN) { E.fused(acc, cur, wr, wc, fr, fq, lds, wid, lane); S.done(cur); }
#undef PG8_SA
#undef PG8_SB
#undef PG8_STAGE
#undef PG8_LDA
#undef PG8_LDB
#undef PG8_MMA
#undef PG8_WAIT_V
#undef PG8_WAIT_L
#undef PG8_BAR
#undef PG8_SCHED
}
}
namespace pg8 {
__device__ __forceinline__ unsigned cvt_pk_bf16(float lo, float hi) { unsigned r; asm volatile("v_cvt_pk_bf16_f32 %0, %1, %2" : "=v"(r) : "v"(lo), "v"(hi)); return r; }
struct EpiF32 {
    static constexpr bool PERM = false, AFTER_DRAIN = false;
    float* C; int ldc;
    __device__ __forceinline__ void operator()(const f32x4 (&acc)[2][2][4][2], const Unit& u, int wr, int wc, int, int) const {
        int ln_ = threadIdx.x & 63; asm volatile("" : "+v"(ln_)); const int fr = ln_ & 15, fq = ln_ >> 4;
        const int row0 = u.pm * BM + wr * 64 + fr, col0 = u.pn * BM + wc * 32 + 4 * fq;
#pragma unroll
        for (int ai = 0; ai < 2; ++ai)
#pragma unroll
            for (int m = 0; m < 4; ++m) { float* rowp = C + (size_t)(row0 + ai * HALF + m * 16) * ldc + col0;
#pragma unroll
                for (int bj = 0; bj < 2; ++bj)
#pragma unroll
                    for (int n = 0; n < 2; ++n) *(f32x4*)(rowp + bj * HALF + n * 16) = acc[ai][bj][m][n]; }
    }
};
struct EpiResid {
    static constexpr bool PERM = false, AFTER_DRAIN = false;
    float* X; int ldc; float alpha;
    __device__ __forceinline__ void operator()(const f32x4 (&acc)[2][2][4][2], const Unit& u, int wr, int wc, int, int) const {
        int ln_ = threadIdx.x & 63; asm volatile("" : "+v"(ln_)); const int fr = ln_ & 15, fq = ln_ >> 4;
        const int row0 = u.pm * BM + wr * 64 + fr, col0 = u.pn * BM + wc * 32 + 4 * fq;
#pragma unroll
        for (int ai = 0; ai < 2; ++ai)
#pragma unroll
            for (int m = 0; m < 4; ++m) { float* rowp = X + (size_t)(row0 + ai * HALF + m * 16) * ldc + col0;
#pragma unroll
                for (int bj = 0; bj < 2; ++bj) { const f32x4 o0 = *(const f32x4*)(rowp + bj * HALF), o1 = *(const f32x4*)(rowp + bj * HALF + 16);
                    *(f32x4*)(rowp + bj * HALF) = o0 * alpha + acc[ai][bj][m][0]; *(f32x4*)(rowp + bj * HALF + 16) = o1 * alpha + acc[ai][bj][m][1];
                    asm volatile("" ::: "memory"); } }
    }
};
template <int ACT  > struct EpiBf16 {
    static constexpr bool PERM = true, AFTER_DRAIN = false;
    bf16_t* O; int ldc; const float* scale;
    __device__ __forceinline__ void operator()(const f32x4 (&acc)[2][2][4][2], const Unit& u, int wr, int wc, int, int) const {
        int ln_ = threadIdx.x & 63; asm volatile("" : "+v"(ln_)); const int fr = ln_ & 15, fq = ln_ >> 4;
        const int row0 = u.pm * BM + wr * 64 + fr, col0 = u.pn * BM + wc * 32 + 8 * fq;
        f32x4 sv[2][2];
#pragma unroll
        for (int bj = 0; bj < 2; ++bj)
#pragma unroll
            for (int n = 0; n < 2; ++n) sv[bj][n] = (ACT == 0) ? *(const f32x4*)(scale + col0 + bj * HALF + 4 * n) : (f32x4){1.f, 1.f, 1.f, 1.f};
#pragma unroll
        for (int ai = 0; ai < 2; ++ai)
#pragma unroll
            for (int m = 0; m < 4; ++m) { bf16_t* rowp = O + (size_t)(row0 + ai * HALF + m * 16) * ldc + col0;
#pragma unroll
                for (int bj = 0; bj < 2; ++bj) { f32x4 v0 = acc[ai][bj][m][0], v1 = acc[ai][bj][m][1];
                    if (ACT == 0) { v0 = v0 * sv[bj][0]; v1 = v1 * sv[bj][1]; }
                    if (ACT == 1) {
#pragma unroll
                        for (int q = 0; q < 4; ++q) { const float a = fmaxf(v0[q], 0.f), b = fmaxf(v1[q], 0.f); v0[q] = a * a; v1[q] = b * b; } }
                    u32x4 w; w.x = cvt_pk_bf16(v0[0], v0[1]); w.y = cvt_pk_bf16(v0[2], v0[3]); w.z = cvt_pk_bf16(v1[0], v1[1]); w.w = cvt_pk_bf16(v1[2], v1[3]);
                    *(u32x4*)(rowp + bj * HALF) = w; } }
    }
};
}
#define LAS __attribute__((address_space(3)))
#define XB_TMO      128
#define XB_XCNT(j)  (256  + 64 * (j))
#define XB_XSUB(j)  (1280 + 64 * (j))
#define XB_XGEN(j)  (2304 + 64 * (j))
#define XB_TOP      3328
#define XB_TOPGEN   3392
#define XCD_BAR_WORDS 3456
#define XB_SPIN_CAP (1u << 18)

__device__ __forceinline__ unsigned xb_ld(unsigned* p)              { return __hip_atomic_load(p, __ATOMIC_RELAXED, __HIP_MEMORY_SCOPE_AGENT); }
__device__ __forceinline__ unsigned xb_add(unsigned* p, unsigned v) { return __hip_atomic_fetch_add(p, v, __ATOMIC_RELAXED, __HIP_MEMORY_SCOPE_AGENT); }
__device__ __forceinline__ unsigned xb_xcc_id() { return (unsigned)__builtin_amdgcn_s_getreg((3 << 11) | 20) & 0xFu; }
#define XB_SPIN(cond, bar) do { unsigned _sp = 0; while (cond) { __builtin_amdgcn_s_sleep(1); \
    if ((++_sp & 255u) == 0u) { if (xb_ld(&(bar)[XB_TMO])) break; if (_sp > XB_SPIN_CAP) { atomicAdd(&(bar)[XB_TMO], 1u); break; } } } } while (0)

struct XcdBarrier {
    unsigned* bar; unsigned x;
    volatile LAS unsigned* st;
};

__device__ __forceinline__ XcdBarrier xcd_barrier_post(unsigned* bar, volatile LAS unsigned* st) {
    XcdBarrier b; b.bar = bar; b.x = xb_xcc_id(); b.st = st;
    if (threadIdx.x == 0) (void)xb_add(&bar[XB_XCNT(b.x)], 1u);
    return b;
}
__device__ __forceinline__ void xcd_barrier_complete(unsigned* bar, unsigned x, unsigned& nloc, unsigned& nx) {
    const unsigned G = gridDim.x * gridDim.y * gridDim.z;
    unsigned sum, cnt, mine, sp = 0u;
    for (;;) {
        sum = 0u; cnt = 0u; mine = 0u;
#pragma unroll
        for (unsigned j = 0; j < 16; ++j) { const unsigned c = xb_ld(&bar[XB_XCNT(j)]); sum += c; cnt += (c > 0u) ? 1u : 0u; mine = (j == x) ? c : mine; }
        if (sum == G) break;
        __builtin_amdgcn_s_sleep(1);
        if ((++sp & 255u) == 0u) { if (xb_ld(&bar[XB_TMO])) break; if (sp > XB_SPIN_CAP) { atomicAdd(&bar[XB_TMO], 1u); break; } }
    }
    nloc = mine > 0u ? mine : 1u; nx = cnt > 0u ? cnt : 1u;
}

__device__ __attribute__((noinline)) void xcd_barrier_impl(unsigned* bar_, unsigned bx_, volatile LAS unsigned* st_) {
    XcdBarrier b; b.bar = bar_; b.x = bx_; b.st = st_;
    asm volatile("s_waitcnt vmcnt(0)" ::: "memory");
    __syncthreads();
    if (threadIdx.x == 0) {
        unsigned* bar = b.bar;
        __builtin_amdgcn_s_waitcnt(0);
        unsigned nloc = b.st[0], nx = b.st[1];
        if (nloc == 0u) { xcd_barrier_complete(bar, b.x, nloc, nx); b.st[0] = nloc; b.st[1] = nx; }
        const unsigned old = xb_add(&bar[XB_XSUB(b.x)], 1u);
        const unsigned gen = old / nloc;
        if (old + 1u == (gen + 1u) * nloc) {
            __builtin_amdgcn_fence(__ATOMIC_RELEASE, "agent");
            asm volatile("s_waitcnt vmcnt(0)" ::: "memory");
            const unsigned og = xb_add(&bar[XB_TOP], 1u);
            const unsigned tg = og / nx;
            if (og + 1u == (tg + 1u) * nx) xb_add(&bar[XB_TOPGEN], 1u);
            else XB_SPIN(xb_ld(&bar[XB_TOPGEN]) == tg, bar);
            __builtin_amdgcn_fence(__ATOMIC_ACQUIRE, "agent");
            xb_add(&bar[XB_XGEN(b.x)], 1u);
            asm volatile("s_waitcnt vmcnt(0)" ::: "memory");
        } else {
            XB_SPIN(xb_ld(&bar[XB_XGEN(b.x)]) == gen, bar);
            __builtin_amdgcn_fence(__ATOMIC_ACQUIRE, "agent");
            asm volatile("s_waitcnt vmcnt(0)" ::: "memory");
        }
    }
    __syncthreads();
}
__device__ __forceinline__ void xcd_barrier(const XcdBarrier& b) { xcd_barrier_impl(b.bar, b.x, b.st); }
constexpr int NWAVES = 8;
constexpr int RING_BYTES = 131072, LDSCTL_OFF = RING_BYTES, MISC_OFF = LDSCTL_OFF + 320, LDS_BYTES = 147456;
constexpr size_t CTL_ZERO_BYTES = 1u << 20;
constexpr int CW_BAR = 4096;
constexpr int PH_PER_LAYER = 12, N_PHASES = 1 + 4 * PH_PER_LAYER;

DEVI void tr_job(const float* W, int K, int N, bf16* WT, int abmap, int vb, int nvb, float* t) {
    const int units = (K / 64) * ((N + 63) / 64);
    for (int u = vb; u < units; u += nvb) transpose_unit(W, K, N, WT, abmap, u, t);
}
DEVI void ph_prologue(CP p, int vb, int nvb, float* t) {
    bf16 *WINAB = wsb(p, WS_WINAB), *WOUTAB = wsb(p, WS_WOUTAB), *WINCD = wsb(p, WS_WINCD), *WOUTCD = wsb(p, WS_WOUTCD), *WFF1 = wsb(p, WS_WFF1), *WFF2 = wsb(p, WS_WFF2), *POOLW = wsb(p, WS_POOLW);
    for (int j = 0; j < 2; ++j) {
        tr_job(p->w_in_ab + (size_t)j * DM * 4696, DM, 4696, WINAB + (size_t)j * HC_AB * DM, 1, vb, nvb, t);
        tr_job(p->w_out_ab + (size_t)j * DM * DM, DM, DM, WOUTAB + (size_t)j * DM * DM, 0, vb, nvb, t);
        tr_job(p->w_in_cd + (size_t)j * DM * HC_CD, DM, HC_CD, WINCD + (size_t)j * HC_CD * DM, 0, vb, nvb, t);
        tr_job(p->w_out_cd + (size_t)j * DM * DM, DM, DM, WOUTCD + (size_t)j * DM * DM, 0, vb, nvb, t);
        tr_job(p->pool_w + (size_t)j * 4 * 65536, 256, 256, POOLW + (size_t)j * 4 * 65536, 0, vb, nvb, t);
        tr_job(p->pool_w + ((size_t)j * 4 + 1) * 65536, 256, 256, POOLW + ((size_t)j * 4 + 1) * 65536, 0, vb, nvb, t);
        tr_job(p->pool_w + ((size_t)j * 4 + 2) * 65536, 256, 256, POOLW + ((size_t)j * 4 + 2) * 65536, 0, vb, nvb, t);
        tr_job(p->pool_w + ((size_t)j * 4 + 3) * 65536, 256, 256, POOLW + ((size_t)j * 4 + 3) * 65536, 0, vb, nvb, t);
    }
    for (int i = 0; i < 4; ++i) {
        tr_job(p->w_ff1 + (size_t)i * DM * DFF, DM, DFF, WFF1 + (size_t)i * DFF * DM, 0, vb, nvb, t);
        tr_job(p->w_ff2 + (size_t)i * DFF * DM, DFF, DM, WFF2 + (size_t)i * DM * DFF, 0, vb, nvb, t);
    }
    const size_t gt = (size_t)vb * 512 + ltid(), ng = (size_t)nvb * 512;
    for (size_t i = gt; i < (size_t)2 * (HC_AB - 4696) * DM / 8; i += ng) { const size_t per = (size_t)(HC_AB - 4696) * DM / 8; const size_t j = i / per, r = i % per;
        *(u32x4*)(WINAB + j * HC_AB * DM + (size_t)4696 * DM + r * 8) = (u32x4){0u, 0u, 0u, 0u}; }
    bf16* sw = wsb(p, WS_SGUW);
    for (size_t i = gt; i < 2 * 4 * 128 * 128; i += ng) { const int s = (int)i & 127, tt = ((int)i >> 7) & 127; sw[i] = f2bf(s <= tt ? p->sgu_w[i] : 0.f); }
    float* X = wsf(p, WS_X); bf16* XB = wsb(p, WS_XB);
    for (size_t i = gt; i < (size_t)MP * DM / 4; i += ng) {
        const size_t e = i * 4; const int row = (int)(e / DM);
        f32x4 v = (f32x4){0.f, 0.f, 0.f, 0.f};
        if (row < MPR) v = *(const f32x4*)(p->x_prompt + e); else if (row < MR) v = *(const f32x4*)(p->x_sample + (e - (size_t)MPR * DM));
        *(f32x4*)(X + e) = v; uint2 o; o.x = pk2(v.x, v.y); o.y = pk2(v.z, v.w); *(uint2*)(XB + e) = o;
    }
}

template <class Epi> DEVI void run_gemm(PG8_LAS unsigned char* lds, const bf16* A, int lda, int acol, const bf16* Bt, int ldb, int M, int N, int K, const Epi& E) {
    asm volatile("" : "+s"(K));
    pg8::Gemm g{A, Bt, M, N, K, lda, ldb, acol}; pg8::StaticOrder S; S.init(M, N, (int)gridDim.x, lvb());
    pg8::gemm_phase<Epi, pg8::StaticOrder, true, true>(lds, g, S, E);
}

#define IN(k) (lo <= (k) && (k) < hi)
#define SEAM(k) do { if (IN(k) && (k) + 1 < hi) xcd_barrier(bar); } while (0)
template <int I> DEVI void layer_phases(LAS unsigned char* L, unsigned char* lds, const XcdBarrier& bar, int lo, int hi, int nvb) {
    constexpr int base = 1 + PH_PER_LAYER * I, j = I >> 1;
    float* smf = (float*)lds; int* smi = (int*)lds;
    if constexpr ((I & 1) == 0) {
        if (IN(base + 0)) { CP p = PP(); run_gemm(L, wsb(p, WS_XB), DM, 0, wsb(p, WS_WINAB) + (size_t)j * HC_AB * DM, DM, MP, HC_AB, DM, pg8::EpiF32{wsf(p, WS_H), HC_AB}); }
        SEAM(base + 0);
        if (IN(base + 1)) {
            ph_ab_copy(PP(), j, lvb(), nvb);
            for (int u = lvb(); u < 64 * 24; u += nvb) conv_prompt_unit(PP(), j, u / 24, u % 24, (bf16*)lds);
            ph_conv(PP(), j, lvb(), nvb);
            ph_idx_prompt(PP(), lvb(), nvb);
            for (int u = lvb(); u < 8 * 33; u += nvb) idx_sample_unit(PP(), j, u / 33, u % 33, smf);
        }
        SEAM(base + 1);
        if (IN(base + 2)) {
            ph_select_prompt(PP(), lvb(), nvb);
            for (int u = lvb(); u < MSR; u += nvb) select_sample_unit(PP(), u, smi);
            for (int u = lvb(); u < 64 * 16; u += nvb) ssd1_unit(PP(), j, u >> 4, u & 15, smf);
#ifdef EXP_OLDY
            { const int t_ = ltid(), u = (t_ >> 6) * nvb + lvb(); if (u < (NBP + DB) * 32) ssd_seq_unit(PP(), j, u / 32, (u >> 1) & 15, u & 1, t_ & 63); }
#else
            { const int t_ = ltid(), u = (t_ >> 6) * nvb + lvb(); if (u < DB * 32) ssd_seq_unit(PP(), j, NBP + u / 32, (u >> 1) & 15, u & 1, t_ & 63); }
#endif
        }
        SEAM(base + 2);
        if (IN(base + 3)) {
            ph_ssd_scan(PP(), j, lvb(), nvb);
            for (int u = lvb(); u < MSR; u += nvb) attn_sample_unit(PP(), j, u, lds);
            ph_ssd_gate(PP(), j, lvb(), nvb);
        }
        SEAM(base + 3);
        if (IN(base + 4)) {
#ifdef EXP_ATT
            ph_attn_prompt_naive(PP(), lvb(), nvb);
            for (int u = lvb(); u < 256; u += nvb) attn_unit(PP(), (u >> 3) & 1, u & 7, u >> 4, lds, wsb(PP(), WS_HF));
#else
            for (int u = lvb(); u < 256; u += nvb) attn_unit(PP(), (u >> 3) & 1, u & 7, u >> 4, lds, wsb(PP(), WS_AO));
#endif
#ifdef EXP_OLDY
            for (int u = lvb(); u < 64 * 8; u += nvb) ssd3_unit(PP(), j, u >> 3, u & 7, smf, wsb(PP(), WS_HF));
#else
            if (nvb == 256) {
                const int vb_ = lvb(), qb_ = vb_ >> 4, n_ = (0x0001112222333444ull >> (4 * qb_)) & 15, off_ = (qb_ < 3 ? 4 * qb_ : qb_ < 6 ? 12 + 3 * (qb_ - 3) : qb_ < 10 ? 21 + 2 * (qb_ - 6) : qb_ < 13 ? 29 + (qb_ - 10) : 32);
                for (int i = 0; i < n_; ++i) { const int u = off_ * 16 + (vb_ & 15) * n_ + i; ssd3_unit(PP(), j, u >> 3, u & 7, smf, wsb(PP(), WS_AO)); }
            } else for (int u = lvb(); u < 64 * 8; u += nvb) ssd3_unit(PP(), j, u >> 3, u & 7, smf, wsb(PP(), WS_AO));
#endif
        }
        SEAM(base + 4);
#ifdef EXP_ATT
        if (IN(base + 5) && I == 0) { CP p = PP(); diag_cmp(p, 0, wsb(p, WS_AO), DM, wsb(p, WS_HF), DM, MPR, 1024, lvb(), nvb); }
#endif
#ifdef EXP_OLDY
        if (IN(base + 5) && I == 0) { CP p = PP(); const int vb_ = lvb();
            diag_cmp_f32(p, 0, wsf(p, WS_XC), 1536, wsb(p, WS_XCN), 1536, MPR, 1536, vb_, nvb);
            diag_fin_f32(p, 1, wsf(p, WS_ACUM), (size_t)64 * 16 * 128, vb_, nvb);
            diag_fin_f32(p, 2, wsf(p, WS_DTC), (size_t)64 * 16 * 128, vb_, nvb);
            diag_fin_bf16(p, 3, wsb(p, WS_HIN), (size_t)64 * 16 * 8192, vb_, nvb);
            diag_fin_bf16(p, 4, wsb(p, WS_XCT), (size_t)64 * 1536 * 128, vb_, nvb);
            diag_cmp(p, 5, wsb(p, WS_AO) + 1024, DM, wsb(p, WS_HF) + 1024, DM, MPR, 1024, vb_, nvb); }
#endif
        if (IN(base + 5)) { CP p = PP(); run_gemm(L, wsb(p, WS_AO), DM, 0, wsb(p, WS_WOUTAB) + (size_t)j * DM * DM, DM, MP, DM, DM, pg8::EpiResid{wsf(p, WS_X), DM, ALPHA}); }
        SEAM(base + 5);
    } else {
        if (IN(base + 0)) { CP p = PP(); run_gemm(L, wsb(p, WS_XB), DM, 0, wsb(p, WS_WINCD) + (size_t)j * HC_CD * DM, DM, MP, HC_CD, DM, pg8::EpiF32{wsf(p, WS_H), HC_CD}); }
        SEAM(base + 0);
        if (IN(base + 1)) ph_cd_prep(PP(), j, lvb(), nvb);
        SEAM(base + 1);
        if (IN(base + 2)) {
            { CP p = PP(); run_gemm(L, wsb(p, WS_DD), 1024, 256, wsb(p, WS_POOLW) + (size_t)j * 4 * 65536, 256, MP, 1024, 256, pg8::EpiBf16<0>{wsb(p, WS_AO), DM, p->pool_scale + (size_t)j * 1024}); }
            for (int u = lvb(); u < 64 * 16; u += nvb) sgu_unit(PP(), j, u >> 4, (u >> 2) & 3, u & 3, (bf16*)lds);
            ph_sgu_naive(PP(), j, lvb(), nvb);
        }
        if (IN(base + 2) && base + 5 < hi) xcd_barrier(bar);
        if (IN(base + 5)) { CP p = PP(); run_gemm(L, wsb(p, WS_AO), DM, 0, wsb(p, WS_WOUTCD) + (size_t)j * DM * DM, DM, MP, DM, DM, pg8::EpiResid{wsf(p, WS_X), DM, ALPHA}); }
        SEAM(base + 5);
    }
#ifdef EXP_OLDY
    if (IN(base + 6) && I == 0) diag_report(PP(), 6);
#endif
#ifdef EXP_ATT
    if (IN(base + 6) && I == 0) diag_report(PP(), 1);
#endif
    if (IN(base + 6)) { CP p = PP(); ph_ln(p, p->ln1_g + (size_t)I * DM, p->ln1_b + (size_t)I * DM, 0, lvb(), nvb); }
    SEAM(base + 6);
    if (IN(base + 7)) { CP p = PP(); run_gemm(L, wsb(p, WS_XB), DM, 0, wsb(p, WS_WFF1) + (size_t)I * DFF * DM, DM, MP, DFF, DM, pg8::EpiBf16<1>{wsb(p, WS_HF), DFF, nullptr}); }
    SEAM(base + 7);
    if (IN(base + 8)) { CP p = PP(); run_gemm(L, wsb(p, WS_HF), DFF, 0, wsb(p, WS_WFF2) + (size_t)I * DM * DFF, DFF, MP, DM, DFF, pg8::EpiResid{wsf(p, WS_X), DM, ALPHA}); }
    SEAM(base + 8);
    if (IN(base + 9)) { CP p = PP(); ph_ln(p, p->ln2_g + (size_t)I * DM, p->ln2_b + (size_t)I * DM, I == 3, lvb(), nvb); }
    if (I < 3) { if (IN(base + 9) && base + PH_PER_LAYER < hi) xcd_barrier(bar); }
}

__global__ void __launch_bounds__(NWAVES * 64, 2) mk_fwd(P p_kernarg) {
    extern __shared__ __attribute__((aligned(16))) unsigned char lds[];
    LAS unsigned char* L = (LAS unsigned char*)lds;
    volatile LAS unsigned* MISC = (volatile LAS unsigned*)(L + MISC_OFF);
    const int nvb = gridDim.x;
    for (int u = threadIdx.x; u < (LDS_BYTES - LDSCTL_OFF) / 4; u += NWAVES * 64) ((LAS unsigned*)(L + LDSCTL_OFF))[u] = 0u;
    __syncthreads();
    unsigned* ctl = (unsigned*)(PP()->ws + WS_CTL);
    XcdBarrier bar = xcd_barrier_post(ctl + CW_BAR, MISC + 8);
    const int lo = PP()->ph_lo, hi = PP()->ph_hi;
    if (IN(0)) ph_prologue(PP(), lvb(), nvb, (float*)lds);
    SEAM(0);
    layer_phases<0>(L, lds, bar, lo, hi, nvb);
    layer_phases<1>(L, lds, bar, lo, hi, nvb);
    layer_phases<2>(L, lds, bar, lo, hi, nvb);
    layer_phases<3>(L, lds, bar, lo, hi, nvb);
}
#undef IN
#undef SEAM

#ifndef MK_PER_PHASE
#define MK_PER_PHASE 0
#endif
extern "C" void kernel_launch(void* const* d_in, const int* in_sizes, int n_in, void* d_out, int out_size, void* d_ws, size_t ws_size, hipStream_t stream) {
    if (n_in != 31 || (size_t)out_size != O_END || ws_size < WS_END) { fprintf(stderr, "kernel_launch: unexpected sizes n_in %d out %d ws %zu (need %zu)\n", n_in, out_size, ws_size, (size_t)WS_END); return; }
    static int grid = 0;
    if (grid == 0) {
        int dev = 0, cus = 0, per_cu = 0;
        if (hipGetDevice(&dev) != hipSuccess || hipDeviceGetAttribute(&cus, hipDeviceAttributeMultiprocessorCount, dev) != hipSuccess) { grid = -1; return; }
        if (hipFuncSetAttribute((const void*)mk_fwd, hipFuncAttributeMaxDynamicSharedMemorySize, LDS_BYTES) != hipSuccess) { fprintf(stderr, "kernel_launch: hipFuncSetAttribute failed\n"); grid = -1; return; }
        if (hipOccupancyMaxActiveBlocksPerMultiprocessor(&per_cu, (const void*)mk_fwd, NWAVES * 64, LDS_BYTES) != hipSuccess || per_cu < 1) fprintf(stderr, "kernel_launch: occupancy query says %d\n", per_cu);
        (void)hipGetLastError();
        grid = cus;
    }
    if (grid < 0) return;
    (void)hipMemsetAsync((char*)d_ws + WS_CTL, 0, CTL_ZERO_BYTES, stream);
    P p{};
    p.x_prompt = (const float*)d_in[0]; p.x_sample = (const float*)d_in[1]; p.cache_k = (const float*)d_in[2]; p.cache_v = (const float*)d_in[3]; p.cache_ik = (const float*)d_in[4];
    p.state_ssm = (const float*)d_in[5]; p.state_conv = (const float*)d_in[6]; p.state_pool = (const float*)d_in[7]; p.page_table = (const int*)d_in[8];
    p.ln1_g = (const float*)d_in[9]; p.ln1_b = (const float*)d_in[10]; p.ln2_g = (const float*)d_in[11]; p.ln2_b = (const float*)d_in[12];
    p.w_in_ab = (const float*)d_in[13]; p.conv_w = (const float*)d_in[14]; p.conv_b = (const float*)d_in[15]; p.dt_bias = (const float*)d_in[16]; p.a_log = (const float*)d_in[17];
    p.d_skip = (const float*)d_in[18]; p.ssd_g = (const float*)d_in[19]; p.w_out_ab = (const float*)d_in[20]; p.w_in_cd = (const float*)d_in[21]; p.pool_w = (const float*)d_in[22];
    p.pool_scale = (const float*)d_in[23]; p.sgu_ln_g = (const float*)d_in[24]; p.sgu_ln_b = (const float*)d_in[25]; p.sgu_w = (const float*)d_in[26]; p.sgu_b = (const float*)d_in[27];
    p.w_out_cd = (const float*)d_in[28]; p.w_ff1 = (const float*)d_in[29]; p.w_ff2 = (const float*)d_in[30];
    p.out = (float*)d_out; p.ws = (unsigned char*)d_ws;
#if MK_PER_PHASE
    for (int k = 0; k < N_PHASES; ++k) { const int r = (k - 1) % PH_PER_LAYER; if (k > 0 && (r > 9 || (((k - 1) / PH_PER_LAYER) & 1) && (r == 3 || r == 4))) continue; p.ph_lo = k; p.ph_hi = k + 1; hipLaunchKernelGGL(mk_fwd, dim3(grid), dim3(NWAVES * 64), LDS_BYTES, stream, p); }
#else
    p.ph_lo = 0; p.ph_hi = N_PHASES;
    hipLaunchKernelGGL(mk_fwd, dim3(grid), dim3(NWAVES * 64), LDS_BYTES, stream, p);
#endif
}
```

```cpp
#include <hip/hip_runtime.h>
#include <stdint.h>
#include <stdio.h>

typedef unsigned short bf16;
typedef float f32x4 __attribute__((ext_vector_type(4)));
typedef unsigned u32x4 __attribute__((ext_vector_type(4)));
#define DEVI __device__ __forceinline__
typedef short bf16x8 __attribute__((ext_vector_type(8)));
typedef unsigned u32x2 __attribute__((ext_vector_type(2)));
DEVI f32x4 mfma16(bf16x8 bt, bf16x8 a, f32x4 c) { return __builtin_amdgcn_mfma_f32_16x16x32_bf16(bt, a, c, 0, 0, 0); }
typedef float f32x2_t __attribute__((ext_vector_type(2))); typedef __bf16 bf16x2_t __attribute__((ext_vector_type(2)));
DEVI unsigned cvtpk(float lo, float hi) { f32x2_t v = {lo, hi}; bf16x2_t b = __builtin_convertvector(v, bf16x2_t); return __builtin_bit_cast(unsigned, b); }
DEVI float bflo(unsigned w) { return __uint_as_float(w << 16); }
DEVI float bfhi(unsigned w) { return __uint_as_float(w & 0xffff0000u); }

constexpr int DM = 2048, SEQ = 4096, NBP = 2, MPR = NBP * SEQ;
constexpr int DB = 8, DS = 8, MSR = DB * DS;
constexpr int MR = MPR + MSR;
constexpr int MP = 8448;
constexpr int PAST = 16384, PAGE = 128, NPAGES = PAST / PAGE, NPOOL = 1280;
constexpr int NKEY_S = PAST + DS;
constexpr int SCS_LD = 16400;
constexpr int HC_AB = 4864, HC_CD = 3072, DFF = 8192;
constexpr int TOPK = 256;
constexpr int C_Q = 0, C_K = 1024, C_V = 1280, C_QI = 1536, C_Z = 2048, C_XBC = 3072, C_KI = 4608, C_WI = 4672, C_DT = 4680;
constexpr float ALPHA = 1.681792830507429f;
constexpr float EPS = 1e-5f;
constexpr float IDX_SCALE = 0.04419417382415922f;
constexpr float ATT_SCALE = 0.08838834764831845f;

constexpr size_t O_YP = 0;
constexpr size_t O_YS = O_YP + (size_t)MPR * DM;
constexpr size_t O_KP = O_YS + (size_t)MSR * DM;
constexpr size_t O_VP = O_KP + (size_t)2 * MPR * 256;
constexpr size_t O_IP = O_VP + (size_t)2 * MPR * 256;
constexpr size_t O_HP = O_IP + (size_t)2 * MPR * 64;
constexpr size_t O_CP = O_HP + (size_t)2 * NBP * 16 * 64 * 128;
constexpr size_t O_PP = O_CP + (size_t)2 * NBP * 3 * 1536;
constexpr size_t O_KS = O_PP + (size_t)2 * NBP * 15 * 1024;
constexpr size_t O_VS = O_KS + (size_t)2 * MSR * 256;
constexpr size_t O_IS = O_VS + (size_t)2 * MSR * 256;
constexpr size_t O_HS = O_IS + (size_t)2 * MSR * 64;
constexpr size_t O_CS = O_HS + (size_t)2 * DB * 16 * 64 * 128;
constexpr size_t O_PS = O_CS + (size_t)2 * DB * 3 * 1536;
constexpr size_t O_GS = O_PS + (size_t)2 * DB * 15 * 1024;
constexpr size_t O_END = O_GS + (size_t)2 * MSR * 1024;
static_assert(O_END == 29571072, "output size");

constexpr size_t al256(size_t x) { return (x + 255) & ~(size_t)255; }
constexpr size_t WS_CTL = 0;
constexpr size_t WS_X = 1u << 20;
constexpr size_t WS_XB = WS_X + al256((size_t)MP * DM * 4);
constexpr size_t WS_H = WS_XB + al256((size_t)MP * DM * 2);
constexpr size_t WS_AO = WS_H + al256((size_t)MP * HC_AB * 4);
constexpr size_t WS_HF = WS_AO + al256((size_t)MP * DM * 2);
constexpr size_t WS_SC = WS_HF + al256((size_t)MP * DFF * 2);
constexpr size_t WS_MASK = WS_SC + al256((size_t)MPR * SEQ * 4);
constexpr size_t WS_XC = WS_MASK + al256((size_t)MPR * 64 * 8);
constexpr size_t WS_DT = WS_XC + al256((size_t)MP * 1536 * 4);
constexpr size_t WS_Y = WS_DT + al256((size_t)MP * 16 * 4);
constexpr size_t WS_SCS = WS_Y + al256((size_t)MP * 1024 * 4);
constexpr size_t WS_SELS = WS_SCS + al256((size_t)MSR * SCS_LD * 4);
constexpr size_t WS_DD = WS_SELS + al256((size_t)MSR * TOPK * 4);
constexpr size_t WS_U = WS_DD + al256((size_t)MP * 1024 * 2);
constexpr size_t WS_VLN = WS_U + al256((size_t)MP * 1024 * 2);
constexpr size_t WS_WINAB = WS_VLN + al256((size_t)MP * 1024 * 2);
constexpr size_t WS_WOUTAB = WS_WINAB + (size_t)2 * HC_AB * DM * 2;
constexpr size_t WS_WINCD = WS_WOUTAB + (size_t)2 * DM * DM * 2;
constexpr size_t WS_WOUTCD = WS_WINCD + (size_t)2 * HC_CD * DM * 2;
constexpr size_t WS_WFF1 = WS_WOUTCD + (size_t)2 * DM * DM * 2;
constexpr size_t WS_WFF2 = WS_WFF1 + (size_t)4 * DFF * DM * 2;
constexpr size_t WS_POOLW = WS_WFF2 + (size_t)4 * DFF * DM * 2;
constexpr size_t WS_SGUW = WS_POOLW + (size_t)2 * 4 * 256 * 256 * 2;
constexpr size_t WS_XCN = WS_SGUW + (size_t)2 * 4 * 128 * 128 * 2;
constexpr size_t WS_XCT = WS_XCN + al256((size_t)MP * 1536 * 2);
constexpr size_t WS_ACUM = WS_XCT + al256((size_t)64 * 1536 * 128 * 2);
constexpr size_t WS_DTC = WS_ACUM + al256((size_t)64 * 16 * 128 * 4);
constexpr size_t WS_CDEC = WS_DTC + al256((size_t)64 * 16 * 128 * 4);
constexpr size_t WS_ST = WS_CDEC + al256((size_t)64 * 16 * 4);
constexpr size_t WS_HIN = WS_ST + al256((size_t)64 * 16 * 64 * 128 * 4);
constexpr size_t WS_QB = WS_HIN + al256((size_t)64 * 16 * 64 * 128 * 2);
constexpr size_t WS_KB = WS_QB + al256((size_t)MPR * 1024 * 2);
constexpr size_t WS_VB = WS_KB + al256((size_t)MPR * 256 * 2);
constexpr size_t WS_QIB = WS_VB + al256((size_t)MPR * 256 * 2);
constexpr size_t WS_KIB = WS_QIB + al256((size_t)MPR * 512 * 2);
constexpr size_t WS_END = WS_KIB + al256((size_t)MPR * 64 * 2);

struct P {
    const float *x_prompt, *x_sample, *cache_k, *cache_v, *cache_ik, *state_ssm, *state_conv, *state_pool;
    const int* page_table;
    const float *ln1_g, *ln1_b, *ln2_g, *ln2_b, *w_in_ab, *conv_w, *conv_b, *dt_bias, *a_log, *d_skip, *ssd_g, *w_out_ab;
    const float *w_in_cd, *pool_w, *pool_scale, *sgu_ln_g, *sgu_ln_b, *sgu_w, *sgu_b, *w_out_cd, *w_ff1, *w_ff2;
    float* out;
    unsigned char* ws;
    int ph_lo, ph_hi, a2, a3;
};
typedef const __attribute__((address_space(4))) P* CP;
DEVI CP PP() { CP q = (CP)__builtin_amdgcn_kernarg_segment_ptr(); asm volatile("" : "+s"(q)); return q; }
DEVI float* wsf(CP p, size_t off) { return (float*)(p->ws + off); }
DEVI bf16* wsb(CP p, size_t off) { return (bf16*)(p->ws + off); }

DEVI float bf2f(bf16 b) { return __uint_as_float(((unsigned)b) << 16); }
DEVI bf16 f2bf(float f) { unsigned u = __float_as_uint(f); u += 0x7fffu + ((u >> 16) & 1u); return (bf16)(u >> 16); }
DEVI unsigned pk2(float lo, float hi) { return (unsigned)f2bf(lo) | ((unsigned)f2bf(hi) << 16); }
DEVI float wave_sum(float v) {
#pragma unroll
    for (int o = 1; o < 64; o <<= 1) v += __shfl_xor(v, o);
    return v;
}
DEVI int ltid() { int t = threadIdx.x; asm volatile("" : "+v"(t)); return t; }
DEVI int lvb() { int b = blockIdx.x; asm volatile("" : "+s"(b)); return b; }
DEVI float silu_f(float x) { return x / (1.f + __expf(-x)); }
DEVI float softplus_f(float x) { return fmaxf(x, 0.f) + log1pf(__expf(-fabsf(x))); }
DEVI float gelu_f(float x) { return 0.5f * x * (1.f + erff(x * 0.70710678118654752f)); }
DEVI unsigned ord_f(float f) { f = f + 0.0f; unsigned u = __float_as_uint(f); return (u & 0x80000000u) ? ~u : (u | 0x80000000u); }
__host__ __device__ inline int ab_dst_col(int n) {
    if (n < 2048) return n;
    if (n < 2112) return C_KI + (n - 2048);
    if (n < 2120) return C_WI + (n - 2112);
    if (n < 3144) return C_Z + (n - 2120);
    if (n < 4680) return C_XBC + (n - 3144);
    return n;
}

DEVI void transpose_unit(const float* W, int K, int N, bf16* WT, int abmap, int unit, float* t  ) {
    const int TIDX = ltid();
    const int nbn = (N + 63) / 64, kb = unit / nbn, nb = unit % nbn, k0 = kb * 64, n0 = nb * 64, tid = TIDX;
#pragma unroll
    for (int i = 0; i < 8; ++i) { const int kk = (tid >> 6) + 8 * i, n = n0 + (tid & 63); t[kk * 65 + (tid & 63)] = (n < N) ? W[(size_t)(k0 + kk) * N + n] : 0.f; }
    __syncthreads();
    { const int n = n0 + (tid >> 3), kq = (tid & 7) * 8;
      if (n < N) { const int row = abmap ? ab_dst_col(n) : n; const float* s = t + kq * 65 + (tid >> 3);
          u32x4 o; o.x = pk2(s[0], s[65]); o.y = pk2(s[2 * 65], s[3 * 65]); o.z = pk2(s[4 * 65], s[5 * 65]); o.w = pk2(s[6 * 65], s[7 * 65]);
          *(u32x4*)(WT + (size_t)row * K + k0 + kq) = o; } }
    __syncthreads();
}


DEVI void ph_ln(CP p, const float* g, const float* b, int final_out, int vb, int nvb) {
    const int TIDX = ltid();
    float* X = wsf(p, WS_X); bf16* XB = wsb(p, WS_XB);
    const int lane = TIDX & 63, wv = TIDX >> 6;
    for (int row = vb * 8 + wv; row < MR; row += nvb * 8) {
        float* xr = X + (size_t)row * DM; f32x4 v[8]; float s = 0.f;
#pragma unroll
        for (int i = 0; i < 8; ++i) { v[i] = *(const f32x4*)(xr + (i * 64 + lane) * 4); s += (v[i].x + v[i].y) + (v[i].z + v[i].w); }
        const float mean = wave_sum(s) * (1.f / DM); float q = 0.f;
#pragma unroll
        for (int i = 0; i < 8; ++i) { v[i] = v[i] - mean; q += (v[i].x * v[i].x + v[i].y * v[i].y) + (v[i].z * v[i].z + v[i].w * v[i].w); }
        const float rstd = 1.f / sqrtf(wave_sum(q) * (1.f / DM) + EPS);
        float* o = final_out ? (row < MPR ? p->out + O_YP + (size_t)row * DM : p->out + O_YS + (size_t)(row - MPR) * DM) : nullptr;
#pragma unroll
        for (int i = 0; i < 8; ++i) { const int c = (i * 64 + lane) * 4; const f32x4 gg = *(const f32x4*)(g + c), bb = *(const f32x4*)(b + c);
            const f32x4 y = v[i] * rstd * gg + bb; *(f32x4*)(xr + c) = y; uint2 w; w.x = pk2(y.x, y.y); w.y = pk2(y.z, y.w); *(uint2*)(XB + (size_t)row * DM + c) = w;
            if (final_out) *(f32x4*)(o + c) = y; }
    }
}

DEVI void ph_ab_copy(CP p, int j, int vb, int nvb) {
    const int TIDX = ltid();
    const float* H = wsf(p, WS_H); const int tid = TIDX;
    for (int row = vb; row < MR; row += nvb) {
        const float* h = H + (size_t)row * HC_AB;
        float *ko, *vo, *io;
        if (row < MPR) { ko = p->out + O_KP + ((size_t)j * MPR + row) * 256; vo = p->out + O_VP + ((size_t)j * MPR + row) * 256; io = p->out + O_IP + ((size_t)j * MPR + row) * 64; }
        else { const int sr = row - MPR; ko = p->out + O_KS + ((size_t)j * MSR + sr) * 256; vo = p->out + O_VS + ((size_t)j * MSR + sr) * 256; io = p->out + O_IS + ((size_t)j * MSR + sr) * 64; }
        if (tid < 256) ko[tid] = h[C_K + tid]; else vo[tid - 256] = h[C_V + tid - 256];
        if (row < MPR) { const float qs = ATT_SCALE * 1.4426950408889634f;
            *(unsigned*)(wsb(p, WS_QB) + (size_t)row * 1024 + 2 * tid) = cvtpk(h[C_Q + 2 * tid] * qs, h[C_Q + 2 * tid + 1] * qs);
            if (tid < 128) *(unsigned*)(wsb(p, WS_KB) + (size_t)row * 256 + 2 * tid) = cvtpk(h[C_K + 2 * tid], h[C_K + 2 * tid + 1]);
            else if (tid < 256) *(unsigned*)(wsb(p, WS_VB) + (size_t)row * 256 + 2 * (tid - 128)) = cvtpk(h[C_V + 2 * (tid - 128)], h[C_V + 2 * (tid - 128) + 1]);
            else if (tid < 512) *(unsigned*)(wsb(p, WS_QIB) + (size_t)row * 512 + 2 * (tid - 256)) = cvtpk(h[C_QI + 2 * (tid - 256)], h[C_QI + 2 * (tid - 256) + 1]);
            if (tid < 32) *(unsigned*)(wsb(p, WS_KIB) + (size_t)row * 64 + 2 * tid) = cvtpk(h[C_KI + 2 * tid], h[C_KI + 2 * tid + 1]); }
        if (tid < 64) io[tid] = h[C_KI + tid];
        int ci = -1; float* co = nullptr;
        if (row < MPR) { const int b = row / SEQ, t = row % SEQ; if (t >= SEQ - 3) { ci = t - (SEQ - 3); co = p->out + O_CP + (((size_t)j * NBP + b) * 3 + ci) * 1536; } }
        else { const int b = (row - MPR) / DS, t = (row - MPR) % DS; if (t >= DS - 3) { ci = t - (DS - 3); co = p->out + O_CS + (((size_t)j * DB + b) * 3 + ci) * 1536; } }
        if (ci >= 0) for (int c = tid; c < 1536; c += 512) co[c] = h[C_XBC + c];
    }
}

DEVI void ph_conv(CP p, int j, int vb, int nvb) {
    const int TIDX = ltid();
    const float* H = wsf(p, WS_H); float* XC = wsf(p, WS_XC); float* DT = wsf(p, WS_DT);
    const float* cw = p->conv_w + (size_t)j * 4 * 1536; const float* cb = p->conv_b + (size_t)j * 1536;
#ifdef EXP_OLDY
    for (int row = vb; row < MR; row += nvb) {
#else
    for (int row = MPR + vb; row < MR; row += nvb) {
#endif
        const bool pr = row < MPR; const int b = pr ? row / SEQ : (row - MPR) / DS, t = pr ? row % SEQ : (row - MPR) % DS;
        for (int c = TIDX; c < 1536; c += 512) {
            float acc = cb[c];
#pragma unroll
            for (int jj = 0; jj < 4; ++jj) { const int tt = t - 3 + jj; float xv;
                if (tt >= 0) xv = H[(size_t)(row - t + tt) * HC_AB + C_XBC + c];
                else xv = pr ? 0.f : p->state_conv[(((size_t)j * DB + b) * 3 + (3 + tt)) * 1536 + c];
                acc += cw[jj * 1536 + c] * xv; }
            XC[(size_t)row * 1536 + c] = silu_f(acc);
        }
        if (TIDX < 16) DT[row * 16 + TIDX] = softplus_f(H[(size_t)row * HC_AB + C_DT + TIDX] + p->dt_bias[j * 16 + TIDX]);
    }
}

DEVI void ssd_seq_unit(CP p, int j, int sq  , int h, int ph, int lane) {
    const float* XC = wsf(p, WS_XC); const float* DT = wsf(p, WS_DT); float* Y = wsf(p, WS_Y);
    const bool pr = sq < NBP; const int b = pr ? sq : sq - NBP, n = pr ? SEQ : DS, row0 = pr ? b * SEQ : MPR + b * DS, g = h >> 3;
    const int pp = ph * 32 + (lane & 31), nh = lane >> 5;
    const float a = -__expf(p->a_log[j * 16 + h]), Dk = p->d_skip[j * 16 + h];
    float st[64];
    if (pr) {
#pragma unroll
        for (int i = 0; i < 64; ++i) st[i] = 0.f;
    } else { const float* h0 = p->state_ssm + ((((size_t)j * DB + b) * 16 + h) * 64 + pp) * 128 + nh * 64;
#pragma unroll
        for (int i = 0; i < 16; ++i) { const f32x4 v = *(const f32x4*)(h0 + 4 * i); st[4 * i] = v.x; st[4 * i + 1] = v.y; st[4 * i + 2] = v.z; st[4 * i + 3] = v.w; } }
    for (int t = 0; t < n; ++t) {
        const int row = row0 + t; const float dt = DT[row * 16 + h], dA = __expf(dt * a), x = XC[(size_t)row * 1536 + h * 64 + pp], cf = dt * x;
        const float* Bp = XC + (size_t)row * 1536 + 1024 + g * 128 + nh * 64; const float* Cp = Bp + 256;
        float y = 0.f;
#pragma unroll
        for (int i = 0; i < 16; ++i) { if ((i & 7) == 0) asm volatile("" ::: "memory");
            const f32x4 bv = *(const f32x4*)(Bp + 4 * i), cv = *(const f32x4*)(Cp + 4 * i);
            st[4 * i] = st[4 * i] * dA + cf * bv.x; st[4 * i + 1] = st[4 * i + 1] * dA + cf * bv.y; st[4 * i + 2] = st[4 * i + 2] * dA + cf * bv.z; st[4 * i + 3] = st[4 * i + 3] * dA + cf * bv.w;
            y += cv.x * st[4 * i] + cv.y * st[4 * i + 1] + cv.z * st[4 * i + 2] + cv.w * st[4 * i + 3]; }
        y += __shfl_xor(y, 32);
        if (nh == 0) Y[(size_t)row * 1024 + h * 64 + pp] = y + Dk * x;
    }
#ifdef EXP_OLDY
    if (pr) return;
#endif
    float* ho = (pr ? p->out + O_HP + ((((size_t)j * NBP + b) * 16 + h) * 64 + pp) * 128 : p->out + O_HS + ((((size_t)j * DB + b) * 16 + h) * 64 + pp) * 128) + nh * 64;
#pragma unroll
    for (int i = 0; i < 16; ++i) *(f32x4*)(ho + 4 * i) = (f32x4){st[4 * i], st[4 * i + 1], st[4 * i + 2], st[4 * i + 3]};
}

DEVI void conv_prompt_unit(CP p, int j, int ck, int cb, bf16* T  ) {
    const int tid = ltid(), ch = tid & 63, sg = tid >> 6;
    const float* H = wsf(p, WS_H); bf16* XCN = wsb(p, WS_XCN); bf16* XCT = wsb(p, WS_XCT);
    const int row0 = ck * 128, col = cb * 64 + ch, s0 = sg * 16;
    const float* cw = p->conv_w + (size_t)j * 4 * 1536 + col; const float w0 = cw[0], w1 = cw[1536], w2 = cw[2 * 1536], w3 = cw[3 * 1536], bias = p->conv_b[(size_t)j * 1536 + col];
    const float* hp = H + (size_t)(row0 + s0) * HC_AB + C_XBC + col;
    const bool first = ((ck & 31) == 0) && (sg == 0);
    float x0 = first ? 0.f : hp[-3 * HC_AB], x1 = first ? 0.f : hp[-2 * HC_AB], x2 = first ? 0.f : hp[-HC_AB];
#pragma unroll 4
    for (int i = 0; i < 16; ++i) { const float x3 = hp[(size_t)i * HC_AB]; const bf16 v = f2bf(silu_f(bias + w0 * x0 + w1 * x1 + w2 * x2 + w3 * x3));
        XCN[(size_t)(row0 + s0 + i) * 1536 + col] = v; T[ch * 136 + s0 + i] = v; x0 = x1; x1 = x2; x2 = x3; }
    if (cb == 0) for (int idx = tid; idx < 128 * 16; idx += 512) { const int s = idx >> 4, hh = idx & 15;
        wsf(p, WS_DT)[(row0 + s) * 16 + hh] = softplus_f(H[(size_t)(row0 + s) * HC_AB + C_DT + hh] + p->dt_bias[j * 16 + hh]); }
    __syncthreads();
    { const int chh = tid >> 3, sq = (tid & 7) * 16; const u32x4 a = *(const u32x4*)(T + chh * 136 + sq), b = *(const u32x4*)(T + chh * 136 + sq + 8);
      bf16* dst = XCT + ((size_t)ck * 1536 + cb * 64 + chh) * 128 + sq; *(u32x4*)dst = a; *(u32x4*)(dst + 8) = b; }
    __syncthreads();
}
DEVI void ssd1_unit(CP p, int j, int ck, int h, float* sm  ) {
    const int tid = ltid(), lane = tid & 63, wv = tid >> 6, fr = lane & 15, fq = lane >> 4, g = h >> 3;
    if (wv == 0) {
        const float* DT = wsf(p, WS_DT) + (size_t)ck * 128 * 16 + h; const float a = -__expf(p->a_log[j * 16 + h]);
        float* ACUM = wsf(p, WS_ACUM) + ((size_t)ck * 16 + h) * 128; float* DTC = wsf(p, WS_DTC) + ((size_t)ck * 16 + h) * 128;
        const float d0 = DT[(2 * lane) * 16], d1 = DT[(2 * lane + 1) * 16], v0 = d0 * a, v1 = v0 + d1 * a;
        float run = v1;
#pragma unroll
        for (int o = 1; o < 64; o <<= 1) { const float t = __shfl_up(run, o); if (lane >= o) run += t; }
        const float ex = run - v1, a0 = ex + v0, a1 = ex + v1, last = __shfl(run, 63);
        sm[2 * lane] = a0; sm[2 * lane + 1] = a1; ACUM[2 * lane] = a0; ACUM[2 * lane + 1] = a1; DTC[2 * lane] = d0; DTC[2 * lane + 1] = d1;
        sm[128 + 2 * lane] = d0 * __expf(last - a0); sm[128 + 2 * lane + 1] = d1 * __expf(last - a1);
        if (lane == 0) wsf(p, WS_CDEC)[ck * 16 + h] = __expf(last);
    }
    __syncthreads();
    const bf16* XCT = wsb(p, WS_XCT) + (size_t)ck * 1536 * 128;
    const bf16* Btp = XCT + (size_t)(1024 + g * 128 + wv * 16 + fr) * 128 + fq * 8;
    const bf16* xp = XCT + (size_t)(h * 64 + fr) * 128 + fq * 8;
    f32x4 acc[4];
#pragma unroll
    for (int pt = 0; pt < 4; ++pt) acc[pt] = (f32x4){0.f, 0.f, 0.f, 0.f};
#pragma unroll
    for (int k = 0; k < 4; ++k) {
        const bf16x8 bfrag = *(const bf16x8*)(Btp + k * 32);
        const f32x4 wa = *(const f32x4*)(sm + 128 + k * 32 + fq * 8), wb = *(const f32x4*)(sm + 128 + k * 32 + fq * 8 + 4);
#pragma unroll
        for (int pt = 0; pt < 4; ++pt) { const u32x4 xv = *(const u32x4*)(xp + (size_t)pt * 16 * 128 + k * 32);
            u32x4 sv; sv.x = cvtpk(bflo(xv.x) * wa.x, bfhi(xv.x) * wa.y); sv.y = cvtpk(bflo(xv.y) * wa.z, bfhi(xv.y) * wa.w); sv.z = cvtpk(bflo(xv.z) * wb.x, bfhi(xv.z) * wb.y); sv.w = cvtpk(bflo(xv.w) * wb.z, bfhi(xv.w) * wb.w);
            acc[pt] = mfma16(bfrag, __builtin_bit_cast(bf16x8, sv), acc[pt]); }
    }
    float* ST = wsf(p, WS_ST) + ((size_t)ck * 16 + h) * 8192;
#pragma unroll
    for (int pt = 0; pt < 4; ++pt) *(f32x4*)(ST + (size_t)(pt * 16 + fr) * 128 + wv * 16 + fq * 4) = acc[pt];
    __syncthreads();
}
DEVI void ph_ssd_scan(CP p, int j, int vb, int nvb) {
    const float* ST = wsf(p, WS_ST); const float* CDEC = wsf(p, WS_CDEC); bf16* HIN = wsb(p, WS_HIN);
    const int tid = ltid();
    for (int e4 = vb * 512 + tid; e4 < NBP * 16 * 64 * 128 / 4; e4 += nvb * 512) {
        const int b = e4 / (16 * 64 * 32), r = e4 % (16 * 64 * 32), h = r / (64 * 32);
        f32x4 st = (f32x4){0.f, 0.f, 0.f, 0.f};
#pragma unroll 8
        for (int c = 0; c < 32; ++c) { const int ck = b * 32 + c; const size_t off = (size_t)ck * 16 * 8192 + (size_t)r * 4;
            u32x2 o; o.x = cvtpk(st.x, st.y); o.y = cvtpk(st.z, st.w); *(u32x2*)(HIN + off) = o;
            const f32x4 sv = *(const f32x4*)(ST + off); const float d = CDEC[ck * 16 + h]; st = st * d + sv; }
        *(f32x4*)(p->out + O_HP + ((size_t)j * NBP + b) * 16 * 8192 + (size_t)r * 4) = st;
    }
}
DEVI void ssd3_unit(CP p, int j, int ck, int tt, float* red  , bf16* AO) {
    const int tid = ltid(), lane = tid & 63, wv = tid >> 6, fr = lane & 15, fq = lane >> 4, g = wv >> 2;
    const int t0 = tt * 16; const size_t row = (size_t)ck * 128 + t0 + fr;
    const bf16* XCN = wsb(p, WS_XCN); const bf16* XCT = wsb(p, WS_XCT) + (size_t)ck * 1536 * 128; const float* H = wsf(p, WS_H);
    bf16x8 cf[4];
#pragma unroll
    for (int k = 0; k < 4; ++k) cf[k] = *(const bf16x8*)(XCN + row * 1536 + 1280 + g * 128 + k * 32 + fq * 8);
    f32x4 cbt[8];
#pragma unroll
    for (int jt = 0; jt < 8; ++jt) { cbt[jt] = (f32x4){0.f, 0.f, 0.f, 0.f};
        if (jt <= tt) { const bf16* bp = XCN + ((size_t)ck * 128 + jt * 16 + fr) * 1536 + 1024 + g * 128 + fq * 8;
#pragma unroll
            for (int k = 0; k < 4; ++k) cbt[jt] = mfma16(*(const bf16x8*)(bp + k * 32), cf[k], cbt[jt]); } }
    f32x4 yv[2][4]; float ss = 0.f;
#pragma unroll
    for (int hh = 0; hh < 2; ++hh) {
        const int h = 2 * wv + hh;
        const float* AC = wsf(p, WS_ACUM) + ((size_t)ck * 16 + h) * 128; const float* DC = wsf(p, WS_DTC) + ((size_t)ck * 16 + h) * 128;
        const float at = AC[t0 + fr], Dk = p->d_skip[j * 16 + h];
        f32x4 yd[4];
#pragma unroll
        for (int pt = 0; pt < 4; ++pt) yd[pt] = (f32x4){0.f, 0.f, 0.f, 0.f};
#pragma unroll
        for (int q = 0; q < 4; ++q) if (2 * q <= tt) {
            const int sa = 2 * q * 16 + 4 * fq, sb = sa + 16;
            const f32x4 aa = *(const f32x4*)(AC + sa), da = *(const f32x4*)(DC + sa), ab = *(const f32x4*)(AC + sb), db = *(const f32x4*)(DC + sb);
            float la[4], lb[4];
#pragma unroll
            for (int i = 0; i < 4; ++i) { la[i] = (sa + i <= t0 + fr) ? cbt[2 * q][i] * __expf(fminf(at - aa[i], 0.f)) * da[i] : 0.f;
                                          lb[i] = (2 * q + 1 <= tt && sb + i <= t0 + fr) ? cbt[2 * q + 1][i] * __expf(fminf(at - ab[i], 0.f)) * db[i] : 0.f; }
            u32x4 lw; lw.x = cvtpk(la[0], la[1]); lw.y = cvtpk(la[2], la[3]); lw.z = cvtpk(lb[0], lb[1]); lw.w = cvtpk(lb[2], lb[3]);
            const bf16x8 lf = __builtin_bit_cast(bf16x8, lw);
#pragma unroll
            for (int pt = 0; pt < 4; ++pt) { const bf16* xq = XCT + (size_t)(h * 64 + pt * 16 + fr) * 128;
                const u32x2 xa = *(const u32x2*)(xq + sa), xb = *(const u32x2*)(xq + sb); u32x4 xw; xw.x = xa.x; xw.y = xa.y; xw.z = xb.x; xw.w = xb.y;
                yd[pt] = mfma16(__builtin_bit_cast(bf16x8, xw), lf, yd[pt]); }
        }
        const bf16* hq = wsb(p, WS_HIN) + ((size_t)ck * 16 + h) * 8192 + (size_t)fr * 128 + fq * 8; const float eat = __expf(at);
#pragma unroll
        for (int pt = 0; pt < 4; ++pt) { f32x4 of = (f32x4){0.f, 0.f, 0.f, 0.f};
#pragma unroll
            for (int k = 0; k < 4; ++k) of = mfma16(*(const bf16x8*)(hq + (size_t)pt * 16 * 128 + k * 32), cf[k], of);
            const int c0 = h * 64 + pt * 16 + 4 * fq;
            const u32x2 xw = *(const u32x2*)(XCN + row * 1536 + c0); const f32x4 z = *(const f32x4*)(H + row * HC_AB + C_Z + c0);
            f32x4 y = yd[pt] + of * eat;
            y.x += Dk * bflo(xw.x); y.y += Dk * bfhi(xw.x); y.z += Dk * bflo(xw.y); y.w += Dk * bfhi(xw.y);
            y.x *= silu_f(z.x); y.y *= silu_f(z.y); y.z *= silu_f(z.z); y.w *= silu_f(z.w);
            ss += (y.x * y.x + y.y * y.y) + (y.z * y.z + y.w * y.w); yv[hh][pt] = y; }
    }
    ss += __shfl_xor(ss, 16); ss += __shfl_xor(ss, 32);
    if (fq == 0) red[wv * 16 + fr] = ss;
    __syncthreads();
    float tot = 0.f;
#pragma unroll
    for (int w = 0; w < 8; ++w) tot += red[w * 16 + fr];
    const float rs = 1.f / sqrtf(tot * (1.f / 1024.f) + EPS);
    const float* gg = p->ssd_g + (size_t)j * 1024;
#pragma unroll
    for (int hh = 0; hh < 2; ++hh)
#pragma unroll
        for (int pt = 0; pt < 4; ++pt) { const int c0 = (2 * wv + hh) * 64 + pt * 16 + 4 * fq; const f32x4 gv = *(const f32x4*)(gg + c0); const f32x4 o = yv[hh][pt] * rs * gv;
            u32x2 w; w.x = cvtpk(o.x, o.y); w.y = cvtpk(o.z, o.w); *(u32x2*)(AO + row * DM + 1024 + c0) = w; }
    __syncthreads();
}

DEVI void ph_ssd_gate(CP p, int j, int vb, int nvb) {
    const int TIDX = ltid();
    const float* H = wsf(p, WS_H); const float* Y = wsf(p, WS_Y); bf16* AO = wsb(p, WS_AO); const float* g = p->ssd_g + (size_t)j * 1024;
    const int lane = TIDX & 63, wv = TIDX >> 6;
#ifdef EXP_OLDY
    for (int row = vb * 8 + wv; row < MR; row += nvb * 8) {
#else
    for (int row = MPR + vb * 8 + wv; row < MR; row += nvb * 8) {
#endif
        f32x4 v[4]; float q = 0.f;
#pragma unroll
        for (int i = 0; i < 4; ++i) { const int c = (i * 64 + lane) * 4; const f32x4 y = *(const f32x4*)(Y + (size_t)row * 1024 + c), z = *(const f32x4*)(H + (size_t)row * HC_AB + C_Z + c);
            v[i] = (f32x4){y.x * silu_f(z.x), y.y * silu_f(z.y), y.z * silu_f(z.z), y.w * silu_f(z.w)}; q += (v[i].x * v[i].x + v[i].y * v[i].y) + (v[i].z * v[i].z + v[i].w * v[i].w); }
        const float rs = 1.f / sqrtf(wave_sum(q) * (1.f / 1024.f) + EPS);
#pragma unroll
        for (int i = 0; i < 4; ++i) { const int c = (i * 64 + lane) * 4; const f32x4 gg = *(const f32x4*)(g + c); const f32x4 o = v[i] * rs * gg;
            uint2 w; w.x = pk2(o.x, o.y); w.y = pk2(o.z, o.w); *(uint2*)(AO + (size_t)row * DM + 1024 + c) = w; }
    }
}

DEVI void ph_idx_prompt_naive(CP p, int vb, int nvb, float* sm) {
    const int TIDX = ltid();
    const float* H = wsf(p, WS_H); float* SC = wsf(p, WS_SC);
    const int half = TIDX >> 8, tid = TIDX & 255; float* sq = sm + half * 520; float* sw = sq + 512;
    for (int row0 = vb * 2; row0 < MPR; row0 += nvb * 2) {
        const int row = row0 + half, b = row / SEQ, t = row % SEQ;
        sq[tid] = H[(size_t)row * HC_AB + C_QI + tid]; sq[tid + 256] = H[(size_t)row * HC_AB + C_QI + 256 + tid]; if (tid < 8) sw[tid] = H[(size_t)row * HC_AB + C_WI + tid];
        __syncthreads();
        for (int s = tid; s <= t; s += 256) {
            const float* kr = H + (size_t)(b * SEQ + s) * HC_AB + C_KI; float k[64];
#pragma unroll
            for (int i = 0; i < 16; ++i) { const f32x4 v = *(const f32x4*)(kr + 4 * i); k[4 * i] = v.x; k[4 * i + 1] = v.y; k[4 * i + 2] = v.z; k[4 * i + 3] = v.w; }
            float sc = 0.f;
#pragma unroll 1
            for (int h = 0; h < 8; ++h) { float d = 0.f;
#pragma unroll
                for (int i = 0; i < 64; ++i) d += sq[h * 64 + i] * k[i];
                sc += sw[h] * fmaxf(d, 0.f); }
            SC[(size_t)row * SEQ + s] = sc * IDX_SCALE;
        }
        __syncthreads();
    }
}

DEVI void idx_wave_unit(CP p, int b, int qt, int kc, int lane) {
    const int fr = lane & 15, fq = lane >> 4; const size_t row = (size_t)b * SEQ + qt * 16 + fr;
    const bf16* QIB = wsb(p, WS_QIB) + row * 512 + fq * 8; const float* H = wsf(p, WS_H); float* SC = wsf(p, WS_SC) + row * SEQ + 4 * fq;
    bf16x8 qf[8][2]; float wi[8];
#pragma unroll
    for (int h = 0; h < 8; ++h) { qf[h][0] = *(const bf16x8*)(QIB + h * 64); qf[h][1] = *(const bf16x8*)(QIB + h * 64 + 32); wi[h] = H[row * HC_AB + C_WI + h] * IDX_SCALE; }
    const int kt0 = kc * 64, kt1 = (qt < kt0 + 63) ? qt : kt0 + 63;
    const bf16* kp = wsb(p, WS_KIB) + ((size_t)b * SEQ + fr) * 64 + fq * 8;
    bf16x8 k0 = *(const bf16x8*)(kp + (size_t)kt0 * 16 * 64), k1 = *(const bf16x8*)(kp + (size_t)kt0 * 16 * 64 + 32);
    for (int kt = kt0; kt <= kt1; ++kt) {
        const bf16x8 c0 = k0, c1 = k1;
        if (kt < kt1) { k0 = *(const bf16x8*)(kp + (size_t)(kt + 1) * 16 * 64); k1 = *(const bf16x8*)(kp + (size_t)(kt + 1) * 16 * 64 + 32); }
        f32x4 d[8];
#pragma unroll
        for (int h = 0; h < 8; ++h) { d[h] = mfma16(c0, qf[h][0], (f32x4){0.f, 0.f, 0.f, 0.f}); d[h] = mfma16(c1, qf[h][1], d[h]); }
        f32x4 sc = (f32x4){0.f, 0.f, 0.f, 0.f};
#pragma unroll
        for (int h = 0; h < 8; ++h) { sc.x += wi[h] * fmaxf(d[h].x, 0.f); sc.y += wi[h] * fmaxf(d[h].y, 0.f); sc.z += wi[h] * fmaxf(d[h].z, 0.f); sc.w += wi[h] * fmaxf(d[h].w, 0.f); }
        *(f32x4*)(SC + kt * 16) = sc;
    }
}
DEVI void ph_idx_prompt(CP p, int vb, int nvb) {
    const int tid = ltid(), lane = tid & 63, wv = tid >> 6;
    for (int gw = wv * nvb + vb; gw < 2 * 640; gw += 8 * nvb) { const int b = gw / 640, u = gw % 640; int kc, qt;
        if (u < 256) { kc = 0; qt = u; } else if (u < 448) { kc = 1; qt = 64 + (u - 256); } else if (u < 576) { kc = 2; qt = 128 + (u - 448); } else { kc = 3; qt = 192 + (u - 576); }
        idx_wave_unit(p, b, qt, kc, lane); }
}

DEVI void select_prompt_row(const float* SC, unsigned long long* MASK, int row, int lane) {
    const int t = row % SEQ, nk = t + 1; const float* sc = SC + (size_t)row * SEQ;
    unsigned v[64];
#pragma unroll
    for (int jj = 0; jj < 64; ++jj) { const int key = jj * 64 + lane; v[jj] = key < nk ? ord_f(sc[key]) : 0u; }
    unsigned long long mine = 0ull;
    if (nk <= TOPK) {
#pragma unroll
        for (int jj = 0; jj < 64; ++jj) { const unsigned long long m = __ballot(jj * 64 + lane < nk); if (lane == jj) mine = m; }
    } else {
        unsigned T = 0u;
        for (int bit = 31; bit >= 0; --bit) { const unsigned cand = T | (1u << bit); int cnt = 0;
#pragma unroll
            for (int jj = 0; jj < 64; ++jj) cnt += __popcll(__ballot(v[jj] >= cand));
            if (cnt >= TOPK) T = cand; if (cnt == TOPK) break; }
        int cgt = 0;
#pragma unroll
        for (int jj = 0; jj < 64; ++jj) cgt += __popcll(__ballot(v[jj] > T));
        const int need = TOPK - cgt; int run = 0; const unsigned long long lt = (1ull << lane) - 1ull;
#pragma unroll
        for (int jj = 0; jj < 64; ++jj) { const bool eq = v[jj] == T; const unsigned long long me = __ballot(eq); const int pre = run + __popcll(me & lt);
            const bool sel = (v[jj] > T) || (eq && pre < need); run += __popcll(me); const unsigned long long m = __ballot(sel); if (lane == jj) mine = m; }
    }
    MASK[((size_t)(row >> 5) * 64 + lane) * 32 + (row & 31)] = mine;
}
DEVI void ph_select_prompt(CP p, int vb, int nvb) {
    const int TIDX = ltid();
    const int lane = TIDX & 63, wv = TIDX >> 6;
    for (int row = vb * 8 + wv; row < MPR; row += nvb * 8) select_prompt_row(wsf(p, WS_SC), (unsigned long long*)(p->ws + WS_MASK), row, lane);
}

DEVI void ph_attn_prompt_naive(CP p, int vb, int nvb) {
    const int TIDX = ltid();
    const float* H = wsf(p, WS_H); const unsigned long long* MASK = (const unsigned long long*)(p->ws + WS_MASK); bf16* AO = wsb(p, WS_AO);
    const int h = TIDX >> 6, lane = TIDX & 63, g = h >> 2;
    for (int row = vb; row < MPR; row += nvb) {
        const int b = row / SEQ, t = row % SEQ;
        const float q0 = H[(size_t)row * HC_AB + C_Q + h * 128 + lane], q1 = H[(size_t)row * HC_AB + C_Q + h * 128 + 64 + lane];
        float m = -1e30f, l = 0.f, o0 = 0.f, o1 = 0.f;
        for (int jt = 0; jt <= t / 64; ++jt) {
            unsigned long long w = MASK[((size_t)(row >> 5) * 64 + jt) * 32 + (row & 31)];
            while (w) { const int bit = __builtin_ctzll(w); w &= w - 1ull; const int s = jt * 64 + bit;
                const float* kr = H + (size_t)(b * SEQ + s) * HC_AB + C_K + g * 128; const float* vr = H + (size_t)(b * SEQ + s) * HC_AB + C_V + g * 128;
                const float lg = wave_sum(q0 * kr[lane] + q1 * kr[lane + 64]) * ATT_SCALE;
                const float mn = fmaxf(m, lg), al = __expf(m - mn), pe = __expf(lg - mn);
                l = l * al + pe; o0 = o0 * al + pe * vr[lane]; o1 = o1 * al + pe * vr[lane + 64]; m = mn; }
        }
        const float il = 1.f / l;
        AO[(size_t)row * DM + h * 128 + lane] = f2bf(o0 * il); AO[(size_t)row * DM + h * 128 + 64 + lane] = f2bf(o1 * il);
    }
}

constexpr int ATT_KS = 136, ATT_VS = 72, ATT_BUF = 64 * ATT_KS * 2 + 128 * ATT_VS * 2;
DEVI void attn_unit(CP p, int b, int h, int qb, unsigned char* lds, bf16* AO) {
    const int tid = ltid(), lane = tid & 63, wv = tid >> 6, fr = lane & 15, fq = lane >> 4, g = h >> 2;
    const bf16* QB = wsb(p, WS_QB); const bf16* KB = wsb(p, WS_KB) + (size_t)b * SEQ * 256 + g * 128; const bf16* VB = wsb(p, WS_VB) + (size_t)b * SEQ * 256 + g * 128;
    const unsigned long long* MASK = (const unsigned long long*)(p->ws + WS_MASK);
    const int pos0 = qb * 256 + wv * 32;
    const size_t row0 = (size_t)b * SEQ + pos0;
    bf16x8 qf[2][4];
#pragma unroll
    for (int mt = 0; mt < 2; ++mt)
#pragma unroll
        for (int k = 0; k < 4; ++k) qf[mt][k] = *(const bf16x8*)(QB + (row0 + mt * 16 + fr) * 1024 + h * 128 + k * 32 + fq * 8);
    const unsigned long long* mkp = MASK + (row0 >> 5) * 64 * 32 + fr;
    f32x4 o[2][8];
#pragma unroll
    for (int mt = 0; mt < 2; ++mt)
#pragma unroll
        for (int dt = 0; dt < 8; ++dt) o[mt][dt] = (f32x4){0.f, 0.f, 0.f, 0.f};
    float mrow[2] = {-1e30f, -1e30f}, lrow[2] = {0.f, 0.f};
    const int NT = 4 * (qb + 1);
    const int skey = tid >> 3, spart = tid & 7;
    const bf16* kg = KB + (size_t)skey * 256 + spart * 16; const bf16* vg = VB + (size_t)skey * 256 + spart * 16;
    u32x4 sk0, sk1, sv0, sv1; unsigned long long mw[2];
    sk0 = *(const u32x4*)(kg); sk1 = *(const u32x4*)(kg + 8); sv0 = *(const u32x4*)(vg); sv1 = *(const u32x4*)(vg + 8);
    mw[0] = mkp[0]; mw[1] = mkp[16];
    for (int jt = 0; jt < NT; ++jt) {
        unsigned char* buf = lds + (jt & 1) * ATT_BUF; bf16* Ks = (bf16*)buf; bf16* Vt = (bf16*)(buf + 64 * ATT_KS * 2);
        *(u32x4*)(Ks + skey * ATT_KS + spart * 16) = sk0; *(u32x4*)(Ks + skey * ATT_KS + spart * 16 + 8) = sk1;
        { const unsigned w[8] = {sv0.x, sv0.y, sv0.z, sv0.w, sv1.x, sv1.y, sv1.z, sv1.w};
#pragma unroll
          for (int i = 0; i < 8; ++i) { Vt[(spart * 16 + 2 * i) * ATT_VS + skey] = (bf16)(w[i] & 0xffffu); Vt[(spart * 16 + 2 * i + 1) * ATT_VS + skey] = (bf16)(w[i] >> 16); } }
        const unsigned long long m0 = mw[0], m1 = mw[1];
        __syncthreads();
        if (jt + 1 < NT) { const size_t go = (size_t)(jt + 1) * 64 * 256; sk0 = *(const u32x4*)(kg + go); sk1 = *(const u32x4*)(kg + go + 8); sv0 = *(const u32x4*)(vg + go); sv1 = *(const u32x4*)(vg + go + 8);
            mw[0] = mkp[(jt + 1) * 32]; mw[1] = mkp[(jt + 1) * 32 + 16]; }
        if (jt * 64 > pos0 + 31) continue;
        f32x4 sc[2][4];
#pragma unroll
        for (int mt = 0; mt < 2; ++mt)
#pragma unroll
            for (int kt = 0; kt < 4; ++kt) sc[mt][kt] = (f32x4){0.f, 0.f, 0.f, 0.f};
#pragma unroll
        for (int kt = 0; kt < 4; ++kt)
#pragma unroll
            for (int k = 0; k < 4; ++k) { const bf16x8 kf = *(const bf16x8*)(Ks + (kt * 16 + fr) * ATT_KS + k * 32 + fq * 8);
                sc[0][kt] = mfma16(kf, qf[0][k], sc[0][kt]); sc[1][kt] = mfma16(kf, qf[1][k], sc[1][kt]); }
        bf16x8 pf[2][2];
#pragma unroll
        for (int mt = 0; mt < 2; ++mt) {
            const unsigned long long mk = (mt ? m1 : m0) >> (4 * fq);
            float mx = -1e30f;
#pragma unroll
            for (int kt = 0; kt < 4; ++kt)
#pragma unroll
                for (int i = 0; i < 4; ++i) { const bool on = (mk >> (16 * kt + i)) & 1ull; sc[mt][kt][i] = on ? sc[mt][kt][i] : -1e30f; mx = fmaxf(mx, sc[mt][kt][i]); }
            mx = fmaxf(mx, __shfl_xor(mx, 16)); mx = fmaxf(mx, __shfl_xor(mx, 32));
            const float mn = fmaxf(mrow[mt], mx), al = __builtin_amdgcn_exp2f(mrow[mt] - mn); mrow[mt] = mn;
            float ps = 0.f;
#pragma unroll
            for (int kt = 0; kt < 4; ++kt)
#pragma unroll
                for (int i = 0; i < 4; ++i) { const float e = (sc[mt][kt][i] > -1e29f) ? __builtin_amdgcn_exp2f(sc[mt][kt][i] - mn) : 0.f; sc[mt][kt][i] = e; ps += e; }
            lrow[mt] = lrow[mt] * al + ps;
            if (!__all(al == 1.f)) {
#pragma unroll
                for (int dt = 0; dt < 8; ++dt) o[mt][dt] = o[mt][dt] * al; }
#pragma unroll
            for (int ks = 0; ks < 2; ++ks) { u32x4 w; w.x = cvtpk(sc[mt][2 * ks][0], sc[mt][2 * ks][1]); w.y = cvtpk(sc[mt][2 * ks][2], sc[mt][2 * ks][3]);
                w.z = cvtpk(sc[mt][2 * ks + 1][0], sc[mt][2 * ks + 1][1]); w.w = cvtpk(sc[mt][2 * ks + 1][2], sc[mt][2 * ks + 1][3]); pf[mt][ks] = __builtin_bit_cast(bf16x8, w); }
        }
#pragma unroll
        for (int dt = 0; dt < 8; ++dt)
#pragma unroll
            for (int ks = 0; ks < 2; ++ks) { const bf16* vp = Vt + (dt * 16 + fr) * ATT_VS + ks * 32 + 4 * fq;
                const u32x2 va = *(const u32x2*)vp, vb2 = *(const u32x2*)(vp + 16); u32x4 w; w.x = va.x; w.y = va.y; w.z = vb2.x; w.w = vb2.y; const bf16x8 vf = __builtin_bit_cast(bf16x8, w);
                o[0][dt] = mfma16(vf, pf[0][ks], o[0][dt]); o[1][dt] = mfma16(vf, pf[1][ks], o[1][dt]); }
    }
#pragma unroll
    for (int mt = 0; mt < 2; ++mt) { float l = lrow[mt]; l += __shfl_xor(l, 16); l += __shfl_xor(l, 32); const float il = 1.f / l;
        bf16* orow = AO + (row0 + mt * 16 + fr) * DM + h * 128 + 4 * fq;
#pragma unroll
        for (int dt = 0; dt < 8; ++dt) { const f32x4 v = o[mt][dt] * il; u32x2 w; w.x = cvtpk(v.x, v.y); w.y = cvtpk(v.z, v.w); *(u32x2*)(orow + dt * 16) = w; } }
    __syncthreads();
}

DEVI void idx_sample_unit(CP p, int j, int b, int kb, float* sq  ) {
    const int TIDX = ltid();
    const float* H = wsf(p, WS_H); float* SCS = wsf(p, WS_SCS); const int tid = TIDX;
    for (int i = tid; i < 8 * 512; i += 512) sq[i] = H[(size_t)(MPR + b * DS + (i >> 9)) * HC_AB + C_QI + (i & 511)];
    if (tid < 64) sq[4096 + tid] = H[(size_t)(MPR + b * DS + (tid >> 3)) * HC_AB + C_WI + (tid & 7)];
    __syncthreads();
    const int key = kb * 512 + tid;
    if (key < NKEY_S) {
        const float* kr;
        if (key < PAST) { const int pg = p->page_table[b * NPAGES + key / PAGE]; kr = p->cache_ik + (((size_t)j * NPOOL + pg) * PAGE + key % PAGE) * 64; }
        else kr = H + (size_t)(MPR + b * DS + key - PAST) * HC_AB + C_KI;
        float k[64];
#pragma unroll
        for (int i = 0; i < 16; ++i) { const f32x4 v = *(const f32x4*)(kr + 4 * i); k[4 * i] = v.x; k[4 * i + 1] = v.y; k[4 * i + 2] = v.z; k[4 * i + 3] = v.w; }
#pragma unroll 1
        for (int qi = 0; qi < 8; ++qi) { if (key > PAST + qi) continue; float sc = 0.f;
#pragma unroll 1
            for (int h = 0; h < 8; ++h) { float d = 0.f;
#pragma unroll
                for (int i = 0; i < 64; ++i) d += sq[qi * 512 + h * 64 + i] * k[i];
                sc += sq[4096 + qi * 8 + h] * fmaxf(d, 0.f); }
            SCS[(size_t)(b * DS + qi) * SCS_LD + key] = sc * IDX_SCALE; }
    }
    __syncthreads();
}

DEVI void select_sample_unit(CP p, int q, int* red  ) {
    const int TIDX = ltid();
    const float* sc = wsf(p, WS_SCS) + (size_t)q * SCS_LD; int* SELS = (int*)(p->ws + WS_SELS) + q * TOPK;
    const int tid = TIDX, lane = tid & 63, wv = tid >> 6, nk = PAST + (q % DS) + 1;
    unsigned v[33];
#pragma unroll
    for (int jj = 0; jj < 33; ++jj) { const int key = jj * 512 + tid; v[jj] = key < nk ? ord_f(sc[key]) : 0u; }
    unsigned T = 0u; int par = 0;
    for (int bit = 31; bit >= 0; --bit) { const unsigned cand = T | (1u << bit); int cnt = 0;
#pragma unroll
        for (int jj = 0; jj < 33; ++jj) cnt += __popcll(__ballot(v[jj] >= cand));
        if (lane == 0) red[par * 8 + wv] = cnt; __syncthreads();
        int tot = 0;
#pragma unroll
        for (int w = 0; w < 8; ++w) tot += red[par * 8 + w];
        par ^= 1;
        if (tot >= TOPK) T = cand; if (tot == TOPK) break; }
    __syncthreads();
    int* cg = red + 16; int* ce = cg + 33 * 8; int* pg = ce + 33 * 8; int* pe = pg + 33 * 8;
#pragma unroll
    for (int jj = 0; jj < 33; ++jj) { const int a = __popcll(__ballot(v[jj] > T)), e = __popcll(__ballot(v[jj] == T)); if (lane == 0) { cg[jj * 8 + wv] = a; ce[jj * 8 + wv] = e; } }
    __syncthreads();
    if (tid < 33 * 8) { int a = 0, e = 0; for (int i = 0; i < tid; ++i) { a += cg[i]; e += ce[i]; } pg[tid] = a; pe[tid] = e; }
    if (tid == 0) { int a = 0; for (int i = 0; i < 33 * 8; ++i) a += cg[i]; red[0] = a; }
    __syncthreads();
    const int need = TOPK - red[0]; const unsigned long long lt = (1ull << lane) - 1ull;
#pragma unroll
    for (int jj = 0; jj < 33; ++jj) {
        const bool gt = v[jj] > T, eq = v[jj] == T; const unsigned long long me = __ballot(eq), mg = __ballot(gt);
        const int epre = pe[jj * 8 + wv] + __popcll(me & lt), gpre = pg[jj * 8 + wv] + __popcll(mg & lt); const bool sel = gt || (eq && epre < need);
        const int ebc = epre < need ? epre : need;
        if (sel) SELS[gpre + ebc] = jj * 512 + tid;
    }
    __syncthreads();
}

DEVI void attn_sample_unit(CP p, int j, int q, unsigned char* lds) {
    const int tid = ltid(), lane = tid & 63, h = tid >> 6, g = h >> 2, b = q / DS, row = MPR + q;
    const float* H = wsf(p, WS_H); bf16* AO = wsb(p, WS_AO);
    long long* koff = (long long*)lds; float* lg = (float*)(lds + 256 * 8) + h * 256;
    if (tid < TOPK) { const int s = ((const int*)(p->ws + WS_SELS))[q * TOPK + tid];
        if (s < PAST) { const int pg = p->page_table[b * NPAGES + s / PAGE]; koff[tid] = (long long)((((size_t)j * NPOOL + pg) * PAGE + s % PAGE) * 256); }
        else koff[tid] = -(1ll + (long long)((size_t)(MPR + b * DS + s - PAST) * HC_AB + C_K)); }
    const float qs = ATT_SCALE * 1.4426950408889634f;
    const float q0 = H[(size_t)row * HC_AB + C_Q + h * 128 + lane] * qs, q1 = H[(size_t)row * HC_AB + C_Q + h * 128 + 64 + lane] * qs;
    __syncthreads();
    float mx = -1e30f;
    for (int i0 = 0; i0 < TOPK; i0 += 8) { float a0[8], a1[8];
#pragma unroll
        for (int i = 0; i < 8; ++i) { const long long o = koff[i0 + i]; const float* kr = (o >= 0) ? p->cache_k + o + g * 128 : H + (-(o + 1)) + g * 128; a0[i] = kr[lane]; a1[i] = kr[lane + 64]; }
#pragma unroll
        for (int i = 0; i < 8; ++i) { const float v = wave_sum(q0 * a0[i] + q1 * a1[i]); mx = fmaxf(mx, v); if (lane == 0) lg[i0 + i] = v; } }
    asm volatile("s_waitcnt lgkmcnt(0)" ::: "memory");
    float l = 0.f, o0 = 0.f, o1 = 0.f;
    for (int i0 = 0; i0 < TOPK; i0 += 8) { float a0[8], a1[8];
#pragma unroll
        for (int i = 0; i < 8; ++i) { const long long o = koff[i0 + i]; const float* vr = (o >= 0) ? p->cache_v + o + g * 128 : H + (-(o + 1)) + (C_V - C_K) + g * 128; a0[i] = vr[lane]; a1[i] = vr[lane + 64]; }
#pragma unroll
        for (int i = 0; i < 8; ++i) { const float pe = __builtin_amdgcn_exp2f(lg[i0 + i] - mx); l += pe; o0 += pe * a0[i]; o1 += pe * a1[i]; } }
    const float il = 1.f / l;
    AO[(size_t)row * DM + h * 128 + lane] = f2bf(o0 * il); AO[(size_t)row * DM + h * 128 + 64 + lane] = f2bf(o1 * il);
    __syncthreads();
}

DEVI void ph_cd_prep(CP p, int j, int vb, int nvb) {
    const int TIDX = ltid();
    const float* H = wsf(p, WS_H); bf16* DD = wsb(p, WS_DD); bf16* U = wsb(p, WS_U); bf16* VLN = wsb(p, WS_VLN);
    const float* lg = p->sgu_ln_g + (size_t)j * 1024; const float* lb = p->sgu_ln_b + (size_t)j * 1024;
    const int lane = TIDX & 63, wv = TIDX >> 6;
    for (int row = vb * 8 + wv; row < MR; row += nvb * 8) {
        const bool pr = row < MPR; const int b = pr ? row / SEQ : (row - MPR) / DS, t = pr ? row % SEQ : (row - MPR) % DS;
        const float* h = H + (size_t)row * HC_CD;
#pragma unroll 1
        for (int i = 0; i < 4; ++i) { const int c = i * 256 + lane * 4, w = 2 << i; const f32x4 cur = *(const f32x4*)(h + c); f32x4 s = cur; int cnt;
            if (pr) { cnt = (t + 1 < w) ? t + 1 : w; for (int u = 1; u < cnt; ++u) s += *(const f32x4*)(H + (size_t)(row - u) * HC_CD + c); }
            else { cnt = w; for (int u = 1; u < w; ++u) { const int e = 15 + t - u;
                    s += (e >= 15) ? *(const f32x4*)(H + (size_t)(MPR + b * DS + e - 15) * HC_CD + c) : *(const f32x4*)(p->state_pool + (((size_t)j * DB + b) * 15 + e) * 1024 + c); } }
            const float ic = 1.f / (float)cnt; const f32x4 d = s * ic - cur; uint2 o; o.x = pk2(d.x, d.y); o.y = pk2(d.z, d.w); *(uint2*)(DD + (size_t)row * 1024 + c) = o;
            if (pr) { if (t >= SEQ - 15) *(f32x4*)(p->out + O_PP + (((size_t)j * NBP + b) * 15 + (t - (SEQ - 15))) * 1024 + c) = cur; }
            else { *(f32x4*)(p->out + O_PS + (((size_t)j * DB + b) * 15 + 7 + t) * 1024 + c) = cur;
                   if (t == 0) for (int e = 0; e < 7; ++e) *(f32x4*)(p->out + O_PS + (((size_t)j * DB + b) * 15 + e) * 1024 + c) = *(const f32x4*)(p->state_pool + (((size_t)j * DB + b) * 15 + 8 + e) * 1024 + c); }
        }
        asm volatile("" ::: "memory");
#pragma unroll
        for (int i = 0; i < 4; ++i) { const int c = (i * 64 + lane) * 4; const f32x4 u = *(const f32x4*)(h + 1024 + c); uint2 o; o.x = pk2(gelu_f(u.x), gelu_f(u.y)); o.y = pk2(gelu_f(u.z), gelu_f(u.w)); *(uint2*)(U + (size_t)row * 1024 + c) = o; }
        asm volatile("" ::: "memory");
        f32x4 v[4]; float s = 0.f;
#pragma unroll
        for (int i = 0; i < 4; ++i) { const int c = (i * 64 + lane) * 4; const f32x4 x = *(const f32x4*)(h + 2048 + c); v[i] = (f32x4){gelu_f(x.x), gelu_f(x.y), gelu_f(x.z), gelu_f(x.w)}; s += (v[i].x + v[i].y) + (v[i].z + v[i].w); }
        const float mean = wave_sum(s) * (1.f / 1024.f); float q = 0.f;
#pragma unroll
        for (int i = 0; i < 4; ++i) { v[i] = v[i] - mean; q += (v[i].x * v[i].x + v[i].y * v[i].y) + (v[i].z * v[i].z + v[i].w * v[i].w); }
        const float rstd = 1.f / sqrtf(wave_sum(q) * (1.f / 1024.f) + EPS);
#pragma unroll
        for (int i = 0; i < 4; ++i) { const int c = (i * 64 + lane) * 4; const f32x4 y = v[i] * rstd * *(const f32x4*)(lg + c) + *(const f32x4*)(lb + c);
            uint2 o; o.x = pk2(y.x, y.y); o.y = pk2(y.z, y.w); *(uint2*)(VLN + (size_t)row * 1024 + c) = o;
            if (!pr) *(f32x4*)(p->out + O_GS + ((size_t)j * MSR + (row - MPR)) * 1024 + c) = y; }
    }
}

DEVI void sgu_unit(CP p, int j, int ck, int g, int ds, bf16* Vt  ) {
    const int tid = ltid(), lane = tid & 63, wv = tid >> 6, fr = lane & 15, fq = lane >> 4;
    const bf16* VLN = wsb(p, WS_VLN); const bf16* U = wsb(p, WS_U); bf16* AO = wsb(p, WS_AO);
    const size_t row0 = (size_t)ck * 128; const int c0 = g * 256 + ds * 64;
    { const int sp = tid >> 2, part = tid & 3; const bf16* src = VLN + (row0 + sp) * 1024 + c0 + part * 16; const u32x4 a = *(const u32x4*)src, bq = *(const u32x4*)(src + 8);
      const unsigned w[8] = {a.x, a.y, a.z, a.w, bq.x, bq.y, bq.z, bq.w};
#pragma unroll
      for (int i = 0; i < 8; ++i) { Vt[(part * 16 + 2 * i) * 136 + sp] = (bf16)(w[i] & 0xffffu); Vt[(part * 16 + 2 * i + 1) * 136 + sp] = (bf16)(w[i] >> 16); } }
    __syncthreads();
    const bf16* W = wsb(p, WS_SGUW) + (((size_t)j * 4 + g) * 128 + wv * 16 + fr) * 128 + fq * 8;
    f32x4 acc[4];
#pragma unroll
    for (int nt = 0; nt < 4; ++nt) acc[nt] = (f32x4){0.f, 0.f, 0.f, 0.f};
    const int nk = (wv >> 1) + 1;
#pragma unroll
    for (int k = 0; k < 4; ++k) if (k < nk) { const bf16x8 wf = *(const bf16x8*)(W + k * 32);
#pragma unroll
        for (int nt = 0; nt < 4; ++nt) acc[nt] = mfma16(*(const bf16x8*)(Vt + (nt * 16 + fr) * 136 + k * 32 + fq * 8), wf, acc[nt]); }
    const float bs = p->sgu_b[((size_t)j * 4 + g) * 128 + wv * 16 + fr]; const size_t row = row0 + wv * 16 + fr;
#pragma unroll
    for (int nt = 0; nt < 4; ++nt) { const int c = c0 + nt * 16 + 4 * fq; const u32x2 uw = *(const u32x2*)(U + row * 1024 + c);
        const float o0 = bflo(uw.x) * (acc[nt].x + bs), o1 = bfhi(uw.x) * (acc[nt].y + bs), o2 = bflo(uw.y) * (acc[nt].z + bs), o3 = bfhi(uw.y) * (acc[nt].w + bs);
        u32x2 w; w.x = cvtpk(o0, o1); w.y = cvtpk(o2, o3); *(u32x2*)(AO + row * DM + 1024 + c) = w; }
    __syncthreads();
}
DEVI void ph_sgu_naive(CP p, int j, int vb, int nvb) {
    const int TIDX = ltid();
    const bf16* VLN = wsb(p, WS_VLN); const bf16* U = wsb(p, WS_U); bf16* AO = wsb(p, WS_AO);
    for (int row = MPR + vb; row < MR; row += nvb) {
        const bool pr = row < MPR; const int t = pr ? row % SEQ : (row - MPR) % DS;
        const int tt = pr ? (t & 127) : t, base = row - tt;
        for (int d = TIDX; d < 1024; d += 512) { const int g = d >> 8; const float* w = p->sgu_w + (((size_t)j * 4 + g) * 128 + tt) * 128;
            float acc = p->sgu_b[((size_t)j * 4 + g) * 128 + tt];
            for (int s = 0; s <= tt; ++s) acc += w[s] * bf2f(VLN[(size_t)(base + s) * 1024 + d]);
            AO[(size_t)row * DM + 1024 + d] = f2bf(bf2f(U[(size_t)row * 1024 + d]) * acc); }
    }
}


DEVI void diag_cmp(CP p, int k, const bf16* a, int lda, const bf16* b, int ldb, int rows, int cols, int vb, int nvb) {
    unsigned* ctl = (unsigned*)(p->ws + WS_CTL); const int tid = ltid(); float mx = 0.f; unsigned bad = 0;
    for (int r = vb; r < rows; r += nvb) for (int c = tid; c < cols; c += 512) { const float x = bf2f(a[(size_t)r * lda + c]), y = bf2f(b[(size_t)r * ldb + c]); const float d = fabsf(x - y);
        if (!(d == d) || d > 1e30f) bad++; else mx = fmaxf(mx, d); }
    atomicMax(ctl + 64 + 2 * k, __float_as_uint(mx)); if (bad) atomicAdd(ctl + 65 + 2 * k, bad);
}
DEVI void diag_cmp_f32(CP p, int k, const float* a, int lda, const bf16* b, int ldb, int rows, int cols, int vb, int nvb) {
    unsigned* ctl = (unsigned*)(p->ws + WS_CTL); const int tid = ltid(); float mx = 0.f; unsigned bad = 0;
    for (int r = vb; r < rows; r += nvb) for (int c = tid; c < cols; c += 512) { const float x = a[(size_t)r * lda + c], y = bf2f(b[(size_t)r * ldb + c]); const float d = fabsf(x - y);
        if (!(d == d) || d > 1e30f) bad++; else mx = fmaxf(mx, d); }
    atomicMax(ctl + 64 + 2 * k, __float_as_uint(mx)); if (bad) atomicAdd(ctl + 65 + 2 * k, bad);
}
DEVI void diag_fin_f32(CP p, int k, const float* a, size_t n, int vb, int nvb) {
    unsigned* ctl = (unsigned*)(p->ws + WS_CTL); unsigned bad = 0;
    for (size_t i = (size_t)vb * 512 + ltid(); i < n; i += (size_t)nvb * 512) { const float x = a[i]; if (!(x == x) || fabsf(x) > 1e30f) bad++; }
    if (bad) atomicAdd(ctl + 65 + 2 * k, bad);
}
DEVI void diag_fin_bf16(CP p, int k, const bf16* a, size_t n, int vb, int nvb) {
    unsigned* ctl = (unsigned*)(p->ws + WS_CTL); unsigned bad = 0;
    for (size_t i = (size_t)vb * 512 + ltid(); i < n; i += (size_t)nvb * 512) { const float x = bf2f(a[i]); if (!(x == x) || fabsf(x) > 1e30f) bad++; }
    if (bad) atomicAdd(ctl + 65 + 2 * k, bad);
}
DEVI void diag_report(CP p, int nchecks) {
    unsigned* ctl = (unsigned*)(p->ws + WS_CTL);
    if (blockIdx.x == 0 && threadIdx.x == 0) { const unsigned fl = __hip_atomic_load(ctl + 96, __ATOMIC_RELAXED, __HIP_MEMORY_SCOPE_AGENT); if (fl) { p->out[O_KP] = (float)fl * 1e12f; return; } }
    if (blockIdx.x == 0 && threadIdx.x == 0) for (int k = 0; k < nchecks; ++k) { const float mx = __uint_as_float(__hip_atomic_load(ctl + 64 + 2 * k, __ATOMIC_RELAXED, __HIP_MEMORY_SCOPE_AGENT)); const unsigned bad = __hip_atomic_load(ctl + 65 + 2 * k, __ATOMIC_RELAXED, __HIP_MEMORY_SCOPE_AGENT);
        if (bad) { p->out[O_KP] = (70.f + k) * 1e19f; break; } if (mx > 0.06f) { p->out[O_KP] = mx * 1e8f; break; } }
}
namespace pg8 {
#define PG8_LAS __attribute__((address_space(3)))
typedef unsigned short bf16_t;
typedef short bf16x8 __attribute__((ext_vector_type(8)));
typedef float f32x4 __attribute__((ext_vector_type(4)));
typedef unsigned u32x4 __attribute__((ext_vector_type(4)));
constexpr int BM = 256, BK = 64, HALF = 128, HTB = HALF * BK * 2  , STAGE_BYTES = 8 * HTB, NXCD = 8, WGM = 8;

__host__ __device__ __forceinline__ int lds_byte(int r, int c) { const int st = (r >> 4) * 2 + (c >> 5), rr = r & 15, cc = c & 31, ob = rr * 64 + cc * 2; return st * 1024 + (ob ^ (((ob >> 9) & 1) << 5)); }
__host__ __device__ __forceinline__ void stage_rc(int b, int& R, int& C) { const int st = b / 1024, sb = b % 1024, swz = sb ^ (((sb >> 9) & 1) << 5); R = (st >> 1) * 16 + swz / 64; C = (st & 1) * 32 + (swz % 64) / 2; }
__host__ __device__ __forceinline__ int perm32(int rho) { const int n = rho >> 4, i = rho & 15; return 8 * (i >> 2) + 4 * n + (i & 3); }

struct Unit { int pm, pn; };
struct Gemm { const bf16_t* A; const bf16_t* Bt; int M, N, K, lda, ldb, acol; };

struct StaticOrder {
    int nM, nN, nwg, G, c;
    __host__ __device__ void init(int M, int N, int G_, int c_) { nM = M / BM; nN = N / BM; nwg = nM * nN; G = G_; c = c_; }
    __host__ __device__ bool next(int i, Unit& u) const {
        const long L = (long)i * G + c; if (L >= nwg) return false;
        int wgid = (int)L; { const int q = nwg / NXCD, r = nwg % NXCD, xcd = wgid % NXCD, off = wgid / NXCD; wgid = (xcd < r ? xcd * (q + 1) : r * (q + 1) + (xcd - r) * q) + off; }
        const int nig = WGM * nN, gid = wgid / nig, fm = gid * WGM, gsz = (nM - fm) < WGM ? (nM - fm) : WGM;
        u.pm = fm + ((wgid % nig) % gsz); u.pn = (wgid % nig) / gsz; return true;
    }
    __device__ __forceinline__ void a_ready(const Unit&) const {}
    __device__ __forceinline__ void done(const Unit&) const {}
};

template <class Epi, class Sched, bool ALIGN_EPI = false, bool SP2 = false>
__device__ __forceinline__ void gemm_phase(PG8_LAS unsigned char* lds, const Gemm g, const Sched& S, const Epi& E) {
    int tid_ = threadIdx.x; asm volatile("" : "+v"(tid_)); const int tid = tid_, wid = __builtin_amdgcn_readfirstlane(tid >> 6), lane = tid & 63, wr = wid >> 2, wc = wid & 3, fr = lane & 15, fq = lane >> 4;
    const int K = g.K, nt = K / BK;
    unsigned voffA[2], voffB[2];
#pragma unroll
    for (int i = 0; i < 2; ++i) { int R, C; stage_rc(tid * 16 + i * 8192, R, C); const int Rb = Epi::PERM ? ((R & ~31) + perm32(R & 31)) : R;
        voffA[i] = (unsigned)(R * g.lda + C) * 2u; voffB[i] = (unsigned)(Rb * g.ldb + C) * 2u; }
    const size_t kstep = (size_t)(BK * 2);
    const size_t hstepA = (size_t)HALF * g.lda * 2, hstepB = (size_t)HALF * g.ldb * 2;
    const size_t tstepA = 2 * hstepA, tstepB = 2 * hstepB, acolB = (size_t)g.acol * 2;
    const unsigned ldsw = (unsigned)wid * 1024u;
    const int aoff = lds_byte(wr * 64 + fr, fq * 8), boff = lds_byte(wc * 32 + fr, fq * 8);
#define PG8_SA(b, h) (((b) * 2 + (h)) * HTB)
#define PG8_SB(b, h) ((4 + (b) * 2 + (h)) * HTB)
#define PG8_STAGE(bufoff, gbase, voff) do { _Pragma("unroll") for (int _i = 0; _i < 2; ++_i) \
        __builtin_amdgcn_global_load_lds((const unsigned*)((const char*)(gbase) + (voff)[_i]), (PG8_LAS unsigned*)(lds + (bufoff) + ldsw + _i * 8192), 16, 0, 0); } while (0)
#define PG8_LDA(dst, b, h) do { _Pragma("unroll") for (int m = 0; m < 4; ++m) _Pragma("unroll") for (int k = 0; k < 2; ++k) dst[m][k] = *(const PG8_LAS bf16x8*)(lds + PG8_SA(b, h) + aoff + m * 2048 + k * 1024); } while (0)
#define PG8_LDB(dst, b, h) do { _Pragma("unroll") for (int n = 0; n < 2; ++n) _Pragma("unroll") for (int k = 0; k < 2; ++k) dst[n][k] = *(const PG8_LAS bf16x8*)(lds + PG8_SB(b, h) + boff + n * 2048 + k * 1024); } while (0)
#define PG8_MMA(ai, bj, At, Bt) do { __builtin_amdgcn_s_setprio(1); _Pragma("unroll") for (int m = 0; m < 4; ++m) _Pragma("unroll") for (int n = 0; n < 2; ++n) _Pragma("unroll") for (int k = 0; k < 2; ++k) \
        acc[ai][bj][m][n] = __builtin_amdgcn_mfma_f32_16x16x32_bf16(Bt[n][k], At[m][k], acc[ai][bj][m][n], 0, 0, 0); __builtin_amdgcn_s_setprio(0); } while (0)
#define PG8_WAIT_V(n) asm volatile("s_waitcnt vmcnt(" #n ")" ::: "memory")
#define PG8_WAIT_L(n) asm volatile("s_waitcnt lgkmcnt(" #n ")" ::: "memory")
#define PG8_BAR __builtin_amdgcn_s_barrier()
#define PG8_SCHED __builtin_amdgcn_sched_barrier(0)
    Unit cur, nxt; int ui = 0;
    if (!S.next(0, cur)) return;
    f32x4 acc[2][2][4][2];
#pragma unroll
    for (int a = 0; a < 2; ++a)
#pragma unroll
        for (int b = 0; b < 2; ++b)
#pragma unroll
            for (int m = 0; m < 4; ++m)
#pragma unroll
                for (int n = 0; n < 2; ++n) acc[a][b][m][n] = (f32x4){0.f, 0.f, 0.f, 0.f};
    bf16x8 At[4][2], B0[2][2], B1[2][2];
    const char* cA = (const char*)g.A + (size_t)cur.pm * tstepA + (size_t)cur.pn * acolB; const char* cB = (const char*)g.Bt + (size_t)cur.pn * tstepB;
    S.a_ready(cur);
    if constexpr (SP2) {
        PG8_STAGE(PG8_SB(0, 0), cB, voffB); PG8_STAGE(PG8_SB(0, 1), cB + hstepB, voffB); PG8_STAGE(PG8_SA(0, 0), cA, voffA); PG8_STAGE(PG8_SA(0, 1), cA + hstepA, voffA);
        if (wr == 1) PG8_BAR;
        PG8_WAIT_V(2); PG8_BAR;
        PG8_STAGE(PG8_SB(1, 0), cB + kstep, voffB); PG8_STAGE(PG8_SA(1, 0), cA + kstep, voffA); PG8_STAGE(PG8_SB(1, 1), cB + hstepB + kstep, voffB);
        PG8_WAIT_V(6); PG8_BAR;
    } else {
        PG8_STAGE(PG8_SB(0, 0), cB, voffB); PG8_STAGE(PG8_SA(0, 0), cA, voffA); PG8_STAGE(PG8_SB(0, 1), cB + hstepB, voffB); PG8_STAGE(PG8_SA(0, 1), cA + hstepA, voffA);
        if (wr == 1) PG8_BAR;
        PG8_WAIT_V(4); PG8_BAR;
        PG8_STAGE(PG8_SB(1, 0), cB + kstep, voffB); PG8_STAGE(PG8_SA(1, 0), cA + kstep, voffA); PG8_STAGE(PG8_SB(1, 1), cB + hstepB + kstep, voffB);
        PG8_WAIT_V(6); PG8_BAR;
    }
    for (;;) {
        const bool has_next = S.next(ui + 1, nxt);
        const char* nA = has_next ? (const char*)g.A + (size_t)nxt.pm * tstepA + (size_t)nxt.pn * acolB : cA; const char* nB = has_next ? (const char*)g.Bt + (size_t)nxt.pn * tstepB : cB;
        for (int t = 0; t < nt; t += 2) {
            const bool last = (t == nt - 2);
            const char* a1 = cA + (size_t)(t + 1) * kstep;
            const char* a2 = last ? nA : cA + (size_t)(t + 2) * kstep; const char* b2 = last ? nB : cB + (size_t)(t + 2) * kstep;
            const char* a3 = a2 + kstep; const char* b3 = b2 + kstep;
            if (last && has_next) S.a_ready(nxt);
            if constexpr (SP2) {
            PG8_LDB(B0, 0, 0); PG8_LDB(B1, 0, 1); PG8_SCHED; PG8_LDA(At, 0, 0); PG8_STAGE(PG8_SA(1, 1), a1 + hstepA, voffA);
            PG8_WAIT_V(8); PG8_WAIT_L(0); PG8_BAR; PG8_MMA(0, 0, At, B0); PG8_MMA(0, 1, At, B1); PG8_BAR; PG8_SCHED;
            PG8_LDA(At, 0, 1); PG8_STAGE(PG8_SB(0, 0), b2, voffB); PG8_STAGE(PG8_SB(0, 1), b2 + hstepB, voffB); PG8_STAGE(PG8_SA(0, 0), a2, voffA);
            PG8_WAIT_V(8); PG8_WAIT_L(0); PG8_BAR; PG8_MMA(1, 0, At, B0); PG8_MMA(1, 1, At, B1); PG8_BAR; PG8_SCHED;
            PG8_LDB(B0, 1, 0); PG8_LDB(B1, 1, 1); PG8_SCHED; PG8_LDA(At, 1, 0); PG8_STAGE(PG8_SA(0, 1), a2 + hstepA, voffA);
            PG8_WAIT_V(8); PG8_WAIT_L(0); PG8_BAR; PG8_MMA(0, 0, At, B0); PG8_MMA(0, 1, At, B1); PG8_BAR; PG8_SCHED;
            PG8_LDA(At, 1, 1); PG8_STAGE(PG8_SB(1, 0), b3, voffB); PG8_STAGE(PG8_SB(1, 1), b3 + hstepB, voffB); PG8_STAGE(PG8_SA(1, 0), a3, voffA);
            PG8_WAIT_V(8); PG8_WAIT_L(0); PG8_BAR; PG8_MMA(1, 0, At, B0); PG8_MMA(1, 1, At, B1); PG8_BAR; PG8_SCHED;
            } else {
            PG8_LDB(B0, 0, 0); PG8_SCHED; PG8_LDA(At, 0, 0); PG8_STAGE(PG8_SA(1, 1), a1 + hstepA, voffA);
            PG8_WAIT_L(8); PG8_BAR; PG8_WAIT_L(0); PG8_MMA(0, 0, At, B0); PG8_BAR; PG8_SCHED;
            PG8_LDB(B1, 0, 1); PG8_STAGE(PG8_SB(0, 0), b2, voffB);
            PG8_BAR; PG8_WAIT_L(0); PG8_MMA(0, 1, At, B1); PG8_BAR;
            PG8_LDA(At, 0, 1); PG8_STAGE(PG8_SA(0, 0), a2, voffA);
            PG8_BAR; PG8_WAIT_L(0); PG8_MMA(1, 0, At, B0); PG8_BAR; PG8_SCHED;
            PG8_STAGE(PG8_SB(0, 1), b2 + hstepB, voffB);
            PG8_WAIT_V(6); PG8_BAR; PG8_MMA(1, 1, At, B1); PG8_BAR;
            PG8_LDB(B0, 1, 0); PG8_SCHED; PG8_LDA(At, 1, 0); PG8_STAGE(PG8_SA(0, 1), a2 + hstepA, voffA);
            PG8_WAIT_L(8); PG8_BAR; PG8_WAIT_L(0); PG8_MMA(0, 0, At, B0); PG8_BAR; PG8_SCHED;
            PG8_LDB(B1, 1, 1); PG8_STAGE(PG8_SB(1, 0), b3, voffB);
            PG8_BAR; PG8_WAIT_L(0); PG8_MMA(0, 1, At, B1); PG8_BAR;
            PG8_LDA(At, 1, 1); PG8_STAGE(PG8_SA(1, 0), a3, voffA);
            PG8_BAR; PG8_WAIT_L(0); PG8_MMA(1, 0, At, B0); PG8_BAR; PG8_SCHED;
            PG8_STAGE(PG8_SB(1, 1), b3 + hstepB, voffB);
            PG8_WAIT_V(6); PG8_BAR; PG8_MMA(1, 1, At, B1); PG8_BAR;
            }
        }
        if constexpr (ALIGN_EPI) { if (wr == 0) PG8_BAR; }
        if constexpr (!Epi::AFTER_DRAIN) { E(acc, cur, wr, wc, fr, fq); S.done(cur); }
        if (!has_next) break;
#pragma unroll
        for (int a = 0; a < 2; ++a)
#pragma unroll
            for (int b = 0; b < 2; ++b)
#pragma unroll
                for (int m = 0; m < 4; ++m)
#pragma unroll
                    for (int n = 0; n < 2; ++n) acc[a][b][m][n] = (f32x4){0.f, 0.f, 0.f, 0.f};
        cur = nxt; cA = nA; cB = nB; ++ui;
        if constexpr (ALIGN_EPI) { if (wr == 1) PG8_BAR; }
    }
    PG8_WAIT_V(0);
    if constexpr (!ALIGN_EPI) { if (wr == 0) PG8_BAR; }
    PG8_BAR;
    if constexpr (Epi::AFTER_DRAIN) { E.fused(acc, cur, wr, wc, fr, fq, lds, wid, lane); S.done(cur); }
#undef PG8_SA
#undef PG8_SB
#undef PG8_STAGE
#undef PG8_LDA
#undef PG8_LDB
#undef PG8_MMA
#undef PG8_WAIT_V
#undef PG8_WAIT_L
#undef PG8_BAR
#undef PG8_SCHED
}
}
namespace pg8 {
__device__ __forceinline__ unsigned cvt_pk_bf16(float lo, float hi) { unsigned r; asm volatile("v_cvt_pk_bf16_f32 %0, %1, %2" : "=v"(r) : "v"(lo), "v"(hi)); return r; }
struct EpiF32 {
    static constexpr bool PERM = false, AFTER_DRAIN = false;
    float* C; int ldc;
    __device__ __forceinline__ void operator()(const f32x4 (&acc)[2][2][4][2], const Unit& u, int wr, int wc, int, int) const {
        int ln_ = threadIdx.x & 63; asm volatile("" : "+v"(ln_)); const int fr = ln_ & 15, fq = ln_ >> 4;
        const int row0 = u.pm * BM + wr * 64 + fr, col0 = u.pn * BM + wc * 32 + 4 * fq;
#pragma unroll
        for (int ai = 0; ai < 2; ++ai)
#pragma unroll
            for (int m = 0; m < 4; ++m) { float* rowp = C + (size_t)(row0 + ai * HALF + m * 16) * ldc + col0;
#pragma unroll
                for (int bj = 0; bj < 2; ++bj)
#pragma unroll
                    for (int n = 0; n < 2; ++n) *(f32x4*)(rowp + bj * HALF + n * 16) = acc[ai][bj][m][n]; }
    }
};
struct EpiResid {
    static constexpr bool PERM = false, AFTER_DRAIN = false;
    float* X; int ldc; float alpha;
    __device__ __forceinline__ void operator()(const f32x4 (&acc)[2][2][4][2], const Unit& u, int wr, int wc, int, int) const {
        int ln_ = threadIdx.x & 63; asm volatile("" : "+v"(ln_)); const int fr = ln_ & 15, fq = ln_ >> 4;
        const int row0 = u.pm * BM + wr * 64 + fr, col0 = u.pn * BM + wc * 32 + 4 * fq;
#pragma unroll
        for (int ai = 0; ai < 2; ++ai)
#pragma unroll
            for (int m = 0; m < 4; ++m) { float* rowp = X + (size_t)(row0 + ai * HALF + m * 16) * ldc + col0;
#pragma unroll
                for (int bj = 0; bj < 2; ++bj) { const f32x4 o0 = *(const f32x4*)(rowp + bj * HALF), o1 = *(const f32x4*)(rowp + bj * HALF + 16);
                    *(f32x4*)(rowp + bj * HALF) = o0 * alpha + acc[ai][bj][m][0]; *(f32x4*)(rowp + bj * HALF + 16) = o1 * alpha + acc[ai][bj][m][1];
                    asm volatile("" ::: "memory"); } }
    }
};
template <int ACT  > struct EpiBf16 {
    static constexpr bool PERM = true, AFTER_DRAIN = false;
    bf16_t* O; int ldc; const float* scale;
    __device__ __forceinline__ void operator()(const f32x4 (&acc)[2][2][4][2], const Unit& u, int wr, int wc, int, int) const {
        int ln_ = threadIdx.x & 63; asm volatile("" : "+v"(ln_)); const int fr = ln_ & 15, fq = ln_ >> 4;
        const int row0 = u.pm * BM + wr * 64 + fr, col0 = u.pn * BM + wc * 32 + 8 * fq;
        f32x4 sv[2][2];
#pragma unroll
        for (int bj = 0; bj < 2; ++bj)
#pragma unroll
            for (int n = 0; n < 2; ++n) sv[bj][n] = (ACT == 0) ? *(const f32x4*)(scale + col0 + bj * HALF + 4 * n) : (f32x4){1.f, 1.f, 1.f, 1.f};
#pragma unroll
        for (int ai = 0; ai < 2; ++ai)
#pragma unroll
            for (int m = 0; m < 4; ++m) { bf16_t* rowp = O + (size_t)(row0 + ai * HALF + m * 16) * ldc + col0;
#pragma unroll
                for (int bj = 0; bj < 2; ++bj) { f32x4 v0 = acc[ai][bj][m][0], v1 = acc[ai][bj][m][1];
                    if (ACT == 0) { v0 = v0 * sv[bj][0]; v1 = v1 * sv[bj][1]; }
                    if (ACT == 1) {
#pragma unroll
                        for (int q = 0; q < 4; ++q) { const float a = fmaxf(v0[q], 0.f), b = fmaxf(v1[q], 0.f); v0[q] = a * a; v1[q] = b * b; } }
                    u32x4 w; w.x = cvt_pk_bf16(v0[0], v0[1]); w.y = cvt_pk_bf16(v0[2], v0[3]); w.z = cvt_pk_bf16(v1[0], v1[1]); w.w = cvt_pk_bf16(v1[2], v1[3]);
                    *(u32x4*)(rowp + bj * HALF) = w; } }
    }
};
}
#define LAS __attribute__((address_space(3)))
#define XB_TMO      128
#define XB_XCNT(j)  (256  + 64 * (j))
#define XB_XSUB(j)  (1280 + 64 * (j))
#define XB_XGEN(j)  (2304 + 64 * (j))
#define XB_TOP      3328
#define XB_TOPGEN   3392
#define XCD_BAR_WORDS 3456
#define XB_SPIN_CAP (1u << 18)

__device__ __forceinline__ unsigned xb_ld(unsigned* p)              { return __hip_atomic_load(p, __ATOMIC_RELAXED, __HIP_MEMORY_SCOPE_AGENT); }
__device__ __forceinline__ unsigned xb_add(unsigned* p, unsigned v) { return __hip_atomic_fetch_add(p, v, __ATOMIC_RELAXED, __HIP_MEMORY_SCOPE_AGENT); }
__device__ __forceinline__ unsigned xb_xcc_id() { return (unsigned)__builtin_amdgcn_s_getreg((3 << 11) | 20) & 0xFu; }
#define XB_SPIN(cond, bar) do { unsigned _sp = 0; while (cond) { __builtin_amdgcn_s_sleep(1); \
    if ((++_sp & 255u) == 0u) { if (xb_ld(&(bar)[XB_TMO])) break; if (_sp > XB_SPIN_CAP) { atomicAdd(&(bar)[XB_TMO], 1u); break; } } } } while (0)

struct XcdBarrier {
    unsigned* bar; unsigned x;
    volatile LAS unsigned* st;
};

__device__ __forceinline__ XcdBarrier xcd_barrier_post(unsigned* bar, volatile LAS unsigned* st) {
    XcdBarrier b; b.bar = bar; b.x = xb_xcc_id(); b.st = st;
    if (threadIdx.x == 0) (void)xb_add(&bar[XB_XCNT(b.x)], 1u);
    return b;
}
__device__ __forceinline__ void xcd_barrier_complete(unsigned* bar, unsigned x, unsigned& nloc, unsigned& nx) {
    const unsigned G = gridDim.x * gridDim.y * gridDim.z;
    unsigned sum, cnt, mine, sp = 0u;
    for (;;) {
        sum = 0u; cnt = 0u; mine = 0u;
#pragma unroll
        for (unsigned j = 0; j < 16; ++j) { const unsigned c = xb_ld(&bar[XB_XCNT(j)]); sum += c; cnt += (c > 0u) ? 1u : 0u; mine = (j == x) ? c : mine; }
        if (sum == G) break;
        __builtin_amdgcn_s_sleep(1);
        if ((++sp & 255u) == 0u) { if (xb_ld(&bar[XB_TMO])) break; if (sp > XB_SPIN_CAP) { atomicAdd(&bar[XB_TMO], 1u); break; } }
    }
    nloc = mine > 0u ? mine : 1u; nx = cnt > 0u ? cnt : 1u;
}

__device__ __attribute__((noinline)) void xcd_barrier_impl(unsigned* bar_, unsigned bx_, volatile LAS unsigned* st_) {
    XcdBarrier b; b.bar = bar_; b.x = bx_; b.st = st_;
    asm volatile("s_waitcnt vmcnt(0)" ::: "memory");
    __syncthreads();
    if (threadIdx.x == 0) {
        unsigned* bar = b.bar;
        __builtin_amdgcn_s_waitcnt(0);
        unsigned nloc = b.st[0], nx = b.st[1];
        if (nloc == 0u) { xcd_barrier_complete(bar, b.x, nloc, nx); b.st[0] = nloc; b.st[1] = nx; }
        const unsigned old = xb_add(&bar[XB_XSUB(b.x)], 1u);
        const unsigned gen = old / nloc;
        if (old + 1u == (gen + 1u) * nloc) {
            __builtin_amdgcn_fence(__ATOMIC_RELEASE, "agent");
            asm volatile("s_waitcnt vmcnt(0)" ::: "memory");
            const unsigned og = xb_add(&bar[XB_TOP], 1u);
            const unsigned tg = og / nx;
            if (og + 1u == (tg + 1u) * nx) xb_add(&bar[XB_TOPGEN], 1u);
            else XB_SPIN(xb_ld(&bar[XB_TOPGEN]) == tg, bar);
            __builtin_amdgcn_fence(__ATOMIC_ACQUIRE, "agent");
            xb_add(&bar[XB_XGEN(b.x)], 1u);
            asm volatile("s_waitcnt vmcnt(0)" ::: "memory");
        } else {
            XB_SPIN(xb_ld(&bar[XB_XGEN(b.x)]) == gen, bar);
            __builtin_amdgcn_fence(__ATOMIC_ACQUIRE, "agent");
            asm volatile("s_waitcnt vmcnt(0)" ::: "memory");
        }
    }
    __syncthreads();
}
__device__ __forceinline__ void xcd_barrier(const XcdBarrier& b) { xcd_barrier_impl(b.bar, b.x, b.st); }
constexpr int NWAVES = 8;
constexpr int RING_BYTES = 131072, LDSCTL_OFF = RING_BYTES, MISC_OFF = LDSCTL_OFF + 320, LDS_BYTES = 147456;
constexpr size_t CTL_ZERO_BYTES = 1u << 20;
constexpr int CW_BAR = 4096;
constexpr int PH_PER_LAYER = 12, N_PHASES = 1 + 4 * PH_PER_LAYER;

DEVI void tr_job(const float* W, int K, int N, bf16* WT, int abmap, int vb, int nvb, float* t) {
    const int units = (K / 64) * ((N + 63) / 64);
    for (int u = vb; u < units; u += nvb) transpose_unit(W, K, N, WT, abmap, u, t);
}
DEVI void ph_prologue(CP p, int vb, int nvb, float* t) {
    bf16 *WINAB = wsb(p, WS_WINAB), *WOUTAB = wsb(p, WS_WOUTAB), *WINCD = wsb(p, WS_WINCD), *WOUTCD = wsb(p, WS_WOUTCD), *WFF1 = wsb(p, WS_WFF1), *WFF2 = wsb(p, WS_WFF2), *POOLW = wsb(p, WS_POOLW);
    for (int j = 0; j < 2; ++j) {
        tr_job(p->w_in_ab + (size_t)j * DM * 4696, DM, 4696, WINAB + (size_t)j * HC_AB * DM, 1, vb, nvb, t);
        tr_job(p->w_out_ab + (size_t)j * DM * DM, DM, DM, WOUTAB + (size_t)j * DM * DM, 0, vb, nvb, t);
        tr_job(p->w_in_cd + (size_t)j * DM * HC_CD, DM, HC_CD, WINCD + (size_t)j * HC_CD * DM, 0, vb, nvb, t);
        tr_job(p->w_out_cd + (size_t)j * DM * DM, DM, DM, WOUTCD + (size_t)j * DM * DM, 0, vb, nvb, t);
        tr_job(p->pool_w + (size_t)j * 4 * 65536, 256, 256, POOLW + (size_t)j * 4 * 65536, 0, vb, nvb, t);
        tr_job(p->pool_w + ((size_t)j * 4 + 1) * 65536, 256, 256, POOLW + ((size_t)j * 4 + 1) * 65536, 0, vb, nvb, t);
        tr_job(p->pool_w + ((size_t)j * 4 + 2) * 65536, 256, 256, POOLW + ((size_t)j * 4 + 2) * 65536, 0, vb, nvb, t);
        tr_job(p->pool_w + ((size_t)j * 4 + 3) * 65536, 256, 256, POOLW + ((size_t)j * 4 + 3) * 65536, 0, vb, nvb, t);
    }
    for (int i = 0; i < 4; ++i) {
        tr_job(p->w_ff1 + (size_t)i * DM * DFF, DM, DFF, WFF1 + (size_t)i * DFF * DM, 0, vb, nvb, t);
        tr_job(p->w_ff2 + (size_t)i * DFF * DM, DFF, DM, WFF2 + (size_t)i * DM * DFF, 0, vb, nvb, t);
    }
    const size_t gt = (size_t)vb * 512 + ltid(), ng = (size_t)nvb * 512;
    for (size_t i = gt; i < (size_t)2 * (HC_AB - 4696) * DM / 8; i += ng) { const size_t per = (size_t)(HC_AB - 4696) * DM / 8; const size_t j = i / per, r = i % per;
        *(u32x4*)(WINAB + j * HC_AB * DM + (size_t)4696 * DM + r * 8) = (u32x4){0u, 0u, 0u, 0u}; }
    bf16* sw = wsb(p, WS_SGUW);
    for (size_t i = gt; i < 2 * 4 * 128 * 128; i += ng) { const int s = (int)i & 127, tt = ((int)i >> 7) & 127; sw[i] = f2bf(s <= tt ? p->sgu_w[i] : 0.f); }
    float* X = wsf(p, WS_X); bf16* XB = wsb(p, WS_XB);
    for (size_t i = gt; i < (size_t)MP * DM / 4; i += ng) {
        const size_t e = i * 4; const int row = (int)(e / DM);
        f32x4 v = (f32x4){0.f, 0.f, 0.f, 0.f};
        if (row < MPR) v = *(const f32x4*)(p->x_prompt + e); else if (row < MR) v = *(const f32x4*)(p->x_sample + (e - (size_t)MPR * DM));
        *(f32x4*)(X + e) = v; uint2 o; o.x = pk2(v.x, v.y); o.y = pk2(v.z, v.w); *(uint2*)(XB + e) = o;
    }
}

enum { SE_F32 = 0, SE_RESID = 1, SE_RELU2 = 2, SE_SCALE = 3 };
template <int SE> DEVI void skinny_gemm(const bf16* A  , int lda, int acol, const bf16* Bt, int ldb, int N, int K, float* red, int vb, int nvb, float* Cf, bf16* Cb, int ldc, const float* scale) {
    const int tid = ltid(), lane = tid & 63, wv = tid >> 6, fr = lane & 15, fq = lane >> 4;
    const int kw = K >> 3, ks0 = wv * kw;
    for (int u = vb; u < (N >> 4); u += nvb) {
        const int n0 = u * 16, pn = n0 >> 8;
        const bf16* bp = Bt + (size_t)(n0 + fr) * ldb + ks0 + fq * 8; const bf16* ap = A + (size_t)fr * lda + (size_t)pn * acol + ks0 + fq * 8;
        f32x4 acc[4];
#pragma unroll
        for (int mt = 0; mt < 4; ++mt) acc[mt] = (f32x4){0.f, 0.f, 0.f, 0.f};
#pragma unroll 4
        for (int k = 0; k < kw; k += 32) { const bf16x8 bf = *(const bf16x8*)(bp + k);
#pragma unroll
            for (int mt = 0; mt < 4; ++mt) acc[mt] = mfma16(bf, *(const bf16x8*)(ap + (size_t)mt * 16 * lda + k), acc[mt]); }
#pragma unroll
        for (int mt = 0; mt < 4; ++mt) *(f32x4*)(red + (wv * 64 + mt * 16 + fr) * 16 + 4 * fq) = acc[mt];
        __syncthreads();
        { const int r = tid >> 3, c = (tid & 7) * 2; float v0 = 0.f, v1 = 0.f;
#pragma unroll
          for (int w = 0; w < 8; ++w) { const float* q = red + (w * 64 + r) * 16 + c; v0 += q[0]; v1 += q[1]; }
          const size_t o = (size_t)r * ldc + n0 + c;
          if (SE == SE_F32) { Cf[o] = v0; Cf[o + 1] = v1; }
          if (SE == SE_RESID) { Cf[o] = ALPHA * Cf[o] + v0; Cf[o + 1] = ALPHA * Cf[o + 1] + v1; }
          if (SE == SE_RELU2) { const float a = fmaxf(v0, 0.f), b = fmaxf(v1, 0.f); *(unsigned*)(Cb + o) = cvtpk(a * a, b * b); }
          if (SE == SE_SCALE) *(unsigned*)(Cb + o) = cvtpk(v0 * scale[n0 + c], v1 * scale[n0 + c + 1]); }
        __syncthreads();
    }
}
template <class Epi> DEVI void run_gemm(PG8_LAS unsigned char* lds, const bf16* A, int lda, int acol, const bf16* Bt, int ldb, int M, int N, int K, const Epi& E) {
    asm volatile("" : "+s"(K));
    pg8::Gemm g{A, Bt, M, N, K, lda, ldb, acol}; pg8::StaticOrder S; S.init(M, N, (int)gridDim.x, lvb());
    pg8::gemm_phase<Epi, pg8::StaticOrder, true, true>(lds, g, S, E);
}

#define IN(k) (lo <= (k) && (k) < hi)
#define SEAM(k) do { if (IN(k) && (k) + 1 < hi) xcd_barrier(bar); } while (0)
template <int I> DEVI void layer_phases(LAS unsigned char* L, unsigned char* lds, const XcdBarrier& bar, int lo, int hi, int nvb) {
    constexpr int base = 1 + PH_PER_LAYER * I, j = I >> 1;
    float* smf = (float*)lds; int* smi = (int*)lds;
    if constexpr ((I & 1) == 0) {
        if (IN(base + 0)) { CP p = PP(); run_gemm(L, wsb(p, WS_XB), DM, 0, wsb(p, WS_WINAB) + (size_t)j * HC_AB * DM, DM, MPR, HC_AB, DM, pg8::EpiF32{wsf(p, WS_H), HC_AB});
            skinny_gemm<SE_F32>(wsb(p, WS_XB) + (size_t)MPR * DM, DM, 0, wsb(p, WS_WINAB) + (size_t)j * HC_AB * DM, DM, HC_AB, DM, smf, lvb(), nvb, wsf(p, WS_H) + (size_t)MPR * HC_AB, nullptr, HC_AB, nullptr); }
        SEAM(base + 0);
        if (IN(base + 1)) {
            ph_ab_copy(PP(), j, lvb(), nvb);
            for (int u = lvb(); u < 64 * 24; u += nvb) conv_prompt_unit(PP(), j, u / 24, u % 24, (bf16*)lds);
            ph_conv(PP(), j, lvb(), nvb);
            ph_idx_prompt(PP(), lvb(), nvb);
            for (int u = lvb(); u < 8 * 33; u += nvb) idx_sample_unit(PP(), j, u / 33, u % 33, smf);
        }
        SEAM(base + 1);
        if (IN(base + 2)) {
            ph_select_prompt(PP(), lvb(), nvb);
            for (int u = lvb(); u < MSR; u += nvb) select_sample_unit(PP(), u, smi);
            for (int u = lvb(); u < 64 * 16; u += nvb) ssd1_unit(PP(), j, u >> 4, u & 15, smf);
#ifdef EXP_OLDY
            { const int t_ = ltid(), u = (t_ >> 6) * nvb + lvb(); if (u < (NBP + DB) * 32) ssd_seq_unit(PP(), j, u / 32, (u >> 1) & 15, u & 1, t_ & 63); }
#else
            { const int t_ = ltid(), u = (t_ >> 6) * nvb + lvb(); if (u < DB * 32) ssd_seq_unit(PP(), j, NBP + u / 32, (u >> 1) & 15, u & 1, t_ & 63); }
#endif
        }
        SEAM(base + 2);
        if (IN(base + 3)) {
            ph_ssd_scan(PP(), j, lvb(), nvb);
            for (int u = lvb(); u < MSR; u += nvb) attn_sample_unit(PP(), j, u, lds);
            ph_ssd_gate(PP(), j, lvb(), nvb);
        }
        SEAM(base + 3);
        if (IN(base + 4)) {
#ifdef EXP_ATT
            ph_attn_prompt_naive(PP(), lvb(), nvb);
            for (int u = lvb(); u < 256; u += nvb) attn_unit(PP(), (u >> 3) & 1, u & 7, u >> 4, lds, wsb(PP(), WS_HF));
#else
            for (int u = lvb(); u < 256; u += nvb) attn_unit(PP(), (u >> 3) & 1, u & 7, u >> 4, lds, wsb(PP(), WS_AO));
#endif
#ifdef EXP_OLDY
            for (int u = lvb(); u < 64 * 8; u += nvb) ssd3_unit(PP(), j, u >> 3, u & 7, smf, wsb(PP(), WS_HF));
#else
            if (nvb == 256) {
                const int vb_ = lvb(), qb_ = vb_ >> 4, n_ = (0x0001112222333444ull >> (4 * qb_)) & 15, off_ = (qb_ < 3 ? 4 * qb_ : qb_ < 6 ? 12 + 3 * (qb_ - 3) : qb_ < 10 ? 21 + 2 * (qb_ - 6) : qb_ < 13 ? 29 + (qb_ - 10) : 32);
                for (int i = 0; i < n_; ++i) { const int u = off_ * 16 + (vb_ & 15) * n_ + i; ssd3_unit(PP(), j, u >> 3, u & 7, smf, wsb(PP(), WS_AO)); }
            } else for (int u = lvb(); u < 64 * 8; u += nvb) ssd3_unit(PP(), j, u >> 3, u & 7, smf, wsb(PP(), WS_AO));
#endif
        }
        SEAM(base + 4);
#ifdef EXP_ATT
        if (IN(base + 5) && I == 0) { CP p = PP(); diag_cmp(p, 0, wsb(p, WS_AO), DM, wsb(p, WS_HF), DM, MPR, 1024, lvb(), nvb); }
#endif
#ifdef EXP_OLDY
        if (IN(base + 5) && I == 0) { CP p = PP(); const int vb_ = lvb();
            diag_cmp_f32(p, 0, wsf(p, WS_XC), 1536, wsb(p, WS_XCN), 1536, MPR, 1536, vb_, nvb);
            diag_fin_f32(p, 1, wsf(p, WS_ACUM), (size_t)64 * 16 * 128, vb_, nvb);
            diag_fin_f32(p, 2, wsf(p, WS_DTC), (size_t)64 * 16 * 128, vb_, nvb);
            diag_fin_bf16(p, 3, wsb(p, WS_HIN), (size_t)64 * 16 * 8192, vb_, nvb);
            diag_fin_bf16(p, 4, wsb(p, WS_XCT), (size_t)64 * 1536 * 128, vb_, nvb);
            diag_cmp(p, 5, wsb(p, WS_AO) + 1024, DM, wsb(p, WS_HF) + 1024, DM, MPR, 1024, vb_, nvb); }
#endif
        if (IN(base + 5)) { CP p = PP(); run_gemm(L, wsb(p, WS_AO), DM, 0, wsb(p, WS_WOUTAB) + (size_t)j * DM * DM, DM, MPR, DM, DM, pg8::EpiResid{wsf(p, WS_X), DM, ALPHA});
            skinny_gemm<SE_RESID>(wsb(p, WS_AO) + (size_t)MPR * DM, DM, 0, wsb(p, WS_WOUTAB) + (size_t)j * DM * DM, DM, DM, DM, smf, lvb(), nvb, wsf(p, WS_X) + (size_t)MPR * DM, nullptr, DM, nullptr); }
        SEAM(base + 5);
    } else {
        if (IN(base + 0)) { CP p = PP(); run_gemm(L, wsb(p, WS_XB), DM, 0, wsb(p, WS_WINCD) + (size_t)j * HC_CD * DM, DM, MPR, HC_CD, DM, pg8::EpiF32{wsf(p, WS_H), HC_CD});
            skinny_gemm<SE_F32>(wsb(p, WS_XB) + (size_t)MPR * DM, DM, 0, wsb(p, WS_WINCD) + (size_t)j * HC_CD * DM, DM, HC_CD, DM, smf, lvb(), nvb, wsf(p, WS_H) + (size_t)MPR * HC_CD, nullptr, HC_CD, nullptr); }
        SEAM(base + 0);
        if (IN(base + 1)) ph_cd_prep(PP(), j, lvb(), nvb);
        SEAM(base + 1);
        if (IN(base + 2)) {
            { CP p = PP(); run_gemm(L, wsb(p, WS_DD), 1024, 256, wsb(p, WS_POOLW) + (size_t)j * 4 * 65536, 256, MPR, 1024, 256, pg8::EpiBf16<0>{wsb(p, WS_AO), DM, p->pool_scale + (size_t)j * 1024});
              skinny_gemm<SE_SCALE>(wsb(p, WS_DD) + (size_t)MPR * 1024, 1024, 256, wsb(p, WS_POOLW) + (size_t)j * 4 * 65536, 256, 1024, 256, smf, lvb(), nvb, nullptr, wsb(p, WS_AO) + (size_t)MPR * DM, DM, p->pool_scale + (size_t)j * 1024); }
            for (int u = lvb(); u < 64 * 16; u += nvb) sgu_unit(PP(), j, u >> 4, (u >> 2) & 3, u & 3, (bf16*)lds);
            ph_sgu_naive(PP(), j, lvb(), nvb);
        }
        if (IN(base + 2) && base + 5 < hi) xcd_barrier(bar);
        if (IN(base + 5)) { CP p = PP(); run_gemm(L, wsb(p, WS_AO), DM, 0, wsb(p, WS_WOUTCD) + (size_t)j * DM * DM, DM, MPR, DM, DM, pg8::EpiResid{wsf(p, WS_X), DM, ALPHA});
            skinny_gemm<SE_RESID>(wsb(p, WS_AO) + (size_t)MPR * DM, DM, 0, wsb(p, WS_WOUTCD) + (size_t)j * DM * DM, DM, DM, DM, smf, lvb(), nvb, wsf(p, WS_X) + (size_t)MPR * DM, nullptr, DM, nullptr); }
        SEAM(base + 5);
    }
#ifdef EXP_OLDY
    if (IN(base + 6) && I == 0) diag_report(PP(), 6);
#endif
#ifdef EXP_ATT
    if (IN(base + 6) && I == 0) diag_report(PP(), 1);
#endif
    if (IN(base + 6)) { CP p = PP(); ph_ln(p, p->ln1_g + (size_t)I * DM, p->ln1_b + (size_t)I * DM, 0, lvb(), nvb); }
    SEAM(base + 6);
    if (IN(base + 7)) { CP p = PP(); run_gemm(L, wsb(p, WS_XB), DM, 0, wsb(p, WS_WFF1) + (size_t)I * DFF * DM, DM, MPR, DFF, DM, pg8::EpiBf16<1>{wsb(p, WS_HF), DFF, nullptr});
        skinny_gemm<SE_RELU2>(wsb(p, WS_XB) + (size_t)MPR * DM, DM, 0, wsb(p, WS_WFF1) + (size_t)I * DFF * DM, DM, DFF, DM, smf, lvb(), nvb, nullptr, wsb(p, WS_HF) + (size_t)MPR * DFF, DFF, nullptr); }
    SEAM(base + 7);
    if (IN(base + 8)) { CP p = PP(); run_gemm(L, wsb(p, WS_HF), DFF, 0, wsb(p, WS_WFF2) + (size_t)I * DM * DFF, DFF, MPR, DM, DFF, pg8::EpiResid{wsf(p, WS_X), DM, ALPHA});
        skinny_gemm<SE_RESID>(wsb(p, WS_HF) + (size_t)MPR * DFF, DFF, 0, wsb(p, WS_WFF2) + (size_t)I * DM * DFF, DFF, DM, DFF, smf, lvb(), nvb, wsf(p, WS_X) + (size_t)MPR * DM, nullptr, DM, nullptr); }
    SEAM(base + 8);
    if (IN(base + 9)) { CP p = PP(); ph_ln(p, p->ln2_g + (size_t)I * DM, p->ln2_b + (size_t)I * DM, I == 3, lvb(), nvb); }
    if (I < 3) { if (IN(base + 9) && base + PH_PER_LAYER < hi) xcd_barrier(bar); }
}

__global__ void __launch_bounds__(NWAVES * 64, 2) mk_fwd(P p_kernarg) {
    extern __shared__ __attribute__((aligned(16))) unsigned char lds[];
    LAS unsigned char* L = (LAS unsigned char*)lds;
    volatile LAS unsigned* MISC = (volatile LAS unsigned*)(L + MISC_OFF);
    const int nvb = gridDim.x;
    for (int u = threadIdx.x; u < (LDS_BYTES - LDSCTL_OFF) / 4; u += NWAVES * 64) ((LAS unsigned*)(L + LDSCTL_OFF))[u] = 0u;
    __syncthreads();
    unsigned* ctl = (unsigned*)(PP()->ws + WS_CTL);
    XcdBarrier bar = xcd_barrier_post(ctl + CW_BAR, MISC + 8);
    const int lo = PP()->ph_lo, hi = PP()->ph_hi;
    if (IN(0)) ph_prologue(PP(), lvb(), nvb, (float*)lds);
    SEAM(0);
    layer_phases<0>(L, lds, bar, lo, hi, nvb);
    layer_phases<1>(L, lds, bar, lo, hi, nvb);
    layer_phases<2>(L, lds, bar, lo, hi, nvb);
    layer_phases<3>(L, lds, bar, lo, hi, nvb);
}
#undef IN
#undef SEAM

#ifndef MK_PER_PHASE
#define MK_PER_PHASE 0
#endif
extern "C" void kernel_launch(void* const* d_in, const int* in_sizes, int n_in, void* d_out, int out_size, void* d_ws, size_t ws_size, hipStream_t stream) {
    if (n_in != 31 || (size_t)out_size != O_END || ws_size < WS_END) { fprintf(stderr, "kernel_launch: unexpected sizes n_in %d out %d ws %zu (need %zu)\n", n_in, out_size, ws_size, (size_t)WS_END); return; }
    static int grid = 0;
    if (grid == 0) {
        int dev = 0, cus = 0, per_cu = 0;
        if (hipGetDevice(&dev) != hipSuccess || hipDeviceGetAttribute(&cus, hipDeviceAttributeMultiprocessorCount, dev) != hipSuccess) { grid = -1; return; }
        if (hipFuncSetAttribute((const void*)mk_fwd, hipFuncAttributeMaxDynamicSharedMemorySize, LDS_BYTES) != hipSuccess) { fprintf(stderr, "kernel_launch: hipFuncSetAttribute failed\n"); grid = -1; return; }
        if (hipOccupancyMaxActiveBlocksPerMultiprocessor(&per_cu, (const void*)mk_fwd, NWAVES * 64, LDS_BYTES) != hipSuccess || per_cu < 1) fprintf(stderr, "kernel_launch: occupancy query says %d\n", per_cu);
        (void)hipGetLastError();
        grid = cus;
    }
    if (grid < 0) return;
    (void)hipMemsetAsync((char*)d_ws + WS_CTL, 0, CTL_ZERO_BYTES, stream);
    P p{};
    p.x_prompt = (const float*)d_in[0]; p.x_sample = (const float*)d_in[1]; p.cache_k = (const float*)d_in[2]; p.cache_v = (const float*)d_in[3]; p.cache_ik = (const float*)d_in[4];
    p.state_ssm = (const float*)d_in[5]; p.state_conv = (const float*)d_in[6]; p.state_pool = (const float*)d_in[7]; p.page_table = (const int*)d_in[8];
    p.ln1_g = (const float*)d_in[9]; p.ln1_b = (const float*)d_in[10]; p.ln2_g = (const float*)d_in[11]; p.ln2_b = (const float*)d_in[12];
    p.w_in_ab = (const float*)d_in[13]; p.conv_w = (const float*)d_in[14]; p.conv_b = (const float*)d_in[15]; p.dt_bias = (const float*)d_in[16]; p.a_log = (const float*)d_in[17];
    p.d_skip = (const float*)d_in[18]; p.ssd_g = (const float*)d_in[19]; p.w_out_ab = (const float*)d_in[20]; p.w_in_cd = (const float*)d_in[21]; p.pool_w = (const float*)d_in[22];
    p.pool_scale = (const float*)d_in[23]; p.sgu_ln_g = (const float*)d_in[24]; p.sgu_ln_b = (const float*)d_in[25]; p.sgu_w = (const float*)d_in[26]; p.sgu_b = (const float*)d_in[27];
    p.w_out_cd = (const float*)d_in[28]; p.w_ff1 = (const float*)d_in[29]; p.w_ff2 = (const float*)d_in[30];
    p.out = (float*)d_out; p.ws = (unsigned char*)d_ws;
#if MK_PER_PHASE
    for (int k = 0; k < N_PHASES; ++k) { const int r = (k - 1) % PH_PER_LAYER; if (k > 0 && (r > 9 || (((k - 1) / PH_PER_LAYER) & 1) && (r == 3 || r == 4))) continue; p.ph_lo = k; p.ph_hi = k + 1; hipLaunchKernelGGL(mk_fwd, dim3(grid), dim3(NWAVES * 64), LDS_BYTES, stream, p); }
#else
    p.ph_lo = 0; p.ph_hi = N_PHASES;
    hipLaunchKernelGGL(mk_fwd, dim3(grid), dim3(NWAVES * 64), LDS_BYTES, stream, p);
#endif
}
```

```cpp
#include <hip/hip_runtime.h>
#include <stdint.h>
#include <stdio.h>

typedef unsigned short bf16;
typedef float f32x4 __attribute__((ext_vector_type(4)));
typedef unsigned u32x4 __attribute__((ext_vector_type(4)));
#define DEVI __device__ __forceinline__
typedef short bf16x8 __attribute__((ext_vector_type(8)));
typedef unsigned u32x2 __attribute__((ext_vector_type(2)));
DEVI f32x4 mfma16(bf16x8 bt, bf16x8 a, f32x4 c) { return __builtin_amdgcn_mfma_f32_16x16x32_bf16(bt, a, c, 0, 0, 0); }
typedef float f32x2_t __attribute__((ext_vector_type(2))); typedef __bf16 bf16x2_t __attribute__((ext_vector_type(2)));
DEVI unsigned cvtpk(float lo, float hi) { f32x2_t v = {lo, hi}; bf16x2_t b = __builtin_convertvector(v, bf16x2_t); return __builtin_bit_cast(unsigned, b); }
DEVI float bflo(unsigned w) { return __uint_as_float(w << 16); }
DEVI float bfhi(unsigned w) { return __uint_as_float(w & 0xffff0000u); }

constexpr int DM = 2048, SEQ = 4096, NBP = 2, MPR = NBP * SEQ;
constexpr int DB = 8, DS = 8, MSR = DB * DS;
constexpr int MR = MPR + MSR;
constexpr int MP = 8448;
constexpr int PAST = 16384, PAGE = 128, NPAGES = PAST / PAGE, NPOOL = 1280;
constexpr int NKEY_S = PAST + DS;
constexpr int SCS_LD = 16400;
constexpr int HC_AB = 4864, HC_CD = 3072, DFF = 8192;
constexpr int TOPK = 256;
constexpr int C_Q = 0, C_K = 1024, C_V = 1280, C_QI = 1536, C_Z = 2048, C_XBC = 3072, C_KI = 4608, C_WI = 4672, C_DT = 4680;
constexpr float ALPHA = 1.681792830507429f;
constexpr float EPS = 1e-5f;
constexpr float IDX_SCALE = 0.04419417382415922f;
constexpr float ATT_SCALE = 0.08838834764831845f;

constexpr size_t O_YP = 0;
constexpr size_t O_YS = O_YP + (size_t)MPR * DM;
constexpr size_t O_KP = O_YS + (size_t)MSR * DM;
constexpr size_t O_VP = O_KP + (size_t)2 * MPR * 256;
constexpr size_t O_IP = O_VP + (size_t)2 * MPR * 256;
constexpr size_t O_HP = O_IP + (size_t)2 * MPR * 64;
constexpr size_t O_CP = O_HP + (size_t)2 * NBP * 16 * 64 * 128;
constexpr size_t O_PP = O_CP + (size_t)2 * NBP * 3 * 1536;
constexpr size_t O_KS = O_PP + (size_t)2 * NBP * 15 * 1024;
constexpr size_t O_VS = O_KS + (size_t)2 * MSR * 256;
constexpr size_t O_IS = O_VS + (size_t)2 * MSR * 256;
constexpr size_t O_HS = O_IS + (size_t)2 * MSR * 64;
constexpr size_t O_CS = O_HS + (size_t)2 * DB * 16 * 64 * 128;
constexpr size_t O_PS = O_CS + (size_t)2 * DB * 3 * 1536;
constexpr size_t O_GS = O_PS + (size_t)2 * DB * 15 * 1024;
constexpr size_t O_END = O_GS + (size_t)2 * MSR * 1024;
static_assert(O_END == 29571072, "output size");

constexpr size_t al256(size_t x) { return (x + 255) & ~(size_t)255; }
constexpr size_t WS_CTL = 0;
constexpr size_t WS_X = 1u << 20;
constexpr size_t WS_XB = WS_X + al256((size_t)MP * DM * 4);
constexpr size_t WS_H = WS_XB + al256((size_t)MP * DM * 2);
constexpr size_t WS_AO = WS_H + al256((size_t)MP * HC_AB * 4);
constexpr size_t WS_HF = WS_AO + al256((size_t)MP * DM * 2);
constexpr size_t WS_SC = WS_HF + al256((size_t)MP * DFF * 2);
constexpr size_t WS_MASK = WS_SC + al256((size_t)MPR * SEQ * 4);
constexpr size_t WS_XC = WS_MASK + al256((size_t)MPR * 64 * 8);
constexpr size_t WS_DT = WS_XC + al256((size_t)MP * 1536 * 4);
constexpr size_t WS_Y = WS_DT + al256((size_t)MP * 16 * 4);
constexpr size_t WS_SCS = WS_Y + al256((size_t)MP * 1024 * 4);
constexpr size_t WS_SELS = WS_SCS + al256((size_t)MSR * SCS_LD * 4);
constexpr size_t WS_DD = WS_SELS + al256((size_t)MSR * TOPK * 4);
constexpr size_t WS_U = WS_DD + al256((size_t)MP * 1024 * 2);
constexpr size_t WS_VLN = WS_U + al256((size_t)MP * 1024 * 2);
constexpr size_t WS_WINAB = WS_VLN + al256((size_t)MP * 1024 * 2);
constexpr size_t WS_WOUTAB = WS_WINAB + (size_t)2 * HC_AB * DM * 2;
constexpr size_t WS_WINCD = WS_WOUTAB + (size_t)2 * DM * DM * 2;
constexpr size_t WS_WOUTCD = WS_WINCD + (size_t)2 * HC_CD * DM * 2;
constexpr size_t WS_WFF1 = WS_WOUTCD + (size_t)2 * DM * DM * 2;
constexpr size_t WS_WFF2 = WS_WFF1 + (size_t)4 * DFF * DM * 2;
constexpr size_t WS_POOLW = WS_WFF2 + (size_t)4 * DFF * DM * 2;
constexpr size_t WS_SGUW = WS_POOLW + (size_t)2 * 4 * 256 * 256 * 2;
constexpr size_t WS_XCN = WS_SGUW + (size_t)2 * 4 * 128 * 128 * 2;
constexpr size_t WS_XCT = WS_XCN + al256((size_t)MP * 1536 * 2);
constexpr size_t WS_ACUM = WS_XCT + al256((size_t)64 * 1536 * 128 * 2);
constexpr size_t WS_DTC = WS_ACUM + al256((size_t)64 * 16 * 128 * 4);
constexpr size_t WS_CDEC = WS_DTC + al256((size_t)64 * 16 * 128 * 4);
constexpr size_t WS_ST = WS_CDEC + al256((size_t)64 * 16 * 4);
constexpr size_t WS_HIN = WS_ST + al256((size_t)64 * 16 * 64 * 128 * 4);
constexpr size_t WS_QB = WS_HIN + al256((size_t)64 * 16 * 64 * 128 * 2);
constexpr size_t WS_KB = WS_QB + al256((size_t)MPR * 1024 * 2);
constexpr size_t WS_VB = WS_KB + al256((size_t)MPR * 256 * 2);
constexpr size_t WS_QIB = WS_VB + al256((size_t)MPR * 256 * 2);
constexpr size_t WS_KIB = WS_QIB + al256((size_t)MPR * 512 * 2);
constexpr size_t WS_END = WS_KIB + al256((size_t)MPR * 64 * 2);

struct P {
    const float *x_prompt, *x_sample, *cache_k, *cache_v, *cache_ik, *state_ssm, *state_conv, *state_pool;
    const int* page_table;
    const float *ln1_g, *ln1_b, *ln2_g, *ln2_b, *w_in_ab, *conv_w, *conv_b, *dt_bias, *a_log, *d_skip, *ssd_g, *w_out_ab;
    const float *w_in_cd, *pool_w, *pool_scale, *sgu_ln_g, *sgu_ln_b, *sgu_w, *sgu_b, *w_out_cd, *w_ff1, *w_ff2;
    float* out;
    unsigned char* ws;
    int ph_lo, ph_hi, a2, a3;
};
typedef const __attribute__((address_space(4))) P* CP;
DEVI CP PP() { CP q = (CP)__builtin_amdgcn_kernarg_segment_ptr(); asm volatile("" : "+s"(q)); return q; }
DEVI float* wsf(CP p, size_t off) { return (float*)(p->ws + off); }
DEVI bf16* wsb(CP p, size_t off) { return (bf16*)(p->ws + off); }

DEVI float bf2f(bf16 b) { return __uint_as_float(((unsigned)b) << 16); }
DEVI bf16 f2bf(float f) { unsigned u = __float_as_uint(f); u += 0x7fffu + ((u >> 16) & 1u); return (bf16)(u >> 16); }
DEVI unsigned pk2(float lo, float hi) { return (unsigned)f2bf(lo) | ((unsigned)f2bf(hi) << 16); }
DEVI float wave_sum(float v) {
#pragma unroll
    for (int o = 1; o < 64; o <<= 1) v += __shfl_xor(v, o);
    return v;
}
DEVI int ltid() { int t = threadIdx.x; asm volatile("" : "+v"(t)); return t; }
DEVI int lvb() { int b = blockIdx.x; asm volatile("" : "+s"(b)); return b; }
DEVI float silu_f(float x) { return x / (1.f + __expf(-x)); }
DEVI float softplus_f(float x) { return fmaxf(x, 0.f) + log1pf(__expf(-fabsf(x))); }
DEVI float gelu_f(float x) { return 0.5f * x * (1.f + erff(x * 0.70710678118654752f)); }
DEVI unsigned ord_f(float f) { f = f + 0.0f; unsigned u = __float_as_uint(f); return (u & 0x80000000u) ? ~u : (u | 0x80000000u); }
__host__ __device__ inline int ab_dst_col(int n) {
    if (n < 2048) return n;
    if (n < 2112) return C_KI + (n - 2048);
    if (n < 2120) return C_WI + (n - 2112);
    if (n < 3144) return C_Z + (n - 2120);
    if (n < 4680) return C_XBC + (n - 3144);
    return n;
}

DEVI void transpose_unit(const float* W, int K, int N, bf16* WT, int abmap, int unit, float* t  ) {
    const int TIDX = ltid();
    const int nbn = (N + 63) / 64, kb = unit / nbn, nb = unit % nbn, k0 = kb * 64, n0 = nb * 64, tid = TIDX;
#pragma unroll
    for (int i = 0; i < 8; ++i) { const int kk = (tid >> 6) + 8 * i, n = n0 + (tid & 63); t[kk * 65 + (tid & 63)] = (n < N) ? W[(size_t)(k0 + kk) * N + n] : 0.f; }
    __syncthreads();
    { const int n = n0 + (tid >> 3), kq = (tid & 7) * 8;
      if (n < N) { const int row = abmap ? ab_dst_col(n) : n; const float* s = t + kq * 65 + (tid >> 3);
          u32x4 o; o.x = pk2(s[0], s[65]); o.y = pk2(s[2 * 65], s[3 * 65]); o.z = pk2(s[4 * 65], s[5 * 65]); o.w = pk2(s[6 * 65], s[7 * 65]);
          *(u32x4*)(WT + (size_t)row * K + k0 + kq) = o; } }
    __syncthreads();
}


DEVI void ph_ln(CP p, const float* g, const float* b, int final_out, int vb, int nvb) {
    const int TIDX = ltid();
    float* X = wsf(p, WS_X); bf16* XB = wsb(p, WS_XB);
    const int lane = TIDX & 63, wv = TIDX >> 6;
    for (int row = vb * 8 + wv; row < MR; row += nvb * 8) {
        float* xr = X + (size_t)row * DM; f32x4 v[8]; float s = 0.f;
#pragma unroll
        for (int i = 0; i < 8; ++i) { v[i] = *(const f32x4*)(xr + (i * 64 + lane) * 4); s += (v[i].x + v[i].y) + (v[i].z + v[i].w); }
        const float mean = wave_sum(s) * (1.f / DM); float q = 0.f;
#pragma unroll
        for (int i = 0; i < 8; ++i) { v[i] = v[i] - mean; q += (v[i].x * v[i].x + v[i].y * v[i].y) + (v[i].z * v[i].z + v[i].w * v[i].w); }
        const float rstd = 1.f / sqrtf(wave_sum(q) * (1.f / DM) + EPS);
        float* o = final_out ? (row < MPR ? p->out + O_YP + (size_t)row * DM : p->out + O_YS + (size_t)(row - MPR) * DM) : nullptr;
#pragma unroll
        for (int i = 0; i < 8; ++i) { const int c = (i * 64 + lane) * 4; const f32x4 gg = *(const f32x4*)(g + c), bb = *(const f32x4*)(b + c);
            const f32x4 y = v[i] * rstd * gg + bb; *(f32x4*)(xr + c) = y; uint2 w; w.x = pk2(y.x, y.y); w.y = pk2(y.z, y.w); *(uint2*)(XB + (size_t)row * DM + c) = w;
            if (final_out) *(f32x4*)(o + c) = y; }
    }
}

DEVI void ph_ab_copy(CP p, int j, int vb, int nvb) {
    const int TIDX = ltid();
    const float* H = wsf(p, WS_H); const int tid = TIDX;
    for (int row = vb; row < MR; row += nvb) {
        const float* h = H + (size_t)row * HC_AB;
        float *ko, *vo, *io;
        if (row < MPR) { ko = p->out + O_KP + ((size_t)j * MPR + row) * 256; vo = p->out + O_VP + ((size_t)j * MPR + row) * 256; io = p->out + O_IP + ((size_t)j * MPR + row) * 64; }
        else { const int sr = row - MPR; ko = p->out + O_KS + ((size_t)j * MSR + sr) * 256; vo = p->out + O_VS + ((size_t)j * MSR + sr) * 256; io = p->out + O_IS + ((size_t)j * MSR + sr) * 64; }
        if (tid < 256) ko[tid] = h[C_K + tid]; else vo[tid - 256] = h[C_V + tid - 256];
        if (row < MPR) { const float qs = ATT_SCALE * 1.4426950408889634f;
            *(unsigned*)(wsb(p, WS_QB) + (size_t)row * 1024 + 2 * tid) = cvtpk(h[C_Q + 2 * tid] * qs, h[C_Q + 2 * tid + 1] * qs);
            if (tid < 128) *(unsigned*)(wsb(p, WS_KB) + (size_t)row * 256 + 2 * tid) = cvtpk(h[C_K + 2 * tid], h[C_K + 2 * tid + 1]);
            else if (tid < 256) *(unsigned*)(wsb(p, WS_VB) + (size_t)row * 256 + 2 * (tid - 128)) = cvtpk(h[C_V + 2 * (tid - 128)], h[C_V + 2 * (tid - 128) + 1]);
            else if (tid < 512) *(unsigned*)(wsb(p, WS_QIB) + (size_t)row * 512 + 2 * (tid - 256)) = cvtpk(h[C_QI + 2 * (tid - 256)], h[C_QI + 2 * (tid - 256) + 1]);
            if (tid < 32) *(unsigned*)(wsb(p, WS_KIB) + (size_t)row * 64 + 2 * tid) = cvtpk(h[C_KI + 2 * tid], h[C_KI + 2 * tid + 1]); }
        if (tid < 64) io[tid] = h[C_KI + tid];
        int ci = -1; float* co = nullptr;
        if (row < MPR) { const int b = row / SEQ, t = row % SEQ; if (t >= SEQ - 3) { ci = t - (SEQ - 3); co = p->out + O_CP + (((size_t)j * NBP + b) * 3 + ci) * 1536; } }
        else { const int b = (row - MPR) / DS, t = (row - MPR) % DS; if (t >= DS - 3) { ci = t - (DS - 3); co = p->out + O_CS + (((size_t)j * DB + b) * 3 + ci) * 1536; } }
        if (ci >= 0) for (int c = tid; c < 1536; c += 512) co[c] = h[C_XBC + c];
    }
}

DEVI void ph_conv(CP p, int j, int vb, int nvb) {
    const int TIDX = ltid();
    const float* H = wsf(p, WS_H); float* XC = wsf(p, WS_XC); float* DT = wsf(p, WS_DT);
    const float* cw = p->conv_w + (size_t)j * 4 * 1536; const float* cb = p->conv_b + (size_t)j * 1536;
#ifdef EXP_OLDY
    for (int row = vb; row < MR; row += nvb) {
#else
    for (int row = MPR + vb; row < MR; row += nvb) {
#endif
        const bool pr = row < MPR; const int b = pr ? row / SEQ : (row - MPR) / DS, t = pr ? row % SEQ : (row - MPR) % DS;
        for (int c = TIDX; c < 1536; c += 512) {
            float acc = cb[c];
#pragma unroll
            for (int jj = 0; jj < 4; ++jj) { const int tt = t - 3 + jj; float xv;
                if (tt >= 0) xv = H[(size_t)(row - t + tt) * HC_AB + C_XBC + c];
                else xv = pr ? 0.f : p->state_conv[(((size_t)j * DB + b) * 3 + (3 + tt)) * 1536 + c];
                acc += cw[jj * 1536 + c] * xv; }
            XC[(size_t)row * 1536 + c] = silu_f(acc);
        }
        if (TIDX < 16) DT[row * 16 + TIDX] = softplus_f(H[(size_t)row * HC_AB + C_DT + TIDX] + p->dt_bias[j * 16 + TIDX]);
    }
}

DEVI void ssd_seq_unit(CP p, int j, int sq  , int h, int ph, int lane) {
    const float* XC = wsf(p, WS_XC); const float* DT = wsf(p, WS_DT); float* Y = wsf(p, WS_Y);
    const bool pr = sq < NBP; const int b = pr ? sq : sq - NBP, n = pr ? SEQ : DS, row0 = pr ? b * SEQ : MPR + b * DS, g = h >> 3;
    const int pp = ph * 32 + (lane & 31), nh = lane >> 5;
    const float a = -__expf(p->a_log[j * 16 + h]), Dk = p->d_skip[j * 16 + h];
    float st[64];
    if (pr) {
#pragma unroll
        for (int i = 0; i < 64; ++i) st[i] = 0.f;
    } else { const float* h0 = p->state_ssm + ((((size_t)j * DB + b) * 16 + h) * 64 + pp) * 128 + nh * 64;
#pragma unroll
        for (int i = 0; i < 16; ++i) { const f32x4 v = *(const f32x4*)(h0 + 4 * i); st[4 * i] = v.x; st[4 * i + 1] = v.y; st[4 * i + 2] = v.z; st[4 * i + 3] = v.w; } }
    for (int t = 0; t < n; ++t) {
        const int row = row0 + t; const float dt = DT[row * 16 + h], dA = __expf(dt * a), x = XC[(size_t)row * 1536 + h * 64 + pp], cf = dt * x;
        const float* Bp = XC + (size_t)row * 1536 + 1024 + g * 128 + nh * 64; const float* Cp = Bp + 256;
        float y = 0.f;
#pragma unroll
        for (int i = 0; i < 16; ++i) { if ((i & 7) == 0) asm volatile("" ::: "memory");
            const f32x4 bv = *(const f32x4*)(Bp + 4 * i), cv = *(const f32x4*)(Cp + 4 * i);
            st[4 * i] = st[4 * i] * dA + cf * bv.x; st[4 * i + 1] = st[4 * i + 1] * dA + cf * bv.y; st[4 * i + 2] = st[4 * i + 2] * dA + cf * bv.z; st[4 * i + 3] = st[4 * i + 3] * dA + cf * bv.w;
            y += cv.x * st[4 * i] + cv.y * st[4 * i + 1] + cv.z * st[4 * i + 2] + cv.w * st[4 * i + 3]; }
        y += __shfl_xor(y, 32);
        if (nh == 0) Y[(size_t)row * 1024 + h * 64 + pp] = y + Dk * x;
    }
#ifdef EXP_OLDY
    if (pr) return;
#endif
    float* ho = (pr ? p->out + O_HP + ((((size_t)j * NBP + b) * 16 + h) * 64 + pp) * 128 : p->out + O_HS + ((((size_t)j * DB + b) * 16 + h) * 64 + pp) * 128) + nh * 64;
#pragma unroll
    for (int i = 0; i < 16; ++i) *(f32x4*)(ho + 4 * i) = (f32x4){st[4 * i], st[4 * i + 1], st[4 * i + 2], st[4 * i + 3]};
}

DEVI void conv_prompt_unit(CP p, int j, int ck, int cb, bf16* T  ) {
    const int tid = ltid(), ch = tid & 63, sg = tid >> 6;
    const float* H = wsf(p, WS_H); bf16* XCN = wsb(p, WS_XCN); bf16* XCT = wsb(p, WS_XCT);
    const int row0 = ck * 128, col = cb * 64 + ch, s0 = sg * 16;
    const float* cw = p->conv_w + (size_t)j * 4 * 1536 + col; const float w0 = cw[0], w1 = cw[1536], w2 = cw[2 * 1536], w3 = cw[3 * 1536], bias = p->conv_b[(size_t)j * 1536 + col];
    const float* hp = H + (size_t)(row0 + s0) * HC_AB + C_XBC + col;
    const bool first = ((ck & 31) == 0) && (sg == 0);
    float x0 = first ? 0.f : hp[-3 * HC_AB], x1 = first ? 0.f : hp[-2 * HC_AB], x2 = first ? 0.f : hp[-HC_AB];
#pragma unroll 4
    for (int i = 0; i < 16; ++i) { const float x3 = hp[(size_t)i * HC_AB]; const bf16 v = f2bf(silu_f(bias + w0 * x0 + w1 * x1 + w2 * x2 + w3 * x3));
        XCN[(size_t)(row0 + s0 + i) * 1536 + col] = v; T[ch * 136 + s0 + i] = v; x0 = x1; x1 = x2; x2 = x3; }
    if (cb == 0) for (int idx = tid; idx < 128 * 16; idx += 512) { const int s = idx >> 4, hh = idx & 15;
        wsf(p, WS_DT)[(row0 + s) * 16 + hh] = softplus_f(H[(size_t)(row0 + s) * HC_AB + C_DT + hh] + p->dt_bias[j * 16 + hh]); }
    __syncthreads();
    { const int chh = tid >> 3, sq = (tid & 7) * 16; const u32x4 a = *(const u32x4*)(T + chh * 136 + sq), b = *(const u32x4*)(T + chh * 136 + sq + 8);
      bf16* dst = XCT + ((size_t)ck * 1536 + cb * 64 + chh) * 128 + sq; *(u32x4*)dst = a; *(u32x4*)(dst + 8) = b; }
    __syncthreads();
}
DEVI void ssd1_unit(CP p, int j, int ck, int h, float* sm  ) {
    const int tid = ltid(), lane = tid & 63, wv = tid >> 6, fr = lane & 15, fq = lane >> 4, g = h >> 3;
    if (wv == 0) {
        const float* DT = wsf(p, WS_DT) + (size_t)ck * 128 * 16 + h; const float a = -__expf(p->a_log[j * 16 + h]);
        float* ACUM = wsf(p, WS_ACUM) + ((size_t)ck * 16 + h) * 128; float* DTC = wsf(p, WS_DTC) + ((size_t)ck * 16 + h) * 128;
        const float d0 = DT[(2 * lane) * 16], d1 = DT[(2 * lane + 1) * 16], v0 = d0 * a, v1 = v0 + d1 * a;
        float run = v1;
#pragma unroll
        for (int o = 1; o < 64; o <<= 1) { const float t = __shfl_up(run, o); if (lane >= o) run += t; }
        const float ex = run - v1, a0 = ex + v0, a1 = ex + v1, last = __shfl(run, 63);
        sm[2 * lane] = a0; sm[2 * lane + 1] = a1; ACUM[2 * lane] = a0; ACUM[2 * lane + 1] = a1; DTC[2 * lane] = d0; DTC[2 * lane + 1] = d1;
        sm[128 + 2 * lane] = d0 * __expf(last - a0); sm[128 + 2 * lane + 1] = d1 * __expf(last - a1);
        if (lane == 0) wsf(p, WS_CDEC)[ck * 16 + h] = __expf(last);
    }
    __syncthreads();
    const bf16* XCT = wsb(p, WS_XCT) + (size_t)ck * 1536 * 128;
    const bf16* Btp = XCT + (size_t)(1024 + g * 128 + wv * 16 + fr) * 128 + fq * 8;
    const bf16* xp = XCT + (size_t)(h * 64 + fr) * 128 + fq * 8;
    f32x4 acc[4];
#pragma unroll
    for (int pt = 0; pt < 4; ++pt) acc[pt] = (f32x4){0.f, 0.f, 0.f, 0.f};
#pragma unroll
    for (int k = 0; k < 4; ++k) {
        const bf16x8 bfrag = *(const bf16x8*)(Btp + k * 32);
        const f32x4 wa = *(const f32x4*)(sm + 128 + k * 32 + fq * 8), wb = *(const f32x4*)(sm + 128 + k * 32 + fq * 8 + 4);
#pragma unroll
        for (int pt = 0; pt < 4; ++pt) { const u32x4 xv = *(const u32x4*)(xp + (size_t)pt * 16 * 128 + k * 32);
            u32x4 sv; sv.x = cvtpk(bflo(xv.x) * wa.x, bfhi(xv.x) * wa.y); sv.y = cvtpk(bflo(xv.y) * wa.z, bfhi(xv.y) * wa.w); sv.z = cvtpk(bflo(xv.z) * wb.x, bfhi(xv.z) * wb.y); sv.w = cvtpk(bflo(xv.w) * wb.z, bfhi(xv.w) * wb.w);
            acc[pt] = mfma16(bfrag, __builtin_bit_cast(bf16x8, sv), acc[pt]); }
    }
    float* ST = wsf(p, WS_ST) + ((size_t)ck * 16 + h) * 8192;
#pragma unroll
    for (int pt = 0; pt < 4; ++pt) *(f32x4*)(ST + (size_t)(pt * 16 + fr) * 128 + wv * 16 + fq * 4) = acc[pt];
    __syncthreads();
}
DEVI void ph_ssd_scan(CP p, int j, int vb, int nvb) {
    const float* ST = wsf(p, WS_ST); const float* CDEC = wsf(p, WS_CDEC); bf16* HIN = wsb(p, WS_HIN);
    const int tid = ltid();
    for (int e4 = vb * 512 + tid; e4 < NBP * 16 * 64 * 128 / 4; e4 += nvb * 512) {
        const int b = e4 / (16 * 64 * 32), r = e4 % (16 * 64 * 32), h = r / (64 * 32);
        f32x4 st = (f32x4){0.f, 0.f, 0.f, 0.f};
#pragma unroll 8
        for (int c = 0; c < 32; ++c) { const int ck = b * 32 + c; const size_t off = (size_t)ck * 16 * 8192 + (size_t)r * 4;
            u32x2 o; o.x = cvtpk(st.x, st.y); o.y = cvtpk(st.z, st.w); *(u32x2*)(HIN + off) = o;
            const f32x4 sv = *(const f32x4*)(ST + off); const float d = CDEC[ck * 16 + h]; st = st * d + sv; }
        *(f32x4*)(p->out + O_HP + ((size_t)j * NBP + b) * 16 * 8192 + (size_t)r * 4) = st;
    }
}
DEVI void ssd3_unit(CP p, int j, int ck, int tt, float* red  , bf16* AO) {
    const int tid = ltid(), lane = tid & 63, wv = tid >> 6, fr = lane & 15, fq = lane >> 4, g = wv >> 2;
    const int t0 = tt * 16; const size_t row = (size_t)ck * 128 + t0 + fr;
    const bf16* XCN = wsb(p, WS_XCN); const bf16* XCT = wsb(p, WS_XCT) + (size_t)ck * 1536 * 128; const float* H = wsf(p, WS_H);
    bf16x8 cf[4];
#pragma unroll
    for (int k = 0; k < 4; ++k) cf[k] = *(const bf16x8*)(XCN + row * 1536 + 1280 + g * 128 + k * 32 + fq * 8);
    f32x4 cbt[8];
#pragma unroll
    for (int jt = 0; jt < 8; ++jt) { cbt[jt] = (f32x4){0.f, 0.f, 0.f, 0.f};
        if (jt <= tt) { const bf16* bp = XCN + ((size_t)ck * 128 + jt * 16 + fr) * 1536 + 1024 + g * 128 + fq * 8;
#pragma unroll
            for (int k = 0; k < 4; ++k) cbt[jt] = mfma16(*(const bf16x8*)(bp + k * 32), cf[k], cbt[jt]); } }
    f32x4 yv[2][4]; float ss = 0.f;
#pragma unroll
    for (int hh = 0; hh < 2; ++hh) {
        const int h = 2 * wv + hh;
        const float* AC = wsf(p, WS_ACUM) + ((size_t)ck * 16 + h) * 128; const float* DC = wsf(p, WS_DTC) + ((size_t)ck * 16 + h) * 128;
        const float at = AC[t0 + fr], Dk = p->d_skip[j * 16 + h];
        f32x4 yd[4];
#pragma unroll
        for (int pt = 0; pt < 4; ++pt) yd[pt] = (f32x4){0.f, 0.f, 0.f, 0.f};
#pragma unroll
        for (int q = 0; q < 4; ++q) if (2 * q <= tt) {
            const int sa = 2 * q * 16 + 4 * fq, sb = sa + 16;
            const f32x4 aa = *(const f32x4*)(AC + sa), da = *(const f32x4*)(DC + sa), ab = *(const f32x4*)(AC + sb), db = *(const f32x4*)(DC + sb);
            float la[4], lb[4];
#pragma unroll
            for (int i = 0; i < 4; ++i) { la[i] = (sa + i <= t0 + fr) ? cbt[2 * q][i] * __expf(fminf(at - aa[i], 0.f)) * da[i] : 0.f;
                                          lb[i] = (2 * q + 1 <= tt && sb + i <= t0 + fr) ? cbt[2 * q + 1][i] * __expf(fminf(at - ab[i], 0.f)) * db[i] : 0.f; }
            u32x4 lw; lw.x = cvtpk(la[0], la[1]); lw.y = cvtpk(la[2], la[3]); lw.z = cvtpk(lb[0], lb[1]); lw.w = cvtpk(lb[2], lb[3]);
            const bf16x8 lf = __builtin_bit_cast(bf16x8, lw);
#pragma unroll
            for (int pt = 0; pt < 4; ++pt) { const bf16* xq = XCT + (size_t)(h * 64 + pt * 16 + fr) * 128;
                const u32x2 xa = *(const u32x2*)(xq + sa), xb = *(const u32x2*)(xq + sb); u32x4 xw; xw.x = xa.x; xw.y = xa.y; xw.z = xb.x; xw.w = xb.y;
                yd[pt] = mfma16(__builtin_bit_cast(bf16x8, xw), lf, yd[pt]); }
        }
        const bf16* hq = wsb(p, WS_HIN) + ((size_t)ck * 16 + h) * 8192 + (size_t)fr * 128 + fq * 8; const float eat = __expf(at);
#pragma unroll
        for (int pt = 0; pt < 4; ++pt) { f32x4 of = (f32x4){0.f, 0.f, 0.f, 0.f};
#pragma unroll
            for (int k = 0; k < 4; ++k) of = mfma16(*(const bf16x8*)(hq + (size_t)pt * 16 * 128 + k * 32), cf[k], of);
            const int c0 = h * 64 + pt * 16 + 4 * fq;
            const u32x2 xw = *(const u32x2*)(XCN + row * 1536 + c0); const f32x4 z = *(const f32x4*)(H + row * HC_AB + C_Z + c0);
            f32x4 y = yd[pt] + of * eat;
            y.x += Dk * bflo(xw.x); y.y += Dk * bfhi(xw.x); y.z += Dk * bflo(xw.y); y.w += Dk * bfhi(xw.y);
            y.x *= silu_f(z.x); y.y *= silu_f(z.y); y.z *= silu_f(z.z); y.w *= silu_f(z.w);
            ss += (y.x * y.x + y.y * y.y) + (y.z * y.z + y.w * y.w); yv[hh][pt] = y; }
    }
    ss += __shfl_xor(ss, 16); ss += __shfl_xor(ss, 32);
    if (fq == 0) red[wv * 16 + fr] = ss;
    __syncthreads();
    float tot = 0.f;
#pragma unroll
    for (int w = 0; w < 8; ++w) tot += red[w * 16 + fr];
    const float rs = 1.f / sqrtf(tot * (1.f / 1024.f) + EPS);
    const float* gg = p->ssd_g + (size_t)j * 1024;
#pragma unroll
    for (int hh = 0; hh < 2; ++hh)
#pragma unroll
        for (int pt = 0; pt < 4; ++pt) { const int c0 = (2 * wv + hh) * 64 + pt * 16 + 4 * fq; const f32x4 gv = *(const f32x4*)(gg + c0); const f32x4 o = yv[hh][pt] * rs * gv;
            u32x2 w; w.x = cvtpk(o.x, o.y); w.y = cvtpk(o.z, o.w); *(u32x2*)(AO + row * DM + 1024 + c0) = w; }
    __syncthreads();
}

DEVI void ph_ssd_gate(CP p, int j, int vb, int nvb) {
    const int TIDX = ltid();
    const float* H = wsf(p, WS_H); const float* Y = wsf(p, WS_Y); bf16* AO = wsb(p, WS_AO); const float* g = p->ssd_g + (size_t)j * 1024;
    const int lane = TIDX & 63, wv = TIDX >> 6;
#ifdef EXP_OLDY
    for (int row = vb * 8 + wv; row < MR; row += nvb * 8) {
#else
    for (int row = MPR + vb * 8 + wv; row < MR; row += nvb * 8) {
#endif
        f32x4 v[4]; float q = 0.f;
#pragma unroll
        for (int i = 0; i < 4; ++i) { const int c = (i * 64 + lane) * 4; const f32x4 y = *(const f32x4*)(Y + (size_t)row * 1024 + c), z = *(const f32x4*)(H + (size_t)row * HC_AB + C_Z + c);
            v[i] = (f32x4){y.x * silu_f(z.x), y.y * silu_f(z.y), y.z * silu_f(z.z), y.w * silu_f(z.w)}; q += (v[i].x * v[i].x + v[i].y * v[i].y) + (v[i].z * v[i].z + v[i].w * v[i].w); }
        const float rs = 1.f / sqrtf(wave_sum(q) * (1.f / 1024.f) + EPS);
#pragma unroll
        for (int i = 0; i < 4; ++i) { const int c = (i * 64 + lane) * 4; const f32x4 gg = *(const f32x4*)(g + c); const f32x4 o = v[i] * rs * gg;
            uint2 w; w.x = pk2(o.x, o.y); w.y = pk2(o.z, o.w); *(uint2*)(AO + (size_t)row * DM + 1024 + c) = w; }
    }
}

DEVI void ph_idx_prompt_naive(CP p, int vb, int nvb, float* sm) {
    const int TIDX = ltid();
    const float* H = wsf(p, WS_H); float* SC = wsf(p, WS_SC);
    const int half = TIDX >> 8, tid = TIDX & 255; float* sq = sm + half * 520; float* sw = sq + 512;
    for (int row0 = vb * 2; row0 < MPR; row0 += nvb * 2) {
        const int row = row0 + half, b = row / SEQ, t = row % SEQ;
        sq[tid] = H[(size_t)row * HC_AB + C_QI + tid]; sq[tid + 256] = H[(size_t)row * HC_AB + C_QI + 256 + tid]; if (tid < 8) sw[tid] = H[(size_t)row * HC_AB + C_WI + tid];
        __syncthreads();
        for (int s = tid; s <= t; s += 256) {
            const float* kr = H + (size_t)(b * SEQ + s) * HC_AB + C_KI; float k[64];
#pragma unroll
            for (int i = 0; i < 16; ++i) { const f32x4 v = *(const f32x4*)(kr + 4 * i); k[4 * i] = v.x; k[4 * i + 1] = v.y; k[4 * i + 2] = v.z; k[4 * i + 3] = v.w; }
            float sc = 0.f;
#pragma unroll 1
            for (int h = 0; h < 8; ++h) { float d = 0.f;
#pragma unroll
                for (int i = 0; i < 64; ++i) d += sq[h * 64 + i] * k[i];
                sc += sw[h] * fmaxf(d, 0.f); }
            SC[(size_t)row * SEQ + s] = sc * IDX_SCALE;
        }
        __syncthreads();
    }
}

DEVI void idx_wave_unit(CP p, int b, int qt, int kc, int lane) {
    const int fr = lane & 15, fq = lane >> 4; const size_t row = (size_t)b * SEQ + qt * 16 + fr;
    const bf16* QIB = wsb(p, WS_QIB) + row * 512 + fq * 8; const float* H = wsf(p, WS_H); float* SC = wsf(p, WS_SC) + row * SEQ + 4 * fq;
    bf16x8 qf[8][2]; float wi[8];
#pragma unroll
    for (int h = 0; h < 8; ++h) { qf[h][0] = *(const bf16x8*)(QIB + h * 64); qf[h][1] = *(const bf16x8*)(QIB + h * 64 + 32); wi[h] = H[row * HC_AB + C_WI + h] * IDX_SCALE; }
    const int kt0 = kc * 64, kt1 = (qt < kt0 + 63) ? qt : kt0 + 63;
    const bf16* kp = wsb(p, WS_KIB) + ((size_t)b * SEQ + fr) * 64 + fq * 8;
    bf16x8 k0 = *(const bf16x8*)(kp + (size_t)kt0 * 16 * 64), k1 = *(const bf16x8*)(kp + (size_t)kt0 * 16 * 64 + 32);
    for (int kt = kt0; kt <= kt1; ++kt) {
        const bf16x8 c0 = k0, c1 = k1;
        if (kt < kt1) { k0 = *(const bf16x8*)(kp + (size_t)(kt + 1) * 16 * 64); k1 = *(const bf16x8*)(kp + (size_t)(kt + 1) * 16 * 64 + 32); }
        f32x4 d[8];
#pragma unroll
        for (int h = 0; h < 8; ++h) { d[h] = mfma16(c0, qf[h][0], (f32x4){0.f, 0.f, 0.f, 0.f}); d[h] = mfma16(c1, qf[h][1], d[h]); }
        f32x4 sc = (f32x4){0.f, 0.f, 0.f, 0.f};
#pragma unroll
        for (int h = 0; h < 8; ++h) { sc.x += wi[h] * fmaxf(d[h].x, 0.f); sc.y += wi[h] * fmaxf(d[h].y, 0.f); sc.z += wi[h] * fmaxf(d[h].z, 0.f); sc.w += wi[h] * fmaxf(d[h].w, 0.f); }
        *(f32x4*)(SC + kt * 16) = sc;
    }
}
DEVI void ph_idx_prompt(CP p, int vb, int nvb) {
    const int tid = ltid(), lane = tid & 63, wv = tid >> 6;
    for (int gw = wv * nvb + vb; gw < 2 * 640; gw += 8 * nvb) { const int b = gw / 640, u = gw % 640; int kc, qt;
        if (u < 256) { kc = 0; qt = u; } else if (u < 448) { kc = 1; qt = 64 + (u - 256); } else if (u < 576) { kc = 2; qt = 128 + (u - 448); } else { kc = 3; qt = 192 + (u - 576); }
        idx_wave_unit(p, b, qt, kc, lane); }
}

DEVI void select_prompt_row(const float* SC, unsigned long long* MASK, int row, int lane) {
    const int t = row % SEQ, nk = t + 1; const float* sc = SC + (size_t)row * SEQ;
    unsigned v[64];
#pragma unroll
    for (int jj = 0; jj < 64; ++jj) { const int key = jj * 64 + lane; v[jj] = key < nk ? ord_f(sc[key]) : 0u; }
    unsigned long long mine = 0ull;
    if (nk <= TOPK) {
#pragma unroll
        for (int jj = 0; jj < 64; ++jj) { const unsigned long long m = __ballot(jj * 64 + lane < nk); if (lane == jj) mine = m; }
    } else {
        unsigned T = 0u;
        for (int bit = 31; bit >= 0; --bit) { const unsigned cand = T | (1u << bit); int cnt = 0;
#pragma unroll
            for (int jj = 0; jj < 64; ++jj) cnt += __popcll(__ballot(v[jj] >= cand));
            if (cnt >= TOPK) T = cand; if (cnt == TOPK) break; }
        int cgt = 0;
#pragma unroll
        for (int jj = 0; jj < 64; ++jj) cgt += __popcll(__ballot(v[jj] > T));
        const int need = TOPK - cgt; int run = 0; const unsigned long long lt = (1ull << lane) - 1ull;
#pragma unroll
        for (int jj = 0; jj < 64; ++jj) { const bool eq = v[jj] == T; const unsigned long long me = __ballot(eq); const int pre = run + __popcll(me & lt);
            const bool sel = (v[jj] > T) || (eq && pre < need); run += __popcll(me); const unsigned long long m = __ballot(sel); if (lane == jj) mine = m; }
    }
    MASK[((size_t)(row >> 5) * 64 + lane) * 32 + (row & 31)] = mine;
}
DEVI void ph_select_prompt(CP p, int vb, int nvb) {
    const int TIDX = ltid();
    const int lane = TIDX & 63, wv = TIDX >> 6;
    for (int row = vb * 8 + wv; row < MPR; row += nvb * 8) select_prompt_row(wsf(p, WS_SC), (unsigned long long*)(p->ws + WS_MASK), row, lane);
}

DEVI void ph_attn_prompt_naive(CP p, int vb, int nvb) {
    const int TIDX = ltid();
    const float* H = wsf(p, WS_H); const unsigned long long* MASK = (const unsigned long long*)(p->ws + WS_MASK); bf16* AO = wsb(p, WS_AO);
    const int h = TIDX >> 6, lane = TIDX & 63, g = h >> 2;
    for (int row = vb; row < MPR; row += nvb) {
        const int b = row / SEQ, t = row % SEQ;
        const float q0 = H[(size_t)row * HC_AB + C_Q + h * 128 + lane], q1 = H[(size_t)row * HC_AB + C_Q + h * 128 + 64 + lane];
        float m = -1e30f, l = 0.f, o0 = 0.f, o1 = 0.f;
        for (int jt = 0; jt <= t / 64; ++jt) {
            unsigned long long w = MASK[((size_t)(row >> 5) * 64 + jt) * 32 + (row & 31)];
            while (w) { const int bit = __builtin_ctzll(w); w &= w - 1ull; const int s = jt * 64 + bit;
                const float* kr = H + (size_t)(b * SEQ + s) * HC_AB + C_K + g * 128; const float* vr = H + (size_t)(b * SEQ + s) * HC_AB + C_V + g * 128;
                const float lg = wave_sum(q0 * kr[lane] + q1 * kr[lane + 64]) * ATT_SCALE;
                const float mn = fmaxf(m, lg), al = __expf(m - mn), pe = __expf(lg - mn);
                l = l * al + pe; o0 = o0 * al + pe * vr[lane]; o1 = o1 * al + pe * vr[lane + 64]; m = mn; }
        }
        const float il = 1.f / l;
        AO[(size_t)row * DM + h * 128 + lane] = f2bf(o0 * il); AO[(size_t)row * DM + h * 128 + 64 + lane] = f2bf(o1 * il);
    }
}

constexpr int ATT_KS = 136, ATT_VS = 72, ATT_BUF = 64 * ATT_KS * 2 + 128 * ATT_VS * 2;
DEVI void attn_unit(CP p, int b, int h, int qb, unsigned char* lds, bf16* AO) {
    const int tid = ltid(), lane = tid & 63, wv = tid >> 6, fr = lane & 15, fq = lane >> 4, g = h >> 2;
    const bf16* QB = wsb(p, WS_QB); const bf16* KB = wsb(p, WS_KB) + (size_t)b * SEQ * 256 + g * 128; const bf16* VB = wsb(p, WS_VB) + (size_t)b * SEQ * 256 + g * 128;
    const unsigned long long* MASK = (const unsigned long long*)(p->ws + WS_MASK);
    const int pos0 = qb * 256 + wv * 32;
    const size_t row0 = (size_t)b * SEQ + pos0;
    bf16x8 qf[2][4];
#pragma unroll
    for (int mt = 0; mt < 2; ++mt)
#pragma unroll
        for (int k = 0; k < 4; ++k) qf[mt][k] = *(const bf16x8*)(QB + (row0 + mt * 16 + fr) * 1024 + h * 128 + k * 32 + fq * 8);
    const unsigned long long* mkp = MASK + (row0 >> 5) * 64 * 32 + fr;
    f32x4 o[2][8];
#pragma unroll
    for (int mt = 0; mt < 2; ++mt)
#pragma unroll
        for (int dt = 0; dt < 8; ++dt) o[mt][dt] = (f32x4){0.f, 0.f, 0.f, 0.f};
    float mrow[2] = {-1e30f, -1e30f}, lrow[2] = {0.f, 0.f};
    const int NT = 4 * (qb + 1);
    const int skey = tid >> 3, spart = tid & 7;
    const bf16* kg = KB + (size_t)skey * 256 + spart * 16; const bf16* vg = VB + (size_t)skey * 256 + spart * 16;
    u32x4 sk0, sk1, sv0, sv1; unsigned long long mw[2];
    sk0 = *(const u32x4*)(kg); sk1 = *(const u32x4*)(kg + 8); sv0 = *(const u32x4*)(vg); sv1 = *(const u32x4*)(vg + 8);
    mw[0] = mkp[0]; mw[1] = mkp[16];
    for (int jt = 0; jt < NT; ++jt) {
        unsigned char* buf = lds + (jt & 1) * ATT_BUF; bf16* Ks = (bf16*)buf; bf16* Vt = (bf16*)(buf + 64 * ATT_KS * 2);
        *(u32x4*)(Ks + skey * ATT_KS + spart * 16) = sk0; *(u32x4*)(Ks + skey * ATT_KS + spart * 16 + 8) = sk1;
        { const unsigned w[8] = {sv0.x, sv0.y, sv0.z, sv0.w, sv1.x, sv1.y, sv1.z, sv1.w};
#pragma unroll
          for (int i = 0; i < 8; ++i) { Vt[(spart * 16 + 2 * i) * ATT_VS + skey] = (bf16)(w[i] & 0xffffu); Vt[(spart * 16 + 2 * i + 1) * ATT_VS + skey] = (bf16)(w[i] >> 16); } }
        const unsigned long long m0 = mw[0], m1 = mw[1];
        __syncthreads();
        if (jt + 1 < NT) { const size_t go = (size_t)(jt + 1) * 64 * 256; sk0 = *(const u32x4*)(kg + go); sk1 = *(const u32x4*)(kg + go + 8); sv0 = *(const u32x4*)(vg + go); sv1 = *(const u32x4*)(vg + go + 8);
            mw[0] = mkp[(jt + 1) * 32]; mw[1] = mkp[(jt + 1) * 32 + 16]; }
        if (jt * 64 > pos0 + 31) continue;
        f32x4 sc[2][4];
#pragma unroll
        for (int mt = 0; mt < 2; ++mt)
#pragma unroll
            for (int kt = 0; kt < 4; ++kt) sc[mt][kt] = (f32x4){0.f, 0.f, 0.f, 0.f};
#pragma unroll
        for (int kt = 0; kt < 4; ++kt)
#pragma unroll
            for (int k = 0; k < 4; ++k) { const bf16x8 kf = *(const bf16x8*)(Ks + (kt * 16 + fr) * ATT_KS + k * 32 + fq * 8);
                sc[0][kt] = mfma16(kf, qf[0][k], sc[0][kt]); sc[1][kt] = mfma16(kf, qf[1][k], sc[1][kt]); }
        bf16x8 pf[2][2];
#pragma unroll
        for (int mt = 0; mt < 2; ++mt) {
            const unsigned long long mk = (mt ? m1 : m0) >> (4 * fq);
            float mx = -1e30f;
#pragma unroll
            for (int kt = 0; kt < 4; ++kt)
#pragma unroll
                for (int i = 0; i < 4; ++i) { const bool on = (mk >> (16 * kt + i)) & 1ull; sc[mt][kt][i] = on ? sc[mt][kt][i] : -1e30f; mx = fmaxf(mx, sc[mt][kt][i]); }
            mx = fmaxf(mx, __shfl_xor(mx, 16)); mx = fmaxf(mx, __shfl_xor(mx, 32));
            const float mn = fmaxf(mrow[mt], mx), al = __builtin_amdgcn_exp2f(mrow[mt] - mn); mrow[mt] = mn;
            float ps = 0.f;
#pragma unroll
            for (int kt = 0; kt < 4; ++kt)
#pragma unroll
                for (int i = 0; i < 4; ++i) { const float e = (sc[mt][kt][i] > -1e29f) ? __builtin_amdgcn_exp2f(sc[mt][kt][i] - mn) : 0.f; sc[mt][kt][i] = e; ps += e; }
            lrow[mt] = lrow[mt] * al + ps;
            if (!__all(al == 1.f)) {
#pragma unroll
                for (int dt = 0; dt < 8; ++dt) o[mt][dt] = o[mt][dt] * al; }
#pragma unroll
            for (int ks = 0; ks < 2; ++ks) { u32x4 w; w.x = cvtpk(sc[mt][2 * ks][0], sc[mt][2 * ks][1]); w.y = cvtpk(sc[mt][2 * ks][2], sc[mt][2 * ks][3]);
                w.z = cvtpk(sc[mt][2 * ks + 1][0], sc[mt][2 * ks + 1][1]); w.w = cvtpk(sc[mt][2 * ks + 1][2], sc[mt][2 * ks + 1][3]); pf[mt][ks] = __builtin_bit_cast(bf16x8, w); }
        }
#pragma unroll
        for (int dt = 0; dt < 8; ++dt)
#pragma unroll
            for (int ks = 0; ks < 2; ++ks) { const bf16* vp = Vt + (dt * 16 + fr) * ATT_VS + ks * 32 + 4 * fq;
                const u32x2 va = *(const u32x2*)vp, vb2 = *(const u32x2*)(vp + 16); u32x4 w; w.x = va.x; w.y = va.y; w.z = vb2.x; w.w = vb2.y; const bf16x8 vf = __builtin_bit_cast(bf16x8, w);
                o[0][dt] = mfma16(vf, pf[0][ks], o[0][dt]); o[1][dt] = mfma16(vf, pf[1][ks], o[1][dt]); }
    }
#pragma unroll
    for (int mt = 0; mt < 2; ++mt) { float l = lrow[mt]; l += __shfl_xor(l, 16); l += __shfl_xor(l, 32); const float il = 1.f / l;
        bf16* orow = AO + (row0 + mt * 16 + fr) * DM + h * 128 + 4 * fq;
#pragma unroll
        for (int dt = 0; dt < 8; ++dt) { const f32x4 v = o[mt][dt] * il; u32x2 w; w.x = cvtpk(v.x, v.y); w.y = cvtpk(v.z, v.w); *(u32x2*)(orow + dt * 16) = w; } }
    __syncthreads();
}

DEVI void idx_sample_unit(CP p, int j, int b, int kb, float* sq  ) {
    const int TIDX = ltid();
    const float* H = wsf(p, WS_H); float* SCS = wsf(p, WS_SCS); const int tid = TIDX;
    for (int i = tid; i < 8 * 512; i += 512) sq[i] = H[(size_t)(MPR + b * DS + (i >> 9)) * HC_AB + C_QI + (i & 511)];
    if (tid < 64) sq[4096 + tid] = H[(size_t)(MPR + b * DS + (tid >> 3)) * HC_AB + C_WI + (tid & 7)];
    __syncthreads();
    const int key = kb * 512 + tid;
    if (key < NKEY_S) {
        const float* kr;
        if (key < PAST) { const int pg = p->page_table[b * NPAGES + key / PAGE]; kr = p->cache_ik + (((size_t)j * NPOOL + pg) * PAGE + key % PAGE) * 64; }
        else kr = H + (size_t)(MPR + b * DS + key - PAST) * HC_AB + C_KI;
        float k[64];
#pragma unroll
        for (int i = 0; i < 16; ++i) { const f32x4 v = *(const f32x4*)(kr + 4 * i); k[4 * i] = v.x; k[4 * i + 1] = v.y; k[4 * i + 2] = v.z; k[4 * i + 3] = v.w; }
#pragma unroll 1
        for (int qi = 0; qi < 8; ++qi) { if (key > PAST + qi) continue; float sc = 0.f;
#pragma unroll 1
            for (int h = 0; h < 8; ++h) { float d = 0.f;
#pragma unroll
                for (int i = 0; i < 64; ++i) d += sq[qi * 512 + h * 64 + i] * k[i];
                sc += sq[4096 + qi * 8 + h] * fmaxf(d, 0.f); }
            SCS[(size_t)(b * DS + qi) * SCS_LD + key] = sc * IDX_SCALE; }
    }
    __syncthreads();
}

DEVI void select_sample_unit(CP p, int q, int* red  ) {
    const int TIDX = ltid();
    const float* sc = wsf(p, WS_SCS) + (size_t)q * SCS_LD; int* SELS = (int*)(p->ws + WS_SELS) + q * TOPK;
    const int tid = TIDX, lane = tid & 63, wv = tid >> 6, nk = PAST + (q % DS) + 1;
    unsigned v[33];
#pragma unroll
    for (int jj = 0; jj < 33; ++jj) { const int key = jj * 512 + tid; v[jj] = key < nk ? ord_f(sc[key]) : 0u; }
    unsigned T = 0u; int par = 0;
    for (int bit = 31; bit >= 0; --bit) { const unsigned cand = T | (1u << bit); int cnt = 0;
#pragma unroll
        for (int jj = 0; jj < 33; ++jj) cnt += __popcll(__ballot(v[jj] >= cand));
        if (lane == 0) red[par * 8 + wv] = cnt; __syncthreads();
        int tot = 0;
#pragma unroll
        for (int w = 0; w < 8; ++w) tot += red[par * 8 + w];
        par ^= 1;
        if (tot >= TOPK) T = cand; if (tot == TOPK) break; }
    __syncthreads();
    int* cg = red + 16; int* ce = cg + 33 * 8; int* pg = ce + 33 * 8; int* pe = pg + 33 * 8;
#pragma unroll
    for (int jj = 0; jj < 33; ++jj) { const int a = __popcll(__ballot(v[jj] > T)), e = __popcll(__ballot(v[jj] == T)); if (lane == 0) { cg[jj * 8 + wv] = a; ce[jj * 8 + wv] = e; } }
    __syncthreads();
    if (tid < 33 * 8) { int a = 0, e = 0; for (int i = 0; i < tid; ++i) { a += cg[i]; e += ce[i]; } pg[tid] = a; pe[tid] = e; }
    if (tid == 0) { int a = 0; for (int i = 0; i < 33 * 8; ++i) a += cg[i]; red[0] = a; }
    __syncthreads();
    const int need = TOPK - red[0]; const unsigned long long lt = (1ull << lane) - 1ull;
#pragma unroll
    for (int jj = 0; jj < 33; ++jj) {
        const bool gt = v[jj] > T, eq = v[jj] == T; const unsigned long long me = __ballot(eq), mg = __ballot(gt);
        const int epre = pe[jj * 8 + wv] + __popcll(me & lt), gpre = pg[jj * 8 + wv] + __popcll(mg & lt); const bool sel = gt || (eq && epre < need);
        const int ebc = epre < need ? epre : need;
        if (sel) SELS[gpre + ebc] = jj * 512 + tid;
    }
    __syncthreads();
}

DEVI void attn_sample_unit(CP p, int j, int q, unsigned char* lds) {
    const int tid = ltid(), lane = tid & 63, h = tid >> 6, g = h >> 2, b = q / DS, row = MPR + q;
    const float* H = wsf(p, WS_H); bf16* AO = wsb(p, WS_AO);
    long long* koff = (long long*)lds; float* lg = (float*)(lds + 256 * 8) + h * 256;
    if (tid < TOPK) { const int s = ((const int*)(p->ws + WS_SELS))[q * TOPK + tid];
        if (s < PAST) { const int pg = p->page_table[b * NPAGES + s / PAGE]; koff[tid] = (long long)((((size_t)j * NPOOL + pg) * PAGE + s % PAGE) * 256); }
        else koff[tid] = -(1ll + (long long)((size_t)(MPR + b * DS + s - PAST) * HC_AB + C_K)); }
    const float qs = ATT_SCALE * 1.4426950408889634f;
    const float q0 = H[(size_t)row * HC_AB + C_Q + h * 128 + lane] * qs, q1 = H[(size_t)row * HC_AB + C_Q + h * 128 + 64 + lane] * qs;
    __syncthreads();
    float mx = -1e30f;
    for (int i0 = 0; i0 < TOPK; i0 += 8) { float a0[8], a1[8];
#pragma unroll
        for (int i = 0; i < 8; ++i) { const long long o = koff[i0 + i]; const float* kr = (o >= 0) ? p->cache_k + o + g * 128 : H + (-(o + 1)) + g * 128; a0[i] = kr[lane]; a1[i] = kr[lane + 64]; }
#pragma unroll
        for (int i = 0; i < 8; ++i) { const float v = wave_sum(q0 * a0[i] + q1 * a1[i]); mx = fmaxf(mx, v); if (lane == 0) lg[i0 + i] = v; } }
    asm volatile("s_waitcnt lgkmcnt(0)" ::: "memory");
    float l = 0.f, o0 = 0.f, o1 = 0.f;
    for (int i0 = 0; i0 < TOPK; i0 += 8) { float a0[8], a1[8];
#pragma unroll
        for (int i = 0; i < 8; ++i) { const long long o = koff[i0 + i]; const float* vr = (o >= 0) ? p->cache_v + o + g * 128 : H + (-(o + 1)) + (C_V - C_K) + g * 128; a0[i] = vr[lane]; a1[i] = vr[lane + 64]; }
#pragma unroll
        for (int i = 0; i < 8; ++i) { const float pe = __builtin_amdgcn_exp2f(lg[i0 + i] - mx); l += pe; o0 += pe * a0[i]; o1 += pe * a1[i]; } }
    const float il = 1.f / l;
    AO[(size_t)row * DM + h * 128 + lane] = f2bf(o0 * il); AO[(size_t)row * DM + h * 128 + 64 + lane] = f2bf(o1 * il);
    __syncthreads();
}

DEVI void ph_cd_prep(CP p, int j, int vb, int nvb) {
    const int TIDX = ltid();
    const float* H = wsf(p, WS_H); bf16* DD = wsb(p, WS_DD); bf16* U = wsb(p, WS_U); bf16* VLN = wsb(p, WS_VLN);
    const float* lg = p->sgu_ln_g + (size_t)j * 1024; const float* lb = p->sgu_ln_b + (size_t)j * 1024;
    const int lane = TIDX & 63, wv = TIDX >> 6;
    for (int row = vb * 8 + wv; row < MR; row += nvb * 8) {
        const bool pr = row < MPR; const int b = pr ? row / SEQ : (row - MPR) / DS, t = pr ? row % SEQ : (row - MPR) % DS;
        const float* h = H + (size_t)row * HC_CD;
#pragma unroll 1
        for (int i = 0; i < 4; ++i) { const int c = i * 256 + lane * 4, w = 2 << i; const f32x4 cur = *(const f32x4*)(h + c); f32x4 s = cur; int cnt;
            if (pr) { cnt = (t + 1 < w) ? t + 1 : w; for (int u = 1; u < cnt; ++u) s += *(const f32x4*)(H + (size_t)(row - u) * HC_CD + c); }
            else { cnt = w; for (int u = 1; u < w; ++u) { const int e = 15 + t - u;
                    s += (e >= 15) ? *(const f32x4*)(H + (size_t)(MPR + b * DS + e - 15) * HC_CD + c) : *(const f32x4*)(p->state_pool + (((size_t)j * DB + b) * 15 + e) * 1024 + c); } }
            const float ic = 1.f / (float)cnt; const f32x4 d = s * ic - cur; uint2 o; o.x = pk2(d.x, d.y); o.y = pk2(d.z, d.w); *(uint2*)(DD + (size_t)row * 1024 + c) = o;
            if (pr) { if (t >= SEQ - 15) *(f32x4*)(p->out + O_PP + (((size_t)j * NBP + b) * 15 + (t - (SEQ - 15))) * 1024 + c) = cur; }
            else { *(f32x4*)(p->out + O_PS + (((size_t)j * DB + b) * 15 + 7 + t) * 1024 + c) = cur;
                   if (t == 0) for (int e = 0; e < 7; ++e) *(f32x4*)(p->out + O_PS + (((size_t)j * DB + b) * 15 + e) * 1024 + c) = *(const f32x4*)(p->state_pool + (((size_t)j * DB + b) * 15 + 8 + e) * 1024 + c); }
        }
        asm volatile("" ::: "memory");
#pragma unroll
        for (int i = 0; i < 4; ++i) { const int c = (i * 64 + lane) * 4; const f32x4 u = *(const f32x4*)(h + 1024 + c); uint2 o; o.x = pk2(gelu_f(u.x), gelu_f(u.y)); o.y = pk2(gelu_f(u.z), gelu_f(u.w)); *(uint2*)(U + (size_t)row * 1024 + c) = o; }
        asm volatile("" ::: "memory");
        f32x4 v[4]; float s = 0.f;
#pragma unroll
        for (int i = 0; i < 4; ++i) { const int c = (i * 64 + lane) * 4; const f32x4 x = *(const f32x4*)(h + 2048 + c); v[i] = (f32x4){gelu_f(x.x), gelu_f(x.y), gelu_f(x.z), gelu_f(x.w)}; s += (v[i].x + v[i].y) + (v[i].z + v[i].w); }
        const float mean = wave_sum(s) * (1.f / 1024.f); float q = 0.f;
#pragma unroll
        for (int i = 0; i < 4; ++i) { v[i] = v[i] - mean; q += (v[i].x * v[i].x + v[i].y * v[i].y) + (v[i].z * v[i].z + v[i].w * v[i].w); }
        const float rstd = 1.f / sqrtf(wave_sum(q) * (1.f / 1024.f) + EPS);
#pragma unroll
        for (int i = 0; i < 4; ++i) { const int c = (i * 64 + lane) * 4; const f32x4 y = v[i] * rstd * *(const f32x4*)(lg + c) + *(const f32x4*)(lb + c);
            uint2 o; o.x = pk2(y.x, y.y); o.y = pk2(y.z, y.w); *(uint2*)(VLN + (size_t)row * 1024 + c) = o;
            if (!pr) *(f32x4*)(p->out + O_GS + ((size_t)j * MSR + (row - MPR)) * 1024 + c) = y; }
    }
}

DEVI void sgu_unit(CP p, int j, int ck, int g, int ds, bf16* Vt  ) {
    const int tid = ltid(), lane = tid & 63, wv = tid >> 6, fr = lane & 15, fq = lane >> 4;
    const bf16* VLN = wsb(p, WS_VLN); const bf16* U = wsb(p, WS_U); bf16* AO = wsb(p, WS_AO);
    const size_t row0 = (size_t)ck * 128; const int c0 = g * 256 + ds * 64;
    { const int sp = tid >> 2, part = tid & 3; const bf16* src = VLN + (row0 + sp) * 1024 + c0 + part * 16; const u32x4 a = *(const u32x4*)src, bq = *(const u32x4*)(src + 8);
      const unsigned w[8] = {a.x, a.y, a.z, a.w, bq.x, bq.y, bq.z, bq.w};
#pragma unroll
      for (int i = 0; i < 8; ++i) { Vt[(part * 16 + 2 * i) * 136 + sp] = (bf16)(w[i] & 0xffffu); Vt[(part * 16 + 2 * i + 1) * 136 + sp] = (bf16)(w[i] >> 16); } }
    __syncthreads();
    const bf16* W = wsb(p, WS_SGUW) + (((size_t)j * 4 + g) * 128 + wv * 16 + fr) * 128 + fq * 8;
    f32x4 acc[4];
#pragma unroll
    for (int nt = 0; nt < 4; ++nt) acc[nt] = (f32x4){0.f, 0.f, 0.f, 0.f};
    const int nk = (wv >> 1) + 1;
#pragma unroll
    for (int k = 0; k < 4; ++k) if (k < nk) { const bf16x8 wf = *(const bf16x8*)(W + k * 32);
#pragma unroll
        for (int nt = 0; nt < 4; ++nt) acc[nt] = mfma16(*(const bf16x8*)(Vt + (nt * 16 + fr) * 136 + k * 32 + fq * 8), wf, acc[nt]); }
    const float bs = p->sgu_b[((size_t)j * 4 + g) * 128 + wv * 16 + fr]; const size_t row = row0 + wv * 16 + fr;
#pragma unroll
    for (int nt = 0; nt < 4; ++nt) { const int c = c0 + nt * 16 + 4 * fq; const u32x2 uw = *(const u32x2*)(U + row * 1024 + c);
        const float o0 = bflo(uw.x) * (acc[nt].x + bs), o1 = bfhi(uw.x) * (acc[nt].y + bs), o2 = bflo(uw.y) * (acc[nt].z + bs), o3 = bfhi(uw.y) * (acc[nt].w + bs);
        u32x2 w; w.x = cvtpk(o0, o1); w.y = cvtpk(o2, o3); *(u32x2*)(AO + row * DM + 1024 + c) = w; }
    __syncthreads();
}
DEVI void ph_sgu_naive(CP p, int j, int vb, int nvb) {
    const int TIDX = ltid();
    const bf16* VLN = wsb(p, WS_VLN); const bf16* U = wsb(p, WS_U); bf16* AO = wsb(p, WS_AO);
    for (int row = MPR + vb; row < MR; row += nvb) {
        const bool pr = row < MPR; const int t = pr ? row % SEQ : (row - MPR) % DS;
        const int tt = pr ? (t & 127) : t, base = row - tt;
        for (int d = TIDX; d < 1024; d += 512) { const int g = d >> 8; const float* w = p->sgu_w + (((size_t)j * 4 + g) * 128 + tt) * 128;
            float acc = p->sgu_b[((size_t)j * 4 + g) * 128 + tt];
            for (int s = 0; s <= tt; ++s) acc += w[s] * bf2f(VLN[(size_t)(base + s) * 1024 + d]);
            AO[(size_t)row * DM + 1024 + d] = f2bf(bf2f(U[(size_t)row * 1024 + d]) * acc); }
    }
}


DEVI void diag_cmp(CP p, int k, const bf16* a, int lda, const bf16* b, int ldb, int rows, int cols, int vb, int nvb) {
    unsigned* ctl = (unsigned*)(p->ws + WS_CTL); const int tid = ltid(); float mx = 0.f; unsigned bad = 0;
    for (int r = vb; r < rows; r += nvb) for (int c = tid; c < cols; c += 512) { const float x = bf2f(a[(size_t)r * lda + c]), y = bf2f(b[(size_t)r * ldb + c]); const float d = fabsf(x - y);
        if (!(d == d) || d > 1e30f) bad++; else mx = fmaxf(mx, d); }
    atomicMax(ctl + 64 + 2 * k, __float_as_uint(mx)); if (bad) atomicAdd(ctl + 65 + 2 * k, bad);
}
DEVI void diag_cmp_f32(CP p, int k, const float* a, int lda, const bf16* b, int ldb, int rows, int cols, int vb, int nvb) {
    unsigned* ctl = (unsigned*)(p->ws + WS_CTL); const int tid = ltid(); float mx = 0.f; unsigned bad = 0;
    for (int r = vb; r < rows; r += nvb) for (int c = tid; c < cols; c += 512) { const float x = a[(size_t)r * lda + c], y = bf2f(b[(size_t)r * ldb + c]); const float d = fabsf(x - y);
        if (!(d == d) || d > 1e30f) bad++; else mx = fmaxf(mx, d); }
    atomicMax(ctl + 64 + 2 * k, __float_as_uint(mx)); if (bad) atomicAdd(ctl + 65 + 2 * k, bad);
}
DEVI void diag_fin_f32(CP p, int k, const float* a, size_t n, int vb, int nvb) {
    unsigned* ctl = (unsigned*)(p->ws + WS_CTL); unsigned bad = 0;
    for (size_t i = (size_t)vb * 512 + ltid(); i < n; i += (size_t)nvb * 512) { const float x = a[i]; if (!(x == x) || fabsf(x) > 1e30f) bad++; }
    if (bad) atomicAdd(ctl + 65 + 2 * k, bad);
}
DEVI void diag_fin_bf16(CP p, int k, const bf16* a, size_t n, int vb, int nvb) {
    unsigned* ctl = (unsigned*)(p->ws + WS_CTL); unsigned bad = 0;
    for (size_t i = (size_t)vb * 512 + ltid(); i < n; i += (size_t)nvb * 512) { const float x = bf2f(a[i]); if (!(x == x) || fabsf(x) > 1e30f) bad++; }
    if (bad) atomicAdd(ctl + 65 + 2 * k, bad);
}
DEVI void diag_report(CP p, int nchecks) {
    unsigned* ctl = (unsigned*)(p->ws + WS_CTL);
    if (blockIdx.x == 0 && threadIdx.x == 0) { const unsigned fl = __hip_atomic_load(ctl + 96, __ATOMIC_RELAXED, __HIP_MEMORY_SCOPE_AGENT); if (fl) { p->out[O_KP] = (float)fl * 1e12f; return; } }
    if (blockIdx.x == 0 && threadIdx.x == 0) for (int k = 0; k < nchecks; ++k) { const float mx = __uint_as_float(__hip_atomic_load(ctl + 64 + 2 * k, __ATOMIC_RELAXED, __HIP_MEMORY_SCOPE_AGENT)); const unsigned bad = __hip_atomic_load(ctl + 65 + 2 * k, __ATOMIC_RELAXED, __HIP_MEMORY_SCOPE_AGENT);
        if (bad) { p->out[O_KP] = (70.f + k) * 1e19f; break; } if (mx > 0.06f) { p->out[O_KP] = mx * 1e8f; break; } }
}
namespace pg8 {
#define PG8_LAS __attribute__((address_space(3)))
typedef unsigned short bf16_t;
typedef short bf16x8 __attribute__((ext_vector_type(8)));
typedef float f32x4 __attribute__((ext_vector_type(4)));
typedef unsigned u32x4 __attribute__((ext_vector_type(4)));
constexpr int BM = 256, BK = 64, HALF = 128, HTB = HALF * BK * 2  , STAGE_BYTES = 8 * HTB, NXCD = 8, WGM = 8;

__host__ __device__ __forceinline__ int lds_byte(int r, int c) { const int st = (r >> 4) * 2 + (c >> 5), rr = r & 15, cc = c & 31, ob = rr * 64 + cc * 2; return st * 1024 + (ob ^ (((ob >> 9) & 1) << 5)); }
__host__ __device__ __forceinline__ void stage_rc(int b, int& R, int& C) { const int st = b / 1024, sb = b % 1024, swz = sb ^ (((sb >> 9) & 1) << 5); R = (st >> 1) * 16 + swz / 64; C = (st & 1) * 32 + (swz % 64) / 2; }
__host__ __device__ __forceinline__ int perm32(int rho) { const int n = rho >> 4, i = rho & 15; return 8 * (i >> 2) + 4 * n + (i & 3); }

struct Unit { int pm, pn; };
struct Gemm { const bf16_t* A; const bf16_t* Bt; int M, N, K, lda, ldb, acol; };

struct StaticOrder {
    int nM, nN, nwg, G, c;
    __host__ __device__ void init(int M, int N, int G_, int c_) { nM = M / BM; nN = N / BM; nwg = nM * nN; G = G_; c = c_; }
    __host__ __device__ bool next(int i, Unit& u) const {
        const long L = (long)i * G + c; if (L >= nwg) return false;
        int wgid = (int)L; { const int q = nwg / NXCD, r = nwg % NXCD, xcd = wgid % NXCD, off = wgid / NXCD; wgid = (xcd < r ? xcd * (q + 1) : r * (q + 1) + (xcd - r) * q) + off; }
        const int nig = WGM * nN, gid = wgid / nig, fm = gid * WGM, gsz = (nM - fm) < WGM ? (nM - fm) : WGM;
        u.pm = fm + ((wgid % nig) % gsz); u.pn = (wgid % nig) / gsz; return true;
    }
    __device__ __forceinline__ void a_ready(const Unit&) const {}
    __device__ __forceinline__ void done(const Unit&) const {}
};

template <class Epi, class Sched, bool ALIGN_EPI = false, bool SP2 = false>
__device__ __forceinline__ void gemm_phase(PG8_LAS unsigned char* lds, const Gemm g, const Sched& S, const Epi& E) {
    int tid_ = threadIdx.x; asm volatile("" : "+v"(tid_)); const int tid = tid_, wid = __builtin_amdgcn_readfirstlane(tid >> 6), lane = tid & 63, wr = wid >> 2, wc = wid & 3, fr = lane & 15, fq = lane >> 4;
    const int K = g.K, nt = K / BK;
    unsigned voffA[2], voffB[2];
#pragma unroll
    for (int i = 0; i < 2; ++i) { int R, C; stage_rc(tid * 16 + i * 8192, R, C); const int Rb = Epi::PERM ? ((R & ~31) + perm32(R & 31)) : R;
        voffA[i] = (unsigned)(R * g.lda + C) * 2u; voffB[i] = (unsigned)(Rb * g.ldb + C) * 2u; }
    const size_t kstep = (size_t)(BK * 2);
    const size_t hstepA = (size_t)HALF * g.lda * 2, hstepB = (size_t)HALF * g.ldb * 2;
    const size_t tstepA = 2 * hstepA, tstepB = 2 * hstepB, acolB = (size_t)g.acol * 2;
    const unsigned ldsw = (unsigned)wid * 1024u;
    const int aoff = lds_byte(wr * 64 + fr, fq * 8), boff = lds_byte(wc * 32 + fr, fq * 8);
#define PG8_SA(b, h) (((b) * 2 + (h)) * HTB)
#define PG8_SB(b, h) ((4 + (b) * 2 + (h)) * HTB)
#define PG8_STAGE(bufoff, gbase, voff) do { _Pragma("unroll") for (int _i = 0; _i < 2; ++_i) \
        __builtin_amdgcn_global_load_lds((const unsigned*)((const char*)(gbase) + (voff)[_i]), (PG8_LAS unsigned*)(lds + (bufoff) + ldsw + _i * 8192), 16, 0, 0); } while (0)
#define PG8_LDA(dst, b, h) do { _Pragma("unroll") for (int m = 0; m < 4; ++m) _Pragma("unroll") for (int k = 0; k < 2; ++k) dst[m][k] = *(const PG8_LAS bf16x8*)(lds + PG8_SA(b, h) + aoff + m * 2048 + k * 1024); } while (0)
#define PG8_LDB(dst, b, h) do { _Pragma("unroll") for (int n = 0; n < 2; ++n) _Pragma("unroll") for (int k = 0; k < 2; ++k) dst[n][k] = *(const PG8_LAS bf16x8*)(lds + PG8_SB(b, h) + boff + n * 2048 + k * 1024); } while (0)
#define PG8_MMA(ai, bj, At, Bt) do { __builtin_amdgcn_s_setprio(1); _Pragma("unroll") for (int m = 0; m < 4; ++m) _Pragma("unroll") for (int n = 0; n < 2; ++n) _Pragma("unroll") for (int k = 0; k < 2; ++k) \
        acc[ai][bj][m][n] = __builtin_amdgcn_mfma_f32_16x16x32_bf16(Bt[n][k], At[m][k], acc[ai][bj][m][n], 0, 0, 0); __builtin_amdgcn_s_setprio(0); } while (0)
#define PG8_WAIT_V(n) asm volatile("s_waitcnt vmcnt(" #n ")" ::: "memory")
#define PG8_WAIT_L(n) asm volatile("s_waitcnt lgkmcnt(" #n ")" ::: "memory")
#define PG8_BAR __builtin_amdgcn_s_barrier()
#define PG8_SCHED __builtin_amdgcn_sched_barrier(0)
    Unit cur, nxt; int ui = 0;
    if (!S.next(0, cur)) return;
    f32x4 acc[2][2][4][2];
#pragma unroll
    for (int a = 0; a < 2; ++a)
#pragma unroll
        for (int b = 0; b < 2; ++b)
#pragma unroll
            for (int m = 0; m < 4; ++m)
#pragma unroll
                for (int n = 0; n < 2; ++n) acc[a][b][m][n] = (f32x4){0.f, 0.f, 0.f, 0.f};
    bf16x8 At[4][2], B0[2][2], B1[2][2];
    const char* cA = (const char*)g.A + (size_t)cur.pm * tstepA + (size_t)cur.pn * acolB; const char* cB = (const char*)g.Bt + (size_t)cur.pn * tstepB;
    S.a_ready(cur);
    if constexpr (SP2) {
        PG8_STAGE(PG8_SB(0, 0), cB, voffB); PG8_STAGE(PG8_SB(0, 1), cB + hstepB, voffB); PG8_STAGE(PG8_SA(0, 0), cA, voffA); PG8_STAGE(PG8_SA(0, 1), cA + hstepA, voffA);
        if (wr == 1) PG8_BAR;
        PG8_WAIT_V(2); PG8_BAR;
        PG8_STAGE(PG8_SB(1, 0), cB + kstep, voffB); PG8_STAGE(PG8_SA(1, 0), cA + kstep, voffA); PG8_STAGE(PG8_SB(1, 1), cB + hstepB + kstep, voffB);
        PG8_WAIT_V(6); PG8_BAR;
    } else {
        PG8_STAGE(PG8_SB(0, 0), cB, voffB); PG8_STAGE(PG8_SA(0, 0), cA, voffA); PG8_STAGE(PG8_SB(0, 1), cB + hstepB, voffB); PG8_STAGE(PG8_SA(0, 1), cA + hstepA, voffA);
        if (wr == 1) PG8_BAR;
        PG8_WAIT_V(4); PG8_BAR;
        PG8_STAGE(PG8_SB(1, 0), cB + kstep, voffB); PG8_STAGE(PG8_SA(1, 0), cA + kstep, voffA); PG8_STAGE(PG8_SB(1, 1), cB + hstepB + kstep, voffB);
        PG8_WAIT_V(6); PG8_BAR;
    }
    for (;;) {
        const bool has_next = S.next(ui + 1, nxt);
        const char* nA = has_next ? (const char*)g.A + (size_t)nxt.pm * tstepA + (size_t)nxt.pn * acolB : cA; const char* nB = has_next ? (const char*)g.Bt + (size_t)nxt.pn * tstepB : cB;
        for (int t = 0; t < nt; t += 2) {
            const bool last = (t == nt - 2);
            const char* a1 = cA + (size_t)(t + 1) * kstep;
            const char* a2 = last ? nA : cA + (size_t)(t + 2) * kstep; const char* b2 = last ? nB : cB + (size_t)(t + 2) * kstep;
            const char* a3 = a2 + kstep; const char* b3 = b2 + kstep;
            if (last && has_next) S.a_ready(nxt);
            if constexpr (SP2) {
            PG8_LDB(B0, 0, 0); PG8_LDB(B1, 0, 1); PG8_SCHED; PG8_LDA(At, 0, 0); PG8_STAGE(PG8_SA(1, 1), a1 + hstepA, voffA);
            PG8_WAIT_V(8); PG8_WAIT_L(0); PG8_BAR; PG8_MMA(0, 0, At, B0); PG8_MMA(0, 1, At, B1); PG8_BAR; PG8_SCHED;
            PG8_LDA(At, 0, 1); PG8_STAGE(PG8_SB(0, 0), b2, voffB); PG8_STAGE(PG8_SB(0, 1), b2 + hstepB, voffB); PG8_STAGE(PG8_SA(0, 0), a2, voffA);
            PG8_WAIT_V(8); PG8_WAIT_L(0); PG8_BAR; PG8_MMA(1, 0, At, B0); PG8_MMA(1, 1, At, B1); PG8_BAR; PG8_SCHED;
            PG8_LDB(B0, 1, 0); PG8_LDB(B1, 1, 1); PG8_SCHED; PG8_LDA(At, 1, 0); PG8_STAGE(PG8_SA(0, 1), a2 + hstepA, voffA);
            PG8_WAIT_V(8); PG8_WAIT_L(0); PG8_BAR; PG8_MMA(0, 0, At, B0); PG8_MMA(0, 1, At, B1); PG8_BAR; PG8_SCHED;
            PG8_LDA(At, 1, 1); PG8_STAGE(PG8_SB(1, 0), b3, voffB); PG8_STAGE(PG8_SB(1, 1), b3 + hstepB, voffB); PG8_STAGE(PG8_SA(1, 0), a3, voffA);
            PG8_WAIT_V(8); PG8_WAIT_L(0); PG8_BAR; PG8_MMA(1, 0, At, B0); PG8_MMA(1, 1, At, B1); PG8_BAR; PG8_SCHED;
            } else {
            PG8_LDB(B0, 0, 0); PG8_SCHED; PG8_LDA(At, 0, 0); PG8_STAGE(PG8_SA(1, 1), a1 + hstepA, voffA);
            PG8_WAIT_L(8); PG8_BAR; PG8_WAIT_L(0); PG8_MMA(0, 0, At, B0); PG8_BAR; PG8_SCHED;
            PG8_LDB(B1, 0, 1); PG8_STAGE(PG8_SB(0, 0), b2, voffB);
            PG8_BAR; PG8_WAIT_L(0); PG8_MMA(0, 1, At, B1); PG8_BAR;
            PG8_LDA(At, 0, 1); PG8_STAGE(PG8_SA(0, 0), a2, voffA);
            PG8_BAR; PG8_WAIT_L(0); PG8_MMA(1, 0, At, B0); PG8_BAR; PG8_SCHED;
            PG8_STAGE(PG8_SB(0, 1), b2 + hstepB, voffB);
            PG8_WAIT_V(6); PG8_BAR; PG8_MMA(1, 1, At, B1); PG8_BAR;
            PG8_LDB(B0, 1, 0); PG8_SCHED; PG8_LDA(At, 1, 0); PG8_STAGE(PG8_SA(0, 1), a2 + hstepA, voffA);
            PG8_WAIT_L(8); PG8_BAR; PG8_WAIT_L(0); PG8_MMA(0, 0, At, B0); PG8_BAR; PG8_SCHED;
            PG8_LDB(B1, 1, 1); PG8_STAGE(PG8_SB(1, 0), b3, voffB);
            PG8_BAR; PG8_WAIT_L(0); PG8_MMA(0, 1, At, B1); PG8_BAR;
            PG8_LDA(At, 1, 1); PG8_STAGE(PG8_SA(1, 0), a3, voffA);
            PG8_BAR; PG8_WAIT_L(0); PG8_MMA(1, 0, At, B0); PG8_BAR; PG8_SCHED;
            PG8_STAGE(PG8_SB(1, 1), b3 + hstepB, voffB);
            PG8_WAIT_V(6); PG8_BAR; PG8_MMA(1, 1, At, B1); PG8_BAR;
            }
        }
        if constexpr (ALIGN_EPI) { if (wr == 0) PG8_BAR; }
        if constexpr (!Epi::AFTER_DRAIN) { E(acc, cur, wr, wc, fr, fq); S.done(cur); }
        if (!has_next) break;
#pragma unroll
        for (int a = 0; a < 2; ++a)
#pragma unroll
            for (int b = 0; b < 2; ++b)
#pragma unroll
                for (int m = 0; m < 4; ++m)
#pragma unroll
                    for (int n = 0; n < 2; ++n) acc[a][b][m][n] = (f32x4){0.f, 0.f, 0.f, 0.f};
        cur = nxt; cA = nA; cB = nB; ++ui;
        if constexpr (ALIGN_EPI) { if (wr == 1) PG8_BAR; }
    }
    PG8_WAIT_V(0);
    if constexpr (!ALIGN_EPI) { if (wr == 0) PG8_BAR; }
    PG8_BAR;
    if constexpr (Epi::AFTER_DRAIN) { E.fused(acc, cur, wr, wc, fr, fq, lds, wid, lane); S.done(cur); }
#undef PG8_SA
#undef PG8_SB
#undef PG8_STAGE
#undef PG8_LDA
#undef PG8_LDB
#undef PG8_MMA
#undef PG8_WAIT_V
#undef PG8_WAIT_L
#undef PG8_BAR
#undef PG8_SCHED
}
}
namespace pg8 {
__device__ __forceinline__ unsigned cvt_pk_bf16(float lo, float hi) { unsigned r; asm volatile("v_cvt_pk_bf16_f32 %0, %1, %2" : "=v"(r) : "v"(lo), "v"(hi)); return r; }
struct EpiF32 {
    static constexpr bool PERM = false, AFTER_DRAIN = false;
    float* C; int ldc;
    __device__ __forceinline__ void operator()(const f32x4 (&acc)[2][2][4][2], const Unit& u, int wr, int wc, int, int) const {
        int ln_ = threadIdx.x & 63; asm volatile("" : "+v"(ln_)); const int fr = ln_ & 15, fq = ln_ >> 4;
        const int row0 = u.pm * BM + wr * 64 + fr, col0 = u.pn * BM + wc * 32 + 4 * fq;
#pragma unroll
        for (int ai = 0; ai < 2; ++ai)
#pragma unroll
            for (int m = 0; m < 4; ++m) { float* rowp = C + (size_t)(row0 + ai * HALF + m * 16) * ldc + col0;
#pragma unroll
                for (int bj = 0; bj < 2; ++bj)
#pragma unroll
                    for (int n = 0; n < 2; ++n) *(f32x4*)(rowp + bj * HALF + n * 16) = acc[ai][bj][m][n]; }
    }
};
struct EpiResid {
    static constexpr bool PERM = false, AFTER_DRAIN = false;
    float* X; int ldc; float alpha;
    __device__ __forceinline__ void operator()(const f32x4 (&acc)[2][2][4][2], const Unit& u, int wr, int wc, int, int) const {
        int ln_ = threadIdx.x & 63; asm volatile("" : "+v"(ln_)); const int fr = ln_ & 15, fq = ln_ >> 4;
        const int row0 = u.pm * BM + wr * 64 + fr, col0 = u.pn * BM + wc * 32 + 4 * fq;
#pragma unroll
        for (int ai = 0; ai < 2; ++ai)
#pragma unroll
            for (int m = 0; m < 4; ++m) { float* rowp = X + (size_t)(row0 + ai * HALF + m * 16) * ldc + col0;
#pragma unroll
                for (int bj = 0; bj < 2; ++bj) { const f32x4 o0 = *(const f32x4*)(rowp + bj * HALF), o1 = *(const f32x4*)(rowp + bj * HALF + 16);
                    *(f32x4*)(rowp + bj * HALF) = o0 * alpha + acc[ai][bj][m][0]; *(f32x4*)(rowp + bj * HALF + 16) = o1 * alpha + acc[ai][bj][m][1];
                    asm volatile("" ::: "memory"); } }
    }
};
template <int ACT  > struct EpiBf16 {
    static constexpr bool PERM = true, AFTER_DRAIN = false;
    bf16_t* O; int ldc; const float* scale;
    __device__ __forceinline__ void operator()(const f32x4 (&acc)[2][2][4][2], const Unit& u, int wr, int wc, int, int) const {
        int ln_ = threadIdx.x & 63; asm volatile("" : "+v"(ln_)); const int fr = ln_ & 15, fq = ln_ >> 4;
        const int row0 = u.pm * BM + wr * 64 + fr, col0 = u.pn * BM + wc * 32 + 8 * fq;
        f32x4 sv[2][2];
#pragma unroll
        for (int bj = 0; bj < 2; ++bj)
#pragma unroll
            for (int n = 0; n < 2; ++n) sv[bj][n] = (ACT == 0) ? *(const f32x4*)(scale + col0 + bj * HALF + 4 * n) : (f32x4){1.f, 1.f, 1.f, 1.f};
#pragma unroll
        for (int ai = 0; ai < 2; ++ai)
#pragma unroll
            for (int m = 0; m < 4; ++m) { bf16_t* rowp = O + (size_t)(row0 + ai * HALF + m * 16) * ldc + col0;
#pragma unroll
                for (int bj = 0; bj < 2; ++bj) { f32x4 v0 = acc[ai][bj][m][0], v1 = acc[ai][bj][m][1];
                    if (ACT == 0) { v0 = v0 * sv[bj][0]; v1 = v1 * sv[bj][1]; }
                    if (ACT == 1) {
#pragma unroll
                        for (int q = 0; q < 4; ++q) { const float a = fmaxf(v0[q], 0.f), b = fmaxf(v1[q], 0.f); v0[q] = a * a; v1[q] = b * b; } }
                    u32x4 w; w.x = cvt_pk_bf16(v0[0], v0[1]); w.y = cvt_pk_bf16(v0[2], v0[3]); w.z = cvt_pk_bf16(v1[0], v1[1]); w.w = cvt_pk_bf16(v1[2], v1[3]);
                    *(u32x4*)(rowp + bj * HALF) = w; } }
    }
};
}
#define LAS __attribute__((address_space(3)))
#define XB_TMO      128
#define XB_XCNT(j)  (256  + 64 * (j))
#define XB_XSUB(j)  (1280 + 64 * (j))
#define XB_XGEN(j)  (2304 + 64 * (j))
#define XB_TOP      3328
#define XB_TOPGEN   3392
#define XCD_BAR_WORDS 3456
#define XB_SPIN_CAP (1u << 18)

__device__ __forceinline__ unsigned xb_ld(unsigned* p)              { return __hip_atomic_load(p, __ATOMIC_RELAXED, __HIP_MEMORY_SCOPE_AGENT); }
__device__ __forceinline__ unsigned xb_add(unsigned* p, unsigned v) { return __hip_atomic_fetch_add(p, v, __ATOMIC_RELAXED, __HIP_MEMORY_SCOPE_AGENT); }
__device__ __forceinline__ unsigned xb_xcc_id() { return (unsigned)__builtin_amdgcn_s_getreg((3 << 11) | 20) & 0xFu; }
#define XB_SPIN(cond, bar) do { unsigned _sp = 0; while (cond) { __builtin_amdgcn_s_sleep(1); \
    if ((++_sp & 255u) == 0u) { if (xb_ld(&(bar)[XB_TMO])) break; if (_sp > XB_SPIN_CAP) { atomicAdd(&(bar)[XB_TMO], 1u); break; } } } } while (0)

struct XcdBarrier {
    unsigned* bar; unsigned x;
    volatile LAS unsigned* st;
};

__device__ __forceinline__ XcdBarrier xcd_barrier_post(unsigned* bar, volatile LAS unsigned* st) {
    XcdBarrier b; b.bar = bar; b.x = xb_xcc_id(); b.st = st;
    if (threadIdx.x == 0) (void)xb_add(&bar[XB_XCNT(b.x)], 1u);
    return b;
}
__device__ __forceinline__ void xcd_barrier_complete(unsigned* bar, unsigned x, unsigned& nloc, unsigned& nx) {
    const unsigned G = gridDim.x * gridDim.y * gridDim.z;
    unsigned sum, cnt, mine, sp = 0u;
    for (;;) {
        sum = 0u; cnt = 0u; mine = 0u;
#pragma unroll
        for (unsigned j = 0; j < 16; ++j) { const unsigned c = xb_ld(&bar[XB_XCNT(j)]); sum += c; cnt += (c > 0u) ? 1u : 0u; mine = (j == x) ? c : mine; }
        if (sum == G) break;
        __builtin_amdgcn_s_sleep(1);
        if ((++sp & 255u) == 0u) { if (xb_ld(&bar[XB_TMO])) break; if (sp > XB_SPIN_CAP) { atomicAdd(&bar[XB_TMO], 1u); break; } }
    }
    nloc = mine > 0u ? mine : 1u; nx = cnt > 0u ? cnt : 1u;
}

__device__ __attribute__((noinline)) void xcd_barrier_impl(unsigned* bar_, unsigned bx_, volatile LAS unsigned* st_) {
    XcdBarrier b; b.bar = bar_; b.x = bx_; b.st = st_;
    asm volatile("s_waitcnt vmcnt(0)" ::: "memory");
    __syncthreads();
    if (threadIdx.x == 0) {
        unsigned* bar = b.bar;
        __builtin_amdgcn_s_waitcnt(0);
        unsigned nloc = b.st[0], nx = b.st[1];
        if (nloc == 0u) { xcd_barrier_complete(bar, b.x, nloc, nx); b.st[0] = nloc; b.st[1] = nx; }
        const unsigned old = xb_add(&bar[XB_XSUB(b.x)], 1u);
        const unsigned gen = old / nloc;
        if (old + 1u == (gen + 1u) * nloc) {
            __builtin_amdgcn_fence(__ATOMIC_RELEASE, "agent");
            asm volatile("s_waitcnt vmcnt(0)" ::: "memory");
            const unsigned og = xb_add(&bar[XB_TOP], 1u);
            const unsigned tg = og / nx;
            if (og + 1u == (tg + 1u) * nx) xb_add(&bar[XB_TOPGEN], 1u);
            else XB_SPIN(xb_ld(&bar[XB_TOPGEN]) == tg, bar);
            __builtin_amdgcn_fence(__ATOMIC_ACQUIRE, "agent");
            xb_add(&bar[XB_XGEN(b.x)], 1u);
            asm volatile("s_waitcnt vmcnt(0)" ::: "memory");
        } else {
            XB_SPIN(xb_ld(&bar[XB_XGEN(b.x)]) == gen, bar);
            __builtin_amdgcn_fence(__ATOMIC_ACQUIRE, "agent");
            asm volatile("s_waitcnt vmcnt(0)" ::: "memory");
        }
    }
    __syncthreads();
}
__device__ __forceinline__ void xcd_barrier(const XcdBarrier& b) { xcd_barrier_impl(b.bar, b.x, b.st); }
constexpr int NWAVES = 8;
constexpr int RING_BYTES = 131072, LDSCTL_OFF = RING_BYTES, MISC_OFF = LDSCTL_OFF + 320, LDS_BYTES = 147456;
constexpr size_t CTL_ZERO_BYTES = 1u << 20;
constexpr int CW_BAR = 4096;
constexpr int PH_PER_LAYER = 12, N_PHASES = 1 + 4 * PH_PER_LAYER;

DEVI void tr_item(const float* W, int K, int N, bf16* WT, int abmap, int item, float* scr, int lane) {
    const int nblk = (N + 63) >> 6, kb = item / nblk, nb = item - kb * nblk, k0 = 64 * kb, n0 = 64 * nb;
    const int g4 = lane & 15, kr = lane >> 4; const bool ok = n0 + 4 * g4 < N;
    const float* src = W + (size_t)(k0 + kr) * N + n0 + 4 * g4;
    f32x4 v[16];
#pragma unroll
    for (int i = 0; i < 16; ++i) v[i] = ok ? *(const f32x4*)(src + (size_t)(4 * i) * N) : (f32x4){0.f, 0.f, 0.f, 0.f};
#pragma unroll
    for (int i = 0; i < 16; ++i) { const int k = 4 * i + kr; *(f32x4*)(scr + k * 64 + ((g4 ^ (k >> 3)) << 2)) = v[i]; }
    asm volatile("s_waitcnt lgkmcnt(0)" ::: "memory");
    const int c = lane & 7;
#pragma unroll
    for (int jj = 0; jj < 8; ++jj) { const int n = (lane >> 3) + 8 * jj; const float* s = scr + (8 * c) * 64 + ((((n >> 2) ^ c) << 2) | (n & 3));
        if (n0 + n < N) { const int row = abmap ? ab_dst_col(n0 + n) : n0 + n;
            u32x4 o; o.x = cvtpk(s[0], s[64]); o.y = cvtpk(s[2 * 64], s[3 * 64]); o.z = cvtpk(s[4 * 64], s[5 * 64]); o.w = cvtpk(s[6 * 64], s[7 * 64]);
            *(u32x4*)(WT + (size_t)row * K + k0 + 8 * c) = o; } }
    asm volatile("s_waitcnt lgkmcnt(0)" ::: "memory");
}
DEVI void tr_job(const float* W, int K, int N, bf16* WT, int abmap, int vb, int nvb, float* t) {
    const int tid = ltid(), lane = tid & 63, wv = tid >> 6; float* scr = t + wv * 4096;
    const int items = (K >> 6) * ((N + 63) >> 6);
    for (int it = wv * nvb + vb; it < items; it += 8 * nvb) tr_item(W, K, N, WT, abmap, it, scr, lane);
}
DEVI void ph_prologue(CP p, int vb, int nvb, float* t) {
    bf16 *WINAB = wsb(p, WS_WINAB), *WOUTAB = wsb(p, WS_WOUTAB), *WINCD = wsb(p, WS_WINCD), *WOUTCD = wsb(p, WS_WOUTCD), *WFF1 = wsb(p, WS_WFF1), *WFF2 = wsb(p, WS_WFF2), *POOLW = wsb(p, WS_POOLW);
    for (int j = 0; j < 2; ++j) {
        tr_job(p->w_in_ab + (size_t)j * DM * 4696, DM, 4696, WINAB + (size_t)j * HC_AB * DM, 1, vb, nvb, t);
        tr_job(p->w_out_ab + (size_t)j * DM * DM, DM, DM, WOUTAB + (size_t)j * DM * DM, 0, vb, nvb, t);
        tr_job(p->w_in_cd + (size_t)j * DM * HC_CD, DM, HC_CD, WINCD + (size_t)j * HC_CD * DM, 0, vb, nvb, t);
        tr_job(p->w_out_cd + (size_t)j * DM * DM, DM, DM, WOUTCD + (size_t)j * DM * DM, 0, vb, nvb, t);
        tr_job(p->pool_w + (size_t)j * 4 * 65536, 256, 256, POOLW + (size_t)j * 4 * 65536, 0, vb, nvb, t);
        tr_job(p->pool_w + ((size_t)j * 4 + 1) * 65536, 256, 256, POOLW + ((size_t)j * 4 + 1) * 65536, 0, vb, nvb, t);
        tr_job(p->pool_w + ((size_t)j * 4 + 2) * 65536, 256, 256, POOLW + ((size_t)j * 4 + 2) * 65536, 0, vb, nvb, t);
        tr_job(p->pool_w + ((size_t)j * 4 + 3) * 65536, 256, 256, POOLW + ((size_t)j * 4 + 3) * 65536, 0, vb, nvb, t);
    }
    for (int i = 0; i < 4; ++i) {
        tr_job(p->w_ff1 + (size_t)i * DM * DFF, DM, DFF, WFF1 + (size_t)i * DFF * DM, 0, vb, nvb, t);
        tr_job(p->w_ff2 + (size_t)i * DFF * DM, DFF, DM, WFF2 + (size_t)i * DM * DFF, 0, vb, nvb, t);
    }
    const size_t gt = (size_t)vb * 512 + ltid(), ng = (size_t)nvb * 512;
    for (size_t i = gt; i < (size_t)2 * (HC_AB - 4696) * DM / 8; i += ng) { const size_t per = (size_t)(HC_AB - 4696) * DM / 8; const size_t j = i / per, r = i % per;
        *(u32x4*)(WINAB + j * HC_AB * DM + (size_t)4696 * DM + r * 8) = (u32x4){0u, 0u, 0u, 0u}; }
    bf16* sw = wsb(p, WS_SGUW);
    for (size_t i = gt; i < 2 * 4 * 128 * 128; i += ng) { const int s = (int)i & 127, tt = ((int)i >> 7) & 127; sw[i] = f2bf(s <= tt ? p->sgu_w[i] : 0.f); }
    float* X = wsf(p, WS_X); bf16* XB = wsb(p, WS_XB);
    for (size_t i = gt; i < (size_t)MP * DM / 4; i += ng) {
        const size_t e = i * 4; const int row = (int)(e / DM);
        f32x4 v = (f32x4){0.f, 0.f, 0.f, 0.f};
        if (row < MPR) v = *(const f32x4*)(p->x_prompt + e); else if (row < MR) v = *(const f32x4*)(p->x_sample + (e - (size_t)MPR * DM));
        *(f32x4*)(X + e) = v; uint2 o; o.x = pk2(v.x, v.y); o.y = pk2(v.z, v.w); *(uint2*)(XB + e) = o;
    }
}

enum { SE_F32 = 0, SE_RESID = 1, SE_RELU2 = 2, SE_SCALE = 3 };
template <int SE> DEVI void skinny_gemm(const bf16* A  , int lda, int acol, const bf16* Bt, int ldb, int N, int K, float* red, int vb, int nvb, float* Cf, bf16* Cb, int ldc, const float* scale) {
    const int tid = ltid(), lane = tid & 63, wv = tid >> 6, fr = lane & 15, fq = lane >> 4;
    const int kw = K >> 3, ks0 = wv * kw;
    for (int u = vb; u < (N >> 4); u += nvb) {
        const int n0 = u * 16, pn = n0 >> 8;
        const bf16* bp = Bt + (size_t)(n0 + fr) * ldb + ks0 + fq * 8; const bf16* ap = A + (size_t)fr * lda + (size_t)pn * acol + ks0 + fq * 8;
        f32x4 acc[4];
#pragma unroll
        for (int mt = 0; mt < 4; ++mt) acc[mt] = (f32x4){0.f, 0.f, 0.f, 0.f};
#pragma unroll 4
        for (int k = 0; k < kw; k += 32) { const bf16x8 bf = *(const bf16x8*)(bp + k);
#pragma unroll
            for (int mt = 0; mt < 4; ++mt) acc[mt] = mfma16(bf, *(const bf16x8*)(ap + (size_t)mt * 16 * lda + k), acc[mt]); }
#pragma unroll
        for (int mt = 0; mt < 4; ++mt) *(f32x4*)(red + (wv * 64 + mt * 16 + fr) * 16 + 4 * fq) = acc[mt];
        __syncthreads();
        { const int r = tid >> 3, c = (tid & 7) * 2; float v0 = 0.f, v1 = 0.f;
#pragma unroll
          for (int w = 0; w < 8; ++w) { const float* q = red + (w * 64 + r) * 16 + c; v0 += q[0]; v1 += q[1]; }
          const size_t o = (size_t)r * ldc + n0 + c;
          if (SE == SE_F32) { Cf[o] = v0; Cf[o + 1] = v1; }
          if (SE == SE_RESID) { Cf[o] = ALPHA * Cf[o] + v0; Cf[o + 1] = ALPHA * Cf[o + 1] + v1; }
          if (SE == SE_RELU2) { const float a = fmaxf(v0, 0.f), b = fmaxf(v1, 0.f); *(unsigned*)(Cb + o) = cvtpk(a * a, b * b); }
          if (SE == SE_SCALE) *(unsigned*)(Cb + o) = cvtpk(v0 * scale[n0 + c], v1 * scale[n0 + c + 1]); }
        __syncthreads();
    }
}
template <class Epi> DEVI void run_gemm(PG8_LAS unsigned char* lds, const bf16* A, int lda, int acol, const bf16* Bt, int ldb, int M, int N, int K, const Epi& E) {
    asm volatile("" : "+s"(K));
    pg8::Gemm g{A, Bt, M, N, K, lda, ldb, acol}; pg8::StaticOrder S; S.init(M, N, (int)gridDim.x, lvb());
    pg8::gemm_phase<Epi, pg8::StaticOrder, true, true>(lds, g, S, E);
}

#define IN(k) (lo <= (k) && (k) < hi)
#define SEAM(k) do { if (IN(k) && (k) + 1 < hi) xcd_barrier(bar); } while (0)
template <int I> DEVI void layer_phases(LAS unsigned char* L, unsigned char* lds, const XcdBarrier& bar, int lo, int hi, int nvb) {
    constexpr int base = 1 + PH_PER_LAYER * I, j = I >> 1;
    float* smf = (float*)lds; int* smi = (int*)lds;
    if constexpr ((I & 1) == 0) {
        if (IN(base + 0)) { CP p = PP(); run_gemm(L, wsb(p, WS_XB), DM, 0, wsb(p, WS_WINAB) + (size_t)j * HC_AB * DM, DM, MPR, HC_AB, DM, pg8::EpiF32{wsf(p, WS_H), HC_AB});
            skinny_gemm<SE_F32>(wsb(p, WS_XB) + (size_t)MPR * DM, DM, 0, wsb(p, WS_WINAB) + (size_t)j * HC_AB * DM, DM, HC_AB, DM, smf, lvb(), nvb, wsf(p, WS_H) + (size_t)MPR * HC_AB, nullptr, HC_AB, nullptr); }
        SEAM(base + 0);
        if (IN(base + 1)) {
            ph_ab_copy(PP(), j, lvb(), nvb);
            for (int u = lvb(); u < 64 * 24; u += nvb) conv_prompt_unit(PP(), j, u / 24, u % 24, (bf16*)lds);
            ph_conv(PP(), j, lvb(), nvb);
            ph_idx_prompt(PP(), lvb(), nvb);
            for (int u = lvb(); u < 8 * 33; u += nvb) idx_sample_unit(PP(), j, u / 33, u % 33, smf);
        }
        SEAM(base + 1);
        if (IN(base + 2)) {
            ph_select_prompt(PP(), lvb(), nvb);
            for (int u = lvb(); u < MSR; u += nvb) select_sample_unit(PP(), u, smi);
            for (int u = lvb(); u < 64 * 16; u += nvb) ssd1_unit(PP(), j, u >> 4, u & 15, smf);
#ifdef EXP_OLDY
            { const int t_ = ltid(), u = (t_ >> 6) * nvb + lvb(); if (u < (NBP + DB) * 32) ssd_seq_unit(PP(), j, u / 32, (u >> 1) & 15, u & 1, t_ & 63); }
#else
            { const int t_ = ltid(), u = (t_ >> 6) * nvb + lvb(); if (u < DB * 32) ssd_seq_unit(PP(), j, NBP + u / 32, (u >> 1) & 15, u & 1, t_ & 63); }
#endif
        }
        SEAM(base + 2);
        if (IN(base + 3)) {
            ph_ssd_scan(PP(), j, lvb(), nvb);
            for (int u = lvb(); u < MSR; u += nvb) attn_sample_unit(PP(), j, u, lds);
            ph_ssd_gate(PP(), j, lvb(), nvb);
        }
        SEAM(base + 3);
        if (IN(base + 4)) {
#ifdef EXP_ATT
            ph_attn_prompt_naive(PP(), lvb(), nvb);
            for (int u = lvb(); u < 256; u += nvb) attn_unit(PP(), (u >> 3) & 1, u & 7, u >> 4, lds, wsb(PP(), WS_HF));
#else
            for (int u = lvb(); u < 256; u += nvb) attn_unit(PP(), (u >> 3) & 1, u & 7, u >> 4, lds, wsb(PP(), WS_AO));
#endif
#ifdef DUP_ATT
            for (int u = lvb(); u < 256; u += nvb) attn_unit(PP(), (u >> 3) & 1, u & 7, u >> 4, lds, wsb(PP(), WS_AO));
#endif
#ifdef EXP_OLDY
            for (int u = lvb(); u < 64 * 8; u += nvb) ssd3_unit(PP(), j, u >> 3, u & 7, smf, wsb(PP(), WS_HF));
#else
            if (nvb == 256) {
                const int vb_ = lvb(), qb_ = vb_ >> 4, n_ = (0x0001112222333444ull >> (4 * qb_)) & 15, off_ = (qb_ < 3 ? 4 * qb_ : qb_ < 6 ? 12 + 3 * (qb_ - 3) : qb_ < 10 ? 21 + 2 * (qb_ - 6) : qb_ < 13 ? 29 + (qb_ - 10) : 32);
                for (int i = 0; i < n_; ++i) { const int u = off_ * 16 + (vb_ & 15) * n_ + i; ssd3_unit(PP(), j, u >> 3, u & 7, smf, wsb(PP(), WS_AO)); }
            } else for (int u = lvb(); u < 64 * 8; u += nvb) ssd3_unit(PP(), j, u >> 3, u & 7, smf, wsb(PP(), WS_AO));
#endif
        }
        SEAM(base + 4);
#ifdef EXP_ATT
        if (IN(base + 5) && I == 0) { CP p = PP(); diag_cmp(p, 0, wsb(p, WS_AO), DM, wsb(p, WS_HF), DM, MPR, 1024, lvb(), nvb); }
#endif
#ifdef EXP_OLDY
        if (IN(base + 5) && I == 0) { CP p = PP(); const int vb_ = lvb();
            diag_cmp_f32(p, 0, wsf(p, WS_XC), 1536, wsb(p, WS_XCN), 1536, MPR, 1536, vb_, nvb);
            diag_fin_f32(p, 1, wsf(p, WS_ACUM), (size_t)64 * 16 * 128, vb_, nvb);
            diag_fin_f32(p, 2, wsf(p, WS_DTC), (size_t)64 * 16 * 128, vb_, nvb);
            diag_fin_bf16(p, 3, wsb(p, WS_HIN), (size_t)64 * 16 * 8192, vb_, nvb);
            diag_fin_bf16(p, 4, wsb(p, WS_XCT), (size_t)64 * 1536 * 128, vb_, nvb);
            diag_cmp(p, 5, wsb(p, WS_AO) + 1024, DM, wsb(p, WS_HF) + 1024, DM, MPR, 1024, vb_, nvb); }
#endif
        if (IN(base + 5)) { CP p = PP(); run_gemm(L, wsb(p, WS_AO), DM, 0, wsb(p, WS_WOUTAB) + (size_t)j * DM * DM, DM, MPR, DM, DM, pg8::EpiResid{wsf(p, WS_X), DM, ALPHA});
            skinny_gemm<SE_RESID>(wsb(p, WS_AO) + (size_t)MPR * DM, DM, 0, wsb(p, WS_WOUTAB) + (size_t)j * DM * DM, DM, DM, DM, smf, lvb(), nvb, wsf(p, WS_X) + (size_t)MPR * DM, nullptr, DM, nullptr); }
        SEAM(base + 5);
    } else {
        if (IN(base + 0)) { CP p = PP(); run_gemm(L, wsb(p, WS_XB), DM, 0, wsb(p, WS_WINCD) + (size_t)j * HC_CD * DM, DM, MPR, HC_CD, DM, pg8::EpiF32{wsf(p, WS_H), HC_CD});
            skinny_gemm<SE_F32>(wsb(p, WS_XB) + (size_t)MPR * DM, DM, 0, wsb(p, WS_WINCD) + (size_t)j * HC_CD * DM, DM, HC_CD, DM, smf, lvb(), nvb, wsf(p, WS_H) + (size_t)MPR * HC_CD, nullptr, HC_CD, nullptr); }
        SEAM(base + 0);
        if (IN(base + 1)) ph_cd_prep(PP(), j, lvb(), nvb);
        SEAM(base + 1);
        if (IN(base + 2)) {
            { CP p = PP(); run_gemm(L, wsb(p, WS_DD), 1024, 256, wsb(p, WS_POOLW) + (size_t)j * 4 * 65536, 256, MPR, 1024, 256, pg8::EpiBf16<0>{wsb(p, WS_AO), DM, p->pool_scale + (size_t)j * 1024});
              skinny_gemm<SE_SCALE>(wsb(p, WS_DD) + (size_t)MPR * 1024, 1024, 256, wsb(p, WS_POOLW) + (size_t)j * 4 * 65536, 256, 1024, 256, smf, lvb(), nvb, nullptr, wsb(p, WS_AO) + (size_t)MPR * DM, DM, p->pool_scale + (size_t)j * 1024); }
            for (int u = lvb(); u < 64 * 16; u += nvb) sgu_unit(PP(), j, u >> 4, (u >> 2) & 3, u & 3, (bf16*)lds);
            ph_sgu_naive(PP(), j, lvb(), nvb);
        }
        if (IN(base + 2) && base + 5 < hi) xcd_barrier(bar);
        if (IN(base + 5)) { CP p = PP(); run_gemm(L, wsb(p, WS_AO), DM, 0, wsb(p, WS_WOUTCD) + (size_t)j * DM * DM, DM, MPR, DM, DM, pg8::EpiResid{wsf(p, WS_X), DM, ALPHA});
            skinny_gemm<SE_RESID>(wsb(p, WS_AO) + (size_t)MPR * DM, DM, 0, wsb(p, WS_WOUTCD) + (size_t)j * DM * DM, DM, DM, DM, smf, lvb(), nvb, wsf(p, WS_X) + (size_t)MPR * DM, nullptr, DM, nullptr); }
        SEAM(base + 5);
    }
#ifdef EXP_OLDY
    if (IN(base + 6) && I == 0) diag_report(PP(), 6);
#endif
#ifdef EXP_ATT
    if (IN(base + 6) && I == 0) diag_report(PP(), 1);
#endif
    if (IN(base + 6)) { CP p = PP(); ph_ln(p, p->ln1_g + (size_t)I * DM, p->ln1_b + (size_t)I * DM, 0, lvb(), nvb); }
    SEAM(base + 6);
    if (IN(base + 7)) { CP p = PP(); run_gemm(L, wsb(p, WS_XB), DM, 0, wsb(p, WS_WFF1) + (size_t)I * DFF * DM, DM, MPR, DFF, DM, pg8::EpiBf16<1>{wsb(p, WS_HF), DFF, nullptr});
        skinny_gemm<SE_RELU2>(wsb(p, WS_XB) + (size_t)MPR * DM, DM, 0, wsb(p, WS_WFF1) + (size_t)I * DFF * DM, DM, DFF, DM, smf, lvb(), nvb, nullptr, wsb(p, WS_HF) + (size_t)MPR * DFF, DFF, nullptr); }
    SEAM(base + 7);
    if (IN(base + 8)) { CP p = PP(); run_gemm(L, wsb(p, WS_HF), DFF, 0, wsb(p, WS_WFF2) + (size_t)I * DM * DFF, DFF, MPR, DM, DFF, pg8::EpiResid{wsf(p, WS_X), DM, ALPHA});
        skinny_gemm<SE_RESID>(wsb(p, WS_HF) + (size_t)MPR * DFF, DFF, 0, wsb(p, WS_WFF2) + (size_t)I * DM * DFF, DFF, DM, DFF, smf, lvb(), nvb, wsf(p, WS_X) + (size_t)MPR * DM, nullptr, DM, nullptr); }
    SEAM(base + 8);
    if (IN(base + 9)) { CP p = PP(); ph_ln(p, p->ln2_g + (size_t)I * DM, p->ln2_b + (size_t)I * DM, I == 3, lvb(), nvb); }
    if (I < 3) { if (IN(base + 9) && base + PH_PER_LAYER < hi) xcd_barrier(bar); }
}

__global__ void __launch_bounds__(NWAVES * 64, 2) mk_fwd(P p_kernarg) {
    extern __shared__ __attribute__((aligned(16))) unsigned char lds[];
    LAS unsigned char* L = (LAS unsigned char*)lds;
    volatile LAS unsigned* MISC = (volatile LAS unsigned*)(L + MISC_OFF);
    const int nvb = gridDim.x;
    for (int u = threadIdx.x; u < (LDS_BYTES - LDSCTL_OFF) / 4; u += NWAVES * 64) ((LAS unsigned*)(L + LDSCTL_OFF))[u] = 0u;
    __syncthreads();
    unsigned* ctl = (unsigned*)(PP()->ws + WS_CTL);
    XcdBarrier bar = xcd_barrier_post(ctl + CW_BAR, MISC + 8);
    const int lo = PP()->ph_lo, hi = PP()->ph_hi;
    if (IN(0)) ph_prologue(PP(), lvb(), nvb, (float*)lds);
#ifdef DUP_PRO
    if (IN(0)) ph_prologue(PP(), lvb(), nvb, (float*)lds);
#endif
    SEAM(0);
    layer_phases<0>(L, lds, bar, lo, hi, nvb);
    layer_phases<1>(L, lds, bar, lo, hi, nvb);
    layer_phases<2>(L, lds, bar, lo, hi, nvb);
    layer_phases<3>(L, lds, bar, lo, hi, nvb);
}
#undef IN
#undef SEAM

#ifndef MK_PER_PHASE
#define MK_PER_PHASE 0
#endif
extern "C" void kernel_launch(void* const* d_in, const int* in_sizes, int n_in, void* d_out, int out_size, void* d_ws, size_t ws_size, hipStream_t stream) {
    if (n_in != 31 || (size_t)out_size != O_END || ws_size < WS_END) { fprintf(stderr, "kernel_launch: unexpected sizes n_in %d out %d ws %zu (need %zu)\n", n_in, out_size, ws_size, (size_t)WS_END); return; }
    static int grid = 0;
    if (grid == 0) {
        int dev = 0, cus = 0, per_cu = 0;
        if (hipGetDevice(&dev) != hipSuccess || hipDeviceGetAttribute(&cus, hipDeviceAttributeMultiprocessorCount, dev) != hipSuccess) { grid = -1; return; }
        if (hipFuncSetAttribute((const void*)mk_fwd, hipFuncAttributeMaxDynamicSharedMemorySize, LDS_BYTES) != hipSuccess) { fprintf(stderr, "kernel_launch: hipFuncSetAttribute failed\n"); grid = -1; return; }
        if (hipOccupancyMaxActiveBlocksPerMultiprocessor(&per_cu, (const void*)mk_fwd, NWAVES * 64, LDS_BYTES) != hipSuccess || per_cu < 1) fprintf(stderr, "kernel_launch: occupancy query says %d\n", per_cu);
        (void)hipGetLastError();
        grid = cus;
    }
    if (grid < 0) return;
    (void)hipMemsetAsync((char*)d_ws + WS_CTL, 0, CTL_ZERO_BYTES, stream);
    P p{};
    p.x_prompt = (const float*)d_in[0]; p.x_sample = (const float*)d_in[1]; p.cache_k = (const float*)d_in[2]; p.cache_v = (const float*)d_in[3]; p.cache_ik = (const float*)d_in[4];
    p.state_ssm = (const float*)d_in[5]; p.state_conv = (const float*)d_in[6]; p.state_pool = (const float*)d_in[7]; p.page_table = (const int*)d_in[8];
    p.ln1_g = (const float*)d_in[9]; p.ln1_b = (const float*)d_in[10]; p.ln2_g = (const float*)d_in[11]; p.ln2_b = (const float*)d_in[12];
    p.w_in_ab = (const float*)d_in[13]; p.conv_w = (const float*)d_in[14]; p.conv_b = (const float*)d_in[15]; p.dt_bias = (const float*)d_in[16]; p.a_log = (const float*)d_in[17];
    p.d_skip = (const float*)d_in[18]; p.ssd_g = (const float*)d_in[19]; p.w_out_ab = (const float*)d_in[20]; p.w_in_cd = (const float*)d_in[21]; p.pool_w = (const float*)d_in[22];
    p.pool_scale = (const float*)d_in[23]; p.sgu_ln_g = (const float*)d_in[24]; p.sgu_ln_b = (const float*)d_in[25]; p.sgu_w = (const float*)d_in[26]; p.sgu_b = (const float*)d_in[27];
    p.w_out_cd = (const float*)d_in[28]; p.w_ff1 = (const float*)d_in[29]; p.w_ff2 = (const float*)d_in[30];
    p.out = (float*)d_out; p.ws = (unsigned char*)d_ws;
#if MK_PER_PHASE
    for (int k = 0; k < N_PHASES; ++k) { const int r = (k - 1) % PH_PER_LAYER; if (k > 0 && (r > 9 || (((k - 1) / PH_PER_LAYER) & 1) && (r == 3 || r == 4))) continue; p.ph_lo = k; p.ph_hi = k + 1; hipLaunchKernelGGL(mk_fwd, dim3(grid), dim3(NWAVES * 64), LDS_BYTES, stream, p); }
#else
    p.ph_lo = 0; p.ph_hi = N_PHASES;
    hipLaunchKernelGGL(mk_fwd, dim3(grid), dim3(NWAVES * 64), LDS_BYTES, stream, p);
#endif
}
```

```cpp
#include <hip/hip_runtime.h>
#include <stdint.h>
#include <stdio.h>

typedef unsigned short bf16;
typedef float f32x4 __attribute__((ext_vector_type(4)));
typedef unsigned u32x4 __attribute__((ext_vector_type(4)));
#define DEVI __device__ __forceinline__
typedef short bf16x8 __attribute__((ext_vector_type(8)));
typedef unsigned u32x2 __attribute__((ext_vector_type(2)));
DEVI f32x4 mfma16(bf16x8 bt, bf16x8 a, f32x4 c) { return __builtin_amdgcn_mfma_f32_16x16x32_bf16(bt, a, c, 0, 0, 0); }
typedef float f32x2_t __attribute__((ext_vector_type(2))); typedef __bf16 bf16x2_t __attribute__((ext_vector_type(2)));
DEVI unsigned cvtpk(float lo, float hi) { f32x2_t v = {lo, hi}; bf16x2_t b = __builtin_convertvector(v, bf16x2_t); return __builtin_bit_cast(unsigned, b); }
DEVI float bflo(unsigned w) { return __uint_as_float(w << 16); }
DEVI float bfhi(unsigned w) { return __uint_as_float(w & 0xffff0000u); }

constexpr int DM = 2048, SEQ = 4096, NBP = 2, MPR = NBP * SEQ;
constexpr int DB = 8, DS = 8, MSR = DB * DS;
constexpr int MR = MPR + MSR;
constexpr int MP = 8448;
constexpr int PAST = 16384, PAGE = 128, NPAGES = PAST / PAGE, NPOOL = 1280;
constexpr int NKEY_S = PAST + DS;
constexpr int SCS_LD = 16400;
constexpr int HC_AB = 4864, HC_CD = 3072, DFF = 8192;
constexpr int TOPK = 256;
constexpr int C_Q = 0, C_K = 1024, C_V = 1280, C_QI = 1536, C_Z = 2048, C_XBC = 3072, C_KI = 4608, C_WI = 4672, C_DT = 4680;
constexpr float ALPHA = 1.681792830507429f;
constexpr float EPS = 1e-5f;
constexpr float IDX_SCALE = 0.04419417382415922f;
constexpr float ATT_SCALE = 0.08838834764831845f;

constexpr size_t O_YP = 0;
constexpr size_t O_YS = O_YP + (size_t)MPR * DM;
constexpr size_t O_KP = O_YS + (size_t)MSR * DM;
constexpr size_t O_VP = O_KP + (size_t)2 * MPR * 256;
constexpr size_t O_IP = O_VP + (size_t)2 * MPR * 256;
constexpr size_t O_HP = O_IP + (size_t)2 * MPR * 64;
constexpr size_t O_CP = O_HP + (size_t)2 * NBP * 16 * 64 * 128;
constexpr size_t O_PP = O_CP + (size_t)2 * NBP * 3 * 1536;
constexpr size_t O_KS = O_PP + (size_t)2 * NBP * 15 * 1024;
constexpr size_t O_VS = O_KS + (size_t)2 * MSR * 256;
constexpr size_t O_IS = O_VS + (size_t)2 * MSR * 256;
constexpr size_t O_HS = O_IS + (size_t)2 * MSR * 64;
constexpr size_t O_CS = O_HS + (size_t)2 * DB * 16 * 64 * 128;
constexpr size_t O_PS = O_CS + (size_t)2 * DB * 3 * 1536;
constexpr size_t O_GS = O_PS + (size_t)2 * DB * 15 * 1024;
constexpr size_t O_END = O_GS + (size_t)2 * MSR * 1024;
static_assert(O_END == 29571072, "output size");

constexpr size_t al256(size_t x) { return (x + 255) & ~(size_t)255; }
constexpr size_t WS_CTL = 0;
constexpr size_t WS_X = 1u << 20;
constexpr size_t WS_XB = WS_X + al256((size_t)MP * DM * 4);
constexpr size_t WS_H = WS_XB + al256((size_t)MP * DM * 2);
constexpr size_t WS_AO = WS_H + al256((size_t)MP * HC_AB * 4);
constexpr size_t WS_HF = WS_AO + al256((size_t)MP * DM * 2);
constexpr size_t WS_SC = WS_HF + al256((size_t)MP * DFF * 2);
constexpr size_t WS_MASK = WS_SC + al256((size_t)MPR * SEQ * 4);
constexpr size_t WS_XC = WS_MASK + al256((size_t)MPR * 64 * 8);
constexpr size_t WS_DT = WS_XC + al256((size_t)MP * 1536 * 4);
constexpr size_t WS_Y = WS_DT + al256((size_t)MP * 16 * 4);
constexpr size_t WS_SCS = WS_Y + al256((size_t)MP * 1024 * 4);
constexpr size_t WS_SELS = WS_SCS + al256((size_t)MSR * SCS_LD * 4);
constexpr size_t WS_DD = WS_SELS + al256((size_t)MSR * TOPK * 4);
constexpr size_t WS_U = WS_DD + al256((size_t)MP * 1024 * 2);
constexpr size_t WS_VLN = WS_U + al256((size_t)MP * 1024 * 2);
constexpr size_t WS_WINAB = WS_VLN + al256((size_t)MP * 1024 * 2);
constexpr size_t WS_WOUTAB = WS_WINAB + (size_t)2 * HC_AB * DM * 2;
constexpr size_t WS_WINCD = WS_WOUTAB + (size_t)2 * DM * DM * 2;
constexpr size_t WS_WOUTCD = WS_WINCD + (size_t)2 * HC_CD * DM * 2;
constexpr size_t WS_WFF1 = WS_WOUTCD + (size_t)2 * DM * DM * 2;
constexpr size_t WS_WFF2 = WS_WFF1 + (size_t)4 * DFF * DM * 2;
constexpr size_t WS_POOLW = WS_WFF2 + (size_t)4 * DFF * DM * 2;
constexpr size_t WS_SGUW = WS_POOLW + (size_t)2 * 4 * 256 * 256 * 2;
constexpr size_t WS_XCN = WS_SGUW + (size_t)2 * 4 * 128 * 128 * 2;
constexpr size_t WS_XCT = WS_XCN + al256((size_t)MP * 1536 * 2);
constexpr size_t WS_ACUM = WS_XCT + al256((size_t)64 * 1536 * 128 * 2);
constexpr size_t WS_DTC = WS_ACUM + al256((size_t)64 * 16 * 128 * 4);
constexpr size_t WS_CDEC = WS_DTC + al256((size_t)64 * 16 * 128 * 4);
constexpr size_t WS_ST = WS_CDEC + al256((size_t)64 * 16 * 4);
constexpr size_t WS_HIN = WS_ST + al256((size_t)64 * 16 * 64 * 128 * 4);
constexpr size_t WS_QB = WS_HIN + al256((size_t)64 * 16 * 64 * 128 * 2);
constexpr size_t WS_KB = WS_QB + al256((size_t)MPR * 1024 * 2);
constexpr size_t WS_VB = WS_KB + al256((size_t)MPR * 256 * 2);
constexpr size_t WS_QIB = WS_VB + al256((size_t)MPR * 256 * 2);
constexpr size_t WS_KIB = WS_QIB + al256((size_t)MPR * 512 * 2);
constexpr size_t WS_END = WS_KIB + al256((size_t)MPR * 64 * 2);

struct P {
    const float *x_prompt, *x_sample, *cache_k, *cache_v, *cache_ik, *state_ssm, *state_conv, *state_pool;
    const int* page_table;
    const float *ln1_g, *ln1_b, *ln2_g, *ln2_b, *w_in_ab, *conv_w, *conv_b, *dt_bias, *a_log, *d_skip, *ssd_g, *w_out_ab;
    const float *w_in_cd, *pool_w, *pool_scale, *sgu_ln_g, *sgu_ln_b, *sgu_w, *sgu_b, *w_out_cd, *w_ff1, *w_ff2;
    float* out;
    unsigned char* ws;
    int ph_lo, ph_hi, a2, a3;
};
typedef const __attribute__((address_space(4))) P* CP;
DEVI CP PP() { CP q = (CP)__builtin_amdgcn_kernarg_segment_ptr(); asm volatile("" : "+s"(q)); return q; }
DEVI float* wsf(CP p, size_t off) { return (float*)(p->ws + off); }
DEVI bf16* wsb(CP p, size_t off) { return (bf16*)(p->ws + off); }

DEVI float bf2f(bf16 b) { return __uint_as_float(((unsigned)b) << 16); }
DEVI bf16 f2bf(float f) { unsigned u = __float_as_uint(f); u += 0x7fffu + ((u >> 16) & 1u); return (bf16)(u >> 16); }
DEVI unsigned pk2(float lo, float hi) { return (unsigned)f2bf(lo) | ((unsigned)f2bf(hi) << 16); }
DEVI float wave_sum(float v) {
#pragma unroll
    for (int o = 1; o < 64; o <<= 1) v += __shfl_xor(v, o);
    return v;
}
DEVI int ltid() { int t = threadIdx.x; asm volatile("" : "+v"(t)); return t; }
DEVI int lvb() { int b = blockIdx.x; asm volatile("" : "+s"(b)); return b; }
DEVI float silu_f(float x) { return x / (1.f + __expf(-x)); }
DEVI float softplus_f(float x) { return fmaxf(x, 0.f) + log1pf(__expf(-fabsf(x))); }
DEVI float gelu_f(float x) { return 0.5f * x * (1.f + erff(x * 0.70710678118654752f)); }
DEVI unsigned ord_f(float f) { f = f + 0.0f; unsigned u = __float_as_uint(f); return (u & 0x80000000u) ? ~u : (u | 0x80000000u); }
__host__ __device__ inline int ab_dst_col(int n) {
    if (n < 2048) return n;
    if (n < 2112) return C_KI + (n - 2048);
    if (n < 2120) return C_WI + (n - 2112);
    if (n < 3144) return C_Z + (n - 2120);
    if (n < 4680) return C_XBC + (n - 3144);
    return n;
}

DEVI void transpose_unit(const float* W, int K, int N, bf16* WT, int abmap, int unit, float* t  ) {
    const int TIDX = ltid();
    const int nbn = (N + 63) / 64, kb = unit / nbn, nb = unit % nbn, k0 = kb * 64, n0 = nb * 64, tid = TIDX;
#pragma unroll
    for (int i = 0; i < 8; ++i) { const int kk = (tid >> 6) + 8 * i, n = n0 + (tid & 63); t[kk * 65 + (tid & 63)] = (n < N) ? W[(size_t)(k0 + kk) * N + n] : 0.f; }
    __syncthreads();
    { const int n = n0 + (tid >> 3), kq = (tid & 7) * 8;
      if (n < N) { const int row = abmap ? ab_dst_col(n) : n; const float* s = t + kq * 65 + (tid >> 3);
          u32x4 o; o.x = pk2(s[0], s[65]); o.y = pk2(s[2 * 65], s[3 * 65]); o.z = pk2(s[4 * 65], s[5 * 65]); o.w = pk2(s[6 * 65], s[7 * 65]);
          *(u32x4*)(WT + (size_t)row * K + k0 + kq) = o; } }
    __syncthreads();
}


DEVI void ph_ln(CP p, const float* g, const float* b, int final_out, int vb, int nvb) {
    const int TIDX = ltid();
    float* X = wsf(p, WS_X); bf16* XB = wsb(p, WS_XB);
    const int lane = TIDX & 63, wv = TIDX >> 6;
    for (int row = vb * 8 + wv; row < MR; row += nvb * 8) {
        float* xr = X + (size_t)row * DM; f32x4 v[8]; float s = 0.f;
#pragma unroll
        for (int i = 0; i < 8; ++i) { v[i] = *(const f32x4*)(xr + (i * 64 + lane) * 4); s += (v[i].x + v[i].y) + (v[i].z + v[i].w); }
        const float mean = wave_sum(s) * (1.f / DM); float q = 0.f;
#pragma unroll
        for (int i = 0; i < 8; ++i) { v[i] = v[i] - mean; q += (v[i].x * v[i].x + v[i].y * v[i].y) + (v[i].z * v[i].z + v[i].w * v[i].w); }
        const float rstd = 1.f / sqrtf(wave_sum(q) * (1.f / DM) + EPS);
        float* o = final_out ? (row < MPR ? p->out + O_YP + (size_t)row * DM : p->out + O_YS + (size_t)(row - MPR) * DM) : nullptr;
#pragma unroll
        for (int i = 0; i < 8; ++i) { const int c = (i * 64 + lane) * 4; const f32x4 gg = *(const f32x4*)(g + c), bb = *(const f32x4*)(b + c);
            const f32x4 y = v[i] * rstd * gg + bb; *(f32x4*)(xr + c) = y; uint2 w; w.x = pk2(y.x, y.y); w.y = pk2(y.z, y.w); *(uint2*)(XB + (size_t)row * DM + c) = w;
            if (final_out) *(f32x4*)(o + c) = y; }
    }
}

DEVI void ph_ab_copy(CP p, int j, int vb, int nvb) {
    const int TIDX = ltid();
    const float* H = wsf(p, WS_H); const int tid = TIDX;
    for (int row = vb; row < MR; row += nvb) {
        const float* h = H + (size_t)row * HC_AB;
        float *ko, *vo, *io;
        if (row < MPR) { ko = p->out + O_KP + ((size_t)j * MPR + row) * 256; vo = p->out + O_VP + ((size_t)j * MPR + row) * 256; io = p->out + O_IP + ((size_t)j * MPR + row) * 64; }
        else { const int sr = row - MPR; ko = p->out + O_KS + ((size_t)j * MSR + sr) * 256; vo = p->out + O_VS + ((size_t)j * MSR + sr) * 256; io = p->out + O_IS + ((size_t)j * MSR + sr) * 64; }
        if (tid < 256) ko[tid] = h[C_K + tid]; else vo[tid - 256] = h[C_V + tid - 256];
        if (row < MPR) { const float qs = ATT_SCALE * 1.4426950408889634f;
            *(unsigned*)(wsb(p, WS_QB) + (size_t)row * 1024 + 2 * tid) = cvtpk(h[C_Q + 2 * tid] * qs, h[C_Q + 2 * tid + 1] * qs);
            if (tid < 128) *(unsigned*)(wsb(p, WS_KB) + (size_t)row * 256 + 2 * tid) = cvtpk(h[C_K + 2 * tid], h[C_K + 2 * tid + 1]);
            else if (tid < 256) *(unsigned*)(wsb(p, WS_VB) + (size_t)row * 256 + 2 * (tid - 128)) = cvtpk(h[C_V + 2 * (tid - 128)], h[C_V + 2 * (tid - 128) + 1]);
            else if (tid < 512) *(unsigned*)(wsb(p, WS_QIB) + (size_t)row * 512 + 2 * (tid - 256)) = cvtpk(h[C_QI + 2 * (tid - 256)], h[C_QI + 2 * (tid - 256) + 1]);
            if (tid < 32) *(unsigned*)(wsb(p, WS_KIB) + (size_t)row * 64 + 2 * tid) = cvtpk(h[C_KI + 2 * tid], h[C_KI + 2 * tid + 1]); }
        if (tid < 64) io[tid] = h[C_KI + tid];
        int ci = -1; float* co = nullptr;
        if (row < MPR) { const int b = row / SEQ, t = row % SEQ; if (t >= SEQ - 3) { ci = t - (SEQ - 3); co = p->out + O_CP + (((size_t)j * NBP + b) * 3 + ci) * 1536; } }
        else { const int b = (row - MPR) / DS, t = (row - MPR) % DS; if (t >= DS - 3) { ci = t - (DS - 3); co = p->out + O_CS + (((size_t)j * DB + b) * 3 + ci) * 1536; } }
        if (ci >= 0) for (int c = tid; c < 1536; c += 512) co[c] = h[C_XBC + c];
    }
}

DEVI void ph_conv(CP p, int j, int vb, int nvb) {
    const int TIDX = ltid();
    const float* H = wsf(p, WS_H); float* XC = wsf(p, WS_XC); float* DT = wsf(p, WS_DT);
    const float* cw = p->conv_w + (size_t)j * 4 * 1536; const float* cb = p->conv_b + (size_t)j * 1536;
#ifdef EXP_OLDY
    for (int row = vb; row < MR; row += nvb) {
#else
    for (int row = MPR + vb; row < MR; row += nvb) {
#endif
        const bool pr = row < MPR; const int b = pr ? row / SEQ : (row - MPR) / DS, t = pr ? row % SEQ : (row - MPR) % DS;
        for (int c = TIDX; c < 1536; c += 512) {
            float acc = cb[c];
#pragma unroll
            for (int jj = 0; jj < 4; ++jj) { const int tt = t - 3 + jj; float xv;
                if (tt >= 0) xv = H[(size_t)(row - t + tt) * HC_AB + C_XBC + c];
                else xv = pr ? 0.f : p->state_conv[(((size_t)j * DB + b) * 3 + (3 + tt)) * 1536 + c];
                acc += cw[jj * 1536 + c] * xv; }
            XC[(size_t)row * 1536 + c] = silu_f(acc);
        }
        if (TIDX < 16) DT[row * 16 + TIDX] = softplus_f(H[(size_t)row * HC_AB + C_DT + TIDX] + p->dt_bias[j * 16 + TIDX]);
    }
}

DEVI void ssd_seq_unit(CP p, int j, int sq  , int h, int ph, int lane) {
    const float* XC = wsf(p, WS_XC); const float* DT = wsf(p, WS_DT); float* Y = wsf(p, WS_Y);
    const bool pr = sq < NBP; const int b = pr ? sq : sq - NBP, n = pr ? SEQ : DS, row0 = pr ? b * SEQ : MPR + b * DS, g = h >> 3;
    const int pp = ph * 32 + (lane & 31), nh = lane >> 5;
    const float a = -__expf(p->a_log[j * 16 + h]), Dk = p->d_skip[j * 16 + h];
    float st[64];
    if (pr) {
#pragma unroll
        for (int i = 0; i < 64; ++i) st[i] = 0.f;
    } else { const float* h0 = p->state_ssm + ((((size_t)j * DB + b) * 16 + h) * 64 + pp) * 128 + nh * 64;
#pragma unroll
        for (int i = 0; i < 16; ++i) { const f32x4 v = *(const f32x4*)(h0 + 4 * i); st[4 * i] = v.x; st[4 * i + 1] = v.y; st[4 * i + 2] = v.z; st[4 * i + 3] = v.w; } }
    for (int t = 0; t < n; ++t) {
        const int row = row0 + t; const float dt = DT[row * 16 + h], dA = __expf(dt * a), x = XC[(size_t)row * 1536 + h * 64 + pp], cf = dt * x;
        const float* Bp = XC + (size_t)row * 1536 + 1024 + g * 128 + nh * 64; const float* Cp = Bp + 256;
        float y = 0.f;
#pragma unroll
        for (int i = 0; i < 16; ++i) { if ((i & 7) == 0) asm volatile("" ::: "memory");
            const f32x4 bv = *(const f32x4*)(Bp + 4 * i), cv = *(const f32x4*)(Cp + 4 * i);
            st[4 * i] = st[4 * i] * dA + cf * bv.x; st[4 * i + 1] = st[4 * i + 1] * dA + cf * bv.y; st[4 * i + 2] = st[4 * i + 2] * dA + cf * bv.z; st[4 * i + 3] = st[4 * i + 3] * dA + cf * bv.w;
            y += cv.x * st[4 * i] + cv.y * st[4 * i + 1] + cv.z * st[4 * i + 2] + cv.w * st[4 * i + 3]; }
        y += __shfl_xor(y, 32);
        if (nh == 0) Y[(size_t)row * 1024 + h * 64 + pp] = y + Dk * x;
    }
#ifdef EXP_OLDY
    if (pr) return;
#endif
    float* ho = (pr ? p->out + O_HP + ((((size_t)j * NBP + b) * 16 + h) * 64 + pp) * 128 : p->out + O_HS + ((((size_t)j * DB + b) * 16 + h) * 64 + pp) * 128) + nh * 64;
#pragma unroll
    for (int i = 0; i < 16; ++i) *(f32x4*)(ho + 4 * i) = (f32x4){st[4 * i], st[4 * i + 1], st[4 * i + 2], st[4 * i + 3]};
}

DEVI void conv_prompt_unit(CP p, int j, int ck, int cb, bf16* T  ) {
    const int tid = ltid(), ch = tid & 63, sg = tid >> 6;
    const float* H = wsf(p, WS_H); bf16* XCN = wsb(p, WS_XCN); bf16* XCT = wsb(p, WS_XCT);
    const int row0 = ck * 128, col = cb * 64 + ch, s0 = sg * 16;
    const float* cw = p->conv_w + (size_t)j * 4 * 1536 + col; const float w0 = cw[0], w1 = cw[1536], w2 = cw[2 * 1536], w3 = cw[3 * 1536], bias = p->conv_b[(size_t)j * 1536 + col];
    const float* hp = H + (size_t)(row0 + s0) * HC_AB + C_XBC + col;
    const bool first = ((ck & 31) == 0) && (sg == 0);
    float x0 = first ? 0.f : hp[-3 * HC_AB], x1 = first ? 0.f : hp[-2 * HC_AB], x2 = first ? 0.f : hp[-HC_AB];
#pragma unroll 4
    for (int i = 0; i < 16; ++i) { const float x3 = hp[(size_t)i * HC_AB]; const bf16 v = f2bf(silu_f(bias + w0 * x0 + w1 * x1 + w2 * x2 + w3 * x3));
        XCN[(size_t)(row0 + s0 + i) * 1536 + col] = v; T[ch * 136 + s0 + i] = v; x0 = x1; x1 = x2; x2 = x3; }
    if (cb == 0) for (int idx = tid; idx < 128 * 16; idx += 512) { const int s = idx >> 4, hh = idx & 15;
        wsf(p, WS_DT)[(row0 + s) * 16 + hh] = softplus_f(H[(size_t)(row0 + s) * HC_AB + C_DT + hh] + p->dt_bias[j * 16 + hh]); }
    __syncthreads();
    { const int chh = tid >> 3, sq = (tid & 7) * 16; const u32x4 a = *(const u32x4*)(T + chh * 136 + sq), b = *(const u32x4*)(T + chh * 136 + sq + 8);
      bf16* dst = XCT + ((size_t)ck * 1536 + cb * 64 + chh) * 128 + sq; *(u32x4*)dst = a; *(u32x4*)(dst + 8) = b; }
    __syncthreads();
}
DEVI void ssd1_unit(CP p, int j, int ck, int h, float* sm  ) {
    const int tid = ltid(), lane = tid & 63, wv = tid >> 6, fr = lane & 15, fq = lane >> 4, g = h >> 3;
    if (wv == 0) {
        const float* DT = wsf(p, WS_DT) + (size_t)ck * 128 * 16 + h; const float a = -__expf(p->a_log[j * 16 + h]);
        float* ACUM = wsf(p, WS_ACUM) + ((size_t)ck * 16 + h) * 128; float* DTC = wsf(p, WS_DTC) + ((size_t)ck * 16 + h) * 128;
        const float d0 = DT[(2 * lane) * 16], d1 = DT[(2 * lane + 1) * 16], v0 = d0 * a, v1 = v0 + d1 * a;
        float run = v1;
#pragma unroll
        for (int o = 1; o < 64; o <<= 1) { const float t = __shfl_up(run, o); if (lane >= o) run += t; }
        const float ex = run - v1, a0 = ex + v0, a1 = ex + v1, last = __shfl(run, 63);
        sm[2 * lane] = a0; sm[2 * lane + 1] = a1; ACUM[2 * lane] = a0; ACUM[2 * lane + 1] = a1; DTC[2 * lane] = d0; DTC[2 * lane + 1] = d1;
        sm[128 + 2 * lane] = d0 * __expf(last - a0); sm[128 + 2 * lane + 1] = d1 * __expf(last - a1);
        if (lane == 0) wsf(p, WS_CDEC)[ck * 16 + h] = __expf(last);
    }
    __syncthreads();
    const bf16* XCT = wsb(p, WS_XCT) + (size_t)ck * 1536 * 128;
    const bf16* Btp = XCT + (size_t)(1024 + g * 128 + wv * 16 + fr) * 128 + fq * 8;
    const bf16* xp = XCT + (size_t)(h * 64 + fr) * 128 + fq * 8;
    f32x4 acc[4];
#pragma unroll
    for (int pt = 0; pt < 4; ++pt) acc[pt] = (f32x4){0.f, 0.f, 0.f, 0.f};
#pragma unroll
    for (int k = 0; k < 4; ++k) {
        const bf16x8 bfrag = *(const bf16x8*)(Btp + k * 32);
        const f32x4 wa = *(const f32x4*)(sm + 128 + k * 32 + fq * 8), wb = *(const f32x4*)(sm + 128 + k * 32 + fq * 8 + 4);
#pragma unroll
        for (int pt = 0; pt < 4; ++pt) { const u32x4 xv = *(const u32x4*)(xp + (size_t)pt * 16 * 128 + k * 32);
            u32x4 sv; sv.x = cvtpk(bflo(xv.x) * wa.x, bfhi(xv.x) * wa.y); sv.y = cvtpk(bflo(xv.y) * wa.z, bfhi(xv.y) * wa.w); sv.z = cvtpk(bflo(xv.z) * wb.x, bfhi(xv.z) * wb.y); sv.w = cvtpk(bflo(xv.w) * wb.z, bfhi(xv.w) * wb.w);
            acc[pt] = mfma16(bfrag, __builtin_bit_cast(bf16x8, sv), acc[pt]); }
    }
    float* ST = wsf(p, WS_ST) + ((size_t)ck * 16 + h) * 8192;
#pragma unroll
    for (int pt = 0; pt < 4; ++pt) *(f32x4*)(ST + (size_t)(pt * 16 + fr) * 128 + wv * 16 + fq * 4) = acc[pt];
    __syncthreads();
}
DEVI void ph_ssd_scan(CP p, int j, int vb, int nvb) {
    const float* ST = wsf(p, WS_ST); const float* CDEC = wsf(p, WS_CDEC); bf16* HIN = wsb(p, WS_HIN);
    const int tid = ltid();
    for (int e4 = vb * 512 + tid; e4 < NBP * 16 * 64 * 128 / 4; e4 += nvb * 512) {
        const int b = e4 / (16 * 64 * 32), r = e4 % (16 * 64 * 32), h = r / (64 * 32);
        f32x4 st = (f32x4){0.f, 0.f, 0.f, 0.f};
#pragma unroll 8
        for (int c = 0; c < 32; ++c) { const int ck = b * 32 + c; const size_t off = (size_t)ck * 16 * 8192 + (size_t)r * 4;
            u32x2 o; o.x = cvtpk(st.x, st.y); o.y = cvtpk(st.z, st.w); *(u32x2*)(HIN + off) = o;
            const f32x4 sv = *(const f32x4*)(ST + off); const float d = CDEC[ck * 16 + h]; st = st * d + sv; }
        *(f32x4*)(p->out + O_HP + ((size_t)j * NBP + b) * 16 * 8192 + (size_t)r * 4) = st;
    }
}
DEVI void ssd3_unit(CP p, int j, int ck, int tt, float* red  , bf16* AO) {
    const int tid = ltid(), lane = tid & 63, wv = tid >> 6, fr = lane & 15, fq = lane >> 4, g = wv >> 2;
    const int t0 = tt * 16; const size_t row = (size_t)ck * 128 + t0 + fr;
    const bf16* XCN = wsb(p, WS_XCN); const bf16* XCT = wsb(p, WS_XCT) + (size_t)ck * 1536 * 128; const float* H = wsf(p, WS_H);
    bf16x8 cf[4];
#pragma unroll
    for (int k = 0; k < 4; ++k) cf[k] = *(const bf16x8*)(XCN + row * 1536 + 1280 + g * 128 + k * 32 + fq * 8);
    f32x4 cbt[8];
#pragma unroll
    for (int jt = 0; jt < 8; ++jt) { cbt[jt] = (f32x4){0.f, 0.f, 0.f, 0.f};
        if (jt <= tt) { const bf16* bp = XCN + ((size_t)ck * 128 + jt * 16 + fr) * 1536 + 1024 + g * 128 + fq * 8;
#pragma unroll
            for (int k = 0; k < 4; ++k) cbt[jt] = mfma16(*(const bf16x8*)(bp + k * 32), cf[k], cbt[jt]); } }
    f32x4 yv[2][4]; float ss = 0.f;
#pragma unroll
    for (int hh = 0; hh < 2; ++hh) {
        const int h = 2 * wv + hh;
        const float* AC = wsf(p, WS_ACUM) + ((size_t)ck * 16 + h) * 128; const float* DC = wsf(p, WS_DTC) + ((size_t)ck * 16 + h) * 128;
        const float at = AC[t0 + fr], Dk = p->d_skip[j * 16 + h];
        f32x4 yd[4];
#pragma unroll
        for (int pt = 0; pt < 4; ++pt) yd[pt] = (f32x4){0.f, 0.f, 0.f, 0.f};
#pragma unroll
        for (int q = 0; q < 4; ++q) if (2 * q <= tt) {
            const int sa = 2 * q * 16 + 4 * fq, sb = sa + 16;
            const f32x4 aa = *(const f32x4*)(AC + sa), da = *(const f32x4*)(DC + sa), ab = *(const f32x4*)(AC + sb), db = *(const f32x4*)(DC + sb);
            float la[4], lb[4];
#pragma unroll
            for (int i = 0; i < 4; ++i) { la[i] = (sa + i <= t0 + fr) ? cbt[2 * q][i] * __expf(fminf(at - aa[i], 0.f)) * da[i] : 0.f;
                                          lb[i] = (2 * q + 1 <= tt && sb + i <= t0 + fr) ? cbt[2 * q + 1][i] * __expf(fminf(at - ab[i], 0.f)) * db[i] : 0.f; }
            u32x4 lw; lw.x = cvtpk(la[0], la[1]); lw.y = cvtpk(la[2], la[3]); lw.z = cvtpk(lb[0], lb[1]); lw.w = cvtpk(lb[2], lb[3]);
            const bf16x8 lf = __builtin_bit_cast(bf16x8, lw);
#pragma unroll
            for (int pt = 0; pt < 4; ++pt) { const bf16* xq = XCT + (size_t)(h * 64 + pt * 16 + fr) * 128;
                const u32x2 xa = *(const u32x2*)(xq + sa), xb = *(const u32x2*)(xq + sb); u32x4 xw; xw.x = xa.x; xw.y = xa.y; xw.z = xb.x; xw.w = xb.y;
                yd[pt] = mfma16(__builtin_bit_cast(bf16x8, xw), lf, yd[pt]); }
        }
        const bf16* hq = wsb(p, WS_HIN) + ((size_t)ck * 16 + h) * 8192 + (size_t)fr * 128 + fq * 8; const float eat = __expf(at);
#pragma unroll
        for (int pt = 0; pt < 4; ++pt) { f32x4 of = (f32x4){0.f, 0.f, 0.f, 0.f};
#pragma unroll
            for (int k = 0; k < 4; ++k) of = mfma16(*(const bf16x8*)(hq + (size_t)pt * 16 * 128 + k * 32), cf[k], of);
            const int c0 = h * 64 + pt * 16 + 4 * fq;
            const u32x2 xw = *(const u32x2*)(XCN + row * 1536 + c0); const f32x4 z = *(const f32x4*)(H + row * HC_AB + C_Z + c0);
            f32x4 y = yd[pt] + of * eat;
            y.x += Dk * bflo(xw.x); y.y += Dk * bfhi(xw.x); y.z += Dk * bflo(xw.y); y.w += Dk * bfhi(xw.y);
            y.x *= silu_f(z.x); y.y *= silu_f(z.y); y.z *= silu_f(z.z); y.w *= silu_f(z.w);
            ss += (y.x * y.x + y.y * y.y) + (y.z * y.z + y.w * y.w); yv[hh][pt] = y; }
    }
    ss += __shfl_xor(ss, 16); ss += __shfl_xor(ss, 32);
    if (fq == 0) red[wv * 16 + fr] = ss;
    __syncthreads();
    float tot = 0.f;
#pragma unroll
    for (int w = 0; w < 8; ++w) tot += red[w * 16 + fr];
    const float rs = 1.f / sqrtf(tot * (1.f / 1024.f) + EPS);
    const float* gg = p->ssd_g + (size_t)j * 1024;
#pragma unroll
    for (int hh = 0; hh < 2; ++hh)
#pragma unroll
        for (int pt = 0; pt < 4; ++pt) { const int c0 = (2 * wv + hh) * 64 + pt * 16 + 4 * fq; const f32x4 gv = *(const f32x4*)(gg + c0); const f32x4 o = yv[hh][pt] * rs * gv;
            u32x2 w; w.x = cvtpk(o.x, o.y); w.y = cvtpk(o.z, o.w); *(u32x2*)(AO + row * DM + 1024 + c0) = w; }
    __syncthreads();
}

DEVI void ph_ssd_gate(CP p, int j, int vb, int nvb) {
    const int TIDX = ltid();
    const float* H = wsf(p, WS_H); const float* Y = wsf(p, WS_Y); bf16* AO = wsb(p, WS_AO); const float* g = p->ssd_g + (size_t)j * 1024;
    const int lane = TIDX & 63, wv = TIDX >> 6;
#ifdef EXP_OLDY
    for (int row = vb * 8 + wv; row < MR; row += nvb * 8) {
#else
    for (int row = MPR + vb * 8 + wv; row < MR; row += nvb * 8) {
#endif
        f32x4 v[4]; float q = 0.f;
#pragma unroll
        for (int i = 0; i < 4; ++i) { const int c = (i * 64 + lane) * 4; const f32x4 y = *(const f32x4*)(Y + (size_t)row * 1024 + c), z = *(const f32x4*)(H + (size_t)row * HC_AB + C_Z + c);
            v[i] = (f32x4){y.x * silu_f(z.x), y.y * silu_f(z.y), y.z * silu_f(z.z), y.w * silu_f(z.w)}; q += (v[i].x * v[i].x + v[i].y * v[i].y) + (v[i].z * v[i].z + v[i].w * v[i].w); }
        const float rs = 1.f / sqrtf(wave_sum(q) * (1.f / 1024.f) + EPS);
#pragma unroll
        for (int i = 0; i < 4; ++i) { const int c = (i * 64 + lane) * 4; const f32x4 gg = *(const f32x4*)(g + c); const f32x4 o = v[i] * rs * gg;
            uint2 w; w.x = pk2(o.x, o.y); w.y = pk2(o.z, o.w); *(uint2*)(AO + (size_t)row * DM + 1024 + c) = w; }
    }
}

DEVI void ph_idx_prompt_naive(CP p, int vb, int nvb, float* sm) {
    const int TIDX = ltid();
    const float* H = wsf(p, WS_H); float* SC = wsf(p, WS_SC);
    const int half = TIDX >> 8, tid = TIDX & 255; float* sq = sm + half * 520; float* sw = sq + 512;
    for (int row0 = vb * 2; row0 < MPR; row0 += nvb * 2) {
        const int row = row0 + half, b = row / SEQ, t = row % SEQ;
        sq[tid] = H[(size_t)row * HC_AB + C_QI + tid]; sq[tid + 256] = H[(size_t)row * HC_AB + C_QI + 256 + tid]; if (tid < 8) sw[tid] = H[(size_t)row * HC_AB + C_WI + tid];
        __syncthreads();
        for (int s = tid; s <= t; s += 256) {
            const float* kr = H + (size_t)(b * SEQ + s) * HC_AB + C_KI; float k[64];
#pragma unroll
            for (int i = 0; i < 16; ++i) { const f32x4 v = *(const f32x4*)(kr + 4 * i); k[4 * i] = v.x; k[4 * i + 1] = v.y; k[4 * i + 2] = v.z; k[4 * i + 3] = v.w; }
            float sc = 0.f;
#pragma unroll 1
            for (int h = 0; h < 8; ++h) { float d = 0.f;
#pragma unroll
                for (int i = 0; i < 64; ++i) d += sq[h * 64 + i] * k[i];
                sc += sw[h] * fmaxf(d, 0.f); }
            SC[(size_t)row * SEQ + s] = sc * IDX_SCALE;
        }
        __syncthreads();
    }
}

DEVI void idx_wave_unit(CP p, int b, int qt, int kc, int lane) {
    const int fr = lane & 15, fq = lane >> 4; const size_t row = (size_t)b * SEQ + qt * 16 + fr;
    const bf16* QIB = wsb(p, WS_QIB) + row * 512 + fq * 8; const float* H = wsf(p, WS_H); float* SC = wsf(p, WS_SC) + row * SEQ + 4 * fq;
    bf16x8 qf[8][2]; float wi[8];
#pragma unroll
    for (int h = 0; h < 8; ++h) { qf[h][0] = *(const bf16x8*)(QIB + h * 64); qf[h][1] = *(const bf16x8*)(QIB + h * 64 + 32); wi[h] = H[row * HC_AB + C_WI + h] * IDX_SCALE; }
    const int kt0 = kc * 64, kt1 = (qt < kt0 + 63) ? qt : kt0 + 63;
    const bf16* kp = wsb(p, WS_KIB) + ((size_t)b * SEQ + fr) * 64 + fq * 8;
    bf16x8 k0 = *(const bf16x8*)(kp + (size_t)kt0 * 16 * 64), k1 = *(const bf16x8*)(kp + (size_t)kt0 * 16 * 64 + 32);
    for (int kt = kt0; kt <= kt1; ++kt) {
        const bf16x8 c0 = k0, c1 = k1;
        if (kt < kt1) { k0 = *(const bf16x8*)(kp + (size_t)(kt + 1) * 16 * 64); k1 = *(const bf16x8*)(kp + (size_t)(kt + 1) * 16 * 64 + 32); }
        f32x4 d[8];
#pragma unroll
        for (int h = 0; h < 8; ++h) { d[h] = mfma16(c0, qf[h][0], (f32x4){0.f, 0.f, 0.f, 0.f}); d[h] = mfma16(c1, qf[h][1], d[h]); }
        f32x4 sc = (f32x4){0.f, 0.f, 0.f, 0.f};
#pragma unroll
        for (int h = 0; h < 8; ++h) { sc.x += wi[h] * fmaxf(d[h].x, 0.f); sc.y += wi[h] * fmaxf(d[h].y, 0.f); sc.z += wi[h] * fmaxf(d[h].z, 0.f); sc.w += wi[h] * fmaxf(d[h].w, 0.f); }
        *(f32x4*)(SC + kt * 16) = sc;
    }
}
DEVI void ph_idx_prompt(CP p, int vb, int nvb) {
    const int tid = ltid(), lane = tid & 63, wv = tid >> 6;
    for (int gw = wv * nvb + vb; gw < 2 * 640; gw += 8 * nvb) { const int b = gw / 640, u = gw % 640; int kc, qt;
        if (u < 256) { kc = 0; qt = u; } else if (u < 448) { kc = 1; qt = 64 + (u - 256); } else if (u < 576) { kc = 2; qt = 128 + (u - 448); } else { kc = 3; qt = 192 + (u - 576); }
        idx_wave_unit(p, b, qt, kc, lane); }
}

DEVI void select_prompt_row(const float* SC, unsigned long long* MASK, int row, int lane) {
    const int t = row % SEQ, nk = t + 1; const float* sc = SC + (size_t)row * SEQ;
    unsigned v[64];
#pragma unroll
    for (int jj = 0; jj < 64; ++jj) { const int key = jj * 64 + lane; v[jj] = key < nk ? ord_f(sc[key]) : 0u; }
    unsigned long long mine = 0ull;
    if (nk <= TOPK) {
#pragma unroll
        for (int jj = 0; jj < 64; ++jj) { const unsigned long long m = __ballot(jj * 64 + lane < nk); if (lane == jj) mine = m; }
    } else {
        unsigned T = 0u;
        for (int bit = 31; bit >= 0; --bit) { const unsigned cand = T | (1u << bit); int cnt = 0;
#pragma unroll
            for (int jj = 0; jj < 64; ++jj) cnt += __popcll(__ballot(v[jj] >= cand));
            if (cnt >= TOPK) T = cand; if (cnt == TOPK) break; }
        int cgt = 0;
#pragma unroll
        for (int jj = 0; jj < 64; ++jj) cgt += __popcll(__ballot(v[jj] > T));
        const int need = TOPK - cgt; int run = 0; const unsigned long long lt = (1ull << lane) - 1ull;
#pragma unroll
        for (int jj = 0; jj < 64; ++jj) { const bool eq = v[jj] == T; const unsigned long long me = __ballot(eq); const int pre = run + __popcll(me & lt);
            const bool sel = (v[jj] > T) || (eq && pre < need); run += __popcll(me); const unsigned long long m = __ballot(sel); if (lane == jj) mine = m; }
    }
    MASK[((size_t)(row >> 5) * 64 + lane) * 32 + (row & 31)] = mine;
}
DEVI void ph_select_prompt(CP p, int vb, int nvb) {
    const int TIDX = ltid();
    const int lane = TIDX & 63, wv = TIDX >> 6;
    for (int row = vb * 8 + wv; row < MPR; row += nvb * 8) select_prompt_row(wsf(p, WS_SC), (unsigned long long*)(p->ws + WS_MASK), row, lane);
}

DEVI void ph_attn_prompt_naive(CP p, int vb, int nvb) {
    const int TIDX = ltid();
    const float* H = wsf(p, WS_H); const unsigned long long* MASK = (const unsigned long long*)(p->ws + WS_MASK); bf16* AO = wsb(p, WS_AO);
    const int h = TIDX >> 6, lane = TIDX & 63, g = h >> 2;
    for (int row = vb; row < MPR; row += nvb) {
        const int b = row / SEQ, t = row % SEQ;
        const float q0 = H[(size_t)row * HC_AB + C_Q + h * 128 + lane], q1 = H[(size_t)row * HC_AB + C_Q + h * 128 + 64 + lane];
        float m = -1e30f, l = 0.f, o0 = 0.f, o1 = 0.f;
        for (int jt = 0; jt <= t / 64; ++jt) {
            unsigned long long w = MASK[((size_t)(row >> 5) * 64 + jt) * 32 + (row & 31)];
            while (w) { const int bit = __builtin_ctzll(w); w &= w - 1ull; const int s = jt * 64 + bit;
                const float* kr = H + (size_t)(b * SEQ + s) * HC_AB + C_K + g * 128; const float* vr = H + (size_t)(b * SEQ + s) * HC_AB + C_V + g * 128;
                const float lg = wave_sum(q0 * kr[lane] + q1 * kr[lane + 64]) * ATT_SCALE;
                const float mn = fmaxf(m, lg), al = __expf(m - mn), pe = __expf(lg - mn);
                l = l * al + pe; o0 = o0 * al + pe * vr[lane]; o1 = o1 * al + pe * vr[lane + 64]; m = mn; }
        }
        const float il = 1.f / l;
        AO[(size_t)row * DM + h * 128 + lane] = f2bf(o0 * il); AO[(size_t)row * DM + h * 128 + 64 + lane] = f2bf(o1 * il);
    }
}

constexpr int ATT_KS = 136, ATT_VS = 72, ATT_BUF = 64 * ATT_KS * 2 + 128 * ATT_VS * 2;
DEVI void attn_unit(CP p, int b, int h, int qb, unsigned char* lds, bf16* AO) {
    const int tid = ltid(), lane = tid & 63, wv = tid >> 6, fr = lane & 15, fq = lane >> 4, g = h >> 2;
    const bf16* QB = wsb(p, WS_QB); const bf16* KB = wsb(p, WS_KB) + (size_t)b * SEQ * 256 + g * 128; const bf16* VB = wsb(p, WS_VB) + (size_t)b * SEQ * 256 + g * 128;
    const unsigned long long* MASK = (const unsigned long long*)(p->ws + WS_MASK);
    const int pos0 = qb * 256 + wv * 32;
    const size_t row0 = (size_t)b * SEQ + pos0;
    bf16x8 qf[2][4];
#pragma unroll
    for (int mt = 0; mt < 2; ++mt)
#pragma unroll
        for (int k = 0; k < 4; ++k) qf[mt][k] = *(const bf16x8*)(QB + (row0 + mt * 16 + fr) * 1024 + h * 128 + k * 32 + fq * 8);
    const unsigned long long* mkp = MASK + (row0 >> 5) * 64 * 32 + fr;
    f32x4 o[2][8];
#pragma unroll
    for (int mt = 0; mt < 2; ++mt)
#pragma unroll
        for (int dt = 0; dt < 8; ++dt) o[mt][dt] = (f32x4){0.f, 0.f, 0.f, 0.f};
    float mrow[2] = {-1e30f, -1e30f}, lrow[2] = {0.f, 0.f};
    const int NT = 4 * (qb + 1);
    const int skey = tid >> 3, spart = tid & 7;
    const bf16* kg = KB + (size_t)skey * 256 + spart * 16; const bf16* vg = VB + (size_t)skey * 256 + spart * 16;
    u32x4 sk0, sk1, sv0, sv1; unsigned long long mw[2];
    sk0 = *(const u32x4*)(kg); sk1 = *(const u32x4*)(kg + 8); sv0 = *(const u32x4*)(vg); sv1 = *(const u32x4*)(vg + 8);
    mw[0] = mkp[0]; mw[1] = mkp[16];
    for (int jt = 0; jt < NT; ++jt) {
        unsigned char* buf = lds + (jt & 1) * ATT_BUF; bf16* Ks = (bf16*)buf; bf16* Vt = (bf16*)(buf + 64 * ATT_KS * 2);
        *(u32x4*)(Ks + skey * ATT_KS + spart * 16) = sk0; *(u32x4*)(Ks + skey * ATT_KS + spart * 16 + 8) = sk1;
        { const unsigned w[8] = {sv0.x, sv0.y, sv0.z, sv0.w, sv1.x, sv1.y, sv1.z, sv1.w};
#pragma unroll
          for (int i = 0; i < 8; ++i) { Vt[(spart * 16 + 2 * i) * ATT_VS + skey] = (bf16)(w[i] & 0xffffu); Vt[(spart * 16 + 2 * i + 1) * ATT_VS + skey] = (bf16)(w[i] >> 16); } }
        const unsigned long long m0 = mw[0], m1 = mw[1];
        __syncthreads();
        if (jt + 1 < NT) { const size_t go = (size_t)(jt + 1) * 64 * 256; sk0 = *(const u32x4*)(kg + go); sk1 = *(const u32x4*)(kg + go + 8); sv0 = *(const u32x4*)(vg + go); sv1 = *(const u32x4*)(vg + go + 8);
            mw[0] = mkp[(jt + 1) * 32]; mw[1] = mkp[(jt + 1) * 32 + 16]; }
        if (jt * 64 > pos0 + 31) continue;
        f32x4 sc[2][4];
#pragma unroll
        for (int mt = 0; mt < 2; ++mt)
#pragma unroll
            for (int kt = 0; kt < 4; ++kt) sc[mt][kt] = (f32x4){0.f, 0.f, 0.f, 0.f};
#pragma unroll
        for (int kt = 0; kt < 4; ++kt)
#pragma unroll
            for (int k = 0; k < 4; ++k) { const bf16x8 kf = *(const bf16x8*)(Ks + (kt * 16 + fr) * ATT_KS + k * 32 + fq * 8);
                sc[0][kt] = mfma16(kf, qf[0][k], sc[0][kt]); sc[1][kt] = mfma16(kf, qf[1][k], sc[1][kt]); }
        bf16x8 pf[2][2];
#pragma unroll
        for (int mt = 0; mt < 2; ++mt) {
            const unsigned long long mk = (mt ? m1 : m0) >> (4 * fq);
            float mx = -1e30f;
#pragma unroll
            for (int kt = 0; kt < 4; ++kt)
#pragma unroll
                for (int i = 0; i < 4; ++i) { const bool on = (mk >> (16 * kt + i)) & 1ull; sc[mt][kt][i] = on ? sc[mt][kt][i] : -1e30f; mx = fmaxf(mx, sc[mt][kt][i]); }
            mx = fmaxf(mx, __shfl_xor(mx, 16)); mx = fmaxf(mx, __shfl_xor(mx, 32));
            const float mn = fmaxf(mrow[mt], mx), al = __builtin_amdgcn_exp2f(mrow[mt] - mn); mrow[mt] = mn;
            float ps = 0.f;
#pragma unroll
            for (int kt = 0; kt < 4; ++kt)
#pragma unroll
                for (int i = 0; i < 4; ++i) { const float e = (sc[mt][kt][i] > -1e29f) ? __builtin_amdgcn_exp2f(sc[mt][kt][i] - mn) : 0.f; sc[mt][kt][i] = e; ps += e; }
            lrow[mt] = lrow[mt] * al + ps;
            if (!__all(al == 1.f)) {
#pragma unroll
                for (int dt = 0; dt < 8; ++dt) o[mt][dt] = o[mt][dt] * al; }
#pragma unroll
            for (int ks = 0; ks < 2; ++ks) { u32x4 w; w.x = cvtpk(sc[mt][2 * ks][0], sc[mt][2 * ks][1]); w.y = cvtpk(sc[mt][2 * ks][2], sc[mt][2 * ks][3]);
                w.z = cvtpk(sc[mt][2 * ks + 1][0], sc[mt][2 * ks + 1][1]); w.w = cvtpk(sc[mt][2 * ks + 1][2], sc[mt][2 * ks + 1][3]); pf[mt][ks] = __builtin_bit_cast(bf16x8, w); }
        }
#pragma unroll
        for (int dt = 0; dt < 8; ++dt)
#pragma unroll
            for (int ks = 0; ks < 2; ++ks) { const bf16* vp = Vt + (dt * 16 + fr) * ATT_VS + ks * 32 + 4 * fq;
                const u32x2 va = *(const u32x2*)vp, vb2 = *(const u32x2*)(vp + 16); u32x4 w; w.x = va.x; w.y = va.y; w.z = vb2.x; w.w = vb2.y; const bf16x8 vf = __builtin_bit_cast(bf16x8, w);
                o[0][dt] = mfma16(vf, pf[0][ks], o[0][dt]); o[1][dt] = mfma16(vf, pf[1][ks], o[1][dt]); }
    }
#pragma unroll
    for (int mt = 0; mt < 2; ++mt) { float l = lrow[mt]; l += __shfl_xor(l, 16); l += __shfl_xor(l, 32); const float il = 1.f / l;
        bf16* orow = AO + (row0 + mt * 16 + fr) * DM + h * 128 + 4 * fq;
#pragma unroll
        for (int dt = 0; dt < 8; ++dt) { const f32x4 v = o[mt][dt] * il; u32x2 w; w.x = cvtpk(v.x, v.y); w.y = cvtpk(v.z, v.w); *(u32x2*)(orow + dt * 16) = w; } }
    __syncthreads();
}

DEVI void idx_sample_unit(CP p, int j, int b, int kb, float* sq  ) {
    const int TIDX = ltid();
    const float* H = wsf(p, WS_H); float* SCS = wsf(p, WS_SCS); const int tid = TIDX;
    for (int i = tid; i < 8 * 512; i += 512) sq[i] = H[(size_t)(MPR + b * DS + (i >> 9)) * HC_AB + C_QI + (i & 511)];
    if (tid < 64) sq[4096 + tid] = H[(size_t)(MPR + b * DS + (tid >> 3)) * HC_AB + C_WI + (tid & 7)];
    __syncthreads();
    const int key = kb * 512 + tid;
    if (key < NKEY_S) {
        const float* kr;
        if (key < PAST) { const int pg = p->page_table[b * NPAGES + key / PAGE]; kr = p->cache_ik + (((size_t)j * NPOOL + pg) * PAGE + key % PAGE) * 64; }
        else kr = H + (size_t)(MPR + b * DS + key - PAST) * HC_AB + C_KI;
        float k[64];
#pragma unroll
        for (int i = 0; i < 16; ++i) { const f32x4 v = *(const f32x4*)(kr + 4 * i); k[4 * i] = v.x; k[4 * i + 1] = v.y; k[4 * i + 2] = v.z; k[4 * i + 3] = v.w; }
#pragma unroll 1
        for (int qi = 0; qi < 8; ++qi) { if (key > PAST + qi) continue; float sc = 0.f;
#pragma unroll 1
            for (int h = 0; h < 8; ++h) { float d = 0.f;
#pragma unroll
                for (int i = 0; i < 64; ++i) d += sq[qi * 512 + h * 64 + i] * k[i];
                sc += sq[4096 + qi * 8 + h] * fmaxf(d, 0.f); }
            SCS[(size_t)(b * DS + qi) * SCS_LD + key] = sc * IDX_SCALE; }
    }
    __syncthreads();
}

DEVI void select_sample_unit(CP p, int q, int* red  ) {
    const int TIDX = ltid();
    const float* sc = wsf(p, WS_SCS) + (size_t)q * SCS_LD; int* SELS = (int*)(p->ws + WS_SELS) + q * TOPK;
    const int tid = TIDX, lane = tid & 63, wv = tid >> 6, nk = PAST + (q % DS) + 1;
    unsigned v[33];
#pragma unroll
    for (int jj = 0; jj < 33; ++jj) { const int key = jj * 512 + tid; v[jj] = key < nk ? ord_f(sc[key]) : 0u; }
    unsigned T = 0u; int par = 0;
    for (int bit = 31; bit >= 0; --bit) { const unsigned cand = T | (1u << bit); int cnt = 0;
#pragma unroll
        for (int jj = 0; jj < 33; ++jj) cnt += __popcll(__ballot(v[jj] >= cand));
        if (lane == 0) red[par * 8 + wv] = cnt; __syncthreads();
        int tot = 0;
#pragma unroll
        for (int w = 0; w < 8; ++w) tot += red[par * 8 + w];
        par ^= 1;
        if (tot >= TOPK) T = cand; if (tot == TOPK) break; }
    __syncthreads();
    int* cg = red + 16; int* ce = cg + 33 * 8; int* pg = ce + 33 * 8; int* pe = pg + 33 * 8;
#pragma unroll
    for (int jj = 0; jj < 33; ++jj) { const int a = __popcll(__ballot(v[jj] > T)), e = __popcll(__ballot(v[jj] == T)); if (lane == 0) { cg[jj * 8 + wv] = a; ce[jj * 8 + wv] = e; } }
    __syncthreads();
    if (tid < 33 * 8) { int a = 0, e = 0; for (int i = 0; i < tid; ++i) { a += cg[i]; e += ce[i]; } pg[tid] = a; pe[tid] = e; }
    if (tid == 0) { int a = 0; for (int i = 0; i < 33 * 8; ++i) a += cg[i]; red[0] = a; }
    __syncthreads();
    const int need = TOPK - red[0]; const unsigned long long lt = (1ull << lane) - 1ull;
#pragma unroll
    for (int jj = 0; jj < 33; ++jj) {
        const bool gt = v[jj] > T, eq = v[jj] == T; const unsigned long long me = __ballot(eq), mg = __ballot(gt);
        const int epre = pe[jj * 8 + wv] + __popcll(me & lt), gpre = pg[jj * 8 + wv] + __popcll(mg & lt); const bool sel = gt || (eq && epre < need);
        const int ebc = epre < need ? epre : need;
        if (sel) SELS[gpre + ebc] = jj * 512 + tid;
    }
    __syncthreads();
}

DEVI void attn_sample_unit(CP p, int j, int q, int g, unsigned char* lds) {
    const int tid = ltid(), lane = tid & 63, wv = tid >> 6, b = q / DS, row = MPR + q;
    const float* H = wsf(p, WS_H); bf16* AO = wsb(p, WS_AO);
    long long* koff = (long long*)lds; float* lg = (float*)(lds + 2048); float* ml = (float*)(lds + 2048 + 4096); float* part = (float*)(lds + 2048 + 4096 + 64);
    if (tid < TOPK) { const int s = ((const int*)(p->ws + WS_SELS))[q * TOPK + tid];
        if (s < PAST) { const int pg = p->page_table[b * NPAGES + s / PAGE]; koff[tid] = (long long)((((size_t)j * NPOOL + pg) * PAGE + s % PAGE) * 256 + g * 128); }
        else koff[tid] = -(1ll + (long long)((size_t)(MPR + b * DS + s - PAST) * HC_AB + C_K + g * 128)); }
    const float qs = ATT_SCALE * 1.4426950408889634f; float q0[4], q1[4];
#pragma unroll
    for (int hh = 0; hh < 4; ++hh) { q0[hh] = H[(size_t)row * HC_AB + C_Q + (g * 4 + hh) * 128 + lane] * qs; q1[hh] = H[(size_t)row * HC_AB + C_Q + (g * 4 + hh) * 128 + 64 + lane] * qs; }
    __syncthreads();
    for (int i0 = wv * 32; i0 < wv * 32 + 32; i0 += 8) { float a0[8], a1[8];
#pragma unroll
        for (int i = 0; i < 8; ++i) { const long long o = koff[i0 + i]; const float* kr = (o >= 0) ? p->cache_k + o : H + (-(o + 1)); a0[i] = kr[lane]; a1[i] = kr[lane + 64]; }
#pragma unroll
        for (int i = 0; i < 8; ++i)
#pragma unroll
            for (int hh = 0; hh < 4; ++hh) { const float v = wave_sum(q0[hh] * a0[i] + q1[hh] * a1[i]); if (lane == 0) lg[hh * 256 + i0 + i] = v; } }
    __syncthreads();
    float mh[4], lh[4];
#pragma unroll
    for (int hh = 0; hh < 4; ++hh) { const float x0 = lg[hh * 256 + lane], x1 = lg[hh * 256 + 64 + lane], x2 = lg[hh * 256 + 128 + lane], x3 = lg[hh * 256 + 192 + lane];
        float m = fmaxf(fmaxf(x0, x1), fmaxf(x2, x3));
#pragma unroll
        for (int o = 1; o < 64; o <<= 1) m = fmaxf(m, __shfl_xor(m, o));
        mh[hh] = m; lh[hh] = wave_sum(__builtin_amdgcn_exp2f(x0 - m) + __builtin_amdgcn_exp2f(x1 - m) + __builtin_amdgcn_exp2f(x2 - m) + __builtin_amdgcn_exp2f(x3 - m)); }
    if (wv == 0 && lane < 4) ml[lane] = lh[lane];
    float o0[4] = {0.f, 0.f, 0.f, 0.f}, o1[4] = {0.f, 0.f, 0.f, 0.f};
    for (int i0 = wv * 32; i0 < wv * 32 + 32; i0 += 8) { float a0[8], a1[8];
#pragma unroll
        for (int i = 0; i < 8; ++i) { const long long o = koff[i0 + i]; const float* vr = (o >= 0) ? p->cache_v + o : H + (-(o + 1)) + (C_V - C_K); a0[i] = vr[lane]; a1[i] = vr[lane + 64]; }
#pragma unroll
        for (int i = 0; i < 8; ++i)
#pragma unroll
            for (int hh = 0; hh < 4; ++hh) { const float pe = __builtin_amdgcn_exp2f(lg[hh * 256 + i0 + i] - mh[hh]); o0[hh] += pe * a0[i]; o1[hh] += pe * a1[i]; } }
#pragma unroll
    for (int hh = 0; hh < 4; ++hh) { part[(wv * 4 + hh) * 128 + lane] = o0[hh]; part[(wv * 4 + hh) * 128 + 64 + lane] = o1[hh]; }
    __syncthreads();
    { const int hh = tid >> 7, d = tid & 127; float v = 0.f;
#pragma unroll
      for (int w = 0; w < 8; ++w) v += part[(w * 4 + hh) * 128 + d];
      AO[(size_t)row * DM + (g * 4 + hh) * 128 + d] = f2bf(v / ml[hh]); }
    __syncthreads();
}

DEVI void ph_cd_prep(CP p, int j, int vb, int nvb) {
    const int TIDX = ltid();
    const float* H = wsf(p, WS_H); bf16* DD = wsb(p, WS_DD); bf16* U = wsb(p, WS_U); bf16* VLN = wsb(p, WS_VLN);
    const float* lg = p->sgu_ln_g + (size_t)j * 1024; const float* lb = p->sgu_ln_b + (size_t)j * 1024;
    const int lane = TIDX & 63, wv = TIDX >> 6;
    for (int row = vb * 8 + wv; row < MR; row += nvb * 8) {
        const bool pr = row < MPR; const int b = pr ? row / SEQ : (row - MPR) / DS, t = pr ? row % SEQ : (row - MPR) % DS;
        const float* h = H + (size_t)row * HC_CD;
#pragma unroll 1
        for (int i = 0; i < 4; ++i) { const int c = i * 256 + lane * 4, w = 2 << i; const f32x4 cur = *(const f32x4*)(h + c); f32x4 s = cur; int cnt;
            if (pr) { cnt = (t + 1 < w) ? t + 1 : w; for (int u = 1; u < cnt; ++u) s += *(const f32x4*)(H + (size_t)(row - u) * HC_CD + c); }
            else { cnt = w; for (int u = 1; u < w; ++u) { const int e = 15 + t - u;
                    s += (e >= 15) ? *(const f32x4*)(H + (size_t)(MPR + b * DS + e - 15) * HC_CD + c) : *(const f32x4*)(p->state_pool + (((size_t)j * DB + b) * 15 + e) * 1024 + c); } }
            const float ic = 1.f / (float)cnt; const f32x4 d = s * ic - cur; uint2 o; o.x = pk2(d.x, d.y); o.y = pk2(d.z, d.w); *(uint2*)(DD + (size_t)row * 1024 + c) = o;
            if (pr) { if (t >= SEQ - 15) *(f32x4*)(p->out + O_PP + (((size_t)j * NBP + b) * 15 + (t - (SEQ - 15))) * 1024 + c) = cur; }
            else { *(f32x4*)(p->out + O_PS + (((size_t)j * DB + b) * 15 + 7 + t) * 1024 + c) = cur;
                   if (t == 0) for (int e = 0; e < 7; ++e) *(f32x4*)(p->out + O_PS + (((size_t)j * DB + b) * 15 + e) * 1024 + c) = *(const f32x4*)(p->state_pool + (((size_t)j * DB + b) * 15 + 8 + e) * 1024 + c); }
        }
        asm volatile("" ::: "memory");
#pragma unroll
        for (int i = 0; i < 4; ++i) { const int c = (i * 64 + lane) * 4; const f32x4 u = *(const f32x4*)(h + 1024 + c); uint2 o; o.x = pk2(gelu_f(u.x), gelu_f(u.y)); o.y = pk2(gelu_f(u.z), gelu_f(u.w)); *(uint2*)(U + (size_t)row * 1024 + c) = o; }
        asm volatile("" ::: "memory");
        f32x4 v[4]; float s = 0.f;
#pragma unroll
        for (int i = 0; i < 4; ++i) { const int c = (i * 64 + lane) * 4; const f32x4 x = *(const f32x4*)(h + 2048 + c); v[i] = (f32x4){gelu_f(x.x), gelu_f(x.y), gelu_f(x.z), gelu_f(x.w)}; s += (v[i].x + v[i].y) + (v[i].z + v[i].w); }
        const float mean = wave_sum(s) * (1.f / 1024.f); float q = 0.f;
#pragma unroll
        for (int i = 0; i < 4; ++i) { v[i] = v[i] - mean; q += (v[i].x * v[i].x + v[i].y * v[i].y) + (v[i].z * v[i].z + v[i].w * v[i].w); }
        const float rstd = 1.f / sqrtf(wave_sum(q) * (1.f / 1024.f) + EPS);
#pragma unroll
        for (int i = 0; i < 4; ++i) { const int c = (i * 64 + lane) * 4; const f32x4 y = v[i] * rstd * *(const f32x4*)(lg + c) + *(const f32x4*)(lb + c);
            uint2 o; o.x = pk2(y.x, y.y); o.y = pk2(y.z, y.w); *(uint2*)(VLN + (size_t)row * 1024 + c) = o;
            if (!pr) *(f32x4*)(p->out + O_GS + ((size_t)j * MSR + (row - MPR)) * 1024 + c) = y; }
    }
}

DEVI void sgu_unit(CP p, int j, int ck, int g, int ds, bf16* Vt  ) {
    const int tid = ltid(), lane = tid & 63, wv = tid >> 6, fr = lane & 15, fq = lane >> 4;
    const bf16* VLN = wsb(p, WS_VLN); const bf16* U = wsb(p, WS_U); bf16* AO = wsb(p, WS_AO);
    const size_t row0 = (size_t)ck * 128; const int c0 = g * 256 + ds * 64;
    { const int sp = tid >> 2, part = tid & 3; const bf16* src = VLN + (row0 + sp) * 1024 + c0 + part * 16; const u32x4 a = *(const u32x4*)src, bq = *(const u32x4*)(src + 8);
      const unsigned w[8] = {a.x, a.y, a.z, a.w, bq.x, bq.y, bq.z, bq.w};
#pragma unroll
      for (int i = 0; i < 8; ++i) { Vt[(part * 16 + 2 * i) * 136 + sp] = (bf16)(w[i] & 0xffffu); Vt[(part * 16 + 2 * i + 1) * 136 + sp] = (bf16)(w[i] >> 16); } }
    __syncthreads();
    const bf16* W = wsb(p, WS_SGUW) + (((size_t)j * 4 + g) * 128 + wv * 16 + fr) * 128 + fq * 8;
    f32x4 acc[4];
#pragma unroll
    for (int nt = 0; nt < 4; ++nt) acc[nt] = (f32x4){0.f, 0.f, 0.f, 0.f};
    const int nk = (wv >> 1) + 1;
#pragma unroll
    for (int k = 0; k < 4; ++k) if (k < nk) { const bf16x8 wf = *(const bf16x8*)(W + k * 32);
#pragma unroll
        for (int nt = 0; nt < 4; ++nt) acc[nt] = mfma16(*(const bf16x8*)(Vt + (nt * 16 + fr) * 136 + k * 32 + fq * 8), wf, acc[nt]); }
    const float bs = p->sgu_b[((size_t)j * 4 + g) * 128 + wv * 16 + fr]; const size_t row = row0 + wv * 16 + fr;
#pragma unroll
    for (int nt = 0; nt < 4; ++nt) { const int c = c0 + nt * 16 + 4 * fq; const u32x2 uw = *(const u32x2*)(U + row * 1024 + c);
        const float o0 = bflo(uw.x) * (acc[nt].x + bs), o1 = bfhi(uw.x) * (acc[nt].y + bs), o2 = bflo(uw.y) * (acc[nt].z + bs), o3 = bfhi(uw.y) * (acc[nt].w + bs);
        u32x2 w; w.x = cvtpk(o0, o1); w.y = cvtpk(o2, o3); *(u32x2*)(AO + row * DM + 1024 + c) = w; }
    __syncthreads();
}
DEVI void ph_sgu_naive(CP p, int j, int vb, int nvb) {
    const int TIDX = ltid();
    const bf16* VLN = wsb(p, WS_VLN); const bf16* U = wsb(p, WS_U); bf16* AO = wsb(p, WS_AO);
    for (int row = MPR + vb; row < MR; row += nvb) {
        const bool pr = row < MPR; const int t = pr ? row % SEQ : (row - MPR) % DS;
        const int tt = pr ? (t & 127) : t, base = row - tt;
        for (int d = TIDX; d < 1024; d += 512) { const int g = d >> 8; const float* w = p->sgu_w + (((size_t)j * 4 + g) * 128 + tt) * 128;
            float acc = p->sgu_b[((size_t)j * 4 + g) * 128 + tt];
            for (int s = 0; s <= tt; ++s) acc += w[s] * bf2f(VLN[(size_t)(base + s) * 1024 + d]);
            AO[(size_t)row * DM + 1024 + d] = f2bf(bf2f(U[(size_t)row * 1024 + d]) * acc); }
    }
}


DEVI void diag_cmp(CP p, int k, const bf16* a, int lda, const bf16* b, int ldb, int rows, int cols, int vb, int nvb) {
    unsigned* ctl = (unsigned*)(p->ws + WS_CTL); const int tid = ltid(); float mx = 0.f; unsigned bad = 0;
    for (int r = vb; r < rows; r += nvb) for (int c = tid; c < cols; c += 512) { const float x = bf2f(a[(size_t)r * lda + c]), y = bf2f(b[(size_t)r * ldb + c]); const float d = fabsf(x - y);
        if (!(d == d) || d > 1e30f) bad++; else mx = fmaxf(mx, d); }
    atomicMax(ctl + 64 + 2 * k, __float_as_uint(mx)); if (bad) atomicAdd(ctl + 65 + 2 * k, bad);
}
DEVI void diag_cmp_f32(CP p, int k, const float* a, int lda, const bf16* b, int ldb, int rows, int cols, int vb, int nvb) {
    unsigned* ctl = (unsigned*)(p->ws + WS_CTL); const int tid = ltid(); float mx = 0.f; unsigned bad = 0;
    for (int r = vb; r < rows; r += nvb) for (int c = tid; c < cols; c += 512) { const float x = a[(size_t)r * lda + c], y = bf2f(b[(size_t)r * ldb + c]); const float d = fabsf(x - y);
        if (!(d == d) || d > 1e30f) bad++; else mx = fmaxf(mx, d); }
    atomicMax(ctl + 64 + 2 * k, __float_as_uint(mx)); if (bad) atomicAdd(ctl + 65 + 2 * k, bad);
}
DEVI void diag_fin_f32(CP p, int k, const float* a, size_t n, int vb, int nvb) {
    unsigned* ctl = (unsigned*)(p->ws + WS_CTL); unsigned bad = 0;
    for (size_t i = (size_t)vb * 512 + ltid(); i < n; i += (size_t)nvb * 512) { const float x = a[i]; if (!(x == x) || fabsf(x) > 1e30f) bad++; }
    if (bad) atomicAdd(ctl + 65 + 2 * k, bad);
}
DEVI void diag_fin_bf16(CP p, int k, const bf16* a, size_t n, int vb, int nvb) {
    unsigned* ctl = (unsigned*)(p->ws + WS_CTL); unsigned bad = 0;
    for (size_t i = (size_t)vb * 512 + ltid(); i < n; i += (size_t)nvb * 512) { const float x = bf2f(a[i]); if (!(x == x) || fabsf(x) > 1e30f) bad++; }
    if (bad) atomicAdd(ctl + 65 + 2 * k, bad);
}
DEVI void diag_report(CP p, int nchecks) {
    unsigned* ctl = (unsigned*)(p->ws + WS_CTL);
    if (blockIdx.x == 0 && threadIdx.x == 0) { const unsigned fl = __hip_atomic_load(ctl + 96, __ATOMIC_RELAXED, __HIP_MEMORY_SCOPE_AGENT); if (fl) { p->out[O_KP] = (float)fl * 1e12f; return; } }
    if (blockIdx.x == 0 && threadIdx.x == 0) for (int k = 0; k < nchecks; ++k) { const float mx = __uint_as_float(__hip_atomic_load(ctl + 64 + 2 * k, __ATOMIC_RELAXED, __HIP_MEMORY_SCOPE_AGENT)); const unsigned bad = __hip_atomic_load(ctl + 65 + 2 * k, __ATOMIC_RELAXED, __HIP_MEMORY_SCOPE_AGENT);
        if (bad) { p->out[O_KP] = (70.f + k) * 1e19f; break; } if (mx > 0.06f) { p->out[O_KP] = mx * 1e8f; break; } }
}
namespace pg8 {
#define PG8_LAS __attribute__((address_space(3)))
typedef unsigned short bf16_t;
typedef short bf16x8 __attribute__((ext_vector_type(8)));
typedef float f32x4 __attribute__((ext_vector_type(4)));
typedef unsigned u32x4 __attribute__((ext_vector_type(4)));
constexpr int BM = 256, BK = 64, HALF = 128, HTB = HALF * BK * 2  , STAGE_BYTES = 8 * HTB, NXCD = 8, WGM = 8;

__host__ __device__ __forceinline__ int lds_byte(int r, int c) { const int st = (r >> 4) * 2 + (c >> 5), rr = r & 15, cc = c & 31, ob = rr * 64 + cc * 2; return st * 1024 + (ob ^ (((ob >> 9) & 1) << 5)); }
__host__ __device__ __forceinline__ void stage_rc(int b, int& R, int& C) { const int st = b / 1024, sb = b % 1024, swz = sb ^ (((sb >> 9) & 1) << 5); R = (st >> 1) * 16 + swz / 64; C = (st & 1) * 32 + (swz % 64) / 2; }
__host__ __device__ __forceinline__ int perm32(int rho) { const int n = rho >> 4, i = rho & 15; return 8 * (i >> 2) + 4 * n + (i & 3); }

struct Unit { int pm, pn; };
struct Gemm { const bf16_t* A; const bf16_t* Bt; int M, N, K, lda, ldb, acol; };

struct StaticOrder {
    int nM, nN, nwg, G, c;
    __host__ __device__ void init(int M, int N, int G_, int c_) { nM = M / BM; nN = N / BM; nwg = nM * nN; G = G_; c = c_; }
    __host__ __device__ bool next(int i, Unit& u) const {
        const long L = (long)i * G + c; if (L >= nwg) return false;
        int wgid = (int)L; { const int q = nwg / NXCD, r = nwg % NXCD, xcd = wgid % NXCD, off = wgid / NXCD; wgid = (xcd < r ? xcd * (q + 1) : r * (q + 1) + (xcd - r) * q) + off; }
        const int nig = WGM * nN, gid = wgid / nig, fm = gid * WGM, gsz = (nM - fm) < WGM ? (nM - fm) : WGM;
        u.pm = fm + ((wgid % nig) % gsz); u.pn = (wgid % nig) / gsz; return true;
    }
    __device__ __forceinline__ void a_ready(const Unit&) const {}
    __device__ __forceinline__ void done(const Unit&) const {}
};

template <class Epi, class Sched, bool ALIGN_EPI = false, bool SP2 = false>
__device__ __forceinline__ void gemm_phase(PG8_LAS unsigned char* lds, const Gemm g, const Sched& S, const Epi& E) {
    int tid_ = threadIdx.x; asm volatile("" : "+v"(tid_)); const int tid = tid_, wid = __builtin_amdgcn_readfirstlane(tid >> 6), lane = tid & 63, wr = wid >> 2, wc = wid & 3, fr = lane & 15, fq = lane >> 4;
    const int K = g.K, nt = K / BK;
    unsigned voffA[2], voffB[2];
#pragma unroll
    for (int i = 0; i < 2; ++i) { int R, C; stage_rc(tid * 16 + i * 8192, R, C); const int Rb = Epi::PERM ? ((R & ~31) + perm32(R & 31)) : R;
        voffA[i] = (unsigned)(R * g.lda + C) * 2u; voffB[i] = (unsigned)(Rb * g.ldb + C) * 2u; }
    const size_t kstep = (size_t)(BK * 2);
    const size_t hstepA = (size_t)HALF * g.lda * 2, hstepB = (size_t)HALF * g.ldb * 2;
    const size_t tstepA = 2 * hstepA, tstepB = 2 * hstepB, acolB = (size_t)g.acol * 2;
    const unsigned ldsw = (unsigned)wid * 1024u;
    const int aoff = lds_byte(wr * 64 + fr, fq * 8), boff = lds_byte(wc * 32 + fr, fq * 8);
#define PG8_SA(b, h) (((b) * 2 + (h)) * HTB)
#define PG8_SB(b, h) ((4 + (b) * 2 + (h)) * HTB)
#define PG8_STAGE(bufoff, gbase, voff) do { _Pragma("unroll") for (int _i = 0; _i < 2; ++_i) \
        __builtin_amdgcn_global_load_lds((const unsigned*)((const char*)(gbase) + (voff)[_i]), (PG8_LAS unsigned*)(lds + (bufoff) + ldsw + _i * 8192), 16, 0, 0); } while (0)
#define PG8_LDA(dst, b, h) do { _Pragma("unroll") for (int m = 0; m < 4; ++m) _Pragma("unroll") for (int k = 0; k < 2; ++k) dst[m][k] = *(const PG8_LAS bf16x8*)(lds + PG8_SA(b, h) + aoff + m * 2048 + k * 1024); } while (0)
#define PG8_LDB(dst, b, h) do { _Pragma("unroll") for (int n = 0; n < 2; ++n) _Pragma("unroll") for (int k = 0; k < 2; ++k) dst[n][k] = *(const PG8_LAS bf16x8*)(lds + PG8_SB(b, h) + boff + n * 2048 + k * 1024); } while (0)
#define PG8_MMA(ai, bj, At, Bt) do { __builtin_amdgcn_s_setprio(1); _Pragma("unroll") for (int m = 0; m < 4; ++m) _Pragma("unroll") for (int n = 0; n < 2; ++n) _Pragma("unroll") for (int k = 0; k < 2; ++k) \
        acc[ai][bj][m][n] = __builtin_amdgcn_mfma_f32_16x16x32_bf16(Bt[n][k], At[m][k], acc[ai][bj][m][n], 0, 0, 0); __builtin_amdgcn_s_setprio(0); } while (0)
#define PG8_WAIT_V(n) asm volatile("s_waitcnt vmcnt(" #n ")" ::: "memory")
#define PG8_WAIT_L(n) asm volatile("s_waitcnt lgkmcnt(" #n ")" ::: "memory")
#define PG8_BAR __builtin_amdgcn_s_barrier()
#define PG8_SCHED __builtin_amdgcn_sched_barrier(0)
    Unit cur, nxt; int ui = 0;
    if (!S.next(0, cur)) return;
    f32x4 acc[2][2][4][2];
#pragma unroll
    for (int a = 0; a < 2; ++a)
#pragma unroll
        for (int b = 0; b < 2; ++b)
#pragma unroll
            for (int m = 0; m < 4; ++m)
#pragma unroll
                for (int n = 0; n < 2; ++n) acc[a][b][m][n] = (f32x4){0.f, 0.f, 0.f, 0.f};
    bf16x8 At[4][2], B0[2][2], B1[2][2];
    const char* cA = (const char*)g.A + (size_t)cur.pm * tstepA + (size_t)cur.pn * acolB; const char* cB = (const char*)g.Bt + (size_t)cur.pn * tstepB;
    S.a_ready(cur);
    if constexpr (SP2) {
        PG8_STAGE(PG8_SB(0, 0), cB, voffB); PG8_STAGE(PG8_SB(0, 1), cB + hstepB, voffB); PG8_STAGE(PG8_SA(0, 0), cA, voffA); PG8_STAGE(PG8_SA(0, 1), cA + hstepA, voffA);
        if (wr == 1) PG8_BAR;
        PG8_WAIT_V(2); PG8_BAR;
        PG8_STAGE(PG8_SB(1, 0), cB + kstep, voffB); PG8_STAGE(PG8_SA(1, 0), cA + kstep, voffA); PG8_STAGE(PG8_SB(1, 1), cB + hstepB + kstep, voffB);
        PG8_WAIT_V(6); PG8_BAR;
    } else {
        PG8_STAGE(PG8_SB(0, 0), cB, voffB); PG8_STAGE(PG8_SA(0, 0), cA, voffA); PG8_STAGE(PG8_SB(0, 1), cB + hstepB, voffB); PG8_STAGE(PG8_SA(0, 1), cA + hstepA, voffA);
        if (wr == 1) PG8_BAR;
        PG8_WAIT_V(4); PG8_BAR;
        PG8_STAGE(PG8_SB(1, 0), cB + kstep, voffB); PG8_STAGE(PG8_SA(1, 0), cA + kstep, voffA); PG8_STAGE(PG8_SB(1, 1), cB + hstepB + kstep, voffB);
        PG8_WAIT_V(6); PG8_BAR;
    }
    for (;;) {
        const bool has_next = S.next(ui + 1, nxt);
        const char* nA = has_next ? (const char*)g.A + (size_t)nxt.pm * tstepA + (size_t)nxt.pn * acolB : cA; const char* nB = has_next ? (const char*)g.Bt + (size_t)nxt.pn * tstepB : cB;
        for (int t = 0; t < nt; t += 2) {
            const bool last = (t == nt - 2);
            const char* a1 = cA + (size_t)(t + 1) * kstep;
            const char* a2 = last ? nA : cA + (size_t)(t + 2) * kstep; const char* b2 = last ? nB : cB + (size_t)(t + 2) * kstep;
            const char* a3 = a2 + kstep; const char* b3 = b2 + kstep;
            if (last && has_next) S.a_ready(nxt);
            if constexpr (SP2) {
            PG8_LDB(B0, 0, 0); PG8_LDB(B1, 0, 1); PG8_SCHED; PG8_LDA(At, 0, 0); PG8_STAGE(PG8_SA(1, 1), a1 + hstepA, voffA);
            PG8_WAIT_V(8); PG8_WAIT_L(0); PG8_BAR; PG8_MMA(0, 0, At, B0); PG8_MMA(0, 1, At, B1); PG8_BAR; PG8_SCHED;
            PG8_LDA(At, 0, 1); PG8_STAGE(PG8_SB(0, 0), b2, voffB); PG8_STAGE(PG8_SB(0, 1), b2 + hstepB, voffB); PG8_STAGE(PG8_SA(0, 0), a2, voffA);
            PG8_WAIT_V(8); PG8_WAIT_L(0); PG8_BAR; PG8_MMA(1, 0, At, B0); PG8_MMA(1, 1, At, B1); PG8_BAR; PG8_SCHED;
            PG8_LDB(B0, 1, 0); PG8_LDB(B1, 1, 1); PG8_SCHED; PG8_LDA(At, 1, 0); PG8_STAGE(PG8_SA(0, 1), a2 + hstepA, voffA);
            PG8_WAIT_V(8); PG8_WAIT_L(0); PG8_BAR; PG8_MMA(0, 0, At, B0); PG8_MMA(0, 1, At, B1); PG8_BAR; PG8_SCHED;
            PG8_LDA(At, 1, 1); PG8_STAGE(PG8_SB(1, 0), b3, voffB); PG8_STAGE(PG8_SB(1, 1), b3 + hstepB, voffB); PG8_STAGE(PG8_SA(1, 0), a3, voffA);
            PG8_WAIT_V(8); PG8_WAIT_L(0); PG8_BAR; PG8_MMA(1, 0, At, B0); PG8_MMA(1, 1, At, B1); PG8_BAR; PG8_SCHED;
            } else {
            PG8_LDB(B0, 0, 0); PG8_SCHED; PG8_LDA(At, 0, 0); PG8_STAGE(PG8_SA(1, 1), a1 + hstepA, voffA);
            PG8_WAIT_L(8); PG8_BAR; PG8_WAIT_L(0); PG8_MMA(0, 0, At, B0); PG8_BAR; PG8_SCHED;
            PG8_LDB(B1, 0, 1); PG8_STAGE(PG8_SB(0, 0), b2, voffB);
            PG8_BAR; PG8_WAIT_L(0); PG8_MMA(0, 1, At, B1); PG8_BAR;
            PG8_LDA(At, 0, 1); PG8_STAGE(PG8_SA(0, 0), a2, voffA);
            PG8_BAR; PG8_WAIT_L(0); PG8_MMA(1, 0, At, B0); PG8_BAR; PG8_SCHED;
            PG8_STAGE(PG8_SB(0, 1), b2 + hstepB, voffB);
            PG8_WAIT_V(6); PG8_BAR; PG8_MMA(1, 1, At, B1); PG8_BAR;
            PG8_LDB(B0, 1, 0); PG8_SCHED; PG8_LDA(At, 1, 0); PG8_STAGE(PG8_SA(0, 1), a2 + hstepA, voffA);
            PG8_WAIT_L(8); PG8_BAR; PG8_WAIT_L(0); PG8_MMA(0, 0, At, B0); PG8_BAR; PG8_SCHED;
            PG8_LDB(B1, 1, 1); PG8_STAGE(PG8_SB(1, 0), b3, voffB);
            PG8_BAR; PG8_WAIT_L(0); PG8_MMA(0, 1, At, B1); PG8_BAR;
            PG8_LDA(At, 1, 1); PG8_STAGE(PG8_SA(1, 0), a3, voffA);
            PG8_BAR; PG8_WAIT_L(0); PG8_MMA(1, 0, At, B0); PG8_BAR; PG8_SCHED;
            PG8_STAGE(PG8_SB(1, 1), b3 + hstepB, voffB);
            PG8_WAIT_V(6); PG8_BAR; PG8_MMA(1, 1, At, B1); PG8_BAR;
            }
        }
        if constexpr (ALIGN_EPI) { if (wr == 0) PG8_BAR; }
        if constexpr (!Epi::AFTER_DRAIN) { E(acc, cur, wr, wc, fr, fq); S.done(cur); }
        if (!has_next) break;
#pragma unroll
        for (int a = 0; a < 2; ++a)
#pragma unroll
            for (int b = 0; b < 2; ++b)
#pragma unroll
                for (int m = 0; m < 4; ++m)
#pragma unroll
                    for (int n = 0; n < 2; ++n) acc[a][b][m][n] = (f32x4){0.f, 0.f, 0.f, 0.f};
        cur = nxt; cA = nA; cB = nB; ++ui;
        if constexpr (ALIGN_EPI) { if (wr == 1) PG8_BAR; }
    }
    PG8_WAIT_V(0);
    if constexpr (!ALIGN_EPI) { if (wr == 0) PG8_BAR; }
    PG8_BAR;
    if constexpr (Epi::AFTER_DRAIN) { E.fused(acc, cur, wr, wc, fr, fq, lds, wid, lane); S.done(cur); }
#undef PG8_SA
#undef PG8_SB
#undef PG8_STAGE
#undef PG8_LDA
#undef PG8_LDB
#undef PG8_MMA
#undef PG8_WAIT_V
#undef PG8_WAIT_L
#undef PG8_BAR
#undef PG8_SCHED
}
}
namespace pg8 {
__device__ __forceinline__ unsigned cvt_pk_bf16(float lo, float hi) { unsigned r; asm volatile("v_cvt_pk_bf16_f32 %0, %1, %2" : "=v"(r) : "v"(lo), "v"(hi)); return r; }
struct EpiF32 {
    static constexpr bool PERM = false, AFTER_DRAIN = false;
    float* C; int ldc;
    __device__ __forceinline__ void operator()(const f32x4 (&acc)[2][2][4][2], const Unit& u, int wr, int wc, int, int) const {
        int ln_ = threadIdx.x & 63; asm volatile("" : "+v"(ln_)); const int fr = ln_ & 15, fq = ln_ >> 4;
        const int row0 = u.pm * BM + wr * 64 + fr, col0 = u.pn * BM + wc * 32 + 4 * fq;
#pragma unroll
        for (int ai = 0; ai < 2; ++ai)
#pragma unroll
            for (int m = 0; m < 4; ++m) { float* rowp = C + (size_t)(row0 + ai * HALF + m * 16) * ldc + col0;
#pragma unroll
                for (int bj = 0; bj < 2; ++bj)
#pragma unroll
                    for (int n = 0; n < 2; ++n) *(f32x4*)(rowp + bj * HALF + n * 16) = acc[ai][bj][m][n]; }
    }
};
struct EpiResid {
    static constexpr bool PERM = false, AFTER_DRAIN = false;
    float* X; int ldc; float alpha;
    __device__ __forceinline__ void operator()(const f32x4 (&acc)[2][2][4][2], const Unit& u, int wr, int wc, int, int) const {
        int ln_ = threadIdx.x & 63; asm volatile("" : "+v"(ln_)); const int fr = ln_ & 15, fq = ln_ >> 4;
        const int row0 = u.pm * BM + wr * 64 + fr, col0 = u.pn * BM + wc * 32 + 4 * fq;
#pragma unroll
        for (int ai = 0; ai < 2; ++ai)
#pragma unroll
            for (int m = 0; m < 4; ++m) { float* rowp = X + (size_t)(row0 + ai * HALF + m * 16) * ldc + col0;
#pragma unroll
                for (int bj = 0; bj < 2; ++bj) { const f32x4 o0 = *(const f32x4*)(rowp + bj * HALF), o1 = *(const f32x4*)(rowp + bj * HALF + 16);
                    *(f32x4*)(rowp + bj * HALF) = o0 * alpha + acc[ai][bj][m][0]; *(f32x4*)(rowp + bj * HALF + 16) = o1 * alpha + acc[ai][bj][m][1];
                    asm volatile("" ::: "memory"); } }
    }
};
template <int ACT  > struct EpiBf16 {
    static constexpr bool PERM = true, AFTER_DRAIN = false;
    bf16_t* O; int ldc; const float* scale;
    __device__ __forceinline__ void operator()(const f32x4 (&acc)[2][2][4][2], const Unit& u, int wr, int wc, int, int) const {
        int ln_ = threadIdx.x & 63; asm volatile("" : "+v"(ln_)); const int fr = ln_ & 15, fq = ln_ >> 4;
        const int row0 = u.pm * BM + wr * 64 + fr, col0 = u.pn * BM + wc * 32 + 8 * fq;
        f32x4 sv[2][2];
#pragma unroll
        for (int bj = 0; bj < 2; ++bj)
#pragma unroll
            for (int n = 0; n < 2; ++n) sv[bj][n] = (ACT == 0) ? *(const f32x4*)(scale + col0 + bj * HALF + 4 * n) : (f32x4){1.f, 1.f, 1.f, 1.f};
#pragma unroll
        for (int ai = 0; ai < 2; ++ai)
#pragma unroll
            for (int m = 0; m < 4; ++m) { bf16_t* rowp = O + (size_t)(row0 + ai * HALF + m * 16) * ldc + col0;
#pragma unroll
                for (int bj = 0; bj < 2; ++bj) { f32x4 v0 = acc[ai][bj][m][0], v1 = acc[ai][bj][m][1];
                    if (ACT == 0) { v0 = v0 * sv[bj][0]; v1 = v1 * sv[bj][1]; }
                    if (ACT == 1) {
#pragma unroll
                        for (int q = 0; q < 4; ++q) { const float a = fmaxf(v0[q], 0.f), b = fmaxf(v1[q], 0.f); v0[q] = a * a; v1[q] = b * b; } }
                    u32x4 w; w.x = cvt_pk_bf16(v0[0], v0[1]); w.y = cvt_pk_bf16(v0[2], v0[3]); w.z = cvt_pk_bf16(v1[0], v1[1]); w.w = cvt_pk_bf16(v1[2], v1[3]);
                    *(u32x4*)(rowp + bj * HALF) = w; } }
    }
};
}
#define LAS __attribute__((address_space(3)))
#define XB_TMO      128
#define XB_XCNT(j)  (256  + 64 * (j))
#define XB_XSUB(j)  (1280 + 64 * (j))
#define XB_XGEN(j)  (2304 + 64 * (j))
#define XB_TOP      3328
#define XB_TOPGEN   3392
#define XCD_BAR_WORDS 3456
#define XB_SPIN_CAP (1u << 18)

__device__ __forceinline__ unsigned xb_ld(unsigned* p)              { return __hip_atomic_load(p, __ATOMIC_RELAXED, __HIP_MEMORY_SCOPE_AGENT); }
__device__ __forceinline__ unsigned xb_add(unsigned* p, unsigned v) { return __hip_atomic_fetch_add(p, v, __ATOMIC_RELAXED, __HIP_MEMORY_SCOPE_AGENT); }
__device__ __forceinline__ unsigned xb_xcc_id() { return (unsigned)__builtin_amdgcn_s_getreg((3 << 11) | 20) & 0xFu; }
#define XB_SPIN(cond, bar) do { unsigned _sp = 0; while (cond) { __builtin_amdgcn_s_sleep(1); \
    if ((++_sp & 255u) == 0u) { if (xb_ld(&(bar)[XB_TMO])) break; if (_sp > XB_SPIN_CAP) { atomicAdd(&(bar)[XB_TMO], 1u); break; } } } } while (0)

struct XcdBarrier {
    unsigned* bar; unsigned x;
    volatile LAS unsigned* st;
};

__device__ __forceinline__ XcdBarrier xcd_barrier_post(unsigned* bar, volatile LAS unsigned* st) {
    XcdBarrier b; b.bar = bar; b.x = xb_xcc_id(); b.st = st;
    if (threadIdx.x == 0) (void)xb_add(&bar[XB_XCNT(b.x)], 1u);
    return b;
}
__device__ __forceinline__ void xcd_barrier_complete(unsigned* bar, unsigned x, unsigned& nloc, unsigned& nx) {
    const unsigned G = gridDim.x * gridDim.y * gridDim.z;
    unsigned sum, cnt, mine, sp = 0u;
    for (;;) {
        sum = 0u; cnt = 0u; mine = 0u;
#pragma unroll
        for (unsigned j = 0; j < 16; ++j) { const unsigned c = xb_ld(&bar[XB_XCNT(j)]); sum += c; cnt += (c > 0u) ? 1u : 0u; mine = (j == x) ? c : mine; }
        if (sum == G) break;
        __builtin_amdgcn_s_sleep(1);
        if ((++sp & 255u) == 0u) { if (xb_ld(&bar[XB_TMO])) break; if (sp > XB_SPIN_CAP) { atomicAdd(&bar[XB_TMO], 1u); break; } }
    }
    nloc = mine > 0u ? mine : 1u; nx = cnt > 0u ? cnt : 1u;
}

__device__ __attribute__((noinline)) void xcd_barrier_impl(unsigned* bar_, unsigned bx_, volatile LAS unsigned* st_) {
    XcdBarrier b; b.bar = bar_; b.x = bx_; b.st = st_;
    asm volatile("s_waitcnt vmcnt(0)" ::: "memory");
    __syncthreads();
    if (threadIdx.x == 0) {
        unsigned* bar = b.bar;
        __builtin_amdgcn_s_waitcnt(0);
        unsigned nloc = b.st[0], nx = b.st[1];
        if (nloc == 0u) { xcd_barrier_complete(bar, b.x, nloc, nx); b.st[0] = nloc; b.st[1] = nx; }
        const unsigned old = xb_add(&bar[XB_XSUB(b.x)], 1u);
        const unsigned gen = old / nloc;
        if (old + 1u == (gen + 1u) * nloc) {
            __builtin_amdgcn_fence(__ATOMIC_RELEASE, "agent");
            asm volatile("s_waitcnt vmcnt(0)" ::: "memory");
            const unsigned og = xb_add(&bar[XB_TOP], 1u);
            const unsigned tg = og / nx;
            if (og + 1u == (tg + 1u) * nx) xb_add(&bar[XB_TOPGEN], 1u);
            else XB_SPIN(xb_ld(&bar[XB_TOPGEN]) == tg, bar);
            __builtin_amdgcn_fence(__ATOMIC_ACQUIRE, "agent");
            xb_add(&bar[XB_XGEN(b.x)], 1u);
            asm volatile("s_waitcnt vmcnt(0)" ::: "memory");
        } else {
            XB_SPIN(xb_ld(&bar[XB_XGEN(b.x)]) == gen, bar);
            __builtin_amdgcn_fence(__ATOMIC_ACQUIRE, "agent");
            asm volatile("s_waitcnt vmcnt(0)" ::: "memory");
        }
    }
    __syncthreads();
}
__device__ __forceinline__ void xcd_barrier(const XcdBarrier& b) { xcd_barrier_impl(b.bar, b.x, b.st); }
constexpr int NWAVES = 8;
constexpr int RING_BYTES = 131072, LDSCTL_OFF = RING_BYTES, MISC_OFF = LDSCTL_OFF + 320, LDS_BYTES = 147456;
constexpr size_t CTL_ZERO_BYTES = 1u << 20;
constexpr int CW_BAR = 4096;
constexpr int PH_PER_LAYER = 12, N_PHASES = 1 + 4 * PH_PER_LAYER;

DEVI void tr_item(const float* W, int K, int N, bf16* WT, int abmap, int item, float* scr, int lane) {
    const int nblk = (N + 63) >> 6, kb = item / nblk, nb = item - kb * nblk, k0 = 64 * kb, n0 = 64 * nb;
    const int g4 = lane & 15, kr = lane >> 4; const bool ok = n0 + 4 * g4 < N;
    const float* src = W + (size_t)(k0 + kr) * N + n0 + 4 * g4;
    f32x4 v[16];
#pragma unroll
    for (int i = 0; i < 16; ++i) v[i] = ok ? *(const f32x4*)(src + (size_t)(4 * i) * N) : (f32x4){0.f, 0.f, 0.f, 0.f};
#pragma unroll
    for (int i = 0; i < 16; ++i) { const int k = 4 * i + kr; *(f32x4*)(scr + k * 64 + ((g4 ^ (k >> 3)) << 2)) = v[i]; }
    asm volatile("s_waitcnt lgkmcnt(0)" ::: "memory");
    const int c = lane & 7;
#pragma unroll
    for (int jj = 0; jj < 8; ++jj) { const int n = (lane >> 3) + 8 * jj; const float* s = scr + (8 * c) * 64 + ((((n >> 2) ^ c) << 2) | (n & 3));
        if (n0 + n < N) { const int row = abmap ? ab_dst_col(n0 + n) : n0 + n;
            u32x4 o; o.x = cvtpk(s[0], s[64]); o.y = cvtpk(s[2 * 64], s[3 * 64]); o.z = cvtpk(s[4 * 64], s[5 * 64]); o.w = cvtpk(s[6 * 64], s[7 * 64]);
            *(u32x4*)(WT + (size_t)row * K + k0 + 8 * c) = o; } }
    asm volatile("s_waitcnt lgkmcnt(0)" ::: "memory");
}
DEVI void tr_job(const float* W, int K, int N, bf16* WT, int abmap, int vb, int nvb, float* t) {
    const int tid = ltid(), lane = tid & 63, wv = tid >> 6; float* scr = t + wv * 4096;
    const int items = (K >> 6) * ((N + 63) >> 6);
    for (int it = wv * nvb + vb; it < items; it += 8 * nvb) tr_item(W, K, N, WT, abmap, it, scr, lane);
}
DEVI void ph_prologue(CP p, int vb, int nvb, float* t) {
    bf16 *WINAB = wsb(p, WS_WINAB), *WOUTAB = wsb(p, WS_WOUTAB), *WINCD = wsb(p, WS_WINCD), *WOUTCD = wsb(p, WS_WOUTCD), *WFF1 = wsb(p, WS_WFF1), *WFF2 = wsb(p, WS_WFF2), *POOLW = wsb(p, WS_POOLW);
    for (int j = 0; j < 2; ++j) {
        tr_job(p->w_in_ab + (size_t)j * DM * 4696, DM, 4696, WINAB + (size_t)j * HC_AB * DM, 1, vb, nvb, t);
        tr_job(p->w_out_ab + (size_t)j * DM * DM, DM, DM, WOUTAB + (size_t)j * DM * DM, 0, vb, nvb, t);
        tr_job(p->w_in_cd + (size_t)j * DM * HC_CD, DM, HC_CD, WINCD + (size_t)j * HC_CD * DM, 0, vb, nvb, t);
        tr_job(p->w_out_cd + (size_t)j * DM * DM, DM, DM, WOUTCD + (size_t)j * DM * DM, 0, vb, nvb, t);
        tr_job(p->pool_w + (size_t)j * 4 * 65536, 256, 256, POOLW + (size_t)j * 4 * 65536, 0, vb, nvb, t);
        tr_job(p->pool_w + ((size_t)j * 4 + 1) * 65536, 256, 256, POOLW + ((size_t)j * 4 + 1) * 65536, 0, vb, nvb, t);
        tr_job(p->pool_w + ((size_t)j * 4 + 2) * 65536, 256, 256, POOLW + ((size_t)j * 4 + 2) * 65536, 0, vb, nvb, t);
        tr_job(p->pool_w + ((size_t)j * 4 + 3) * 65536, 256, 256, POOLW + ((size_t)j * 4 + 3) * 65536, 0, vb, nvb, t);
    }
    for (int i = 0; i < 4; ++i) {
        tr_job(p->w_ff1 + (size_t)i * DM * DFF, DM, DFF, WFF1 + (size_t)i * DFF * DM, 0, vb, nvb, t);
        tr_job(p->w_ff2 + (size_t)i * DFF * DM, DFF, DM, WFF2 + (size_t)i * DM * DFF, 0, vb, nvb, t);
    }
    const size_t gt = (size_t)vb * 512 + ltid(), ng = (size_t)nvb * 512;
    for (size_t i = gt; i < (size_t)2 * (HC_AB - 4696) * DM / 8; i += ng) { const size_t per = (size_t)(HC_AB - 4696) * DM / 8; const size_t j = i / per, r = i % per;
        *(u32x4*)(WINAB + j * HC_AB * DM + (size_t)4696 * DM + r * 8) = (u32x4){0u, 0u, 0u, 0u}; }
    bf16* sw = wsb(p, WS_SGUW);
    for (size_t i = gt; i < 2 * 4 * 128 * 128; i += ng) { const int s = (int)i & 127, tt = ((int)i >> 7) & 127; sw[i] = f2bf(s <= tt ? p->sgu_w[i] : 0.f); }
    float* X = wsf(p, WS_X); bf16* XB = wsb(p, WS_XB);
    for (size_t i = gt; i < (size_t)MP * DM / 4; i += ng) {
        const size_t e = i * 4; const int row = (int)(e / DM);
        f32x4 v = (f32x4){0.f, 0.f, 0.f, 0.f};
        if (row < MPR) v = *(const f32x4*)(p->x_prompt + e); else if (row < MR) v = *(const f32x4*)(p->x_sample + (e - (size_t)MPR * DM));
        *(f32x4*)(X + e) = v; uint2 o; o.x = pk2(v.x, v.y); o.y = pk2(v.z, v.w); *(uint2*)(XB + e) = o;
    }
}

enum { SE_F32 = 0, SE_RESID = 1, SE_RELU2 = 2, SE_SCALE = 3 };
template <int SE> DEVI void skinny_gemm(const bf16* A  , int lda, int acol, const bf16* Bt, int ldb, int N, int K, float* red, int vb, int nvb, float* Cf, bf16* Cb, int ldc, const float* scale) {
    const int tid = ltid(), lane = tid & 63, wv = tid >> 6, fr = lane & 15, fq = lane >> 4;
    const int kw = K >> 3, ks0 = wv * kw;
    for (int u = vb; u < (N >> 4); u += nvb) {
        const int n0 = u * 16, pn = n0 >> 8;
        const bf16* bp = Bt + (size_t)(n0 + fr) * ldb + ks0 + fq * 8; const bf16* ap = A + (size_t)fr * lda + (size_t)pn * acol + ks0 + fq * 8;
        f32x4 acc[4];
#pragma unroll
        for (int mt = 0; mt < 4; ++mt) acc[mt] = (f32x4){0.f, 0.f, 0.f, 0.f};
#pragma unroll 4
        for (int k = 0; k < kw; k += 32) { const bf16x8 bf = *(const bf16x8*)(bp + k);
#pragma unroll
            for (int mt = 0; mt < 4; ++mt) acc[mt] = mfma16(bf, *(const bf16x8*)(ap + (size_t)mt * 16 * lda + k), acc[mt]); }
#pragma unroll
        for (int mt = 0; mt < 4; ++mt) *(f32x4*)(red + (wv * 64 + mt * 16 + fr) * 16 + 4 * fq) = acc[mt];
        __syncthreads();
        { const int r = tid >> 3, c = (tid & 7) * 2; float v0 = 0.f, v1 = 0.f;
#pragma unroll
          for (int w = 0; w < 8; ++w) { const float* q = red + (w * 64 + r) * 16 + c; v0 += q[0]; v1 += q[1]; }
          const size_t o = (size_t)r * ldc + n0 + c;
          if (SE == SE_F32) { Cf[o] = v0; Cf[o + 1] = v1; }
          if (SE == SE_RESID) { Cf[o] = ALPHA * Cf[o] + v0; Cf[o + 1] = ALPHA * Cf[o + 1] + v1; }
          if (SE == SE_RELU2) { const float a = fmaxf(v0, 0.f), b = fmaxf(v1, 0.f); *(unsigned*)(Cb + o) = cvtpk(a * a, b * b); }
          if (SE == SE_SCALE) *(unsigned*)(Cb + o) = cvtpk(v0 * scale[n0 + c], v1 * scale[n0 + c + 1]); }
        __syncthreads();
    }
}
template <class Epi> DEVI void run_gemm(PG8_LAS unsigned char* lds, const bf16* A, int lda, int acol, const bf16* Bt, int ldb, int M, int N, int K, const Epi& E) {
    asm volatile("" : "+s"(K));
    pg8::Gemm g{A, Bt, M, N, K, lda, ldb, acol}; pg8::StaticOrder S; S.init(M, N, (int)gridDim.x, lvb());
    pg8::gemm_phase<Epi, pg8::StaticOrder, true, true>(lds, g, S, E);
}

#define IN(k) (lo <= (k) && (k) < hi)
#define SEAM(k) do { if (IN(k) && (k) + 1 < hi) xcd_barrier(bar); } while (0)
template <int I> DEVI void layer_phases(LAS unsigned char* L, unsigned char* lds, const XcdBarrier& bar, int lo, int hi, int nvb) {
    constexpr int base = 1 + PH_PER_LAYER * I, j = I >> 1;
    float* smf = (float*)lds; int* smi = (int*)lds;
    if constexpr ((I & 1) == 0) {
        if (IN(base + 0)) { CP p = PP(); run_gemm(L, wsb(p, WS_XB), DM, 0, wsb(p, WS_WINAB) + (size_t)j * HC_AB * DM, DM, MPR, HC_AB, DM, pg8::EpiF32{wsf(p, WS_H), HC_AB});
            skinny_gemm<SE_F32>(wsb(p, WS_XB) + (size_t)MPR * DM, DM, 0, wsb(p, WS_WINAB) + (size_t)j * HC_AB * DM, DM, HC_AB, DM, smf, lvb(), nvb, wsf(p, WS_H) + (size_t)MPR * HC_AB, nullptr, HC_AB, nullptr); }
        SEAM(base + 0);
        if (IN(base + 1)) {
            ph_ab_copy(PP(), j, lvb(), nvb);
            for (int u = lvb(); u < 64 * 24; u += nvb) conv_prompt_unit(PP(), j, u / 24, u % 24, (bf16*)lds);
            ph_conv(PP(), j, lvb(), nvb);
            ph_idx_prompt(PP(), lvb(), nvb);
            for (int u = lvb(); u < 8 * 33; u += nvb) idx_sample_unit(PP(), j, u / 33, u % 33, smf);
        }
        SEAM(base + 1);
        if (IN(base + 2)) {
            ph_select_prompt(PP(), lvb(), nvb);
            for (int u = lvb(); u < MSR; u += nvb) select_sample_unit(PP(), u, smi);
            for (int u = lvb(); u < 64 * 16; u += nvb) ssd1_unit(PP(), j, u >> 4, u & 15, smf);
#ifdef EXP_OLDY
            { const int t_ = ltid(), u = (t_ >> 6) * nvb + lvb(); if (u < (NBP + DB) * 32) ssd_seq_unit(PP(), j, u / 32, (u >> 1) & 15, u & 1, t_ & 63); }
#else
            { const int t_ = ltid(), u = (t_ >> 6) * nvb + lvb(); if (u < DB * 32) ssd_seq_unit(PP(), j, NBP + u / 32, (u >> 1) & 15, u & 1, t_ & 63); }
#endif
        }
        SEAM(base + 2);
        if (IN(base + 3)) {
            ph_ssd_scan(PP(), j, lvb(), nvb);
            for (int u = lvb(); u < 2 * MSR; u += nvb) attn_sample_unit(PP(), j, u >> 1, u & 1, lds);
            ph_ssd_gate(PP(), j, lvb(), nvb);
        }
        SEAM(base + 3);
        if (IN(base + 4)) {
#ifdef EXP_ATT
            ph_attn_prompt_naive(PP(), lvb(), nvb);
            for (int u = lvb(); u < 256; u += nvb) attn_unit(PP(), (u >> 3) & 1, u & 7, u >> 4, lds, wsb(PP(), WS_HF));
#else
            for (int u = lvb(); u < 256; u += nvb) attn_unit(PP(), (u >> 3) & 1, u & 7, u >> 4, lds, wsb(PP(), WS_AO));
#endif
#ifdef DUP_ATT
            for (int u = lvb(); u < 256; u += nvb) attn_unit(PP(), (u >> 3) & 1, u & 7, u >> 4, lds, wsb(PP(), WS_AO));
#endif
#ifdef EXP_OLDY
            for (int u = lvb(); u < 64 * 8; u += nvb) ssd3_unit(PP(), j, u >> 3, u & 7, smf, wsb(PP(), WS_HF));
#else
            if (nvb == 256) {
                const int vb_ = lvb(), qb_ = vb_ >> 4, n_ = (0x0001112222333444ull >> (4 * qb_)) & 15, off_ = (qb_ < 3 ? 4 * qb_ : qb_ < 6 ? 12 + 3 * (qb_ - 3) : qb_ < 10 ? 21 + 2 * (qb_ - 6) : qb_ < 13 ? 29 + (qb_ - 10) : 32);
                for (int i = 0; i < n_; ++i) { const int u = off_ * 16 + (vb_ & 15) * n_ + i; ssd3_unit(PP(), j, u >> 3, u & 7, smf, wsb(PP(), WS_AO)); }
            } else for (int u = lvb(); u < 64 * 8; u += nvb) ssd3_unit(PP(), j, u >> 3, u & 7, smf, wsb(PP(), WS_AO));
#endif
        }
        SEAM(base + 4);
#ifdef EXP_ATT
        if (IN(base + 5) && I == 0) { CP p = PP(); diag_cmp(p, 0, wsb(p, WS_AO), DM, wsb(p, WS_HF), DM, MPR, 1024, lvb(), nvb); }
#endif
#ifdef EXP_OLDY
        if (IN(base + 5) && I == 0) { CP p = PP(); const int vb_ = lvb();
            diag_cmp_f32(p, 0, wsf(p, WS_XC), 1536, wsb(p, WS_XCN), 1536, MPR, 1536, vb_, nvb);
            diag_fin_f32(p, 1, wsf(p, WS_ACUM), (size_t)64 * 16 * 128, vb_, nvb);
            diag_fin_f32(p, 2, wsf(p, WS_DTC), (size_t)64 * 16 * 128, vb_, nvb);
            diag_fin_bf16(p, 3, wsb(p, WS_HIN), (size_t)64 * 16 * 8192, vb_, nvb);
            diag_fin_bf16(p, 4, wsb(p, WS_XCT), (size_t)64 * 1536 * 128, vb_, nvb);
            diag_cmp(p, 5, wsb(p, WS_AO) + 1024, DM, wsb(p, WS_HF) + 1024, DM, MPR, 1024, vb_, nvb); }
#endif
        if (IN(base + 5)) { CP p = PP(); run_gemm(L, wsb(p, WS_AO), DM, 0, wsb(p, WS_WOUTAB) + (size_t)j * DM * DM, DM, MPR, DM, DM, pg8::EpiResid{wsf(p, WS_X), DM, ALPHA});
            skinny_gemm<SE_RESID>(wsb(p, WS_AO) + (size_t)MPR * DM, DM, 0, wsb(p, WS_WOUTAB) + (size_t)j * DM * DM, DM, DM, DM, smf, lvb(), nvb, wsf(p, WS_X) + (size_t)MPR * DM, nullptr, DM, nullptr); }
        SEAM(base + 5);
    } else {
        if (IN(base + 0)) { CP p = PP(); run_gemm(L, wsb(p, WS_XB), DM, 0, wsb(p, WS_WINCD) + (size_t)j * HC_CD * DM, DM, MPR, HC_CD, DM, pg8::EpiF32{wsf(p, WS_H), HC_CD});
            skinny_gemm<SE_F32>(wsb(p, WS_XB) + (size_t)MPR * DM, DM, 0, wsb(p, WS_WINCD) + (size_t)j * HC_CD * DM, DM, HC_CD, DM, smf, lvb(), nvb, wsf(p, WS_H) + (size_t)MPR * HC_CD, nullptr, HC_CD, nullptr); }
        SEAM(base + 0);
        if (IN(base + 1)) ph_cd_prep(PP(), j, lvb(), nvb);
        SEAM(base + 1);
        if (IN(base + 2)) {
            { CP p = PP(); run_gemm(L, wsb(p, WS_DD), 1024, 256, wsb(p, WS_POOLW) + (size_t)j * 4 * 65536, 256, MPR, 1024, 256, pg8::EpiBf16<0>{wsb(p, WS_AO), DM, p->pool_scale + (size_t)j * 1024});
              skinny_gemm<SE_SCALE>(wsb(p, WS_DD) + (size_t)MPR * 1024, 1024, 256, wsb(p, WS_POOLW) + (size_t)j * 4 * 65536, 256, 1024, 256, smf, lvb(), nvb, nullptr, wsb(p, WS_AO) + (size_t)MPR * DM, DM, p->pool_scale + (size_t)j * 1024); }
            for (int u = lvb(); u < 64 * 16; u += nvb) sgu_unit(PP(), j, u >> 4, (u >> 2) & 3, u & 3, (bf16*)lds);
            ph_sgu_naive(PP(), j, lvb(), nvb);
        }
        if (IN(base + 2) && base + 5 < hi) xcd_barrier(bar);
        if (IN(base + 5)) { CP p = PP(); run_gemm(L, wsb(p, WS_AO), DM, 0, wsb(p, WS_WOUTCD) + (size_t)j * DM * DM, DM, MPR, DM, DM, pg8::EpiResid{wsf(p, WS_X), DM, ALPHA});
            skinny_gemm<SE_RESID>(wsb(p, WS_AO) + (size_t)MPR * DM, DM, 0, wsb(p, WS_WOUTCD) + (size_t)j * DM * DM, DM, DM, DM, smf, lvb(), nvb, wsf(p, WS_X) + (size_t)MPR * DM, nullptr, DM, nullptr); }
        SEAM(base + 5);
    }
#ifdef EXP_OLDY
    if (IN(base + 6) && I == 0) diag_report(PP(), 6);
#endif
#ifdef EXP_ATT
    if (IN(base + 6) && I == 0) diag_report(PP(), 1);
#endif
    if (IN(base + 6)) { CP p = PP(); ph_ln(p, p->ln1_g + (size_t)I * DM, p->ln1_b + (size_t)I * DM, 0, lvb(), nvb); }
    SEAM(base + 6);
    if (IN(base + 7)) { CP p = PP(); run_gemm(L, wsb(p, WS_XB), DM, 0, wsb(p, WS_WFF1) + (size_t)I * DFF * DM, DM, MPR, DFF, DM, pg8::EpiBf16<1>{wsb(p, WS_HF), DFF, nullptr});
        skinny_gemm<SE_RELU2>(wsb(p, WS_XB) + (size_t)MPR * DM, DM, 0, wsb(p, WS_WFF1) + (size_t)I * DFF * DM, DM, DFF, DM, smf, lvb(), nvb, nullptr, wsb(p, WS_HF) + (size_t)MPR * DFF, DFF, nullptr); }
    SEAM(base + 7);
    if (IN(base + 8)) { CP p = PP(); run_gemm(L, wsb(p, WS_HF), DFF, 0, wsb(p, WS_WFF2) + (size_t)I * DM * DFF, DFF, MPR, DM, DFF, pg8::EpiResid{wsf(p, WS_X), DM, ALPHA});
        skinny_gemm<SE_RESID>(wsb(p, WS_HF) + (size_t)MPR * DFF, DFF, 0, wsb(p, WS_WFF2) + (size_t)I * DM * DFF, DFF, DM, DFF, smf, lvb(), nvb, wsf(p, WS_X) + (size_t)MPR * DM, nullptr, DM, nullptr); }
    SEAM(base + 8);
    if (IN(base + 9)) { CP p = PP(); ph_ln(p, p->ln2_g + (size_t)I * DM, p->ln2_b + (size_t)I * DM, I == 3, lvb(), nvb); }
    if (I < 3) { if (IN(base + 9) && base + PH_PER_LAYER < hi) xcd_barrier(bar); }
}

__global__ void __launch_bounds__(NWAVES * 64, 2) mk_fwd(P p_kernarg) {
    extern __shared__ __attribute__((aligned(16))) unsigned char lds[];
    LAS unsigned char* L = (LAS unsigned char*)lds;
    volatile LAS unsigned* MISC = (volatile LAS unsigned*)(L + MISC_OFF);
    const int nvb = gridDim.x;
    for (int u = threadIdx.x; u < (LDS_BYTES - LDSCTL_OFF) / 4; u += NWAVES * 64) ((LAS unsigned*)(L + LDSCTL_OFF))[u] = 0u;
    __syncthreads();
    unsigned* ctl = (unsigned*)(PP()->ws + WS_CTL);
    XcdBarrier bar = xcd_barrier_post(ctl + CW_BAR, MISC + 8);
    const int lo = PP()->ph_lo, hi = PP()->ph_hi;
    if (IN(0)) ph_prologue(PP(), lvb(), nvb, (float*)lds);
#ifdef DUP_PRO
    if (IN(0)) ph_prologue(PP(), lvb(), nvb, (float*)lds);
#endif
    SEAM(0);
    layer_phases<0>(L, lds, bar, lo, hi, nvb);
    layer_phases<1>(L, lds, bar, lo, hi, nvb);
    layer_phases<2>(L, lds, bar, lo, hi, nvb);
    layer_phases<3>(L, lds, bar, lo, hi, nvb);
}
#undef IN
#undef SEAM

#ifndef MK_PER_PHASE
#define MK_PER_PHASE 0
#endif
extern "C" void kernel_launch(void* const* d_in, const int* in_sizes, int n_in, void* d_out, int out_size, void* d_ws, size_t ws_size, hipStream_t stream) {
    if (n_in != 31 || (size_t)out_size != O_END || ws_size < WS_END) { fprintf(stderr, "kernel_launch: unexpected sizes n_in %d out %d ws %zu (need %zu)\n", n_in, out_size, ws_size, (size_t)WS_END); return; }
    static int grid = 0;
    if (grid == 0) {
        int dev = 0, cus = 0, per_cu = 0;
        if (hipGetDevice(&dev) != hipSuccess || hipDeviceGetAttribute(&cus, hipDeviceAttributeMultiprocessorCount, dev) != hipSuccess) { grid = -1; return; }
        if (hipFuncSetAttribute((const void*)mk_fwd, hipFuncAttributeMaxDynamicSharedMemorySize, LDS_BYTES) != hipSuccess) { fprintf(stderr, "kernel_launch: hipFuncSetAttribute failed\n"); grid = -1; return; }
        if (hipOccupancyMaxActiveBlocksPerMultiprocessor(&per_cu, (const void*)mk_fwd, NWAVES * 64, LDS_BYTES) != hipSuccess || per_cu < 1) fprintf(stderr, "kernel_launch: occupancy query says %d\n", per_cu);
        (void)hipGetLastError();
        grid = cus;
    }
    if (grid < 0) return;
    (void)hipMemsetAsync((char*)d_ws + WS_CTL, 0, CTL_ZERO_BYTES, stream);
    P p{};
    p.x_prompt = (const float*)d_in[0]; p.x_sample = (const float*)d_in[1]; p.cache_k = (const float*)d_in[2]; p.cache_v = (const float*)d_in[3]; p.cache_ik = (const float*)d_in[4];
    p.state_ssm = (const float*)d_in[5]; p.state_conv = (const float*)d_in[6]; p.state_pool = (const float*)d_in[7]; p.page_table = (const int*)d_in[8];
    p.ln1_g = (const float*)d_in[9]; p.ln1_b = (const float*)d_in[10]; p.ln2_g = (const float*)d_in[11]; p.ln2_b = (const float*)d_in[12];
    p.w_in_ab = (const float*)d_in[13]; p.conv_w = (const float*)d_in[14]; p.conv_b = (const float*)d_in[15]; p.dt_bias = (const float*)d_in[16]; p.a_log = (const float*)d_in[17];
    p.d_skip = (const float*)d_in[18]; p.ssd_g = (const float*)d_in[19]; p.w_out_ab = (const float*)d_in[20]; p.w_in_cd = (const float*)d_in[21]; p.pool_w = (const float*)d_in[22];
    p.pool_scale = (const float*)d_in[23]; p.sgu_ln_g = (const float*)d_in[24]; p.sgu_ln_b = (const float*)d_in[25]; p.sgu_w = (const float*)d_in[26]; p.sgu_b = (const float*)d_in[27];
    p.w_out_cd = (const float*)d_in[28]; p.w_ff1 = (const float*)d_in[29]; p.w_ff2 = (const float*)d_in[30];
    p.out = (float*)d_out; p.ws = (unsigned char*)d_ws;
#if MK_PER_PHASE
    for (int k = 0; k < N_PHASES; ++k) { const int r = (k - 1) % PH_PER_LAYER; if (k > 0 && (r > 9 || (((k - 1) / PH_PER_LAYER) & 1) && (r == 3 || r == 4))) continue; p.ph_lo = k; p.ph_hi = k + 1; hipLaunchKernelGGL(mk_fwd, dim3(grid), dim3(NWAVES * 64), LDS_BYTES, stream, p); }
#else
    p.ph_lo = 0; p.ph_hi = N_PHASES;
    hipLaunchKernelGGL(mk_fwd, dim3(grid), dim3(NWAVES * 64), LDS_BYTES, stream, p);
#endif
}
```

```cpp
#include <hip/hip_runtime.h>
#include <stdint.h>
#include <stdio.h>

typedef unsigned short bf16;
typedef float f32x4 __attribute__((ext_vector_type(4)));
typedef unsigned u32x4 __attribute__((ext_vector_type(4)));
#define DEVI __device__ __forceinline__
typedef short bf16x8 __attribute__((ext_vector_type(8)));
typedef unsigned u32x2 __attribute__((ext_vector_type(2)));
DEVI f32x4 mfma16(bf16x8 bt, bf16x8 a, f32x4 c) { return __builtin_amdgcn_mfma_f32_16x16x32_bf16(bt, a, c, 0, 0, 0); }
typedef float f32x2_t __attribute__((ext_vector_type(2))); typedef __bf16 bf16x2_t __attribute__((ext_vector_type(2)));
DEVI unsigned cvtpk(float lo, float hi) { f32x2_t v = {lo, hi}; bf16x2_t b = __builtin_convertvector(v, bf16x2_t); return __builtin_bit_cast(unsigned, b); }
DEVI float bflo(unsigned w) { return __uint_as_float(w << 16); }
DEVI float bfhi(unsigned w) { return __uint_as_float(w & 0xffff0000u); }

constexpr int DM = 2048, SEQ = 4096, NBP = 2, MPR = NBP * SEQ;
constexpr int DB = 8, DS = 8, MSR = DB * DS;
constexpr int MR = MPR + MSR;
constexpr int MP = 8448;
constexpr int PAST = 16384, PAGE = 128, NPAGES = PAST / PAGE, NPOOL = 1280;
constexpr int NKEY_S = PAST + DS;
constexpr int SCS_LD = 16400;
constexpr int HC_AB = 4864, HC_CD = 3072, DFF = 8192;
constexpr int TOPK = 256;
constexpr int C_Q = 0, C_K = 1024, C_V = 1280, C_QI = 1536, C_Z = 2048, C_XBC = 3072, C_KI = 4608, C_WI = 4672, C_DT = 4680;
constexpr float ALPHA = 1.681792830507429f;
constexpr float EPS = 1e-5f;
constexpr float IDX_SCALE = 0.04419417382415922f;
constexpr float ATT_SCALE = 0.08838834764831845f;

constexpr size_t O_YP = 0;
constexpr size_t O_YS = O_YP + (size_t)MPR * DM;
constexpr size_t O_KP = O_YS + (size_t)MSR * DM;
constexpr size_t O_VP = O_KP + (size_t)2 * MPR * 256;
constexpr size_t O_IP = O_VP + (size_t)2 * MPR * 256;
constexpr size_t O_HP = O_IP + (size_t)2 * MPR * 64;
constexpr size_t O_CP = O_HP + (size_t)2 * NBP * 16 * 64 * 128;
constexpr size_t O_PP = O_CP + (size_t)2 * NBP * 3 * 1536;
constexpr size_t O_KS = O_PP + (size_t)2 * NBP * 15 * 1024;
constexpr size_t O_VS = O_KS + (size_t)2 * MSR * 256;
constexpr size_t O_IS = O_VS + (size_t)2 * MSR * 256;
constexpr size_t O_HS = O_IS + (size_t)2 * MSR * 64;
constexpr size_t O_CS = O_HS + (size_t)2 * DB * 16 * 64 * 128;
constexpr size_t O_PS = O_CS + (size_t)2 * DB * 3 * 1536;
constexpr size_t O_GS = O_PS + (size_t)2 * DB * 15 * 1024;
constexpr size_t O_END = O_GS + (size_t)2 * MSR * 1024;
static_assert(O_END == 29571072, "output size");

constexpr size_t al256(size_t x) { return (x + 255) & ~(size_t)255; }
constexpr size_t WS_CTL = 0;
constexpr size_t WS_X = 1u << 20;
constexpr size_t WS_XB = WS_X + al256((size_t)MP * DM * 4);
constexpr size_t WS_H = WS_XB + al256((size_t)MP * DM * 2);
constexpr size_t WS_AO = WS_H + al256((size_t)MP * HC_AB * 4);
constexpr size_t WS_HF = WS_AO + al256((size_t)MP * DM * 2);
constexpr size_t WS_SC = WS_HF + al256((size_t)MP * DFF * 2);
constexpr size_t WS_MASK = WS_SC + al256((size_t)MPR * SEQ * 4);
constexpr size_t WS_XC = WS_MASK + al256((size_t)MPR * 64 * 8);
constexpr size_t WS_DT = WS_XC + al256((size_t)MP * 1536 * 4);
constexpr size_t WS_Y = WS_DT + al256((size_t)MP * 16 * 4);
constexpr size_t WS_SCS = WS_Y + al256((size_t)MP * 1024 * 4);
constexpr size_t WS_SELS = WS_SCS + al256((size_t)MSR * SCS_LD * 4);
constexpr size_t WS_DD = WS_SELS + al256((size_t)MSR * TOPK * 4);
constexpr size_t WS_U = WS_DD + al256((size_t)MP * 1024 * 2);
constexpr size_t WS_VLN = WS_U + al256((size_t)MP * 1024 * 2);
constexpr size_t WS_WINAB = WS_VLN + al256((size_t)MP * 1024 * 2);
constexpr size_t WS_WOUTAB = WS_WINAB + (size_t)2 * HC_AB * DM * 2;
constexpr size_t WS_WINCD = WS_WOUTAB + (size_t)2 * DM * DM * 2;
constexpr size_t WS_WOUTCD = WS_WINCD + (size_t)2 * HC_CD * DM * 2;
constexpr size_t WS_WFF1 = WS_WOUTCD + (size_t)2 * DM * DM * 2;
constexpr size_t WS_WFF2 = WS_WFF1 + (size_t)4 * DFF * DM * 2;
constexpr size_t WS_POOLW = WS_WFF2 + (size_t)4 * DFF * DM * 2;
constexpr size_t WS_SGUW = WS_POOLW + (size_t)2 * 4 * 256 * 256 * 2;
constexpr size_t WS_XCN = WS_SGUW + (size_t)2 * 4 * 128 * 128 * 2;
constexpr size_t WS_XCT = WS_XCN + al256((size_t)MP * 1536 * 2);
constexpr size_t WS_ACUM = WS_XCT + al256((size_t)64 * 1536 * 128 * 2);
constexpr size_t WS_DTC = WS_ACUM + al256((size_t)64 * 16 * 128 * 4);
constexpr size_t WS_CDEC = WS_DTC + al256((size_t)64 * 16 * 128 * 4);
constexpr size_t WS_ST = WS_CDEC + al256((size_t)64 * 16 * 4);
constexpr size_t WS_HIN = WS_ST + al256((size_t)64 * 16 * 64 * 128 * 4);
constexpr size_t WS_QB = WS_HIN + al256((size_t)64 * 16 * 64 * 128 * 2);
constexpr size_t WS_KB = WS_QB + al256((size_t)MPR * 1024 * 2);
constexpr size_t WS_VB = WS_KB + al256((size_t)MPR * 256 * 2);
constexpr size_t WS_QIB = WS_VB + al256((size_t)MPR * 256 * 2);
constexpr size_t WS_KIB = WS_QIB + al256((size_t)MPR * 512 * 2);
constexpr size_t WS_END = WS_KIB + al256((size_t)MPR * 64 * 2);

struct P {
    const float *x_prompt, *x_sample, *cache_k, *cache_v, *cache_ik, *state_ssm, *state_conv, *state_pool;
    const int* page_table;
    const float *ln1_g, *ln1_b, *ln2_g, *ln2_b, *w_in_ab, *conv_w, *conv_b, *dt_bias, *a_log, *d_skip, *ssd_g, *w_out_ab;
    const float *w_in_cd, *pool_w, *pool_scale, *sgu_ln_g, *sgu_ln_b, *sgu_w, *sgu_b, *w_out_cd, *w_ff1, *w_ff2;
    float* out;
    unsigned char* ws;
    int ph_lo, ph_hi, a2, a3;
};
typedef const __attribute__((address_space(4))) P* CP;
DEVI CP PP() { CP q = (CP)__builtin_amdgcn_kernarg_segment_ptr(); asm volatile("" : "+s"(q)); return q; }
DEVI float* wsf(CP p, size_t off) { return (float*)(p->ws + off); }
DEVI bf16* wsb(CP p, size_t off) { return (bf16*)(p->ws + off); }

DEVI float bf2f(bf16 b) { return __uint_as_float(((unsigned)b) << 16); }
DEVI bf16 f2bf(float f) { unsigned u = __float_as_uint(f); u += 0x7fffu + ((u >> 16) & 1u); return (bf16)(u >> 16); }
DEVI unsigned pk2(float lo, float hi) { return (unsigned)f2bf(lo) | ((unsigned)f2bf(hi) << 16); }
DEVI float wave_sum(float v) {
#pragma unroll
    for (int o = 1; o < 64; o <<= 1) v += __shfl_xor(v, o);
    return v;
}
DEVI int ltid() { int t = threadIdx.x; asm volatile("" : "+v"(t)); return t; }
DEVI int lvb() { int b = blockIdx.x; asm volatile("" : "+s"(b)); return b; }
DEVI float silu_f(float x) { return x / (1.f + __expf(-x)); }
DEVI float softplus_f(float x) { return fmaxf(x, 0.f) + log1pf(__expf(-fabsf(x))); }
DEVI float gelu_f(float x) { return 0.5f * x * (1.f + erff(x * 0.70710678118654752f)); }
DEVI unsigned ord_f(float f) { f = f + 0.0f; unsigned u = __float_as_uint(f); return (u & 0x80000000u) ? ~u : (u | 0x80000000u); }
__host__ __device__ inline int ab_dst_col(int n) {
    if (n < 2048) return n;
    if (n < 2112) return C_KI + (n - 2048);
    if (n < 2120) return C_WI + (n - 2112);
    if (n < 3144) return C_Z + (n - 2120);
    if (n < 4680) return C_XBC + (n - 3144);
    return n;
}

DEVI void transpose_unit(const float* W, int K, int N, bf16* WT, int abmap, int unit, float* t  ) {
    const int TIDX = ltid();
    const int nbn = (N + 63) / 64, kb = unit / nbn, nb = unit % nbn, k0 = kb * 64, n0 = nb * 64, tid = TIDX;
#pragma unroll
    for (int i = 0; i < 8; ++i) { const int kk = (tid >> 6) + 8 * i, n = n0 + (tid & 63); t[kk * 65 + (tid & 63)] = (n < N) ? W[(size_t)(k0 + kk) * N + n] : 0.f; }
    __syncthreads();
    { const int n = n0 + (tid >> 3), kq = (tid & 7) * 8;
      if (n < N) { const int row = abmap ? ab_dst_col(n) : n; const float* s = t + kq * 65 + (tid >> 3);
          u32x4 o; o.x = pk2(s[0], s[65]); o.y = pk2(s[2 * 65], s[3 * 65]); o.z = pk2(s[4 * 65], s[5 * 65]); o.w = pk2(s[6 * 65], s[7 * 65]);
          *(u32x4*)(WT + (size_t)row * K + k0 + kq) = o; } }
    __syncthreads();
}


DEVI void ph_ln(CP p, const float* g, const float* b, int final_out, int vb, int nvb) {
    const int TIDX = ltid();
    float* X = wsf(p, WS_X); bf16* XB = wsb(p, WS_XB);
    const int lane = TIDX & 63, wv = TIDX >> 6;
    for (int row = vb * 8 + wv; row < MR; row += nvb * 8) {
        float* xr = X + (size_t)row * DM; f32x4 v[8]; float s = 0.f;
#pragma unroll
        for (int i = 0; i < 8; ++i) { v[i] = *(const f32x4*)(xr + (i * 64 + lane) * 4); s += (v[i].x + v[i].y) + (v[i].z + v[i].w); }
        const float mean = wave_sum(s) * (1.f / DM); float q = 0.f;
#pragma unroll
        for (int i = 0; i < 8; ++i) { v[i] = v[i] - mean; q += (v[i].x * v[i].x + v[i].y * v[i].y) + (v[i].z * v[i].z + v[i].w * v[i].w); }
        const float rstd = 1.f / sqrtf(wave_sum(q) * (1.f / DM) + EPS);
        float* o = final_out ? (row < MPR ? p->out + O_YP + (size_t)row * DM : p->out + O_YS + (size_t)(row - MPR) * DM) : nullptr;
#pragma unroll
        for (int i = 0; i < 8; ++i) { const int c = (i * 64 + lane) * 4; const f32x4 gg = *(const f32x4*)(g + c), bb = *(const f32x4*)(b + c);
            const f32x4 y = v[i] * rstd * gg + bb; *(f32x4*)(xr + c) = y; uint2 w; w.x = pk2(y.x, y.y); w.y = pk2(y.z, y.w); *(uint2*)(XB + (size_t)row * DM + c) = w;
            if (final_out) *(f32x4*)(o + c) = y; }
    }
}

DEVI void ph_ab_copy(CP p, int j, int vb, int nvb) {
    const int TIDX = ltid();
    const float* H = wsf(p, WS_H); const int tid = TIDX;
    for (int row = MPR + vb; row < MR; row += nvb) {
        const float* h = H + (size_t)row * HC_AB; const int sr = row - MPR;
        float* ko = p->out + O_KS + ((size_t)j * MSR + sr) * 256; float* vo = p->out + O_VS + ((size_t)j * MSR + sr) * 256; float* io = p->out + O_IS + ((size_t)j * MSR + sr) * 64;
        if (tid < 256) ko[tid] = h[C_K + tid]; else vo[tid - 256] = h[C_V + tid - 256];
        if (tid < 64) io[tid] = h[C_KI + tid];
        const int b = sr / DS, t = sr % DS;
        if (t >= DS - 3) { float* co = p->out + O_CS + (((size_t)j * DB + b) * 3 + (t - (DS - 3))) * 1536; for (int c = tid; c < 1536; c += 512) co[c] = h[C_XBC + c]; }
    }
    for (int u = vb; u < NBP * 3; u += nvb) { const int b = u / 3, ci = u % 3; const float* h = H + (size_t)(b * SEQ + SEQ - 3 + ci) * HC_AB; float* co = p->out + O_CP + (((size_t)j * NBP + b) * 3 + ci) * 1536;
        for (int c = tid; c < 1536; c += 512) co[c] = h[C_XBC + c]; }
}

DEVI void ph_conv(CP p, int j, int vb, int nvb) {
    const int TIDX = ltid();
    const float* H = wsf(p, WS_H); float* XC = wsf(p, WS_XC); float* DT = wsf(p, WS_DT);
    const float* cw = p->conv_w + (size_t)j * 4 * 1536; const float* cb = p->conv_b + (size_t)j * 1536;
#ifdef EXP_OLDY
    for (int row = vb; row < MR; row += nvb) {
#else
    for (int row = MPR + vb; row < MR; row += nvb) {
#endif
        const bool pr = row < MPR; const int b = pr ? row / SEQ : (row - MPR) / DS, t = pr ? row % SEQ : (row - MPR) % DS;
        for (int c = TIDX; c < 1536; c += 512) {
            float acc = cb[c];
#pragma unroll
            for (int jj = 0; jj < 4; ++jj) { const int tt = t - 3 + jj; float xv;
                if (tt >= 0) xv = H[(size_t)(row - t + tt) * HC_AB + C_XBC + c];
                else xv = pr ? 0.f : p->state_conv[(((size_t)j * DB + b) * 3 + (3 + tt)) * 1536 + c];
                acc += cw[jj * 1536 + c] * xv; }
            XC[(size_t)row * 1536 + c] = silu_f(acc);
        }
        if (TIDX < 16) DT[row * 16 + TIDX] = softplus_f(H[(size_t)row * HC_AB + C_DT + TIDX] + p->dt_bias[j * 16 + TIDX]);
    }
}

DEVI void ssd_seq_unit(CP p, int j, int sq  , int h, int ph, int lane) {
    const float* XC = wsf(p, WS_XC); const float* DT = wsf(p, WS_DT); float* Y = wsf(p, WS_Y);
    const bool pr = sq < NBP; const int b = pr ? sq : sq - NBP, n = pr ? SEQ : DS, row0 = pr ? b * SEQ : MPR + b * DS, g = h >> 3;
    const int pp = ph * 32 + (lane & 31), nh = lane >> 5;
    const float a = -__expf(p->a_log[j * 16 + h]), Dk = p->d_skip[j * 16 + h];
    float st[64];
    if (pr) {
#pragma unroll
        for (int i = 0; i < 64; ++i) st[i] = 0.f;
    } else { const float* h0 = p->state_ssm + ((((size_t)j * DB + b) * 16 + h) * 64 + pp) * 128 + nh * 64;
#pragma unroll
        for (int i = 0; i < 16; ++i) { const f32x4 v = *(const f32x4*)(h0 + 4 * i); st[4 * i] = v.x; st[4 * i + 1] = v.y; st[4 * i + 2] = v.z; st[4 * i + 3] = v.w; } }
    for (int t = 0; t < n; ++t) {
        const int row = row0 + t; const float dt = DT[row * 16 + h], dA = __expf(dt * a), x = XC[(size_t)row * 1536 + h * 64 + pp], cf = dt * x;
        const float* Bp = XC + (size_t)row * 1536 + 1024 + g * 128 + nh * 64; const float* Cp = Bp + 256;
        float y = 0.f;
#pragma unroll
        for (int i = 0; i < 16; ++i) { if ((i & 7) == 0) asm volatile("" ::: "memory");
            const f32x4 bv = *(const f32x4*)(Bp + 4 * i), cv = *(const f32x4*)(Cp + 4 * i);
            st[4 * i] = st[4 * i] * dA + cf * bv.x; st[4 * i + 1] = st[4 * i + 1] * dA + cf * bv.y; st[4 * i + 2] = st[4 * i + 2] * dA + cf * bv.z; st[4 * i + 3] = st[4 * i + 3] * dA + cf * bv.w;
            y += cv.x * st[4 * i] + cv.y * st[4 * i + 1] + cv.z * st[4 * i + 2] + cv.w * st[4 * i + 3]; }
        y += __shfl_xor(y, 32);
        if (nh == 0) Y[(size_t)row * 1024 + h * 64 + pp] = y + Dk * x;
    }
#ifdef EXP_OLDY
    if (pr) return;
#endif
    float* ho = (pr ? p->out + O_HP + ((((size_t)j * NBP + b) * 16 + h) * 64 + pp) * 128 : p->out + O_HS + ((((size_t)j * DB + b) * 16 + h) * 64 + pp) * 128) + nh * 64;
#pragma unroll
    for (int i = 0; i < 16; ++i) *(f32x4*)(ho + 4 * i) = (f32x4){st[4 * i], st[4 * i + 1], st[4 * i + 2], st[4 * i + 3]};
}

DEVI void conv_prompt_unit(CP p, int j, int ck, int cb, bf16* T  ) {
    const int tid = ltid(), ch = tid & 63, sg = tid >> 6;
    const float* H = wsf(p, WS_H); bf16* XCN = wsb(p, WS_XCN); bf16* XCT = wsb(p, WS_XCT);
    const int row0 = ck * 128, col = cb * 64 + ch, s0 = sg * 16;
    const float* cw = p->conv_w + (size_t)j * 4 * 1536 + col; const float w0 = cw[0], w1 = cw[1536], w2 = cw[2 * 1536], w3 = cw[3 * 1536], bias = p->conv_b[(size_t)j * 1536 + col];
    const float* hp = H + (size_t)(row0 + s0) * HC_AB + C_XBC + col;
    const bool first = ((ck & 31) == 0) && (sg == 0);
    float x0 = first ? 0.f : hp[-3 * HC_AB], x1 = first ? 0.f : hp[-2 * HC_AB], x2 = first ? 0.f : hp[-HC_AB];
#pragma unroll
    for (int i = 0; i < 16; ++i) { const float x3 = hp[(size_t)i * HC_AB]; const bf16 v = f2bf(silu_f(bias + w0 * x0 + w1 * x1 + w2 * x2 + w3 * x3));
        XCN[(size_t)(row0 + s0 + i) * 1536 + col] = v; T[ch * 136 + s0 + i] = v; x0 = x1; x1 = x2; x2 = x3; }
    if (cb == 0) for (int idx = tid; idx < 128 * 16; idx += 512) { const int s = idx >> 4, hh = idx & 15;
        wsf(p, WS_DT)[(row0 + s) * 16 + hh] = softplus_f(H[(size_t)(row0 + s) * HC_AB + C_DT + hh] + p->dt_bias[j * 16 + hh]); }
    __syncthreads();
    { const int chh = tid >> 3, sq = (tid & 7) * 16; const u32x4 a = *(const u32x4*)(T + chh * 136 + sq), b = *(const u32x4*)(T + chh * 136 + sq + 8);
      bf16* dst = XCT + ((size_t)ck * 1536 + cb * 64 + chh) * 128 + sq; *(u32x4*)dst = a; *(u32x4*)(dst + 8) = b; }
    __syncthreads();
}
DEVI void ssd1_unit(CP p, int j, int ck, int h, float* sm  ) {
    const int tid = ltid(), lane = tid & 63, wv = tid >> 6, fr = lane & 15, fq = lane >> 4, g = h >> 3;
    if (wv == 0) {
        const float* DT = wsf(p, WS_DT) + (size_t)ck * 128 * 16 + h; const float a = -__expf(p->a_log[j * 16 + h]);
        float* ACUM = wsf(p, WS_ACUM) + ((size_t)ck * 16 + h) * 128; float* DTC = wsf(p, WS_DTC) + ((size_t)ck * 16 + h) * 128;
        const float d0 = DT[(2 * lane) * 16], d1 = DT[(2 * lane + 1) * 16], v0 = d0 * a, v1 = v0 + d1 * a;
        float run = v1;
#pragma unroll
        for (int o = 1; o < 64; o <<= 1) { const float t = __shfl_up(run, o); if (lane >= o) run += t; }
        const float ex = run - v1, a0 = ex + v0, a1 = ex + v1, last = __shfl(run, 63);
        sm[2 * lane] = a0; sm[2 * lane + 1] = a1; ACUM[2 * lane] = a0; ACUM[2 * lane + 1] = a1; DTC[2 * lane] = d0; DTC[2 * lane + 1] = d1;
        sm[128 + 2 * lane] = d0 * __expf(last - a0); sm[128 + 2 * lane + 1] = d1 * __expf(last - a1);
        if (lane == 0) wsf(p, WS_CDEC)[ck * 16 + h] = __expf(last);
    }
    __syncthreads();
    const bf16* XCT = wsb(p, WS_XCT) + (size_t)ck * 1536 * 128;
    const bf16* Btp = XCT + (size_t)(1024 + g * 128 + wv * 16 + fr) * 128 + fq * 8;
    const bf16* xp = XCT + (size_t)(h * 64 + fr) * 128 + fq * 8;
    f32x4 acc[4];
#pragma unroll
    for (int pt = 0; pt < 4; ++pt) acc[pt] = (f32x4){0.f, 0.f, 0.f, 0.f};
#pragma unroll
    for (int k = 0; k < 4; ++k) {
        const bf16x8 bfrag = *(const bf16x8*)(Btp + k * 32);
        const f32x4 wa = *(const f32x4*)(sm + 128 + k * 32 + fq * 8), wb = *(const f32x4*)(sm + 128 + k * 32 + fq * 8 + 4);
#pragma unroll
        for (int pt = 0; pt < 4; ++pt) { const u32x4 xv = *(const u32x4*)(xp + (size_t)pt * 16 * 128 + k * 32);
            u32x4 sv; sv.x = cvtpk(bflo(xv.x) * wa.x, bfhi(xv.x) * wa.y); sv.y = cvtpk(bflo(xv.y) * wa.z, bfhi(xv.y) * wa.w); sv.z = cvtpk(bflo(xv.z) * wb.x, bfhi(xv.z) * wb.y); sv.w = cvtpk(bflo(xv.w) * wb.z, bfhi(xv.w) * wb.w);
            acc[pt] = mfma16(bfrag, __builtin_bit_cast(bf16x8, sv), acc[pt]); }
    }
    float* ST = wsf(p, WS_ST) + ((size_t)ck * 16 + h) * 8192;
#pragma unroll
    for (int pt = 0; pt < 4; ++pt) *(f32x4*)(ST + (size_t)(pt * 16 + fr) * 128 + wv * 16 + fq * 4) = acc[pt];
    __syncthreads();
}
DEVI void ph_ssd_scan(CP p, int j, int vb, int nvb) {
    const float* ST = wsf(p, WS_ST); const float* CDEC = wsf(p, WS_CDEC); bf16* HIN = wsb(p, WS_HIN);
    const int tid = ltid();
    for (int e4 = vb * 512 + tid; e4 < NBP * 16 * 64 * 128 / 4; e4 += nvb * 512) {
        const int b = e4 / (16 * 64 * 32), r = e4 % (16 * 64 * 32), h = r / (64 * 32);
        f32x4 st = (f32x4){0.f, 0.f, 0.f, 0.f};
#pragma unroll 8
        for (int c = 0; c < 32; ++c) { const int ck = b * 32 + c; const size_t off = (size_t)ck * 16 * 8192 + (size_t)r * 4;
            u32x2 o; o.x = cvtpk(st.x, st.y); o.y = cvtpk(st.z, st.w); *(u32x2*)(HIN + off) = o;
            const f32x4 sv = *(const f32x4*)(ST + off); const float d = CDEC[ck * 16 + h]; st = st * d + sv; }
        *(f32x4*)(p->out + O_HP + ((size_t)j * NBP + b) * 16 * 8192 + (size_t)r * 4) = st;
    }
}
DEVI void ssd3_unit(CP p, int j, int ck, int tt, float* red  , bf16* AO) {
    const int tid = ltid(), lane = tid & 63, wv = tid >> 6, fr = lane & 15, fq = lane >> 4, g = wv >> 2;
    const int t0 = tt * 16; const size_t row = (size_t)ck * 128 + t0 + fr;
    const bf16* XCN = wsb(p, WS_XCN); const bf16* XCT = wsb(p, WS_XCT) + (size_t)ck * 1536 * 128; const float* H = wsf(p, WS_H);
    bf16x8 cf[4];
#pragma unroll
    for (int k = 0; k < 4; ++k) cf[k] = *(const bf16x8*)(XCN + row * 1536 + 1280 + g * 128 + k * 32 + fq * 8);
    f32x4 cbt[8];
#pragma unroll
    for (int jt = 0; jt < 8; ++jt) { cbt[jt] = (f32x4){0.f, 0.f, 0.f, 0.f};
        if (jt <= tt) { const bf16* bp = XCN + ((size_t)ck * 128 + jt * 16 + fr) * 1536 + 1024 + g * 128 + fq * 8;
#pragma unroll
            for (int k = 0; k < 4; ++k) cbt[jt] = mfma16(*(const bf16x8*)(bp + k * 32), cf[k], cbt[jt]); } }
    f32x4 yv[2][4]; float ss = 0.f;
#pragma unroll
    for (int hh = 0; hh < 2; ++hh) {
        const int h = 2 * wv + hh;
        const float* AC = wsf(p, WS_ACUM) + ((size_t)ck * 16 + h) * 128; const float* DC = wsf(p, WS_DTC) + ((size_t)ck * 16 + h) * 128;
        const float at = AC[t0 + fr], Dk = p->d_skip[j * 16 + h];
        f32x4 yd[4];
#pragma unroll
        for (int pt = 0; pt < 4; ++pt) yd[pt] = (f32x4){0.f, 0.f, 0.f, 0.f};
#pragma unroll
        for (int q = 0; q < 4; ++q) if (2 * q <= tt) {
            const int sa = 2 * q * 16 + 4 * fq, sb = sa + 16;
            const f32x4 aa = *(const f32x4*)(AC + sa), da = *(const f32x4*)(DC + sa), ab = *(const f32x4*)(AC + sb), db = *(const f32x4*)(DC + sb);
            float la[4], lb[4];
#pragma unroll
            for (int i = 0; i < 4; ++i) { la[i] = (sa + i <= t0 + fr) ? cbt[2 * q][i] * __expf(fminf(at - aa[i], 0.f)) * da[i] : 0.f;
                                          lb[i] = (2 * q + 1 <= tt && sb + i <= t0 + fr) ? cbt[2 * q + 1][i] * __expf(fminf(at - ab[i], 0.f)) * db[i] : 0.f; }
            u32x4 lw; lw.x = cvtpk(la[0], la[1]); lw.y = cvtpk(la[2], la[3]); lw.z = cvtpk(lb[0], lb[1]); lw.w = cvtpk(lb[2], lb[3]);
            const bf16x8 lf = __builtin_bit_cast(bf16x8, lw);
#pragma unroll
            for (int pt = 0; pt < 4; ++pt) { const bf16* xq = XCT + (size_t)(h * 64 + pt * 16 + fr) * 128;
                const u32x2 xa = *(const u32x2*)(xq + sa), xb = *(const u32x2*)(xq + sb); u32x4 xw; xw.x = xa.x; xw.y = xa.y; xw.z = xb.x; xw.w = xb.y;
                yd[pt] = mfma16(__builtin_bit_cast(bf16x8, xw), lf, yd[pt]); }
        }
        const bf16* hq = wsb(p, WS_HIN) + ((size_t)ck * 16 + h) * 8192 + (size_t)fr * 128 + fq * 8; const float eat = __expf(at);
#pragma unroll
        for (int pt = 0; pt < 4; ++pt) { f32x4 of = (f32x4){0.f, 0.f, 0.f, 0.f};
#pragma unroll
            for (int k = 0; k < 4; ++k) of = mfma16(*(const bf16x8*)(hq + (size_t)pt * 16 * 128 + k * 32), cf[k], of);
            const int c0 = h * 64 + pt * 16 + 4 * fq;
            const u32x2 xw = *(const u32x2*)(XCN + row * 1536 + c0); const f32x4 z = *(const f32x4*)(H + row * HC_AB + C_Z + c0);
            f32x4 y = yd[pt] + of * eat;
            y.x += Dk * bflo(xw.x); y.y += Dk * bfhi(xw.x); y.z += Dk * bflo(xw.y); y.w += Dk * bfhi(xw.y);
            y.x *= silu_f(z.x); y.y *= silu_f(z.y); y.z *= silu_f(z.z); y.w *= silu_f(z.w);
            ss += (y.x * y.x + y.y * y.y) + (y.z * y.z + y.w * y.w); yv[hh][pt] = y; }
    }
    ss += __shfl_xor(ss, 16); ss += __shfl_xor(ss, 32);
    if (fq == 0) red[wv * 16 + fr] = ss;
    __syncthreads();
    float tot = 0.f;
#pragma unroll
    for (int w = 0; w < 8; ++w) tot += red[w * 16 + fr];
    const float rs = 1.f / sqrtf(tot * (1.f / 1024.f) + EPS);
    const float* gg = p->ssd_g + (size_t)j * 1024;
#pragma unroll
    for (int hh = 0; hh < 2; ++hh)
#pragma unroll
        for (int pt = 0; pt < 4; ++pt) { const int c0 = (2 * wv + hh) * 64 + pt * 16 + 4 * fq; const f32x4 gv = *(const f32x4*)(gg + c0); const f32x4 o = yv[hh][pt] * rs * gv;
            u32x2 w; w.x = cvtpk(o.x, o.y); w.y = cvtpk(o.z, o.w); *(u32x2*)(AO + row * DM + 1024 + c0) = w; }
    __syncthreads();
}

DEVI void ph_ssd_gate(CP p, int j, int vb, int nvb) {
    const int TIDX = ltid();
    const float* H = wsf(p, WS_H); const float* Y = wsf(p, WS_Y); bf16* AO = wsb(p, WS_AO); const float* g = p->ssd_g + (size_t)j * 1024;
    const int lane = TIDX & 63, wv = TIDX >> 6;
#ifdef EXP_OLDY
    for (int row = vb * 8 + wv; row < MR; row += nvb * 8) {
#else
    for (int row = MPR + vb * 8 + wv; row < MR; row += nvb * 8) {
#endif
        f32x4 v[4]; float q = 0.f;
#pragma unroll
        for (int i = 0; i < 4; ++i) { const int c = (i * 64 + lane) * 4; const f32x4 y = *(const f32x4*)(Y + (size_t)row * 1024 + c), z = *(const f32x4*)(H + (size_t)row * HC_AB + C_Z + c);
            v[i] = (f32x4){y.x * silu_f(z.x), y.y * silu_f(z.y), y.z * silu_f(z.z), y.w * silu_f(z.w)}; q += (v[i].x * v[i].x + v[i].y * v[i].y) + (v[i].z * v[i].z + v[i].w * v[i].w); }
        const float rs = 1.f / sqrtf(wave_sum(q) * (1.f / 1024.f) + EPS);
#pragma unroll
        for (int i = 0; i < 4; ++i) { const int c = (i * 64 + lane) * 4; const f32x4 gg = *(const f32x4*)(g + c); const f32x4 o = v[i] * rs * gg;
            uint2 w; w.x = pk2(o.x, o.y); w.y = pk2(o.z, o.w); *(uint2*)(AO + (size_t)row * DM + 1024 + c) = w; }
    }
}

DEVI void ph_idx_prompt_naive(CP p, int vb, int nvb, float* sm) {
    const int TIDX = ltid();
    const float* H = wsf(p, WS_H); float* SC = wsf(p, WS_SC);
    const int half = TIDX >> 8, tid = TIDX & 255; float* sq = sm + half * 520; float* sw = sq + 512;
    for (int row0 = vb * 2; row0 < MPR; row0 += nvb * 2) {
        const int row = row0 + half, b = row / SEQ, t = row % SEQ;
        sq[tid] = H[(size_t)row * HC_AB + C_QI + tid]; sq[tid + 256] = H[(size_t)row * HC_AB + C_QI + 256 + tid]; if (tid < 8) sw[tid] = H[(size_t)row * HC_AB + C_WI + tid];
        __syncthreads();
        for (int s = tid; s <= t; s += 256) {
            const float* kr = H + (size_t)(b * SEQ + s) * HC_AB + C_KI; float k[64];
#pragma unroll
            for (int i = 0; i < 16; ++i) { const f32x4 v = *(const f32x4*)(kr + 4 * i); k[4 * i] = v.x; k[4 * i + 1] = v.y; k[4 * i + 2] = v.z; k[4 * i + 3] = v.w; }
            float sc = 0.f;
#pragma unroll 1
            for (int h = 0; h < 8; ++h) { float d = 0.f;
#pragma unroll
                for (int i = 0; i < 64; ++i) d += sq[h * 64 + i] * k[i];
                sc += sw[h] * fmaxf(d, 0.f); }
            SC[(size_t)row * SEQ + s] = sc * IDX_SCALE;
        }
        __syncthreads();
    }
}

DEVI void idx_wave_unit(CP p, int b, int qt, int kc, int lane) {
    const int fr = lane & 15, fq = lane >> 4; const size_t row = (size_t)b * SEQ + qt * 16 + fr;
    const bf16* QIB = wsb(p, WS_QIB) + row * 512 + fq * 8; const float* H = wsf(p, WS_H); float* SC = wsf(p, WS_SC) + row * SEQ + 4 * fq;
    bf16x8 qf[8][2]; float wi[8];
#pragma unroll
    for (int h = 0; h < 8; ++h) { qf[h][0] = *(const bf16x8*)(QIB + h * 64); qf[h][1] = *(const bf16x8*)(QIB + h * 64 + 32); wi[h] = H[row * HC_AB + C_WI + h] * IDX_SCALE; }
    const int kt0 = kc * 64, kt1 = (qt < kt0 + 63) ? qt : kt0 + 63;
    const bf16* kp = wsb(p, WS_KIB) + ((size_t)b * SEQ + fr) * 64 + fq * 8;
    bf16x8 k0 = *(const bf16x8*)(kp + (size_t)kt0 * 16 * 64), k1 = *(const bf16x8*)(kp + (size_t)kt0 * 16 * 64 + 32);
    for (int kt = kt0; kt <= kt1; ++kt) {
        const bf16x8 c0 = k0, c1 = k1;
        if (kt < kt1) { k0 = *(const bf16x8*)(kp + (size_t)(kt + 1) * 16 * 64); k1 = *(const bf16x8*)(kp + (size_t)(kt + 1) * 16 * 64 + 32); }
        f32x4 d[8];
#pragma unroll
        for (int h = 0; h < 8; ++h) { d[h] = mfma16(c0, qf[h][0], (f32x4){0.f, 0.f, 0.f, 0.f}); d[h] = mfma16(c1, qf[h][1], d[h]); }
        f32x4 sc = (f32x4){0.f, 0.f, 0.f, 0.f};
#pragma unroll
        for (int h = 0; h < 8; ++h) { sc.x += wi[h] * fmaxf(d[h].x, 0.f); sc.y += wi[h] * fmaxf(d[h].y, 0.f); sc.z += wi[h] * fmaxf(d[h].z, 0.f); sc.w += wi[h] * fmaxf(d[h].w, 0.f); }
        *(f32x4*)(SC + kt * 16) = sc;
    }
}
DEVI void ph_idx_prompt(CP p, int vb, int nvb) {
    const int tid = ltid(), lane = tid & 63, wv = tid >> 6;
    for (int gw = wv * nvb + vb; gw < 2 * 640; gw += 8 * nvb) { const int b = gw / 640, u = gw % 640; int kc, qt;
        if (u < 256) { kc = 0; qt = u; } else if (u < 448) { kc = 1; qt = 64 + (u - 256); } else if (u < 576) { kc = 2; qt = 128 + (u - 448); } else { kc = 3; qt = 192 + (u - 576); }
        idx_wave_unit(p, b, qt, kc, lane); }
}

DEVI void select_prompt_row(const float* SC, unsigned long long* MASK, int row, int lane) {
    const int t = row % SEQ, nk = t + 1; const float* sc = SC + (size_t)row * SEQ;
    unsigned v[64];
#pragma unroll
    for (int jj = 0; jj < 64; ++jj) { const int key = jj * 64 + lane; v[jj] = key < nk ? ord_f(sc[key]) : 0u; }
    unsigned long long mine = 0ull;
    if (nk <= TOPK) {
#pragma unroll
        for (int jj = 0; jj < 64; ++jj) { const unsigned long long m = __ballot(jj * 64 + lane < nk); if (lane == jj) mine = m; }
    } else {
        unsigned T = 0u;
        for (int bit = 31; bit >= 0; --bit) { const unsigned cand = T | (1u << bit); int cnt = 0;
#pragma unroll
            for (int jj = 0; jj < 64; ++jj) cnt += __popcll(__ballot(v[jj] >= cand));
            if (cnt >= TOPK) T = cand; if (cnt == TOPK) break; }
        int cgt = 0;
#pragma unroll
        for (int jj = 0; jj < 64; ++jj) cgt += __popcll(__ballot(v[jj] > T));
        const int need = TOPK - cgt; int run = 0; const unsigned long long lt = (1ull << lane) - 1ull;
#pragma unroll
        for (int jj = 0; jj < 64; ++jj) { const bool eq = v[jj] == T; const unsigned long long me = __ballot(eq); const int pre = run + __popcll(me & lt);
            const bool sel = (v[jj] > T) || (eq && pre < need); run += __popcll(me); const unsigned long long m = __ballot(sel); if (lane == jj) mine = m; }
    }
    MASK[((size_t)(row >> 5) * 64 + lane) * 32 + (row & 31)] = mine;
}
DEVI void ph_select_prompt(CP p, int vb, int nvb) {
    const int TIDX = ltid();
    const int lane = TIDX & 63, wv = TIDX >> 6;
    for (int row = vb * 8 + wv; row < MPR; row += nvb * 8) select_prompt_row(wsf(p, WS_SC), (unsigned long long*)(p->ws + WS_MASK), row, lane);
}

DEVI void ph_attn_prompt_naive(CP p, int vb, int nvb) {
    const int TIDX = ltid();
    const float* H = wsf(p, WS_H); const unsigned long long* MASK = (const unsigned long long*)(p->ws + WS_MASK); bf16* AO = wsb(p, WS_AO);
    const int h = TIDX >> 6, lane = TIDX & 63, g = h >> 2;
    for (int row = vb; row < MPR; row += nvb) {
        const int b = row / SEQ, t = row % SEQ;
        const float q0 = H[(size_t)row * HC_AB + C_Q + h * 128 + lane], q1 = H[(size_t)row * HC_AB + C_Q + h * 128 + 64 + lane];
        float m = -1e30f, l = 0.f, o0 = 0.f, o1 = 0.f;
        for (int jt = 0; jt <= t / 64; ++jt) {
            unsigned long long w = MASK[((size_t)(row >> 5) * 64 + jt) * 32 + (row & 31)];
            while (w) { const int bit = __builtin_ctzll(w); w &= w - 1ull; const int s = jt * 64 + bit;
                const float* kr = H + (size_t)(b * SEQ + s) * HC_AB + C_K + g * 128; const float* vr = H + (size_t)(b * SEQ + s) * HC_AB + C_V + g * 128;
                const float lg = wave_sum(q0 * kr[lane] + q1 * kr[lane + 64]) * ATT_SCALE;
                const float mn = fmaxf(m, lg), al = __expf(m - mn), pe = __expf(lg - mn);
                l = l * al + pe; o0 = o0 * al + pe * vr[lane]; o1 = o1 * al + pe * vr[lane + 64]; m = mn; }
        }
        const float il = 1.f / l;
        AO[(size_t)row * DM + h * 128 + lane] = f2bf(o0 * il); AO[(size_t)row * DM + h * 128 + 64 + lane] = f2bf(o1 * il);
    }
}

constexpr int ATT_KS = 136, ATT_VS = 72, ATT_BUF = 64 * ATT_KS * 2 + 128 * ATT_VS * 2;
DEVI void attn_unit(CP p, int b, int h, int qb, unsigned char* lds, bf16* AO) {
    const int tid = ltid(), lane = tid & 63, wv = tid >> 6, fr = lane & 15, fq = lane >> 4, g = h >> 2;
    const bf16* QB = wsb(p, WS_QB); const bf16* KB = wsb(p, WS_KB) + (size_t)b * SEQ * 256 + g * 128; const bf16* VB = wsb(p, WS_VB) + (size_t)b * SEQ * 256 + g * 128;
    const unsigned long long* MASK = (const unsigned long long*)(p->ws + WS_MASK);
    const int pos0 = qb * 256 + wv * 32;
    const size_t row0 = (size_t)b * SEQ + pos0;
    bf16x8 qf[2][4];
#pragma unroll
    for (int mt = 0; mt < 2; ++mt)
#pragma unroll
        for (int k = 0; k < 4; ++k) qf[mt][k] = *(const bf16x8*)(QB + (row0 + mt * 16 + fr) * 1024 + h * 128 + k * 32 + fq * 8);
    const unsigned long long* mkp = MASK + (row0 >> 5) * 64 * 32 + fr;
    f32x4 o[2][8];
#pragma unroll
    for (int mt = 0; mt < 2; ++mt)
#pragma unroll
        for (int dt = 0; dt < 8; ++dt) o[mt][dt] = (f32x4){0.f, 0.f, 0.f, 0.f};
    float mrow[2] = {-1e30f, -1e30f}, lrow[2] = {0.f, 0.f};
    const int NT = 4 * (qb + 1);
    const int skey = tid >> 3, spart = tid & 7;
    const bf16* kg = KB + (size_t)skey * 256 + spart * 16; const bf16* vg = VB + (size_t)skey * 256 + spart * 16;
    u32x4 sk0, sk1, sv0, sv1; unsigned long long mw[2];
    sk0 = *(const u32x4*)(kg); sk1 = *(const u32x4*)(kg + 8); sv0 = *(const u32x4*)(vg); sv1 = *(const u32x4*)(vg + 8);
    mw[0] = mkp[0]; mw[1] = mkp[16];
    for (int jt = 0; jt < NT; ++jt) {
        unsigned char* buf = lds + (jt & 1) * ATT_BUF; bf16* Ks = (bf16*)buf; bf16* Vt = (bf16*)(buf + 64 * ATT_KS * 2);
        *(u32x4*)(Ks + skey * ATT_KS + spart * 16) = sk0; *(u32x4*)(Ks + skey * ATT_KS + spart * 16 + 8) = sk1;
        { const unsigned w[8] = {sv0.x, sv0.y, sv0.z, sv0.w, sv1.x, sv1.y, sv1.z, sv1.w};
#pragma unroll
          for (int i = 0; i < 8; ++i) { Vt[(spart * 16 + 2 * i) * ATT_VS + skey] = (bf16)(w[i] & 0xffffu); Vt[(spart * 16 + 2 * i + 1) * ATT_VS + skey] = (bf16)(w[i] >> 16); } }
        const unsigned long long m0 = mw[0], m1 = mw[1];
        __syncthreads();
        if (jt + 1 < NT) { const size_t go = (size_t)(jt + 1) * 64 * 256; sk0 = *(const u32x4*)(kg + go); sk1 = *(const u32x4*)(kg + go + 8); sv0 = *(const u32x4*)(vg + go); sv1 = *(const u32x4*)(vg + go + 8);
            mw[0] = mkp[(jt + 1) * 32]; mw[1] = mkp[(jt + 1) * 32 + 16]; }
        if (jt * 64 > pos0 + 31) continue;
        f32x4 sc[2][4];
#pragma unroll
        for (int mt = 0; mt < 2; ++mt)
#pragma unroll
            for (int kt = 0; kt < 4; ++kt) sc[mt][kt] = (f32x4){0.f, 0.f, 0.f, 0.f};
#pragma unroll
        for (int kt = 0; kt < 4; ++kt)
#pragma unroll
            for (int k = 0; k < 4; ++k) { const bf16x8 kf = *(const bf16x8*)(Ks + (kt * 16 + fr) * ATT_KS + k * 32 + fq * 8);
                sc[0][kt] = mfma16(kf, qf[0][k], sc[0][kt]); sc[1][kt] = mfma16(kf, qf[1][k], sc[1][kt]); }
        bf16x8 pf[2][2];
#pragma unroll
        for (int mt = 0; mt < 2; ++mt) {
            const unsigned long long mk = (mt ? m1 : m0) >> (4 * fq);
            float mx = -1e30f;
#pragma unroll
            for (int kt = 0; kt < 4; ++kt)
#pragma unroll
                for (int i = 0; i < 4; ++i) { const bool on = (mk >> (16 * kt + i)) & 1ull; sc[mt][kt][i] = on ? sc[mt][kt][i] : -1e30f; mx = fmaxf(mx, sc[mt][kt][i]); }
            mx = fmaxf(mx, __shfl_xor(mx, 16)); mx = fmaxf(mx, __shfl_xor(mx, 32));
            const float mn = fmaxf(mrow[mt], mx), al = __builtin_amdgcn_exp2f(mrow[mt] - mn); mrow[mt] = mn;
            float ps = 0.f;
#pragma unroll
            for (int kt = 0; kt < 4; ++kt)
#pragma unroll
                for (int i = 0; i < 4; ++i) { const float e = (sc[mt][kt][i] > -1e29f) ? __builtin_amdgcn_exp2f(sc[mt][kt][i] - mn) : 0.f; sc[mt][kt][i] = e; ps += e; }
            lrow[mt] = lrow[mt] * al + ps;
            if (!__all(al == 1.f)) {
#pragma unroll
                for (int dt = 0; dt < 8; ++dt) o[mt][dt] = o[mt][dt] * al; }
#pragma unroll
            for (int ks = 0; ks < 2; ++ks) { u32x4 w; w.x = cvtpk(sc[mt][2 * ks][0], sc[mt][2 * ks][1]); w.y = cvtpk(sc[mt][2 * ks][2], sc[mt][2 * ks][3]);
                w.z = cvtpk(sc[mt][2 * ks + 1][0], sc[mt][2 * ks + 1][1]); w.w = cvtpk(sc[mt][2 * ks + 1][2], sc[mt][2 * ks + 1][3]); pf[mt][ks] = __builtin_bit_cast(bf16x8, w); }
        }
#pragma unroll
        for (int dt = 0; dt < 8; ++dt)
#pragma unroll
            for (int ks = 0; ks < 2; ++ks) { const bf16* vp = Vt + (dt * 16 + fr) * ATT_VS + ks * 32 + 4 * fq;
                const u32x2 va = *(const u32x2*)vp, vb2 = *(const u32x2*)(vp + 16); u32x4 w; w.x = va.x; w.y = va.y; w.z = vb2.x; w.w = vb2.y; const bf16x8 vf = __builtin_bit_cast(bf16x8, w);
                o[0][dt] = mfma16(vf, pf[0][ks], o[0][dt]); o[1][dt] = mfma16(vf, pf[1][ks], o[1][dt]); }
    }
#pragma unroll
    for (int mt = 0; mt < 2; ++mt) { float l = lrow[mt]; l += __shfl_xor(l, 16); l += __shfl_xor(l, 32); const float il = 1.f / l;
        bf16* orow = AO + (row0 + mt * 16 + fr) * DM + h * 128 + 4 * fq;
#pragma unroll
        for (int dt = 0; dt < 8; ++dt) { const f32x4 v = o[mt][dt] * il; u32x2 w; w.x = cvtpk(v.x, v.y); w.y = cvtpk(v.z, v.w); *(u32x2*)(orow + dt * 16) = w; } }
    __syncthreads();
}

DEVI void idx_sample_wave_unit(CP p, int j, int b, int ug, int lane) {
    const int fr = lane & 15, fq = lane >> 4; const float* H = wsf(p, WS_H); float* SCS = wsf(p, WS_SCS);
    const float* qrow = H + (size_t)(MPR + b * DS + (fr & 7)) * HC_AB;
    bf16x8 qf[8][2]; float wi[8];
#pragma unroll
    for (int h = 0; h < 8; ++h) {
#pragma unroll
        for (int k = 0; k < 2; ++k) { const f32x4 x = *(const f32x4*)(qrow + C_QI + h * 64 + k * 32 + fq * 8), y = *(const f32x4*)(qrow + C_QI + h * 64 + k * 32 + fq * 8 + 4);
            u32x4 w; w.x = cvtpk(x.x, x.y); w.y = cvtpk(x.z, x.w); w.z = cvtpk(y.x, y.y); w.w = cvtpk(y.z, y.w); qf[h][k] = __builtin_bit_cast(bf16x8, w); }
        wi[h] = qrow[C_WI + h] * IDX_SCALE; }
    for (int kt = ug * 8; kt < ug * 8 + 8 && kt < (NKEY_S + 15) / 16; ++kt) {
        const int key = kt * 16 + fr; const float* kr;
        if (key < PAST) { const int pg = p->page_table[b * NPAGES + key / PAGE]; kr = p->cache_ik + (((size_t)j * NPOOL + pg) * PAGE + key % PAGE) * 64; }
        else { const int nr = key - PAST < DS ? key - PAST : DS - 1; kr = H + (size_t)(MPR + b * DS + nr) * HC_AB + C_KI; }
        bf16x8 kf[2];
#pragma unroll
        for (int k = 0; k < 2; ++k) { const f32x4 x = *(const f32x4*)(kr + k * 32 + fq * 8), y = *(const f32x4*)(kr + k * 32 + fq * 8 + 4);
            u32x4 w; w.x = cvtpk(x.x, x.y); w.y = cvtpk(x.z, x.w); w.z = cvtpk(y.x, y.y); w.w = cvtpk(y.z, y.w); kf[k] = __builtin_bit_cast(bf16x8, w); }
        f32x4 sc = (f32x4){0.f, 0.f, 0.f, 0.f};
#pragma unroll
        for (int h = 0; h < 8; ++h) { f32x4 d = mfma16(kf[0], qf[h][0], (f32x4){0.f, 0.f, 0.f, 0.f}); d = mfma16(kf[1], qf[h][1], d);
            sc.x += wi[h] * fmaxf(d.x, 0.f); sc.y += wi[h] * fmaxf(d.y, 0.f); sc.z += wi[h] * fmaxf(d.z, 0.f); sc.w += wi[h] * fmaxf(d.w, 0.f); }
        if (fr < 8) *(f32x4*)(SCS + (size_t)(b * DS + fr) * SCS_LD + kt * 16 + 4 * fq) = sc;
    }
}
DEVI void ph_idx_sample(CP p, int j, int vb, int nvb) {
    const int tid = ltid(), lane = tid & 63, wv = tid >> 6;
    for (int gw = wv * nvb + vb; gw < DB * 129; gw += 8 * nvb) idx_sample_wave_unit(p, j, gw / 129, gw % 129, lane);
}

DEVI void select_sample_unit(CP p, int q, int* red  ) {
    const int TIDX = ltid();
    const float* sc = wsf(p, WS_SCS) + (size_t)q * SCS_LD; int* SELS = (int*)(p->ws + WS_SELS) + q * TOPK;
    const int tid = TIDX, lane = tid & 63, wv = tid >> 6, nk = PAST + (q % DS) + 1;
    unsigned v[33];
#pragma unroll
    for (int jj = 0; jj < 33; ++jj) { const int key = jj * 512 + tid; v[jj] = key < nk ? ord_f(sc[key]) : 0u; }
    unsigned T = 0u; int par = 0;
    for (int bit = 31; bit >= 0; --bit) { const unsigned cand = T | (1u << bit); int cnt = 0;
#pragma unroll
        for (int jj = 0; jj < 33; ++jj) cnt += __popcll(__ballot(v[jj] >= cand));
        if (lane == 0) red[par * 8 + wv] = cnt; __syncthreads();
        int tot = 0;
#pragma unroll
        for (int w = 0; w < 8; ++w) tot += red[par * 8 + w];
        par ^= 1;
        if (tot >= TOPK) T = cand; if (tot == TOPK) break; }
    __syncthreads();
    int* cg = red + 16; int* ce = cg + 33 * 8; int* pg = ce + 33 * 8; int* pe = pg + 33 * 8;
#pragma unroll
    for (int jj = 0; jj < 33; ++jj) { const int a = __popcll(__ballot(v[jj] > T)), e = __popcll(__ballot(v[jj] == T)); if (lane == 0) { cg[jj * 8 + wv] = a; ce[jj * 8 + wv] = e; } }
    __syncthreads();
    if (tid < 33 * 8) { int a = 0, e = 0; for (int i = 0; i < tid; ++i) { a += cg[i]; e += ce[i]; } pg[tid] = a; pe[tid] = e; }
    if (tid == 0) { int a = 0; for (int i = 0; i < 33 * 8; ++i) a += cg[i]; red[0] = a; }
    __syncthreads();
    const int need = TOPK - red[0]; const unsigned long long lt = (1ull << lane) - 1ull;
#pragma unroll
    for (int jj = 0; jj < 33; ++jj) {
        const bool gt = v[jj] > T, eq = v[jj] == T; const unsigned long long me = __ballot(eq), mg = __ballot(gt);
        const int epre = pe[jj * 8 + wv] + __popcll(me & lt), gpre = pg[jj * 8 + wv] + __popcll(mg & lt); const bool sel = gt || (eq && epre < need);
        const int ebc = epre < need ? epre : need;
        if (sel) SELS[gpre + ebc] = jj * 512 + tid;
    }
    __syncthreads();
}

DEVI void attn_sample_unit(CP p, int j, int q, int g, unsigned char* lds) {
    const int tid = ltid(), lane = tid & 63, wv = tid >> 6, b = q / DS, row = MPR + q;
    const float* H = wsf(p, WS_H); bf16* AO = wsb(p, WS_AO);
    long long* koff = (long long*)lds; float* lg = (float*)(lds + 2048); float* ml = (float*)(lds + 2048 + 4096); float* part = (float*)(lds + 2048 + 4096 + 64);
    if (tid < TOPK) { const int s = ((const int*)(p->ws + WS_SELS))[q * TOPK + tid];
        if (s < PAST) { const int pg = p->page_table[b * NPAGES + s / PAGE]; koff[tid] = (long long)((((size_t)j * NPOOL + pg) * PAGE + s % PAGE) * 256 + g * 128); }
        else koff[tid] = -(1ll + (long long)((size_t)(MPR + b * DS + s - PAST) * HC_AB + C_K + g * 128)); }
    const float qs = ATT_SCALE * 1.4426950408889634f; float q0[4], q1[4];
#pragma unroll
    for (int hh = 0; hh < 4; ++hh) { q0[hh] = H[(size_t)row * HC_AB + C_Q + (g * 4 + hh) * 128 + lane] * qs; q1[hh] = H[(size_t)row * HC_AB + C_Q + (g * 4 + hh) * 128 + 64 + lane] * qs; }
    __syncthreads();
    for (int i0 = wv * 32; i0 < wv * 32 + 32; i0 += 8) { float a0[8], a1[8];
#pragma unroll
        for (int i = 0; i < 8; ++i) { const long long o = koff[i0 + i]; const float* kr = (o >= 0) ? p->cache_k + o : H + (-(o + 1)); a0[i] = kr[lane]; a1[i] = kr[lane + 64]; }
#pragma unroll
        for (int i = 0; i < 8; ++i)
#pragma unroll
            for (int hh = 0; hh < 4; ++hh) { const float v = wave_sum(q0[hh] * a0[i] + q1[hh] * a1[i]); if (lane == 0) lg[hh * 256 + i0 + i] = v; } }
    __syncthreads();
    float mh[4], lh[4];
#pragma unroll
    for (int hh = 0; hh < 4; ++hh) { const float x0 = lg[hh * 256 + lane], x1 = lg[hh * 256 + 64 + lane], x2 = lg[hh * 256 + 128 + lane], x3 = lg[hh * 256 + 192 + lane];
        float m = fmaxf(fmaxf(x0, x1), fmaxf(x2, x3));
#pragma unroll
        for (int o = 1; o < 64; o <<= 1) m = fmaxf(m, __shfl_xor(m, o));
        mh[hh] = m; lh[hh] = wave_sum(__builtin_amdgcn_exp2f(x0 - m) + __builtin_amdgcn_exp2f(x1 - m) + __builtin_amdgcn_exp2f(x2 - m) + __builtin_amdgcn_exp2f(x3 - m)); }
    if (wv == 0 && lane < 4) ml[lane] = lh[lane];
    float o0[4] = {0.f, 0.f, 0.f, 0.f}, o1[4] = {0.f, 0.f, 0.f, 0.f};
    for (int i0 = wv * 32; i0 < wv * 32 + 32; i0 += 8) { float a0[8], a1[8];
#pragma unroll
        for (int i = 0; i < 8; ++i) { const long long o = koff[i0 + i]; const float* vr = (o >= 0) ? p->cache_v + o : H + (-(o + 1)) + (C_V - C_K); a0[i] = vr[lane]; a1[i] = vr[lane + 64]; }
#pragma unroll
        for (int i = 0; i < 8; ++i)
#pragma unroll
            for (int hh = 0; hh < 4; ++hh) { const float pe = __builtin_amdgcn_exp2f(lg[hh * 256 + i0 + i] - mh[hh]); o0[hh] += pe * a0[i]; o1[hh] += pe * a1[i]; } }
#pragma unroll
    for (int hh = 0; hh < 4; ++hh) { part[(wv * 4 + hh) * 128 + lane] = o0[hh]; part[(wv * 4 + hh) * 128 + 64 + lane] = o1[hh]; }
    __syncthreads();
    { const int hh = tid >> 7, d = tid & 127; float v = 0.f;
#pragma unroll
      for (int w = 0; w < 8; ++w) v += part[(w * 4 + hh) * 128 + d];
      AO[(size_t)row * DM + (g * 4 + hh) * 128 + d] = f2bf(v / ml[hh]); }
    __syncthreads();
}

DEVI void ph_cd_prep(CP p, int j, int vb, int nvb) {
    const int TIDX = ltid();
    const float* H = wsf(p, WS_H); bf16* DD = wsb(p, WS_DD); bf16* U = wsb(p, WS_U); bf16* VLN = wsb(p, WS_VLN);
    const float* lg = p->sgu_ln_g + (size_t)j * 1024; const float* lb = p->sgu_ln_b + (size_t)j * 1024;
    const int lane = TIDX & 63, wv = TIDX >> 6;
    for (int row = vb * 8 + wv; row < MR; row += nvb * 8) {
        const bool pr = row < MPR; const int b = pr ? row / SEQ : (row - MPR) / DS, t = pr ? row % SEQ : (row - MPR) % DS;
        const float* h = H + (size_t)row * HC_CD;
#pragma unroll 1
        for (int i = 0; i < 4; ++i) { const int c = i * 256 + lane * 4, w = 2 << i; const f32x4 cur = *(const f32x4*)(h + c); f32x4 s = cur; int cnt;
            if (pr) { cnt = (t + 1 < w) ? t + 1 : w; for (int u = 1; u < cnt; ++u) s += *(const f32x4*)(H + (size_t)(row - u) * HC_CD + c); }
            else { cnt = w; for (int u = 1; u < w; ++u) { const int e = 15 + t - u;
                    s += (e >= 15) ? *(const f32x4*)(H + (size_t)(MPR + b * DS + e - 15) * HC_CD + c) : *(const f32x4*)(p->state_pool + (((size_t)j * DB + b) * 15 + e) * 1024 + c); } }
            const float ic = 1.f / (float)cnt; const f32x4 d = s * ic - cur; uint2 o; o.x = pk2(d.x, d.y); o.y = pk2(d.z, d.w); *(uint2*)(DD + (size_t)row * 1024 + c) = o;
            if (pr) { if (t >= SEQ - 15) *(f32x4*)(p->out + O_PP + (((size_t)j * NBP + b) * 15 + (t - (SEQ - 15))) * 1024 + c) = cur; }
            else { *(f32x4*)(p->out + O_PS + (((size_t)j * DB + b) * 15 + 7 + t) * 1024 + c) = cur;
                   if (t == 0) for (int e = 0; e < 7; ++e) *(f32x4*)(p->out + O_PS + (((size_t)j * DB + b) * 15 + e) * 1024 + c) = *(const f32x4*)(p->state_pool + (((size_t)j * DB + b) * 15 + 8 + e) * 1024 + c); }
        }
        asm volatile("" ::: "memory");
#pragma unroll
        for (int i = 0; i < 4; ++i) { const int c = (i * 64 + lane) * 4; const f32x4 u = *(const f32x4*)(h + 1024 + c); uint2 o; o.x = pk2(gelu_f(u.x), gelu_f(u.y)); o.y = pk2(gelu_f(u.z), gelu_f(u.w)); *(uint2*)(U + (size_t)row * 1024 + c) = o; }
        asm volatile("" ::: "memory");
        f32x4 v[4]; float s = 0.f;
#pragma unroll
        for (int i = 0; i < 4; ++i) { const int c = (i * 64 + lane) * 4; const f32x4 x = *(const f32x4*)(h + 2048 + c); v[i] = (f32x4){gelu_f(x.x), gelu_f(x.y), gelu_f(x.z), gelu_f(x.w)}; s += (v[i].x + v[i].y) + (v[i].z + v[i].w); }
        const float mean = wave_sum(s) * (1.f / 1024.f); float q = 0.f;
#pragma unroll
        for (int i = 0; i < 4; ++i) { v[i] = v[i] - mean; q += (v[i].x * v[i].x + v[i].y * v[i].y) + (v[i].z * v[i].z + v[i].w * v[i].w); }
        const float rstd = 1.f / sqrtf(wave_sum(q) * (1.f / 1024.f) + EPS);
#pragma unroll
        for (int i = 0; i < 4; ++i) { const int c = (i * 64 + lane) * 4; const f32x4 y = v[i] * rstd * *(const f32x4*)(lg + c) + *(const f32x4*)(lb + c);
            uint2 o; o.x = pk2(y.x, y.y); o.y = pk2(y.z, y.w); *(uint2*)(VLN + (size_t)row * 1024 + c) = o;
            if (!pr) *(f32x4*)(p->out + O_GS + ((size_t)j * MSR + (row - MPR)) * 1024 + c) = y; }
    }
}

DEVI void sgu_unit(CP p, int j, int ck, int g, int ds, bf16* Vt  ) {
    const int tid = ltid(), lane = tid & 63, wv = tid >> 6, fr = lane & 15, fq = lane >> 4;
    const bf16* VLN = wsb(p, WS_VLN); const bf16* U = wsb(p, WS_U); bf16* AO = wsb(p, WS_AO);
    const size_t row0 = (size_t)ck * 128; const int c0 = g * 256 + ds * 64;
    { const int sp = tid >> 2, part = tid & 3; const bf16* src = VLN + (row0 + sp) * 1024 + c0 + part * 16; const u32x4 a = *(const u32x4*)src, bq = *(const u32x4*)(src + 8);
      const unsigned w[8] = {a.x, a.y, a.z, a.w, bq.x, bq.y, bq.z, bq.w};
#pragma unroll
      for (int i = 0; i < 8; ++i) { Vt[(part * 16 + 2 * i) * 136 + sp] = (bf16)(w[i] & 0xffffu); Vt[(part * 16 + 2 * i + 1) * 136 + sp] = (bf16)(w[i] >> 16); } }
    __syncthreads();
    const bf16* W = wsb(p, WS_SGUW) + (((size_t)j * 4 + g) * 128 + wv * 16 + fr) * 128 + fq * 8;
    f32x4 acc[4];
#pragma unroll
    for (int nt = 0; nt < 4; ++nt) acc[nt] = (f32x4){0.f, 0.f, 0.f, 0.f};
    const int nk = (wv >> 1) + 1;
#pragma unroll
    for (int k = 0; k < 4; ++k) if (k < nk) { const bf16x8 wf = *(const bf16x8*)(W + k * 32);
#pragma unroll
        for (int nt = 0; nt < 4; ++nt) acc[nt] = mfma16(*(const bf16x8*)(Vt + (nt * 16 + fr) * 136 + k * 32 + fq * 8), wf, acc[nt]); }
    const float bs = p->sgu_b[((size_t)j * 4 + g) * 128 + wv * 16 + fr]; const size_t row = row0 + wv * 16 + fr;
#pragma unroll
    for (int nt = 0; nt < 4; ++nt) { const int c = c0 + nt * 16 + 4 * fq; const u32x2 uw = *(const u32x2*)(U + row * 1024 + c);
        const float o0 = bflo(uw.x) * (acc[nt].x + bs), o1 = bfhi(uw.x) * (acc[nt].y + bs), o2 = bflo(uw.y) * (acc[nt].z + bs), o3 = bfhi(uw.y) * (acc[nt].w + bs);
        u32x2 w; w.x = cvtpk(o0, o1); w.y = cvtpk(o2, o3); *(u32x2*)(AO + row * DM + 1024 + c) = w; }
    __syncthreads();
}
DEVI void ph_sgu_naive(CP p, int j, int vb, int nvb) {
    const int TIDX = ltid();
    const bf16* VLN = wsb(p, WS_VLN); const bf16* U = wsb(p, WS_U); bf16* AO = wsb(p, WS_AO);
    for (int row = MPR + vb; row < MR; row += nvb) {
        const bool pr = row < MPR; const int t = pr ? row % SEQ : (row - MPR) % DS;
        const int tt = pr ? (t & 127) : t, base = row - tt;
        for (int d = TIDX; d < 1024; d += 512) { const int g = d >> 8; const float* w = p->sgu_w + (((size_t)j * 4 + g) * 128 + tt) * 128;
            float acc = p->sgu_b[((size_t)j * 4 + g) * 128 + tt];
            for (int s = 0; s <= tt; ++s) acc += w[s] * bf2f(VLN[(size_t)(base + s) * 1024 + d]);
            AO[(size_t)row * DM + 1024 + d] = f2bf(bf2f(U[(size_t)row * 1024 + d]) * acc); }
    }
}


DEVI void diag_cmp(CP p, int k, const bf16* a, int lda, const bf16* b, int ldb, int rows, int cols, int vb, int nvb) {
    unsigned* ctl = (unsigned*)(p->ws + WS_CTL); const int tid = ltid(); float mx = 0.f; unsigned bad = 0;
    for (int r = vb; r < rows; r += nvb) for (int c = tid; c < cols; c += 512) { const float x = bf2f(a[(size_t)r * lda + c]), y = bf2f(b[(size_t)r * ldb + c]); const float d = fabsf(x - y);
        if (!(d == d) || d > 1e30f) bad++; else mx = fmaxf(mx, d); }
    atomicMax(ctl + 64 + 2 * k, __float_as_uint(mx)); if (bad) atomicAdd(ctl + 65 + 2 * k, bad);
}
DEVI void diag_cmp_f32(CP p, int k, const float* a, int lda, const bf16* b, int ldb, int rows, int cols, int vb, int nvb) {
    unsigned* ctl = (unsigned*)(p->ws + WS_CTL); const int tid = ltid(); float mx = 0.f; unsigned bad = 0;
    for (int r = vb; r < rows; r += nvb) for (int c = tid; c < cols; c += 512) { const float x = a[(size_t)r * lda + c], y = bf2f(b[(size_t)r * ldb + c]); const float d = fabsf(x - y);
        if (!(d == d) || d > 1e30f) bad++; else mx = fmaxf(mx, d); }
    atomicMax(ctl + 64 + 2 * k, __float_as_uint(mx)); if (bad) atomicAdd(ctl + 65 + 2 * k, bad);
}
DEVI void diag_fin_f32(CP p, int k, const float* a, size_t n, int vb, int nvb) {
    unsigned* ctl = (unsigned*)(p->ws + WS_CTL); unsigned bad = 0;
    for (size_t i = (size_t)vb * 512 + ltid(); i < n; i += (size_t)nvb * 512) { const float x = a[i]; if (!(x == x) || fabsf(x) > 1e30f) bad++; }
    if (bad) atomicAdd(ctl + 65 + 2 * k, bad);
}
DEVI void diag_fin_bf16(CP p, int k, const bf16* a, size_t n, int vb, int nvb) {
    unsigned* ctl = (unsigned*)(p->ws + WS_CTL); unsigned bad = 0;
    for (size_t i = (size_t)vb * 512 + ltid(); i < n; i += (size_t)nvb * 512) { const float x = bf2f(a[i]); if (!(x == x) || fabsf(x) > 1e30f) bad++; }
    if (bad) atomicAdd(ctl + 65 + 2 * k, bad);
}
DEVI void diag_report(CP p, int nchecks) {
    unsigned* ctl = (unsigned*)(p->ws + WS_CTL);
    if (blockIdx.x == 0 && threadIdx.x == 0) { const unsigned fl = __hip_atomic_load(ctl + 96, __ATOMIC_RELAXED, __HIP_MEMORY_SCOPE_AGENT); if (fl) { p->out[O_KP] = (float)fl * 1e12f; return; } }
    if (blockIdx.x == 0 && threadIdx.x == 0) for (int k = 0; k < nchecks; ++k) { const float mx = __uint_as_float(__hip_atomic_load(ctl + 64 + 2 * k, __ATOMIC_RELAXED, __HIP_MEMORY_SCOPE_AGENT)); const unsigned bad = __hip_atomic_load(ctl + 65 + 2 * k, __ATOMIC_RELAXED, __HIP_MEMORY_SCOPE_AGENT);
        if (bad) { p->out[O_KP] = (70.f + k) * 1e19f; break; } if (mx > 0.06f) { p->out[O_KP] = mx * 1e8f; break; } }
}
namespace pg8 {
#define PG8_LAS __attribute__((address_space(3)))
typedef unsigned short bf16_t;
typedef short bf16x8 __attribute__((ext_vector_type(8)));
typedef float f32x4 __attribute__((ext_vector_type(4)));
typedef unsigned u32x4 __attribute__((ext_vector_type(4)));
constexpr int BM = 256, BK = 64, HALF = 128, HTB = HALF * BK * 2  , STAGE_BYTES = 8 * HTB, NXCD = 8, WGM = 8;

__host__ __device__ __forceinline__ int lds_byte(int r, int c) { const int st = (r >> 4) * 2 + (c >> 5), rr = r & 15, cc = c & 31, ob = rr * 64 + cc * 2; return st * 1024 + (ob ^ (((ob >> 9) & 1) << 5)); }
__host__ __device__ __forceinline__ void stage_rc(int b, int& R, int& C) { const int st = b / 1024, sb = b % 1024, swz = sb ^ (((sb >> 9) & 1) << 5); R = (st >> 1) * 16 + swz / 64; C = (st & 1) * 32 + (swz % 64) / 2; }
__host__ __device__ __forceinline__ int perm32(int rho) { const int n = rho >> 4, i = rho & 15; return 8 * (i >> 2) + 4 * n + (i & 3); }

struct Unit { int pm, pn; };
struct Gemm { const bf16_t* A; const bf16_t* Bt; int M, N, K, lda, ldb, acol; };

struct StaticOrder {
    int nM, nN, nwg, G, c;
    __host__ __device__ void init(int M, int N, int G_, int c_) { nM = M / BM; nN = N / BM; nwg = nM * nN; G = G_; c = c_; }
    __host__ __device__ bool next(int i, Unit& u) const {
        const long L = (long)i * G + c; if (L >= nwg) return false;
        int wgid = (int)L; { const int q = nwg / NXCD, r = nwg % NXCD, xcd = wgid % NXCD, off = wgid / NXCD; wgid = (xcd < r ? xcd * (q + 1) : r * (q + 1) + (xcd - r) * q) + off; }
        const int nig = WGM * nN, gid = wgid / nig, fm = gid * WGM, gsz = (nM - fm) < WGM ? (nM - fm) : WGM;
        u.pm = fm + ((wgid % nig) % gsz); u.pn = (wgid % nig) / gsz; return true;
    }
    __device__ __forceinline__ void a_ready(const Unit&) const {}
    __device__ __forceinline__ void done(const Unit&) const {}
};

template <class Epi, class Sched, bool ALIGN_EPI = false, bool SP2 = false>
__device__ __forceinline__ void gemm_phase(PG8_LAS unsigned char* lds, const Gemm g, const Sched& S, const Epi& E) {
    int tid_ = threadIdx.x; asm volatile("" : "+v"(tid_)); const int tid = tid_, wid = __builtin_amdgcn_readfirstlane(tid >> 6), lane = tid & 63, wr = wid >> 2, wc = wid & 3, fr = lane & 15, fq = lane >> 4;
    const int K = g.K, nt = K / BK;
    unsigned voffA[2], voffB[2];
#pragma unroll
    for (int i = 0; i < 2; ++i) { int R, C; stage_rc(tid * 16 + i * 8192, R, C); const int Rb = Epi::PERM ? ((R & ~31) + perm32(R & 31)) : R;
        voffA[i] = (unsigned)(R * g.lda + C) * 2u; voffB[i] = (unsigned)(Rb * g.ldb + C) * 2u; }
    const size_t kstep = (size_t)(BK * 2);
    const size_t hstepA = (size_t)HALF * g.lda * 2, hstepB = (size_t)HALF * g.ldb * 2;
    const size_t tstepA = 2 * hstepA, tstepB = 2 * hstepB, acolB = (size_t)g.acol * 2;
    const unsigned ldsw = (unsigned)wid * 1024u;
    const int aoff = lds_byte(wr * 64 + fr, fq * 8), boff = lds_byte(wc * 32 + fr, fq * 8);
#define PG8_SA(b, h) (((b) * 2 + (h)) * HTB)
#define PG8_SB(b, h) ((4 + (b) * 2 + (h)) * HTB)
#define PG8_STAGE(bufoff, gbase, voff) do { _Pragma("unroll") for (int _i = 0; _i < 2; ++_i) \
        __builtin_amdgcn_global_load_lds((const unsigned*)((const char*)(gbase) + (voff)[_i]), (PG8_LAS unsigned*)(lds + (bufoff) + ldsw + _i * 8192), 16, 0, 0); } while (0)
#define PG8_LDA(dst, b, h) do { _Pragma("unroll") for (int m = 0; m < 4; ++m) _Pragma("unroll") for (int k = 0; k < 2; ++k) dst[m][k] = *(const PG8_LAS bf16x8*)(lds + PG8_SA(b, h) + aoff + m * 2048 + k * 1024); } while (0)
#define PG8_LDB(dst, b, h) do { _Pragma("unroll") for (int n = 0; n < 2; ++n) _Pragma("unroll") for (int k = 0; k < 2; ++k) dst[n][k] = *(const PG8_LAS bf16x8*)(lds + PG8_SB(b, h) + boff + n * 2048 + k * 1024); } while (0)
#define PG8_MMA(ai, bj, At, Bt) do { __builtin_amdgcn_s_setprio(1); _Pragma("unroll") for (int m = 0; m < 4; ++m) _Pragma("unroll") for (int n = 0; n < 2; ++n) _Pragma("unroll") for (int k = 0; k < 2; ++k) \
        acc[ai][bj][m][n] = __builtin_amdgcn_mfma_f32_16x16x32_bf16(Bt[n][k], At[m][k], acc[ai][bj][m][n], 0, 0, 0); __builtin_amdgcn_s_setprio(0); } while (0)
#define PG8_WAIT_V(n) asm volatile("s_waitcnt vmcnt(" #n ")" ::: "memory")
#define PG8_WAIT_L(n) asm volatile("s_waitcnt lgkmcnt(" #n ")" ::: "memory")
#define PG8_BAR __builtin_amdgcn_s_barrier()
#define PG8_SCHED __builtin_amdgcn_sched_barrier(0)
    Unit cur, nxt; int ui = 0;
    if (!S.next(0, cur)) return;
    f32x4 acc[2][2][4][2];
#pragma unroll
    for (int a = 0; a < 2; ++a)
#pragma unroll
        for (int b = 0; b < 2; ++b)
#pragma unroll
            for (int m = 0; m < 4; ++m)
#pragma unroll
                for (int n = 0; n < 2; ++n) acc[a][b][m][n] = (f32x4){0.f, 0.f, 0.f, 0.f};
    bf16x8 At[4][2], B0[2][2], B1[2][2];
    const char* cA = (const char*)g.A + (size_t)cur.pm * tstepA + (size_t)cur.pn * acolB; const char* cB = (const char*)g.Bt + (size_t)cur.pn * tstepB;
    S.a_ready(cur);
    if constexpr (SP2) {
        PG8_STAGE(PG8_SB(0, 0), cB, voffB); PG8_STAGE(PG8_SB(0, 1), cB + hstepB, voffB); PG8_STAGE(PG8_SA(0, 0), cA, voffA); PG8_STAGE(PG8_SA(0, 1), cA + hstepA, voffA);
        if (wr == 1) PG8_BAR;
        PG8_WAIT_V(2); PG8_BAR;
        PG8_STAGE(PG8_SB(1, 0), cB + kstep, voffB); PG8_STAGE(PG8_SA(1, 0), cA + kstep, voffA); PG8_STAGE(PG8_SB(1, 1), cB + hstepB + kstep, voffB);
        PG8_WAIT_V(6); PG8_BAR;
    } else {
        PG8_STAGE(PG8_SB(0, 0), cB, voffB); PG8_STAGE(PG8_SA(0, 0), cA, voffA); PG8_STAGE(PG8_SB(0, 1), cB + hstepB, voffB); PG8_STAGE(PG8_SA(0, 1), cA + hstepA, voffA);
        if (wr == 1) PG8_BAR;
        PG8_WAIT_V(4); PG8_BAR;
        PG8_STAGE(PG8_SB(1, 0), cB + kstep, voffB); PG8_STAGE(PG8_SA(1, 0), cA + kstep, voffA); PG8_STAGE(PG8_SB(1, 1), cB + hstepB + kstep, voffB);
        PG8_WAIT_V(6); PG8_BAR;
    }
    for (;;) {
        const bool has_next = S.next(ui + 1, nxt);
        const char* nA = has_next ? (const char*)g.A + (size_t)nxt.pm * tstepA + (size_t)nxt.pn * acolB : cA; const char* nB = has_next ? (const char*)g.Bt + (size_t)nxt.pn * tstepB : cB;
        for (int t = 0; t < nt; t += 2) {
            const bool last = (t == nt - 2);
            const char* a1 = cA + (size_t)(t + 1) * kstep;
            const char* a2 = last ? nA : cA + (size_t)(t + 2) * kstep; const char* b2 = last ? nB : cB + (size_t)(t + 2) * kstep;
            const char* a3 = a2 + kstep; const char* b3 = b2 + kstep;
            if (last && has_next) S.a_ready(nxt);
            if constexpr (SP2) {
            PG8_LDB(B0, 0, 0); PG8_LDB(B1, 0, 1); PG8_SCHED; PG8_LDA(At, 0, 0); PG8_STAGE(PG8_SA(1, 1), a1 + hstepA, voffA);
            PG8_WAIT_V(8); PG8_WAIT_L(0); PG8_BAR; PG8_MMA(0, 0, At, B0); PG8_MMA(0, 1, At, B1); PG8_BAR; PG8_SCHED;
            PG8_LDA(At, 0, 1); PG8_STAGE(PG8_SB(0, 0), b2, voffB); PG8_STAGE(PG8_SB(0, 1), b2 + hstepB, voffB); PG8_STAGE(PG8_SA(0, 0), a2, voffA);
            PG8_WAIT_V(8); PG8_WAIT_L(0); PG8_BAR; PG8_MMA(1, 0, At, B0); PG8_MMA(1, 1, At, B1); PG8_BAR; PG8_SCHED;
            PG8_LDB(B0, 1, 0); PG8_LDB(B1, 1, 1); PG8_SCHED; PG8_LDA(At, 1, 0); PG8_STAGE(PG8_SA(0, 1), a2 + hstepA, voffA);
            PG8_WAIT_V(8); PG8_WAIT_L(0); PG8_BAR; PG8_MMA(0, 0, At, B0); PG8_MMA(0, 1, At, B1); PG8_BAR; PG8_SCHED;
            PG8_LDA(At, 1, 1); PG8_STAGE(PG8_SB(1, 0), b3, voffB); PG8_STAGE(PG8_SB(1, 1), b3 + hstepB, voffB); PG8_STAGE(PG8_SA(1, 0), a3, voffA);
            PG8_WAIT_V(8); PG8_WAIT_L(0); PG8_BAR; PG8_MMA(1, 0, At, B0); PG8_MMA(1, 1, At, B1); PG8_BAR; PG8_SCHED;
            } else {
            PG8_LDB(B0, 0, 0); PG8_SCHED; PG8_LDA(At, 0, 0); PG8_STAGE(PG8_SA(1, 1), a1 + hstepA, voffA);
            PG8_WAIT_L(8); PG8_BAR; PG8_WAIT_L(0); PG8_MMA(0, 0, At, B0); PG8_BAR; PG8_SCHED;
            PG8_LDB(B1, 0, 1); PG8_STAGE(PG8_SB(0, 0), b2, voffB);
            PG8_BAR; PG8_WAIT_L(0); PG8_MMA(0, 1, At, B1); PG8_BAR;
            PG8_LDA(At, 0, 1); PG8_STAGE(PG8_SA(0, 0), a2, voffA);
            PG8_BAR; PG8_WAIT_L(0); PG8_MMA(1, 0, At, B0); PG8_BAR; PG8_SCHED;
            PG8_STAGE(PG8_SB(0, 1), b2 + hstepB, voffB);
            PG8_WAIT_V(6); PG8_BAR; PG8_MMA(1, 1, At, B1); PG8_BAR;
            PG8_LDB(B0, 1, 0); PG8_SCHED; PG8_LDA(At, 1, 0); PG8_STAGE(PG8_SA(0, 1), a2 + hstepA, voffA);
            PG8_WAIT_L(8); PG8_BAR; PG8_WAIT_L(0); PG8_MMA(0, 0, At, B0); PG8_BAR; PG8_SCHED;
            PG8_LDB(B1, 1, 1); PG8_STAGE(PG8_SB(1, 0), b3, voffB);
            PG8_BAR; PG8_WAIT_L(0); PG8_MMA(0, 1, At, B1); PG8_BAR;
            PG8_LDA(At, 1, 1); PG8_STAGE(PG8_SA(1, 0), a3, voffA);
            PG8_BAR; PG8_WAIT_L(0); PG8_MMA(1, 0, At, B0); PG8_BAR; PG8_SCHED;
            PG8_STAGE(PG8_SB(1, 1), b3 + hstepB, voffB);
            PG8_WAIT_V(6); PG8_BAR; PG8_MMA(1, 1, At, B1); PG8_BAR;
            }
        }
        if constexpr (ALIGN_EPI) { if (wr == 0) PG8_BAR; }
        if constexpr (!Epi::AFTER_DRAIN) { E(acc, cur, wr, wc, fr, fq); S.done(cur); }
        if (!has_next) break;
#pragma unroll
        for (int a = 0; a < 2; ++a)
#pragma unroll
            for (int b = 0; b < 2; ++b)
#pragma unroll
                for (int m = 0; m < 4; ++m)
#pragma unroll
                    for (int n = 0; n < 2; ++n) acc[a][b][m][n] = (f32x4){0.f, 0.f, 0.f, 0.f};
        cur = nxt; cA = nA; cB = nB; ++ui;
        if constexpr (ALIGN_EPI) { if (wr == 1) PG8_BAR; }
    }
    PG8_WAIT_V(0);
    if constexpr (!ALIGN_EPI) { if (wr == 0) PG8_BAR; }
    PG8_BAR;
    if constexpr (Epi::AFTER_DRAIN) { E.fused(acc, cur, wr, wc, fr, fq, lds, wid, lane); S.done(cur); }
#undef PG8_SA
#undef PG8_SB
#undef PG8_STAGE
#undef PG8_LDA
#undef PG8_LDB
#undef PG8_MMA
#undef PG8_WAIT_V
#undef PG8_WAIT_L
#undef PG8_BAR
#undef PG8_SCHED
}
}
namespace pg8 {
__device__ __forceinline__ unsigned cvt_pk_bf16(float lo, float hi) { unsigned r; asm volatile("v_cvt_pk_bf16_f32 %0, %1, %2" : "=v"(r) : "v"(lo), "v"(hi)); return r; }
struct EpiF32 {
    static constexpr bool PERM = false, AFTER_DRAIN = false;
    float* C; int ldc;
    __device__ __forceinline__ void operator()(const f32x4 (&acc)[2][2][4][2], const Unit& u, int wr, int wc, int, int) const {
        int ln_ = threadIdx.x & 63; asm volatile("" : "+v"(ln_)); const int fr = ln_ & 15, fq = ln_ >> 4;
        const int row0 = u.pm * BM + wr * 64 + fr, col0 = u.pn * BM + wc * 32 + 4 * fq;
#pragma unroll
        for (int ai = 0; ai < 2; ++ai)
#pragma unroll
            for (int m = 0; m < 4; ++m) { float* rowp = C + (size_t)(row0 + ai * HALF + m * 16) * ldc + col0;
#pragma unroll
                for (int bj = 0; bj < 2; ++bj)
#pragma unroll
                    for (int n = 0; n < 2; ++n) *(f32x4*)(rowp + bj * HALF + n * 16) = acc[ai][bj][m][n]; }
    }
};
struct EpiResid {
    static constexpr bool PERM = false, AFTER_DRAIN = false;
    float* X; int ldc; float alpha;
    __device__ __forceinline__ void operator()(const f32x4 (&acc)[2][2][4][2], const Unit& u, int wr, int wc, int, int) const {
        int ln_ = threadIdx.x & 63; asm volatile("" : "+v"(ln_)); const int fr = ln_ & 15, fq = ln_ >> 4;
        const int row0 = u.pm * BM + wr * 64 + fr, col0 = u.pn * BM + wc * 32 + 4 * fq;
#pragma unroll
        for (int ai = 0; ai < 2; ++ai)
#pragma unroll
            for (int m = 0; m < 4; ++m) { float* rowp = X + (size_t)(row0 + ai * HALF + m * 16) * ldc + col0;
#pragma unroll
                for (int bj = 0; bj < 2; ++bj) { const f32x4 o0 = *(const f32x4*)(rowp + bj * HALF), o1 = *(const f32x4*)(rowp + bj * HALF + 16);
                    *(f32x4*)(rowp + bj * HALF) = o0 * alpha + acc[ai][bj][m][0]; *(f32x4*)(rowp + bj * HALF + 16) = o1 * alpha + acc[ai][bj][m][1];
                    asm volatile("" ::: "memory"); } }
    }
};
struct EpiAB {
    static constexpr bool PERM = false, AFTER_DRAIN = false;
    unsigned char* ws; float* out; int j;
    __device__ __forceinline__ void operator()(const f32x4 (&acc)[2][2][4][2], const Unit& u, int wr, int wc, int, int) const {
        int ln_ = threadIdx.x & 63; asm volatile("" : "+v"(ln_)); const int fr = ln_ & 15, fq = ln_ >> 4;
        const int row0 = u.pm * BM + wr * 64 + fr, pn = u.pn, cl0 = wc * 32 + 4 * fq;
        const float qs = 0.08838834764831845f * 1.4426950408889634f;
#pragma unroll
        for (int ai = 0; ai < 2; ++ai)
#pragma unroll
            for (int m = 0; m < 4; ++m) { const size_t row = (size_t)(row0 + ai * HALF + m * 16);
#pragma unroll
                for (int bj = 0; bj < 2; ++bj)
#pragma unroll
                    for (int n = 0; n < 2; ++n) { const f32x4 v = acc[ai][bj][m][n]; const int cl = cl0 + bj * HALF + n * 16;
                        if (pn < 4) { u32x2 w; w.x = cvt_pk_bf16(v[0] * qs, v[1] * qs); w.y = cvt_pk_bf16(v[2] * qs, v[3] * qs); *(u32x2*)((bf16_t*)(ws + WS_QB) + row * 1024 + pn * 256 + cl) = w; }
                        else if (pn == 4) { *(f32x4*)(out + O_KP + ((size_t)j * MPR + row) * 256 + cl) = v; u32x2 w; w.x = cvt_pk_bf16(v[0], v[1]); w.y = cvt_pk_bf16(v[2], v[3]); *(u32x2*)((bf16_t*)(ws + WS_KB) + row * 256 + cl) = w; }
                        else if (pn == 5) { *(f32x4*)(out + O_VP + ((size_t)j * MPR + row) * 256 + cl) = v; u32x2 w; w.x = cvt_pk_bf16(v[0], v[1]); w.y = cvt_pk_bf16(v[2], v[3]); *(u32x2*)((bf16_t*)(ws + WS_VB) + row * 256 + cl) = w; }
                        else if (pn < 8) { u32x2 w; w.x = cvt_pk_bf16(v[0], v[1]); w.y = cvt_pk_bf16(v[2], v[3]); *(u32x2*)((bf16_t*)(ws + WS_QIB) + row * 512 + (pn - 6) * 256 + cl) = w; }
                        else { *(f32x4*)((float*)(ws + WS_H) + row * HC_AB + pn * 256 + cl) = v;
                            if (pn == 18 && cl < 64) { *(f32x4*)(out + O_IP + ((size_t)j * MPR + row) * 64 + cl) = v; u32x2 w; w.x = cvt_pk_bf16(v[0], v[1]); w.y = cvt_pk_bf16(v[2], v[3]); *(u32x2*)((bf16_t*)(ws + WS_KIB) + row * 64 + cl) = w; } } }
            }
    }
};
template <int ACT  > struct EpiBf16 {
    static constexpr bool PERM = true, AFTER_DRAIN = false;
    bf16_t* O; int ldc; const float* scale;
    __device__ __forceinline__ void operator()(const f32x4 (&acc)[2][2][4][2], const Unit& u, int wr, int wc, int, int) const {
        int ln_ = threadIdx.x & 63; asm volatile("" : "+v"(ln_)); const int fr = ln_ & 15, fq = ln_ >> 4;
        const int row0 = u.pm * BM + wr * 64 + fr, col0 = u.pn * BM + wc * 32 + 8 * fq;
        f32x4 sv[2][2];
#pragma unroll
        for (int bj = 0; bj < 2; ++bj)
#pragma unroll
            for (int n = 0; n < 2; ++n) sv[bj][n] = (ACT == 0) ? *(const f32x4*)(scale + col0 + bj * HALF + 4 * n) : (f32x4){1.f, 1.f, 1.f, 1.f};
#pragma unroll
        for (int ai = 0; ai < 2; ++ai)
#pragma unroll
            for (int m = 0; m < 4; ++m) { bf16_t* rowp = O + (size_t)(row0 + ai * HALF + m * 16) * ldc + col0;
#pragma unroll
                for (int bj = 0; bj < 2; ++bj) { f32x4 v0 = acc[ai][bj][m][0], v1 = acc[ai][bj][m][1];
                    if (ACT == 0) { v0 = v0 * sv[bj][0]; v1 = v1 * sv[bj][1]; }
                    if (ACT == 1) {
#pragma unroll
                        for (int q = 0; q < 4; ++q) { const float a = fmaxf(v0[q], 0.f), b = fmaxf(v1[q], 0.f); v0[q] = a * a; v1[q] = b * b; } }
                    u32x4 w; w.x = cvt_pk_bf16(v0[0], v0[1]); w.y = cvt_pk_bf16(v0[2], v0[3]); w.z = cvt_pk_bf16(v1[0], v1[1]); w.w = cvt_pk_bf16(v1[2], v1[3]);
                    *(u32x4*)(rowp + bj * HALF) = w; } }
    }
};
}
#define LAS __attribute__((address_space(3)))
#define XB_TMO      128
#define XB_XCNT(j)  (256  + 64 * (j))
#define XB_XSUB(j)  (1280 + 64 * (j))
#define XB_XGEN(j)  (2304 + 64 * (j))
#define XB_TOP      3328
#define XB_TOPGEN   3392
#define XCD_BAR_WORDS 3456
#define XB_SPIN_CAP (1u << 18)

__device__ __forceinline__ unsigned xb_ld(unsigned* p)              { return __hip_atomic_load(p, __ATOMIC_RELAXED, __HIP_MEMORY_SCOPE_AGENT); }
__device__ __forceinline__ unsigned xb_add(unsigned* p, unsigned v) { return __hip_atomic_fetch_add(p, v, __ATOMIC_RELAXED, __HIP_MEMORY_SCOPE_AGENT); }
__device__ __forceinline__ unsigned xb_xcc_id() { return (unsigned)__builtin_amdgcn_s_getreg((3 << 11) | 20) & 0xFu; }
#define XB_SPIN(cond, bar) do { unsigned _sp = 0; while (cond) { __builtin_amdgcn_s_sleep(1); \
    if ((++_sp & 255u) == 0u) { if (xb_ld(&(bar)[XB_TMO])) break; if (_sp > XB_SPIN_CAP) { atomicAdd(&(bar)[XB_TMO], 1u); break; } } } } while (0)

struct XcdBarrier {
    unsigned* bar; unsigned x;
    volatile LAS unsigned* st;
};

__device__ __forceinline__ XcdBarrier xcd_barrier_post(unsigned* bar, volatile LAS unsigned* st) {
    XcdBarrier b; b.bar = bar; b.x = xb_xcc_id(); b.st = st;
    if (threadIdx.x == 0) (void)xb_add(&bar[XB_XCNT(b.x)], 1u);
    return b;
}
__device__ __forceinline__ void xcd_barrier_complete(unsigned* bar, unsigned x, unsigned& nloc, unsigned& nx) {
    const unsigned G = gridDim.x * gridDim.y * gridDim.z;
    unsigned sum, cnt, mine, sp = 0u;
    for (;;) {
        sum = 0u; cnt = 0u; mine = 0u;
#pragma unroll
        for (unsigned j = 0; j < 16; ++j) { const unsigned c = xb_ld(&bar[XB_XCNT(j)]); sum += c; cnt += (c > 0u) ? 1u : 0u; mine = (j == x) ? c : mine; }
        if (sum == G) break;
        __builtin_amdgcn_s_sleep(1);
        if ((++sp & 255u) == 0u) { if (xb_ld(&bar[XB_TMO])) break; if (sp > XB_SPIN_CAP) { atomicAdd(&bar[XB_TMO], 1u); break; } }
    }
    nloc = mine > 0u ? mine : 1u; nx = cnt > 0u ? cnt : 1u;
}

__device__ __attribute__((noinline)) void xcd_barrier_impl(unsigned* bar_, unsigned bx_, volatile LAS unsigned* st_) {
    XcdBarrier b; b.bar = bar_; b.x = bx_; b.st = st_;
    asm volatile("s_waitcnt vmcnt(0)" ::: "memory");
    __syncthreads();
    if (threadIdx.x == 0) {
        unsigned* bar = b.bar;
        __builtin_amdgcn_s_waitcnt(0);
        unsigned nloc = b.st[0], nx = b.st[1];
        if (nloc == 0u) { xcd_barrier_complete(bar, b.x, nloc, nx); b.st[0] = nloc; b.st[1] = nx; }
        const unsigned old = xb_add(&bar[XB_XSUB(b.x)], 1u);
        const unsigned gen = old / nloc;
        if (old + 1u == (gen + 1u) * nloc) {
            __builtin_amdgcn_fence(__ATOMIC_RELEASE, "agent");
            asm volatile("s_waitcnt vmcnt(0)" ::: "memory");
            const unsigned og = xb_add(&bar[XB_TOP], 1u);
            const unsigned tg = og / nx;
            if (og + 1u == (tg + 1u) * nx) xb_add(&bar[XB_TOPGEN], 1u);
            else XB_SPIN(xb_ld(&bar[XB_TOPGEN]) == tg, bar);
            __builtin_amdgcn_fence(__ATOMIC_ACQUIRE, "agent");
            xb_add(&bar[XB_XGEN(b.x)], 1u);
            asm volatile("s_waitcnt vmcnt(0)" ::: "memory");
        } else {
            XB_SPIN(xb_ld(&bar[XB_XGEN(b.x)]) == gen, bar);
            __builtin_amdgcn_fence(__ATOMIC_ACQUIRE, "agent");
            asm volatile("s_waitcnt vmcnt(0)" ::: "memory");
        }
    }
    __syncthreads();
}
__device__ __forceinline__ void xcd_barrier(const XcdBarrier& b) { xcd_barrier_impl(b.bar, b.x, b.st); }
constexpr int NWAVES = 8;
constexpr int RING_BYTES = 131072, LDSCTL_OFF = RING_BYTES, MISC_OFF = LDSCTL_OFF + 320, LDS_BYTES = 147456;
constexpr size_t CTL_ZERO_BYTES = 1u << 20;
constexpr int CW_BAR = 4096;
constexpr int PH_PER_LAYER = 12, N_PHASES = 1 + 4 * PH_PER_LAYER;

DEVI void tr_item(const float* W, int K, int N, bf16* WT, int abmap, int item, float* scr, int lane) {
    const int nblk = (N + 63) >> 6, kb = item / nblk, nb = item - kb * nblk, k0 = 64 * kb, n0 = 64 * nb;
    const int g4 = lane & 15, kr = lane >> 4; const bool ok = n0 + 4 * g4 < N;
    const float* src = W + (size_t)(k0 + kr) * N + n0 + 4 * g4;
    f32x4 v[16];
#pragma unroll
    for (int i = 0; i < 16; ++i) v[i] = ok ? *(const f32x4*)(src + (size_t)(4 * i) * N) : (f32x4){0.f, 0.f, 0.f, 0.f};
#pragma unroll
    for (int i = 0; i < 16; ++i) { const int k = 4 * i + kr; *(f32x4*)(scr + k * 64 + ((g4 ^ (k >> 3)) << 2)) = v[i]; }
    asm volatile("s_waitcnt lgkmcnt(0)" ::: "memory");
    const int c = lane & 7;
#pragma unroll
    for (int jj = 0; jj < 8; ++jj) { const int n = (lane >> 3) + 8 * jj; const float* s = scr + (8 * c) * 64 + ((((n >> 2) ^ c) << 2) | (n & 3));
        if (n0 + n < N) { const int row = abmap ? ab_dst_col(n0 + n) : n0 + n;
            u32x4 o; o.x = cvtpk(s[0], s[64]); o.y = cvtpk(s[2 * 64], s[3 * 64]); o.z = cvtpk(s[4 * 64], s[5 * 64]); o.w = cvtpk(s[6 * 64], s[7 * 64]);
            *(u32x4*)(WT + (size_t)row * K + k0 + 8 * c) = o; } }
    asm volatile("s_waitcnt lgkmcnt(0)" ::: "memory");
}
DEVI void tr_job(const float* W, int K, int N, bf16* WT, int abmap, int vb, int nvb, float* t) {
    const int tid = ltid(), lane = tid & 63, wv = tid >> 6; float* scr = t + wv * 4096;
    const int items = (K >> 6) * ((N + 63) >> 6);
    for (int it = wv * nvb + vb; it < items; it += 8 * nvb) tr_item(W, K, N, WT, abmap, it, scr, lane);
}
DEVI void ph_prologue(CP p, int vb, int nvb, float* t) {
    bf16 *WINAB = wsb(p, WS_WINAB), *WOUTAB = wsb(p, WS_WOUTAB), *WINCD = wsb(p, WS_WINCD), *WOUTCD = wsb(p, WS_WOUTCD), *WFF1 = wsb(p, WS_WFF1), *WFF2 = wsb(p, WS_WFF2), *POOLW = wsb(p, WS_POOLW);
    for (int j = 0; j < 2; ++j) {
        tr_job(p->w_in_ab + (size_t)j * DM * 4696, DM, 4696, WINAB + (size_t)j * HC_AB * DM, 1, vb, nvb, t);
        tr_job(p->w_out_ab + (size_t)j * DM * DM, DM, DM, WOUTAB + (size_t)j * DM * DM, 0, vb, nvb, t);
        tr_job(p->w_in_cd + (size_t)j * DM * HC_CD, DM, HC_CD, WINCD + (size_t)j * HC_CD * DM, 0, vb, nvb, t);
        tr_job(p->w_out_cd + (size_t)j * DM * DM, DM, DM, WOUTCD + (size_t)j * DM * DM, 0, vb, nvb, t);
        tr_job(p->pool_w + (size_t)j * 4 * 65536, 256, 256, POOLW + (size_t)j * 4 * 65536, 0, vb, nvb, t);
        tr_job(p->pool_w + ((size_t)j * 4 + 1) * 65536, 256, 256, POOLW + ((size_t)j * 4 + 1) * 65536, 0, vb, nvb, t);
        tr_job(p->pool_w + ((size_t)j * 4 + 2) * 65536, 256, 256, POOLW + ((size_t)j * 4 + 2) * 65536, 0, vb, nvb, t);
        tr_job(p->pool_w + ((size_t)j * 4 + 3) * 65536, 256, 256, POOLW + ((size_t)j * 4 + 3) * 65536, 0, vb, nvb, t);
    }
    for (int i = 0; i < 4; ++i) {
        tr_job(p->w_ff1 + (size_t)i * DM * DFF, DM, DFF, WFF1 + (size_t)i * DFF * DM, 0, vb, nvb, t);
        tr_job(p->w_ff2 + (size_t)i * DFF * DM, DFF, DM, WFF2 + (size_t)i * DM * DFF, 0, vb, nvb, t);
    }
    const size_t gt = (size_t)vb * 512 + ltid(), ng = (size_t)nvb * 512;
    for (size_t i = gt; i < (size_t)2 * (HC_AB - 4696) * DM / 8; i += ng) { const size_t per = (size_t)(HC_AB - 4696) * DM / 8; const size_t j = i / per, r = i % per;
        *(u32x4*)(WINAB + j * HC_AB * DM + (size_t)4696 * DM + r * 8) = (u32x4){0u, 0u, 0u, 0u}; }
    bf16* sw = wsb(p, WS_SGUW);
    for (size_t i = gt; i < 2 * 4 * 128 * 128; i += ng) { const int s = (int)i & 127, tt = ((int)i >> 7) & 127; sw[i] = f2bf(s <= tt ? p->sgu_w[i] : 0.f); }
    float* X = wsf(p, WS_X); bf16* XB = wsb(p, WS_XB);
    for (size_t i = gt; i < (size_t)MP * DM / 4; i += ng) {
        const size_t e = i * 4; const int row = (int)(e / DM);
        f32x4 v = (f32x4){0.f, 0.f, 0.f, 0.f};
        if (row < MPR) v = *(const f32x4*)(p->x_prompt + e); else if (row < MR) v = *(const f32x4*)(p->x_sample + (e - (size_t)MPR * DM));
        *(f32x4*)(X + e) = v; uint2 o; o.x = pk2(v.x, v.y); o.y = pk2(v.z, v.w); *(uint2*)(XB + e) = o;
    }
}

enum { SE_F32 = 0, SE_RESID = 1, SE_RELU2 = 2, SE_SCALE = 3 };
template <int SE> DEVI void skinny_gemm(const bf16* A  , int lda, int acol, const bf16* Bt, int ldb, int N, int K, float* red, int vb, int nvb, float* Cf, bf16* Cb, int ldc, const float* scale) {
    const int tid = ltid(), lane = tid & 63, wv = tid >> 6, fr = lane & 15, fq = lane >> 4;
    const int kw = K >> 3, ks0 = wv * kw;
    for (int u = vb; u < (N >> 4); u += nvb) {
        const int n0 = u * 16, pn = n0 >> 8;
        const bf16* bp = Bt + (size_t)(n0 + fr) * ldb + ks0 + fq * 8; const bf16* ap = A + (size_t)fr * lda + (size_t)pn * acol + ks0 + fq * 8;
        f32x4 acc[4];
#pragma unroll
        for (int mt = 0; mt < 4; ++mt) acc[mt] = (f32x4){0.f, 0.f, 0.f, 0.f};
#pragma unroll 4
        for (int k = 0; k < kw; k += 32) { const bf16x8 bf = *(const bf16x8*)(bp + k);
#pragma unroll
            for (int mt = 0; mt < 4; ++mt) acc[mt] = mfma16(bf, *(const bf16x8*)(ap + (size_t)mt * 16 * lda + k), acc[mt]); }
#pragma unroll
        for (int mt = 0; mt < 4; ++mt) *(f32x4*)(red + (wv * 64 + mt * 16 + fr) * 16 + 4 * fq) = acc[mt];
        __syncthreads();
        { const int r = tid >> 3, c = (tid & 7) * 2; float v0 = 0.f, v1 = 0.f;
#pragma unroll
          for (int w = 0; w < 8; ++w) { const float* q = red + (w * 64 + r) * 16 + c; v0 += q[0]; v1 += q[1]; }
          const size_t o = (size_t)r * ldc + n0 + c;
          if (SE == SE_F32) { Cf[o] = v0; Cf[o + 1] = v1; }
          if (SE == SE_RESID) { Cf[o] = ALPHA * Cf[o] + v0; Cf[o + 1] = ALPHA * Cf[o + 1] + v1; }
          if (SE == SE_RELU2) { const float a = fmaxf(v0, 0.f), b = fmaxf(v1, 0.f); *(unsigned*)(Cb + o) = cvtpk(a * a, b * b); }
          if (SE == SE_SCALE) *(unsigned*)(Cb + o) = cvtpk(v0 * scale[n0 + c], v1 * scale[n0 + c + 1]); }
        __syncthreads();
    }
}
template <class Epi> DEVI void run_gemm(PG8_LAS unsigned char* lds, const bf16* A, int lda, int acol, const bf16* Bt, int ldb, int M, int N, int K, const Epi& E) {
    asm volatile("" : "+s"(K));
    pg8::Gemm g{A, Bt, M, N, K, lda, ldb, acol}; pg8::StaticOrder S; S.init(M, N, (int)gridDim.x, lvb());
    pg8::gemm_phase<Epi, pg8::StaticOrder, true, true>(lds, g, S, E);
}

#ifndef REP_AB1
#define REP_AB1 1
#endif
#ifndef REP_AB2
#define REP_AB2 1
#endif
#ifndef REP_AB3
#define REP_AB3 1
#endif
#ifndef REP_CD1
#define REP_CD1 1
#endif
#ifndef REP_CD2
#define REP_CD2 1
#endif
#ifndef REP_FF1
#define REP_FF1 1
#endif
#ifndef REP_INP
#define REP_INP 1
#endif
#ifndef REP_SSD3
#define REP_SSD3 1
#endif
#define IN(k) (lo <= (k) && (k) < hi)
#define SEAM(k) do { if (IN(k) && (k) + 1 < hi) xcd_barrier(bar); } while (0)
template <int I> DEVI void layer_phases(LAS unsigned char* L, unsigned char* lds, const XcdBarrier& bar, int lo, int hi, int nvb) {
    constexpr int base = 1 + PH_PER_LAYER * I, j = I >> 1;
    float* smf = (float*)lds; int* smi = (int*)lds;
    if constexpr ((I & 1) == 0) {
        if (IN(base + 0)) { CP p = PP(); run_gemm(L, wsb(p, WS_XB), DM, 0, wsb(p, WS_WINAB) + (size_t)j * HC_AB * DM, DM, MPR, HC_AB, DM, pg8::EpiAB{p->ws, p->out, j});
            skinny_gemm<SE_F32>(wsb(p, WS_XB) + (size_t)MPR * DM, DM, 0, wsb(p, WS_WINAB) + (size_t)j * HC_AB * DM, DM, HC_AB, DM, smf, lvb(), nvb, wsf(p, WS_H) + (size_t)MPR * HC_AB, nullptr, HC_AB, nullptr); }
        SEAM(base + 0);
        if (IN(base + 1)) {
            for (int rep_ = 0; rep_ < REP_AB1; ++rep_) {
            ph_ab_copy(PP(), j, lvb(), nvb);
            for (int u = lvb(); u < 64 * 24; u += nvb) conv_prompt_unit(PP(), j, u / 24, u % 24, (bf16*)lds);
            ph_conv(PP(), j, lvb(), nvb);
            ph_idx_prompt(PP(), lvb(), nvb);
            ph_idx_sample(PP(), j, lvb(), nvb);
                    if (rep_ + 1 < REP_AB1) { asm volatile("s_waitcnt vmcnt(0)" ::: "memory"); __syncthreads(); } }
        }
        SEAM(base + 1);
        if (IN(base + 2)) {
            for (int rep_ = 0; rep_ < REP_AB2; ++rep_) {
            if (nvb == 256) {
                if (lvb() >= 192) { select_sample_unit(PP(), lvb() - 192, smi);
                    { const int t_ = ltid(), u = (t_ >> 6) * 64 + (lvb() - 192); if (u < DB * 32) ssd_seq_unit(PP(), j, NBP + u / 32, (u >> 1) & 15, u & 1, t_ & 63); } }
                else { ph_select_prompt(PP(), lvb(), 192); for (int u = lvb(); u < 64 * 16; u += 192) ssd1_unit(PP(), j, u >> 4, u & 15, smf); }
            } else {
                ph_select_prompt(PP(), lvb(), nvb);
                for (int u = lvb(); u < MSR; u += nvb) select_sample_unit(PP(), u, smi);
                for (int u = lvb(); u < 64 * 16; u += nvb) ssd1_unit(PP(), j, u >> 4, u & 15, smf);
                { const int t_ = ltid(), u = (t_ >> 6) * nvb + lvb(); if (u < DB * 32) ssd_seq_unit(PP(), j, NBP + u / 32, (u >> 1) & 15, u & 1, t_ & 63); }
            }
                    if (rep_ + 1 < REP_AB2) { asm volatile("s_waitcnt vmcnt(0)" ::: "memory"); __syncthreads(); } }
        }
        SEAM(base + 2);
        if (IN(base + 3)) {
            for (int rep_ = 0; rep_ < REP_AB3; ++rep_) {
            ph_ssd_scan(PP(), j, lvb(), nvb);
            for (int u = lvb(); u < 2 * MSR; u += nvb) attn_sample_unit(PP(), j, u >> 1, u & 1, lds);
            ph_ssd_gate(PP(), j, lvb(), nvb);
                    if (rep_ + 1 < REP_AB3) { asm volatile("s_waitcnt vmcnt(0)" ::: "memory"); __syncthreads(); } }
        }
        SEAM(base + 3);
        if (IN(base + 4)) {
#ifdef EXP_ATT
            ph_attn_prompt_naive(PP(), lvb(), nvb);
            for (int u = lvb(); u < 256; u += nvb) attn_unit(PP(), (u >> 3) & 1, u & 7, u >> 4, lds, wsb(PP(), WS_HF));
#else
            for (int u = lvb(); u < 256; u += nvb) attn_unit(PP(), (u >> 3) & 1, u & 7, u >> 4, lds, wsb(PP(), WS_AO));
#endif
#ifdef DUP_ATT
            for (int u = lvb(); u < 256; u += nvb) attn_unit(PP(), (u >> 3) & 1, u & 7, u >> 4, lds, wsb(PP(), WS_AO));
#endif
#ifdef EXP_OLDY
            for (int u = lvb(); u < 64 * 8; u += nvb) ssd3_unit(PP(), j, u >> 3, u & 7, smf, wsb(PP(), WS_HF));
#else
            if (nvb == 256) {
                const int vb_ = lvb(), qb_ = vb_ >> 4, n_ = (0x0001112222333444ull >> (4 * qb_)) & 15, off_ = (qb_ < 3 ? 4 * qb_ : qb_ < 6 ? 12 + 3 * (qb_ - 3) : qb_ < 10 ? 21 + 2 * (qb_ - 6) : qb_ < 13 ? 29 + (qb_ - 10) : 32);
                for (int i = 0; i < n_; ++i) { const int u = off_ * 16 + (vb_ & 15) * n_ + i; ssd3_unit(PP(), j, u >> 3, u & 7, smf, wsb(PP(), WS_AO)); }
            } else for (int u = lvb(); u < 64 * 8; u += nvb) ssd3_unit(PP(), j, u >> 3, u & 7, smf, wsb(PP(), WS_AO));
#endif
        }
        SEAM(base + 4);
#ifdef EXP_ATT
        if (IN(base + 5) && I == 0) { CP p = PP(); diag_cmp(p, 0, wsb(p, WS_AO), DM, wsb(p, WS_HF), DM, MPR, 1024, lvb(), nvb); }
#endif
#ifdef EXP_OLDY
        if (IN(base + 5) && I == 0) { CP p = PP(); const int vb_ = lvb();
            diag_cmp_f32(p, 0, wsf(p, WS_XC), 1536, wsb(p, WS_XCN), 1536, MPR, 1536, vb_, nvb);
            diag_fin_f32(p, 1, wsf(p, WS_ACUM), (size_t)64 * 16 * 128, vb_, nvb);
            diag_fin_f32(p, 2, wsf(p, WS_DTC), (size_t)64 * 16 * 128, vb_, nvb);
            diag_fin_bf16(p, 3, wsb(p, WS_HIN), (size_t)64 * 16 * 8192, vb_, nvb);
            diag_fin_bf16(p, 4, wsb(p, WS_XCT), (size_t)64 * 1536 * 128, vb_, nvb);
            diag_cmp(p, 5, wsb(p, WS_AO) + 1024, DM, wsb(p, WS_HF) + 1024, DM, MPR, 1024, vb_, nvb); }
#endif
        if (IN(base + 5)) { CP p = PP(); run_gemm(L, wsb(p, WS_AO), DM, 0, wsb(p, WS_WOUTAB) + (size_t)j * DM * DM, DM, MPR, DM, DM, pg8::EpiResid{wsf(p, WS_X), DM, ALPHA});
            skinny_gemm<SE_RESID>(wsb(p, WS_AO) + (size_t)MPR * DM, DM, 0, wsb(p, WS_WOUTAB) + (size_t)j * DM * DM, DM, DM, DM, smf, lvb(), nvb, wsf(p, WS_X) + (size_t)MPR * DM, nullptr, DM, nullptr); }
        SEAM(base + 5);
    } else {
        if (IN(base + 0)) { CP p = PP(); run_gemm(L, wsb(p, WS_XB), DM, 0, wsb(p, WS_WINCD) + (size_t)j * HC_CD * DM, DM, MPR, HC_CD, DM, pg8::EpiF32{wsf(p, WS_H), HC_CD});
            skinny_gemm<SE_F32>(wsb(p, WS_XB) + (size_t)MPR * DM, DM, 0, wsb(p, WS_WINCD) + (size_t)j * HC_CD * DM, DM, HC_CD, DM, smf, lvb(), nvb, wsf(p, WS_H) + (size_t)MPR * HC_CD, nullptr, HC_CD, nullptr); }
        SEAM(base + 0);
        if (IN(base + 1)) for (int rep_ = 0; rep_ < REP_CD1; ++rep_) ph_cd_prep(PP(), j, lvb(), nvb);
        SEAM(base + 1);
        if (IN(base + 2)) {
            for (int rep_ = 0; rep_ < REP_CD2; ++rep_) {
            { CP p = PP(); run_gemm(L, wsb(p, WS_DD), 1024, 256, wsb(p, WS_POOLW) + (size_t)j * 4 * 65536, 256, MPR, 1024, 256, pg8::EpiBf16<0>{wsb(p, WS_AO), DM, p->pool_scale + (size_t)j * 1024});
              skinny_gemm<SE_SCALE>(wsb(p, WS_DD) + (size_t)MPR * 1024, 1024, 256, wsb(p, WS_POOLW) + (size_t)j * 4 * 65536, 256, 1024, 256, smf, lvb(), nvb, nullptr, wsb(p, WS_AO) + (size_t)MPR * DM, DM, p->pool_scale + (size_t)j * 1024); }
            for (int u = lvb(); u < 64 * 16; u += nvb) sgu_unit(PP(), j, u >> 4, (u >> 2) & 3, u & 3, (bf16*)lds);
            ph_sgu_naive(PP(), j, lvb(), nvb);
                    if (rep_ + 1 < REP_CD2) { asm volatile("s_waitcnt vmcnt(0)" ::: "memory"); __syncthreads(); } }
        }
        if (IN(base + 2) && base + 5 < hi) xcd_barrier(bar);
        if (IN(base + 5)) { CP p = PP(); run_gemm(L, wsb(p, WS_AO), DM, 0, wsb(p, WS_WOUTCD) + (size_t)j * DM * DM, DM, MPR, DM, DM, pg8::EpiResid{wsf(p, WS_X), DM, ALPHA});
            skinny_gemm<SE_RESID>(wsb(p, WS_AO) + (size_t)MPR * DM, DM, 0, wsb(p, WS_WOUTCD) + (size_t)j * DM * DM, DM, DM, DM, smf, lvb(), nvb, wsf(p, WS_X) + (size_t)MPR * DM, nullptr, DM, nullptr); }
        SEAM(base + 5);
    }
#ifdef EXP_OLDY
    if (IN(base + 6) && I == 0) diag_report(PP(), 6);
#endif
#ifdef EXP_ATT
    if (IN(base + 6) && I == 0) diag_report(PP(), 1);
#endif
    if (IN(base + 6)) { CP p = PP(); ph_ln(p, p->ln1_g + (size_t)I * DM, p->ln1_b + (size_t)I * DM, 0, lvb(), nvb); }
    SEAM(base + 6);
    if (IN(base + 7)) for (int rep_ = 0; rep_ < REP_FF1; ++rep_) { CP p = PP(); run_gemm(L, wsb(p, WS_XB), DM, 0, wsb(p, WS_WFF1) + (size_t)I * DFF * DM, DM, MPR, DFF, DM, pg8::EpiBf16<1>{wsb(p, WS_HF), DFF, nullptr});
        skinny_gemm<SE_RELU2>(wsb(p, WS_XB) + (size_t)MPR * DM, DM, 0, wsb(p, WS_WFF1) + (size_t)I * DFF * DM, DM, DFF, DM, smf, lvb(), nvb, nullptr, wsb(p, WS_HF) + (size_t)MPR * DFF, DFF, nullptr); }
    SEAM(base + 7);
    if (IN(base + 8)) { CP p = PP(); run_gemm(L, wsb(p, WS_HF), DFF, 0, wsb(p, WS_WFF2) + (size_t)I * DM * DFF, DFF, MPR, DM, DFF, pg8::EpiResid{wsf(p, WS_X), DM, ALPHA});
        skinny_gemm<SE_RESID>(wsb(p, WS_HF) + (size_t)MPR * DFF, DFF, 0, wsb(p, WS_WFF2) + (size_t)I * DM * DFF, DFF, DM, DFF, smf, lvb(), nvb, wsf(p, WS_X) + (size_t)MPR * DM, nullptr, DM, nullptr); }
    SEAM(base + 8);
    if (IN(base + 9)) { CP p = PP(); ph_ln(p, p->ln2_g + (size_t)I * DM, p->ln2_b + (size_t)I * DM, I == 3, lvb(), nvb); }
    if (I < 3) { if (IN(base + 9) && base + PH_PER_LAYER < hi) xcd_barrier(bar); }
}

__global__ void __launch_bounds__(NWAVES * 64, 2) mk_fwd(P p_kernarg) {
    extern __shared__ __attribute__((aligned(16))) unsigned char lds[];
    LAS unsigned char* L = (LAS unsigned char*)lds;
    volatile LAS unsigned* MISC = (volatile LAS unsigned*)(L + MISC_OFF);
    const int nvb = gridDim.x;
    for (int u = threadIdx.x; u < (LDS_BYTES - LDSCTL_OFF) / 4; u += NWAVES * 64) ((LAS unsigned*)(L + LDSCTL_OFF))[u] = 0u;
    __syncthreads();
    unsigned* ctl = (unsigned*)(PP()->ws + WS_CTL);
    XcdBarrier bar = xcd_barrier_post(ctl + CW_BAR, MISC + 8);
    const int lo = PP()->ph_lo, hi = PP()->ph_hi;
    if (IN(0)) ph_prologue(PP(), lvb(), nvb, (float*)lds);
#ifdef DUP_PRO
    if (IN(0)) ph_prologue(PP(), lvb(), nvb, (float*)lds);
#endif
    SEAM(0);
    layer_phases<0>(L, lds, bar, lo, hi, nvb);
    layer_phases<1>(L, lds, bar, lo, hi, nvb);
    layer_phases<2>(L, lds, bar, lo, hi, nvb);
    layer_phases<3>(L, lds, bar, lo, hi, nvb);
}
#undef IN
#undef SEAM

#ifndef MK_PER_PHASE
#define MK_PER_PHASE 0
#endif
extern "C" void kernel_launch(void* const* d_in, const int* in_sizes, int n_in, void* d_out, int out_size, void* d_ws, size_t ws_size, hipStream_t stream) {
    if (n_in != 31 || (size_t)out_size != O_END || ws_size < WS_END) { fprintf(stderr, "kernel_launch: unexpected sizes n_in %d out %d ws %zu (need %zu)\n", n_in, out_size, ws_size, (size_t)WS_END); return; }
    static int grid = 0;
    if (grid == 0) {
        int dev = 0, cus = 0, per_cu = 0;
        if (hipGetDevice(&dev) != hipSuccess || hipDeviceGetAttribute(&cus, hipDeviceAttributeMultiprocessorCount, dev) != hipSuccess) { grid = -1; return; }
        if (hipFuncSetAttribute((const void*)mk_fwd, hipFuncAttributeMaxDynamicSharedMemorySize, LDS_BYTES) != hipSuccess) { fprintf(stderr, "kernel_launch: hipFuncSetAttribute failed\n"); grid = -1; return; }
        if (hipOccupancyMaxActiveBlocksPerMultiprocessor(&per_cu, (const void*)mk_fwd, NWAVES * 64, LDS_BYTES) != hipSuccess || per_cu < 1) fprintf(stderr, "kernel_launch: occupancy query says %d\n", per_cu);
        (void)hipGetLastError();
        grid = cus;
    }
    if (grid < 0) return;
    (void)hipMemsetAsync((char*)d_ws + WS_CTL, 0, CTL_ZERO_BYTES, stream);
    P p{};
    p.x_prompt = (const float*)d_in[0]; p.x_sample = (const float*)d_in[1]; p.cache_k = (const float*)d_in[2]; p.cache_v = (const float*)d_in[3]; p.cache_ik = (const float*)d_in[4];
    p.state_ssm = (const float*)d_in[5]; p.state_conv = (const float*)d_in[6]; p.state_pool = (const float*)d_in[7]; p.page_table = (const int*)d_in[8];
    p.ln1_g = (const float*)d_in[9]; p.ln1_b = (const float*)d_in[10]; p.ln2_g = (const float*)d_in[11]; p.ln2_b = (const float*)d_in[12];
    p.w_in_ab = (const float*)d_in[13]; p.conv_w = (const float*)d_in[14]; p.conv_b = (const float*)d_in[15]; p.dt_bias = (const float*)d_in[16]; p.a_log = (const float*)d_in[17];
    p.d_skip = (const float*)d_in[18]; p.ssd_g = (const float*)d_in[19]; p.w_out_ab = (const float*)d_in[20]; p.w_in_cd = (const float*)d_in[21]; p.pool_w = (const float*)d_in[22];
    p.pool_scale = (const float*)d_in[23]; p.sgu_ln_g = (const float*)d_in[24]; p.sgu_ln_b = (const float*)d_in[25]; p.sgu_w = (const float*)d_in[26]; p.sgu_b = (const float*)d_in[27];
    p.w_out_cd = (const float*)d_in[28]; p.w_ff1 = (const float*)d_in[29]; p.w_ff2 = (const float*)d_in[30];
    p.out = (float*)d_out; p.ws = (unsigned char*)d_ws;
#if MK_PER_PHASE
    for (int k = 0; k < N_PHASES; ++k) { const int r = (k - 1) % PH_PER_LAYER; if (k > 0 && (r > 9 || (((k - 1) / PH_PER_LAYER) & 1) && (r == 3 || r == 4))) continue; p.ph_lo = k; p.ph_hi = k + 1; hipLaunchKernelGGL(mk_fwd, dim3(grid), dim3(NWAVES * 64), LDS_BYTES, stream, p); }
#else
    p.ph_lo = 0; p.ph_hi = N_PHASES;
    hipLaunchKernelGGL(mk_fwd, dim3(grid), dim3(NWAVES * 64), LDS_BYTES, stream, p);
#endif
}
```
